# Optimizing an MI355X kernel written in HIP

```python
import math
import jax, jax.numpy as jnp
from jax import lax
import numpy as np


D_MODEL = 1024
BATCH = 16
SEQ = 2048
DEPTH = 1

CHUNK = 64
Q_BLOCK = 128
RMS_EPS = 1e-6
A_HEADS = 8
A_HEAD_DIM = 128
A_Q_RANK = 256
A_KV_RANK = 128
IDX_HEADS = 8
IDX_DIM = 64
TOPK_MAX = 256
T5_BUCKETS = 32
T5_MAX_DIST = 128
R_HEADS = 4
R_QK_DIM = 256
R_V_DIM = 512
ROPE_BASE = 10000.0
N_EXPERTS = 32
TOP_K = 4
D_FF = 1024
SWIGLU_LIMIT = 7.0
SWIGLU_ALPHA = 1.702
MOE_BLOCK = 256
IN_WIDTHS = (A_Q_RANK, A_KV_RANK, IDX_DIM, IDX_HEADS, R_HEADS * R_QK_DIM, R_HEADS * R_QK_DIM, R_HEADS * R_V_DIM, R_HEADS * R_V_DIM, D_MODEL, D_MODEL)
D_IN = sum(IN_WIDTHS)

kernel_name = 'hybrid_dsa_retention_moe_block'


def _rmsnorm(x, g):
    xf = x.astype(jnp.float32)
    y = xf * lax.rsqrt(jnp.mean(xf * xf, axis=-1, keepdims=True) + RMS_EPS)
    return (y * g.astype(jnp.float32)).astype(x.dtype)


def _head_norm(x):
    xf = x.astype(jnp.float32)
    return (xf * lax.rsqrt(jnp.mean(xf * xf, axis=-1, keepdims=True) + RMS_EPS)).astype(x.dtype)


def _t5_bucket(rel):
    nb = T5_BUCKETS // 2
    max_exact = nb // 2
    ret = jnp.where(rel > 0, nb, 0)
    n = jnp.abs(rel)
    nf = jnp.maximum(n, 1).astype(jnp.float32)
    large = max_exact + (jnp.log(nf / max_exact) / math.log(T5_MAX_DIST / max_exact) * (nb - max_exact)).astype(jnp.int32)
    large = jnp.minimum(large, nb - 1)
    return ret + jnp.where(n < max_exact, n, large)


def _rotary(x, pos):
    d = x.shape[-1]
    inv = ROPE_BASE ** (-jnp.arange(0, d, 2, dtype=jnp.float32) / d)
    ang = pos.astype(jnp.float32)[:, None] * inv[None, :]
    cos = jnp.cos(ang)[None, :, None, :]
    sin = jnp.sin(ang)[None, :, None, :]
    xf = x.astype(jnp.float32)
    x1, x2 = xf[..., : d // 2], xf[..., d // 2:]
    return jnp.concatenate([x1 * cos - x2 * sin, x2 * cos + x1 * sin], axis=-1).astype(x.dtype)


def _dsa_attention(q_idx, w_idx, q_lat, k_idx, c_kv, t5_bias, topk):
    B, S = q_idx.shape[:2]
    nb = S // Q_BLOCK

    def blocks(a):
        return a.reshape(B, nb, Q_BLOCK, *a.shape[2:]).swapaxes(0, 1)

    key_chunk = jnp.arange(S) // CHUNK
    scale = A_HEAD_DIM ** -0.5
    table = t5_bias.T.astype(jnp.float32)

    def one_block(args):
        blk, qi, wi, ql = args
        t = blk * Q_BLOCK + jnp.arange(Q_BLOCK)
        q_chunk = t // CHUNK
        adm = key_chunk[None, :] <= q_chunk[:, None]
        rel = jnp.einsum('bqhd,bsd->bqhs', qi, k_idx)
        score = jnp.einsum('bqhs,bqh->bqs', jax.nn.relu(rel), wi).astype(jnp.float32)
        score = jnp.where(adm[None], score, -jnp.inf)
        _, sel = lax.top_k(score, topk)
        valid = (sel // CHUNK) <= q_chunk[None, :, None]
        c_sel = jnp.take_along_axis(c_kv, sel.reshape(B, -1, 1), axis=1).reshape(B, Q_BLOCK, topk, -1)
        logits = jnp.einsum('bqhc,bqkc->bqkh', ql, c_sel).astype(jnp.float32) * scale
        logits = logits + table[_t5_bucket(sel - t[None, :, None])]
        logits = jnp.where(valid[..., None], logits, -jnp.inf)
        p = jax.nn.softmax(logits, axis=2).astype(c_kv.dtype)
        return jnp.einsum('bqkh,bqkc->bqhc', p, c_sel)

    out = lax.map(one_block, (jnp.arange(nb), blocks(q_idx), blocks(w_idx), blocks(q_lat)))
    return out.swapaxes(0, 1).reshape(B, S, A_HEADS, A_KV_RANK)


def _retention(q, k, v):
    B, S, H, dk = q.shape
    dv = v.shape[-1]
    dt = q.dtype
    nc = S // CHUNK
    log_g = jnp.log(1.0 - jnp.exp2(-5.0 - jnp.arange(H, dtype=jnp.float32)))
    i = jnp.arange(CHUNK, dtype=jnp.float32)
    diff = i[:, None] - i[None, :]
    dmask = jnp.where(diff[None] >= 0, jnp.exp(log_g[:, None, None] * jnp.maximum(diff, 0.0)[None]), 0.0).astype(dt)
    xi = jnp.exp(log_g[None, :] * (i[:, None] + 1.0)).astype(dt)
    zeta = jnp.exp(log_g[None, :] * (CHUNK - 1.0 - i[:, None])).astype(dt)
    chunk_decay = jnp.exp(log_g * CHUNK).astype(dt)

    def step(R, qkv):
        qc, kc, vc = qkv
        s = jnp.einsum('bqhd,bkhd->bhqk', qc, kc) * dmask
        inner = jnp.einsum('bhqk,bkhv->bqhv', s, vc)
        cross = jnp.einsum('bqhd,bhdv->bqhv', qc, R) * xi[:, :, None]
        R = R * chunk_decay[:, None, None] + jnp.einsum('bkhd,bkhv->bhdv', kc * zeta[:, :, None], vc)
        return R, inner + cross

    def chunks(a):
        return a.reshape(B, nc, CHUNK, H, a.shape[-1]).swapaxes(0, 1)

    R0 = jnp.zeros((B, H, dk, dv), dt)
    _, o = lax.scan(step, R0, (chunks(q), chunks(k), chunks(v)))
    return o.swapaxes(0, 1).reshape(B, S, H, dv)


def _moe(h, w_router, b_router, w_gate, b_gate, w_up, b_up, w_down, b_down):
    B, S, D = h.shape
    T = B * S
    ht = h.reshape(T, D)
    logits = (ht @ w_router).astype(jnp.float32) + b_router.astype(jnp.float32)
    top_val, top_idx = lax.top_k(logits, TOP_K)
    top_w = jax.nn.softmax(top_val, axis=-1).astype(h.dtype)
    A = T * TOP_K
    flat_e = top_idx.reshape(A)
    flat_tok = jnp.arange(A, dtype=jnp.int32) // TOP_K
    flat_w = top_w.reshape(A)
    order = jnp.argsort(flat_e)
    sorted_e = flat_e[order]
    counts = jnp.zeros((N_EXPERTS,), jnp.int32).at[flat_e].add(1)
    padded = (counts + MOE_BLOCK - 1) // MOE_BLOCK * MOE_BLOCK
    start = jnp.cumsum(counts) - counts
    pad_end = jnp.cumsum(padded)
    pad_start = pad_end - padded
    dest = pad_start[sorted_e] + jnp.arange(A, dtype=jnp.int32) - start[sorted_e]
    n_blocks = -(-A // MOE_BLOCK) + N_EXPERTS
    P = n_blocks * MOE_BLOCK
    buf_tok = jnp.zeros((P,), jnp.int32).at[dest].set(flat_tok[order])
    buf_w = jnp.zeros((P,), h.dtype).at[dest].set(flat_w[order])
    block_e = jnp.minimum(jnp.searchsorted(pad_end, jnp.arange(n_blocks, dtype=jnp.int32) * MOE_BLOCK, side='right'), N_EXPERTS - 1)

    def expert_block(args):
        e, tok = args
        xb = ht[tok]
        g = jnp.minimum(xb @ w_gate[e] + b_gate[e], SWIGLU_LIMIT)
        u = jnp.clip(xb @ w_up[e] + b_up[e], -SWIGLU_LIMIT, SWIGLU_LIMIT)
        a = g * jax.nn.sigmoid(SWIGLU_ALPHA * g) * (u + 1.0)
        return a @ w_down[e] + b_down[e]

    y_buf = lax.map(expert_block, (block_e, buf_tok.reshape(n_blocks, MOE_BLOCK))).reshape(P, D)
    y = jax.ops.segment_sum(y_buf * buf_w[:, None], buf_tok, num_segments=T)
    return y.reshape(B, S, D)


def setup_inputs(seed: int = 0) -> dict:
    key = jax.random.key(seed)
    ks = jax.random.split(key, 24)
    f32 = jnp.float32

    def nrm(k, shape, scale):
        return jax.random.normal(k, shape, f32) * scale

    def gain(k, shape):
        return 1.0 + 0.05 * jax.random.normal(k, shape, f32)

    L, D, E, F = DEPTH, D_MODEL, N_EXPERTS, D_FF
    return {
        'x': nrm(ks[0], (BATCH, SEQ, D), 1.0),
        'norm_mix_g': gain(ks[1], (L, D)),
        'w_in': nrm(ks[2], (L, D, D_IN), D ** -0.5),
        'cq_norm_g': gain(ks[3], (L, A_Q_RANK)),
        'ckv_norm_g': gain(ks[4], (L, A_KV_RANK)),
        'kidx_norm_g': gain(ks[5], (L, IDX_DIM)),
        'w_uq': nrm(ks[6], (L, A_Q_RANK, A_HEADS * A_HEAD_DIM), A_Q_RANK ** -0.5),
        'w_qidx': nrm(ks[7], (L, A_Q_RANK, IDX_HEADS * IDX_DIM), A_Q_RANK ** -0.5),
        'w_uk': nrm(ks[8], (L, A_HEADS, A_KV_RANK, A_HEAD_DIM), A_HEAD_DIM ** -0.5),
        'w_uv': nrm(ks[9], (L, A_HEADS, A_KV_RANK, A_HEAD_DIM), A_KV_RANK ** -0.5),
        't5_bias': nrm(ks[10], (A_HEADS, T5_BUCKETS), 0.5),
        'w_branch_a': nrm(ks[11], (L, A_HEADS * A_HEAD_DIM, D), (A_HEADS * A_HEAD_DIM) ** -0.5),
        'w_branch_b': nrm(ks[12], (L, R_HEADS * R_V_DIM, D), (R_HEADS * R_V_DIM) ** -0.5),
        'w_out': nrm(ks[13], (L, D, D), D ** -0.5),
        'norm_ffn_g': gain(ks[14], (L, D)),
        'w_router': nrm(ks[15], (L, D, E), D ** -0.5),
        'b_router': nrm(ks[16], (L, E), 0.01),
        'w_gate': nrm(ks[17], (L, E, D, F), D ** -0.5),
        'b_gate': nrm(ks[18], (L, E, F), 0.02),
        'w_up': nrm(ks[19], (L, E, D, F), D ** -0.5),
        'b_up': nrm(ks[20], (L, E, F), 0.02),
        'w_down': nrm(ks[21], (L, E, F, D), F ** -0.5),
        'b_down': nrm(ks[22], (L, E, D), 0.02),
        'norm_final_g': gain(ks[23], (D,)),
    }


def reference(x, norm_mix_g, w_in, cq_norm_g, ckv_norm_g, kidx_norm_g, w_uq, w_qidx, w_uk, w_uv, t5_bias, w_branch_a, w_branch_b, w_out, norm_ffn_g, w_router, b_router, w_gate, b_gate, w_up, b_up, w_down, b_down, norm_final_g):
    B, S, _ = x.shape
    pos = jnp.arange(S)
    topk = min(TOPK_MAX, S // 4)
    splits = np.cumsum(IN_WIDTHS)[:-1].tolist()
    for l in range(DEPTH):
        h = _rmsnorm(x, norm_mix_g[l])
        c_q, c_kv, k_idx, w_idx, rq, rk, rv, rg, ga, gb = jnp.split(h @ w_in[l], splits, axis=-1)
        c_q = _rmsnorm(c_q, cq_norm_g[l])
        c_kv = _rmsnorm(c_kv, ckv_norm_g[l])
        k_idx = _rmsnorm(k_idx, kidx_norm_g[l])
        q_a = (c_q @ w_uq[l]).reshape(B, S, A_HEADS, A_HEAD_DIM)
        q_lat = jnp.einsum('bshd,hcd->bshc', q_a, w_uk[l])
        q_idx = (c_q @ w_qidx[l]).reshape(B, S, IDX_HEADS, IDX_DIM) * (IDX_DIM ** -0.5)
        w_idx = w_idx * (IDX_HEADS ** -0.5)
        o_lat = _dsa_attention(q_idx, w_idx, q_lat, k_idx, c_kv, t5_bias, topk)
        o_a = jnp.einsum('bshc,hcd->bshd', o_lat, w_uv[l]).reshape(B, S, A_HEADS * A_HEAD_DIM)
        rq = _rotary(rq.reshape(B, S, R_HEADS, R_QK_DIM), pos)
        rk = _rotary(rk.reshape(B, S, R_HEADS, R_QK_DIM), pos) * (R_QK_DIM ** -0.5)
        o_b = _head_norm(_retention(rq, rk, rv.reshape(B, S, R_HEADS, R_V_DIM)))
        o_b = jax.nn.silu(rg) * o_b.reshape(B, S, R_HEADS * R_V_DIM)
        mix = jax.nn.sigmoid(ga) * (o_a @ w_branch_a[l]) + jax.nn.sigmoid(gb) * (o_b @ w_branch_b[l])
        x = x + mix @ w_out[l]
        x = x + _moe(_rmsnorm(x, norm_ffn_g[l]), w_router[l], b_router[l], w_gate[l], b_gate[l], w_up[l], b_up[l], w_down[l], b_down[l])
    return _rmsnorm(x, norm_final_g)
```

```cpp
#include <hip/hip_runtime.h>
#include <cstdio>
#include <cstdint>

#define LAS __attribute__((address_space(3)))
#define GAS __attribute__((address_space(1)))
typedef unsigned short bf16_t;
typedef short bf16x8 __attribute__((ext_vector_type(8)));
typedef short s16x4 __attribute__((ext_vector_type(4)));
typedef float f32x4 __attribute__((ext_vector_type(4)));
typedef float f32x2 __attribute__((ext_vector_type(2)));
typedef float f32x16 __attribute__((ext_vector_type(16)));
typedef unsigned u32x4 __attribute__((ext_vector_type(4)));
typedef unsigned u32x2 __attribute__((ext_vector_type(2)));
typedef int i32x4 __attribute__((ext_vector_type(4)));
typedef int i32x8 __attribute__((ext_vector_type(8)));

constexpr int NB = 16, SEQ = 2048, T = NB * SEQ, D = 1024;
constexpr int NE = 32, FF = 1024, TOPK_E = 4;
constexpr int HALF_T = T;
constexpr int LIST_CAP = HALF_T;
constexpr int PAD_ROWS = HALF_T * TOPK_E + NE * 256;
constexpr float RMS_EPS = 1e-6f;

constexpr size_t MiB = 1u << 20;
constexpr size_t WS_CTL = 0, CTL_BYTES = 1 * MiB;
constexpr size_t WS_MISC = 5 * MiB;
constexpr size_t MISC_RW_HI = 0, MISC_RW_LO = 65536, MISC_RSTD2 = 131072, MISC_RSTD1 = 262144;
constexpr bool MOE_FP8 = true;
constexpr float W8_SCALE = 32.f, W8_INV = 1.f / 32.f;
constexpr bool X2H = true;
constexpr bool ROWNORM_FUSED = true;
constexpr bool GA8 = true;
constexpr bool MIXA_FP8 = true;
constexpr bool Y_FP8 = true;
constexpr bool INB_FP8 = true;
constexpr bool INC_FP8 = true;
constexpr size_t WS_REC = 6 * MiB, WS_LTOK = 8 * MiB, WS_LRS = 12 * MiB, WS_WD = 48 * MiB, WS_X2B = 96 * MiB, WS_WGU = 144 * MiB, WS_ACT = 208 * MiB, WS_Y = 344 * MiB, WS_X2H = 480 * MiB, WS_END = 552 * MiB;
static_assert(MOE_FP8 && WS_ACT + (size_t)PAD_ROWS * FF <= WS_Y && WS_Y + (size_t)PAD_ROWS * D * (Y_FP8 ? 1 : 2) <= WS_END, "ws map (single-pass MoE needs the fp8 sizes)");
constexpr size_t WS_COSP = 1 * MiB, WS_SINP = 2 * MiB, WS_COST = 3 * MiB, WS_SINT = 4 * MiB;
constexpr size_t MISC_DQ = 393216, MISC_DK = 394240, MISC_DZ = 395264, MISC_RN = 524288;
constexpr size_t WS_WIN = 6 * MiB, WS_XB = 32 * MiB, WS_SMALL = 96 * MiB, WS_QX = 160 * MiB, WS_KP = 224 * MiB, WS_KZT = 288 * MiB, WS_VT = 352 * MiB;
constexpr size_t WS_CKV = 480 * MiB, WS_KIDX = 488 * MiB, WS_WIDX = 492 * MiB, WS_CQN = 493 * MiB, WS_QIDX = 509 * MiB, WS_MASK = 541 * MiB;
constexpr size_t WS_WQ = 552 * MiB, WS_WA = 553 * MiB, WS_WB = 555 * MiB, WS_WOUT = 559 * MiB, WS_END2 = 561 * MiB;
constexpr size_t WS_XB8 = 224 * MiB, WS_WIN8 = 256 * MiB;
constexpr size_t WS_GA = WS_QX, WS_GB = INC_FP8 ? WS_VT : WS_KP,        WS_MIXA = WS_KZT, WS_MIX = WS_VT, WS_QLAT = WS_SMALL, WS_OLAT = WS_VT + 64 * MiB;
constexpr int NIN = 8704;
constexpr int CW_BAR = 1024;
constexpr int CW_CNT = 8192;

__device__ __forceinline__ unsigned f2bf(float f) { unsigned u = __builtin_bit_cast(unsigned, f); return (u + 0x7fffu + ((u >> 16) & 1u)) >> 16; }
__device__ __forceinline__ unsigned pk2(float lo, float hi) { return f2bf(lo) | (f2bf(hi) << 16); }
__device__ __forceinline__ float bf2f(unsigned b) { return __builtin_bit_cast(float, b << 16); }
typedef __bf16 bf16v2_t __attribute__((ext_vector_type(2)));
__device__ __forceinline__ unsigned cvt_pk_bf16(float lo, float hi) { f32x2 v = {lo, hi}; bf16v2_t r = __builtin_convertvector(v, bf16v2_t); return __builtin_bit_cast(unsigned, r); }
__device__ __forceinline__ float wave_sum(float v) {
#pragma unroll
    for (int o = 1; o < 64; o <<= 1) v += __shfl_xor(v, o);
    return v;
}
__device__ __forceinline__ void ld4u(const void* p, unsigned (&w)[4]) { const f32x4 t = *(const f32x4*)p; const float t0 = t[0], t1 = t[1], t2 = t[2], t3 = t[3];
    w[0] = __builtin_bit_cast(unsigned, t0); w[1] = __builtin_bit_cast(unsigned, t1); w[2] = __builtin_bit_cast(unsigned, t2); w[3] = __builtin_bit_cast(unsigned, t3); }
__device__ __forceinline__ unsigned pk4_fp8(float a, float b, float c, float d) { unsigned w = 0u; w = __builtin_amdgcn_cvt_pk_fp8_f32(a, b, w, false); w = __builtin_amdgcn_cvt_pk_fp8_f32(c, d, w, true); return w; }
#define LDS_WAIT() asm volatile("s_waitcnt lgkmcnt(0)" ::: "memory")
#define VM_WAIT() asm volatile("s_waitcnt vmcnt(0)" ::: "memory")

#define XB_TMO      128
#define XB_XCNT(j)  (256  + 64 * (j))
#define XB_XSUB(j)  (1280 + 64 * (j))
#define XB_XGEN(j)  (2304 + 64 * (j))
#define XB_TOP      3328
#define XB_TOPGEN   3392
#define XCD_BAR_WORDS 3456
#define XB_SPIN_CAP (1u << 22)
__device__ __forceinline__ unsigned xb_ld(unsigned* p)              { return __hip_atomic_load(p, __ATOMIC_RELAXED, __HIP_MEMORY_SCOPE_AGENT); }
__device__ __forceinline__ unsigned xb_add(unsigned* p, unsigned v) { return __hip_atomic_fetch_add(p, v, __ATOMIC_RELAXED, __HIP_MEMORY_SCOPE_AGENT); }
__device__ __forceinline__ unsigned xb_xcc_id() { return (unsigned)__builtin_amdgcn_s_getreg((3 << 11) | 20) & 0xFu; }
#define XB_SPIN(cond, bar) do { unsigned _sp = 0; while (cond) { __builtin_amdgcn_s_sleep(1); \
    if ((++_sp & 255u) == 0u) { if (xb_ld(&(bar)[XB_TMO])) break; if (_sp > XB_SPIN_CAP) { atomicAdd(&(bar)[XB_TMO], 1u); break; } } } } while (0)
struct XcdBarrier { unsigned* bar; unsigned x; volatile LAS unsigned* st; };
__device__ __forceinline__ XcdBarrier xcd_barrier_post(unsigned* bar, volatile LAS unsigned* st) {
    XcdBarrier b; b.bar = bar; b.x = xb_xcc_id(); b.st = st;
    if (threadIdx.x == 0) (void)xb_add(&bar[XB_XCNT(b.x)], 1u);
    return b;
}
__device__ __forceinline__ void xcd_barrier_complete(unsigned* bar, unsigned x, unsigned& nloc, unsigned& nx) {
    const unsigned G = gridDim.x * gridDim.y * gridDim.z;
    unsigned sum, cnt, mine, sp = 0u;
    for (;;) {
        sum = 0u; cnt = 0u; mine = 0u;
#pragma unroll
        for (unsigned j = 0; j < 16; ++j) { const unsigned c = xb_ld(&bar[XB_XCNT(j)]); sum += c; cnt += (c > 0u) ? 1u : 0u; mine = (j == x) ? c : mine; }
        if (sum == G) break;
        __builtin_amdgcn_s_sleep(1);
        if ((++sp & 255u) == 0u) { if (xb_ld(&bar[XB_TMO])) break; if (sp > XB_SPIN_CAP) { atomicAdd(&bar[XB_TMO], 1u); break; } }
    }
    nloc = mine > 0u ? mine : 1u; nx = cnt > 0u ? cnt : 1u;
}
__device__ __forceinline__ void xcd_barrier(const XcdBarrier& b) {
    asm volatile("s_waitcnt vmcnt(0)" ::: "memory");
    __syncthreads();
    if (threadIdx.x == 0) {
        unsigned* bar = b.bar;
        __builtin_amdgcn_s_waitcnt(0);
        unsigned nloc = b.st[0], nx = b.st[1];
        if (nloc == 0u) { xcd_barrier_complete(bar, b.x, nloc, nx); b.st[0] = nloc; b.st[1] = nx; }
        const unsigned old = xb_add(&bar[XB_XSUB(b.x)], 1u);
        const unsigned gen = old / nloc;
        if (old + 1u == (gen + 1u) * nloc) {
            __builtin_amdgcn_fence(__ATOMIC_RELEASE, "agent");
            asm volatile("s_waitcnt vmcnt(0)" ::: "memory");
            const unsigned og = xb_add(&bar[XB_TOP], 1u);
            const unsigned tg = og / nx;
            if (og + 1u == (tg + 1u) * nx) xb_add(&bar[XB_TOPGEN], 1u);
            else XB_SPIN(xb_ld(&bar[XB_TOPGEN]) == tg, bar);
            __builtin_amdgcn_fence(__ATOMIC_ACQUIRE, "agent");
            xb_add(&bar[XB_XGEN(b.x)], 1u);
            asm volatile("s_waitcnt vmcnt(0)" ::: "memory");
        } else {
            XB_SPIN(xb_ld(&bar[XB_XGEN(b.x)]) == gen, bar);
            __builtin_amdgcn_fence(__ATOMIC_ACQUIRE, "agent");
            asm volatile("s_waitcnt vmcnt(0)" ::: "memory");
        }
    }
    __syncthreads();
#ifdef ALLWAVE_INV
    __builtin_amdgcn_fence(__ATOMIC_ACQUIRE, "agent"); asm volatile("s_waitcnt vmcnt(0)" ::: "memory");
#endif
}

namespace pg8 {
constexpr int BM = 256, BK = 64, HALF = 128, HTB = HALF * BK * 2, STAGE_BYTES = 8 * HTB;
__host__ __device__ __forceinline__ int lds_byte(int r, int c) { const int st = (r >> 4) * 2 + (c >> 5), rr = r & 15, cc = c & 31, ob = rr * 64 + cc * 2; return st * 1024 + (ob ^ (((ob >> 9) & 1) << 5)); }
__host__ __device__ __forceinline__ void stage_rc(int b, int& R, int& C) { const int st = b / 1024, sb = b % 1024, swz = sb ^ (((sb >> 9) & 1) << 5); R = (st >> 1) * 16 + swz / 64; C = (st & 1) * 32 + (swz % 64) / 2; }
__host__ __device__ __forceinline__ int perm32(int rho) { const int n = rho >> 4, i = rho & 15; return 8 * (i >> 2) + 4 * n + (i & 3); }

struct Unit { int pm, pn, e, j; };

#define PG8_SA(b, h) (((b) * 2 + (h)) * HTB)
#define PG8_SB(b, h) ((4 + (b) * 2 + (h)) * HTB)
#define PG8_STAGE(bufoff, rsrc, soff, voff) do { _Pragma("unroll") for (int _i = 0; _i < 2; ++_i) \
        __builtin_amdgcn_raw_ptr_buffer_load_lds(rsrc, (LAS void*)(lds + (bufoff) + ldsw + _i * 8192), 16, (int)(voff)[_i], (int)(soff), 0, 0); } while (0)
#define PG8_LDA(dst, b, h) do { _Pragma("unroll") for (int m = 0; m < 4; ++m) _Pragma("unroll") for (int k = 0; k < 2; ++k) dst[m][k] = *(const LAS bf16x8*)(lds + PG8_SA(b, h) + aoff + m * 2048 + k * 1024); } while (0)
#define PG8_LDB(dst, b, h) do { _Pragma("unroll") for (int n = 0; n < 2; ++n) _Pragma("unroll") for (int k = 0; k < 2; ++k) dst[n][k] = *(const LAS bf16x8*)(lds + PG8_SB(b, h) + boff + n * 2048 + k * 1024); } while (0)
#define PG8_CAT(x) __builtin_shufflevector(__builtin_bit_cast(i32x4, (x)[0]), __builtin_bit_cast(i32x4, (x)[1]), 0, 1, 2, 3, 4, 5, 6, 7)
#define PG8_MMA(ai, bj, At, Bt) do { __builtin_amdgcn_s_setprio(1); if constexpr (F8) { asm volatile("s_nop 1"); _Pragma("unroll") for (int m = 0; m < 4; ++m) _Pragma("unroll") for (int n = 0; n < 2; ++n) { \
        const i32x8 _b8 = PG8_CAT(Bt[n]), _a8 = PG8_CAT(At[m]); if constexpr (SWAP) asm volatile("v_mfma_f32_16x16x128_f8f6f4 %0, %1, %2, %0" : "+v"(acc[ai][bj][m][n]) : "v"(_a8), "v"(_b8)); \
        else asm volatile("v_mfma_f32_16x16x128_f8f6f4 %0, %1, %2, %0" : "+v"(acc[ai][bj][m][n]) : "v"(_b8), "v"(_a8)); } } else { \
        _Pragma("unroll") for (int m = 0; m < 4; ++m) _Pragma("unroll") for (int n = 0; n < 2; ++n) _Pragma("unroll") for (int k = 0; k < 2; ++k) \
        acc[ai][bj][m][n] = SWAP ? __builtin_amdgcn_mfma_f32_16x16x32_bf16(At[m][k], Bt[n][k], acc[ai][bj][m][n], 0, 0, 0) : __builtin_amdgcn_mfma_f32_16x16x32_bf16(Bt[n][k], At[m][k], acc[ai][bj][m][n], 0, 0, 0); } __builtin_amdgcn_s_setprio(0); } while (0)
#define PG8_ACC_SETTLE() do { _Pragma("unroll") for (int _a = 0; _a < 2; ++_a) _Pragma("unroll") for (int _b = 0; _b < 2; ++_b) \
        asm volatile("s_nop 15\n\ts_nop 7" : "+v"(acc[_a][_b][0][0]), "+v"(acc[_a][_b][0][1]), "+v"(acc[_a][_b][1][0]), "+v"(acc[_a][_b][1][1]), "+v"(acc[_a][_b][2][0]), "+v"(acc[_a][_b][2][1]), "+v"(acc[_a][_b][3][0]), "+v"(acc[_a][_b][3][1])); } while (0)
#define PG8_WAIT_V(n) asm volatile("s_waitcnt vmcnt(" #n ")" ::: "memory")
#define PG8_WAIT_L(n) asm volatile("s_waitcnt lgkmcnt(" #n ")" ::: "memory")
#define PG8_BAR __builtin_amdgcn_s_barrier()
#define PG8_SCHED __builtin_amdgcn_sched_barrier(0)
#define PG8_TRIP(a1, a2, a3, V1h1, V2h0, V2h1, b2, b3) do { \
            PG8_LDB(B0, 0, 0); PG8_SCHED; PG8_LDA(At, 0, 0); PG8_STAGE(PG8_SA(1, 1), rA, (a1) + ahstep, V1h1); \
            PG8_WAIT_L(8); PG8_BAR; PG8_WAIT_L(0); PG8_MMA(0, 0, At, B0); PG8_BAR; PG8_SCHED; \
            PG8_LDB(B1, 0, 1); PG8_STAGE(PG8_SB(0, 0), rB, b2, voffB); \
            PG8_BAR; PG8_WAIT_L(0); PG8_MMA(0, 1, At, B1); PG8_BAR; \
            PG8_LDA(At, 0, 1); PG8_STAGE(PG8_SA(0, 0), rA, a2, V2h0); \
            PG8_BAR; PG8_WAIT_L(0); PG8_MMA(1, 0, At, B0); PG8_BAR; PG8_SCHED; \
            PG8_STAGE(PG8_SB(0, 1), rB, (b2) + hstep, voffB); \
            PG8_WAIT_V(6); PG8_BAR; PG8_MMA(1, 1, At, B1); PG8_BAR; \
            PG8_LDB(B0, 1, 0); PG8_SCHED; PG8_LDA(At, 1, 0); PG8_STAGE(PG8_SA(0, 1), rA, (a2) + ahstep, V2h1); \
            PG8_WAIT_L(8); PG8_BAR; PG8_WAIT_L(0); PG8_MMA(0, 0, At, B0); PG8_BAR; PG8_SCHED; \
            PG8_LDB(B1, 1, 1); PG8_STAGE(PG8_SB(1, 0), rB, b3, voffB); \
            PG8_BAR; PG8_WAIT_L(0); PG8_MMA(0, 1, At, B1); PG8_BAR; \
            PG8_LDA(At, 1, 1); PG8_STAGE(PG8_SA(1, 0), rA, a3, V2h0); \
            PG8_BAR; PG8_WAIT_L(0); PG8_MMA(1, 0, At, B0); PG8_BAR; PG8_SCHED; \
            PG8_STAGE(PG8_SB(1, 1), rB, (b3) + hstep, voffB); \
            PG8_WAIT_V(6); PG8_BAR; PG8_MMA(1, 1, At, B1); PG8_BAR; } while (0)
template <class Epi, class Sched, bool SWAP, bool GATHER, int K, bool F8 = false>
__device__ __forceinline__ void gemm_phase(LAS unsigned char* lds, const int tid, const bf16_t* Abase, const bf16_t* Bbase, const Sched& S, const Epi& E, LAS u32x4* gslots = nullptr) {
    static_assert(!(SWAP && Epi::PERM), "SWAP needs natural B row order");
    const int wid = __builtin_amdgcn_readfirstlane(tid >> 6), lane = tid & 63, wr = wid >> 2, wc = wid & 3, fr = lane & 15, fq = lane >> 4;
    constexpr int nt = K / BK;
    const unsigned long long pa_ = (unsigned long long)Abase, pb_ = (unsigned long long)Bbase;
    const unsigned long long ua_ = ((unsigned long long)(unsigned)__builtin_amdgcn_readfirstlane((int)(pa_ >> 32)) << 32) | (unsigned)__builtin_amdgcn_readfirstlane((int)pa_);
    const unsigned long long ub_ = ((unsigned long long)(unsigned)__builtin_amdgcn_readfirstlane((int)(pb_ >> 32)) << 32) | (unsigned)__builtin_amdgcn_readfirstlane((int)pb_);
    const __amdgpu_buffer_rsrc_t rA = __builtin_amdgcn_make_buffer_rsrc((void*)ua_, 0, 0x7ffffffc, 0x00020000);
    const __amdgpu_buffer_rsrc_t rB = __builtin_amdgcn_make_buffer_rsrc((void*)ub_, 0, 0x7ffffffc, 0x00020000);
    unsigned voffB[2], vA0[2], vA1[2];
#pragma unroll
    for (int i = 0; i < 2; ++i) { int R, C; stage_rc(tid * 16 + i * 8192, R, C); const int Rb = Epi::PERM ? ((R & ~31) + perm32(R & 31)) : R;
        const int Ra = SWAP ? ((R & ~63) | (16 * ((R >> 2) & 3) + 4 * ((R >> 4) & 3) + (R & 3))) : R;
        voffB[i] = (unsigned)(Rb * K + C) * 2u; vA0[i] = (unsigned)(Ra * K + C) * 2u; vA1[i] = vA0[i]; }
    constexpr unsigned kstep = (unsigned)(BK * 2);
    constexpr unsigned hstep = (unsigned)HALF * K * 2;
    constexpr unsigned ahstep = GATHER ? 0u : hstep;
    const unsigned ldsw = (unsigned)wid * 1024u;
    const int aoff = lds_byte(wr * 64 + fr, fq * 8), boff = lds_byte(wc * 32 + fr, fq * 8);
#define PG8_ROWS(d0, d1, u) do { int _t = tid; asm volatile("" : "+v"(_t)); _Pragma("unroll") for (int _i = 0; _i < 2; ++_i) { int _R, _C; stage_rc(_t * 16 + _i * 8192, _R, _C); \
        const int _nr = S.nrows(u); int _x0 = _R < _nr ? _R : _nr - 1, _x1 = (_R + HALF) < _nr ? (_R + HALF) : _nr - 1; const int* _l = S.rows + S.lo(u); \
        d0[_i] = (unsigned)(_l[_x0] * K + _C) * 2u; d1[_i] = (unsigned)(_l[_x1] * K + _C) * 2u; } } while (0)
    Unit cur, nxt; int ui = 0;
    if (!S.next(0, cur)) return;
    f32x4 acc[2][2][4][2];
#pragma unroll
    for (int a = 0; a < 2; ++a)
#pragma unroll
        for (int b = 0; b < 2; ++b)
#pragma unroll
            for (int m = 0; m < 4; ++m)
#pragma unroll
                for (int n = 0; n < 2; ++n) acc[a][b][m][n] = (f32x4){0.f, 0.f, 0.f, 0.f};
    bf16x8 At[4][2], B0[2][2], B1[2][2];
    unsigned cA = S.aoff(cur), cB = S.boff(cur);
    if constexpr (GATHER) { PG8_ROWS(vA0, vA1, cur); gslots[tid] = (u32x4){vA0[0], vA0[1], vA1[0], vA1[1]}; }
    PG8_STAGE(PG8_SB(0, 0), rB, cB, voffB); PG8_STAGE(PG8_SA(0, 0), rA, cA, vA0); PG8_STAGE(PG8_SB(0, 1), rB, cB + hstep, voffB); PG8_STAGE(PG8_SA(0, 1), rA, cA + ahstep, vA1);
    if (wr == 1) PG8_BAR;
    PG8_WAIT_V(4); PG8_BAR;
    PG8_STAGE(PG8_SB(1, 0), rB, cB + kstep, voffB); PG8_STAGE(PG8_SA(1, 0), rA, cA + kstep, vA0); PG8_STAGE(PG8_SB(1, 1), rB, cB + hstep + kstep, voffB);
    PG8_WAIT_V(6); PG8_BAR;
    for (;;) {
        const bool has_next = S.next(ui + 1, nxt);
        const unsigned nA = has_next ? S.aoff(nxt) : cA, nB = has_next ? S.boff(nxt) : cB;
        int nrow0[2] = {0, 0}, nrow1[2] = {0, 0};
        if constexpr (GATHER) { if (has_next) { int _t = tid; asm volatile("" : "+v"(_t)); _Pragma("unroll") for (int _i = 0; _i < 2; ++_i) { int _R, _C; stage_rc(_t * 16 + _i * 8192, _R, _C);
            const int _nr = S.nrows(nxt); const int _x0 = _R < _nr ? _R : _nr - 1, _x1 = (_R + HALF) < _nr ? (_R + HALF) : _nr - 1; const int* _l = S.rows + S.lo(nxt); nrow0[_i] = _l[_x0]; nrow1[_i] = _l[_x1]; } } }
#pragma unroll 1
        for (int t = 0; t < nt; t += 2) {
            const bool last = (t == nt - 2);
            const unsigned a1 = cA + (unsigned)(t + 1) * kstep;
            const unsigned a2 = last ? nA : cA + (unsigned)(t + 2) * kstep, b2 = last ? nB : cB + (unsigned)(t + 2) * kstep;
            if constexpr (!GATHER) {
                PG8_TRIP(a1, a2, a2 + kstep, vA0, vA0, vA0, b2, b2 + kstep);
            } else {
                const int par = ui & 1;
                if (last && has_next) { unsigned n0[2], n1[2]; int _t = tid; asm volatile("" : "+v"(_t));
                    _Pragma("unroll") for (int _i = 0; _i < 2; ++_i) { int _R, _C; stage_rc(_t * 16 + _i * 8192, _R, _C); n0[_i] = (unsigned)(nrow0[_i] * K + _C) * 2u; n1[_i] = (unsigned)(nrow1[_i] * K + _C) * 2u; }
                    gslots[(par ^ 1) * 512 + tid] = (u32x4){n0[0], n0[1], n1[0], n1[1]}; }
                const u32x4 vc = gslots[par * 512 + tid], vn = gslots[((last && has_next) ? (par ^ 1) : par) * 512 + tid];
                const unsigned c1[2] = {vc.z, vc.w}, n0[2] = {vn.x, vn.y}, n1[2] = {vn.z, vn.w};
                PG8_TRIP(a1, a2, a2 + kstep, c1, n0, n1, b2, b2 + kstep);
            }
        }
        if constexpr (F8) PG8_ACC_SETTLE();
        E(acc, cur, wr, wc, fr, fq);
        if (!has_next) break;
#pragma unroll
        for (int a = 0; a < 2; ++a)
#pragma unroll
            for (int b = 0; b < 2; ++b)
#pragma unroll
                for (int m = 0; m < 4; ++m)
#pragma unroll
                    for (int n = 0; n < 2; ++n) acc[a][b][m][n] = (f32x4){0.f, 0.f, 0.f, 0.f};
        cur = nxt; cA = nA; cB = nB; ++ui;
    }
    PG8_WAIT_V(0);
    if (wr == 0) PG8_BAR;
    PG8_BAR;
#undef PG8_ROWS
}
}

struct Args { const float* in[24]; float* out; unsigned char* ws; long long pass; };
enum { I_X = 0, I_NORM_MIX_G, I_W_IN, I_CQ_G, I_CKV_G, I_KIDX_G, I_W_UQ, I_W_QIDX, I_W_UK, I_W_UV, I_T5, I_W_BA, I_W_BB, I_W_OUT, I_NORM_FFN_G, I_W_ROUTER, I_B_ROUTER,
       I_W_GATE, I_B_GATE, I_W_UP, I_B_UP, I_W_DOWN, I_B_DOWN, I_NORM_FINAL_G };

constexpr int LDS_STAGE = 0, LDS_MISC = 131072, LDS_BYTES = 163840;
constexpr int LM_BAR = 0;
constexpr int LM_TEND = 64;
constexpr int LM_CNT = 192;
constexpr int LM_PSTART = 320;
constexpr int LM_LCNT = 448;
constexpr int LM_GBASE = 576;
constexpr int LM_REC = 1024;
constexpr int LM_SCR = 9216;
constexpr int LM_SLOTS = 1024;
constexpr int LM_TILE = 27648;

struct Frame { LAS unsigned char* lds; LAS unsigned char* misc; int tid, lane, wave, G, bid; };
#define GAS __attribute__((address_space(1)))
typedef const __attribute__((address_space(4))) Args CArgs;
typedef CArgs& ArgsRef;
#define WS(a) ((unsigned char*)(GAS unsigned char*)(a).ws)
#define OUT(a) ((float*)(GAS float*)(a).out)
#define IN(a, i) ((const float*)(GAS const float*)(a).in[i])
__device__ __forceinline__ ArgsRef phase_args() { CArgs* ap = (CArgs*)__builtin_amdgcn_kernarg_segment_ptr(); asm volatile("" : "+s"(ap)); return *ap; }
__device__ __forceinline__ Frame make_frame(unsigned char* lds_raw) {
    Frame F; int tid = threadIdx.x; asm volatile("" : "+v"(tid)); int bid = blockIdx.x; asm volatile("" : "+s"(bid)); int G = gridDim.x; asm volatile("" : "+s"(G));
    F.lds = (LAS unsigned char*)lds_raw; F.misc = F.lds + LDS_MISC; F.tid = tid; F.lane = tid & 63; F.wave = __builtin_amdgcn_readfirstlane(tid >> 6); F.G = G; F.bid = bid; return F;
}

struct DenseOrder {
    int nM, nN, nwg, G, c, K; size_t a0, b0;
    __device__ __forceinline__ void init(int M, int N, int K_, int G_, int c_, size_t a0_ = 0, size_t b0_ = 0) { nM = M / 256; nN = N / 256; nwg = nM * nN; G = G_; c = c_; K = K_; a0 = a0_; b0 = b0_; }
    __device__ __forceinline__ bool next(int i, pg8::Unit& u) const {
        const long L = (long)i * G + c; if (L >= nwg) return false;
        int wgid = (int)L; { const int q = nwg / 8, r = nwg % 8, xcd = wgid % 8, off = wgid / 8; wgid = (xcd < r ? xcd * (q + 1) : r * (q + 1) + (xcd - r) * q) + off; }
        const int nig = 8 * nN, gid = wgid / nig, fm = gid * 8, gsz = (nM - fm) < 8 ? (nM - fm) : 8;
        u.pm = fm + ((wgid % nig) % gsz); u.pn = (wgid % nig) / gsz; u.e = 0; u.j = 0; return true;
    }
    __device__ __forceinline__ unsigned aoff(const pg8::Unit& u) const { return (unsigned)(a0 + (size_t)u.pm * 256 * K * 2); }
    __device__ __forceinline__ unsigned boff(const pg8::Unit& u) const { return (unsigned)(b0 + (size_t)u.pn * 256 * K * 2); }
};
template <int NPN, bool GATHER, int ROWB = 2048> struct MoeOrder {
    const LAS int* tile_e; const LAS int* cnt; const int* rows; int ntiles, G, c;
    __device__ __forceinline__ bool next(int i, pg8::Unit& u) const {
        int pm, pn;
        if (G == 256) {
            constexpr int PMG = 32 / NPN; const int xcd = c & 7, slot = c >> 3;
            pm = (i * 8 + xcd) * PMG + slot / NPN; pn = slot % NPN; if (pm >= ntiles) return false; }
        else { const int L = i * G + c; if (L >= ntiles * NPN) return false; pm = L / NPN; pn = L % NPN; }
        const int ej = __builtin_amdgcn_readfirstlane(tile_e[pm]);
        u.pm = pm; u.pn = pn; u.e = ej >> 16; u.j = ej & 0xffff; return true;
    }
    __device__ __forceinline__ int nrows(const pg8::Unit& u) const { int nr = __builtin_amdgcn_readfirstlane(cnt[u.e]) - 256 * u.j; return nr > 256 ? 256 : nr; }
    __device__ __forceinline__ int lo(const pg8::Unit& u) const { return u.e * LIST_CAP + 256 * u.j; }
    __device__ __forceinline__ unsigned aoff(const pg8::Unit& u) const { return GATHER ? 0u : (unsigned)u.pm * 256u * (unsigned)ROWB; }
    __device__ __forceinline__ unsigned boff(const pg8::Unit& u) const { return (unsigned)(u.e * NPN + u.pn) * 256u * (unsigned)ROWB; }
};

struct EpiGateUp { static constexpr bool PERM = true;
    bf16_t* act; const float* bgate; const float* bup; const float* lrs; const LAS int* cnt;
    __device__ __forceinline__ void operator()(const f32x4 (&acc)[2][2][4][2], const pg8::Unit& u, int wr, int wc, int fr, int fq) const {
        const int f0 = 128 * u.pn + 32 * wc + 8 * fq; const float* rsl = lrs + u.e * LIST_CAP + 256 * u.j; const int nrows = cnt[u.e] - 256 * u.j;
        f32x4 bg[2], bu[2]; float rsv[2][4];
#pragma unroll
        for (int n = 0; n < 2; ++n) { bg[n] = *(const f32x4*)(bgate + u.e * FF + f0 + 4 * n); bu[n] = *(const f32x4*)(bup + u.e * FF + f0 + 4 * n); }
#pragma unroll
        for (int ai = 0; ai < 2; ++ai)
#pragma unroll
            for (int m = 0; m < 4; ++m) rsv[ai][m] = rsl[128 * ai + 64 * wr + 16 * m + fr];
#pragma unroll
        for (int ai = 0; ai < 2; ++ai)
#pragma unroll
            for (int m = 0; m < 4; ++m) { const int r = 128 * ai + 64 * wr + 16 * m + fr; const float rs = r < nrows ? rsv[ai][m] * (MOE_FP8 ? W8_INV : 1.f) : 0.f;
                float a[8];
#pragma unroll
                for (int n = 0; n < 2; ++n)
#pragma unroll
                    for (int i = 0; i < 4; ++i) { float g = acc[ai][0][m][n][i] * rs + bg[n][i], up = acc[ai][1][m][n][i] * rs + bu[n][i];
                        g = fminf(g, 7.f); up = fminf(fmaxf(up, -7.f), 7.f);
                        const float sg = __builtin_amdgcn_rcpf(1.f + __builtin_amdgcn_exp2f(-1.702f * 1.4426950408889634f * g));
                        a[4 * n + i] = g * sg * (up + 1.f); }
                if constexpr (MOE_FP8) { u32x2 w8; w8.x = pk4_fp8(a[0], a[1], a[2], a[3]); w8.y = pk4_fp8(a[4], a[5], a[6], a[7]); *(u32x2*)((unsigned char*)act + ((size_t)u.pm * 256 + r) * FF + f0) = w8; }
                else { u32x4 w; w.x = cvt_pk_bf16(a[0], a[1]); w.y = cvt_pk_bf16(a[2], a[3]); w.z = cvt_pk_bf16(a[4], a[5]); w.w = cvt_pk_bf16(a[6], a[7]);
                *(u32x4*)(act + ((size_t)u.pm * 256 + r) * FF + f0) = w; } }
    }
};
struct EpiDown { static constexpr bool PERM = true;
    bf16_t* y; const float* bdown;
    __device__ __forceinline__ void operator()(const f32x4 (&acc)[2][2][4][2], const pg8::Unit& u, int wr, int wc, int fr, int fq) const {
        const int c0 = 256 * u.pn + 32 * wc + 8 * fq;
        f32x4 bv[2][2];
#pragma unroll
        for (int bj = 0; bj < 2; ++bj)
#pragma unroll
            for (int n = 0; n < 2; ++n) bv[bj][n] = *(const f32x4*)(bdown + u.e * D + c0 + 128 * bj + 4 * n);
#pragma unroll
        for (int ai = 0; ai < 2; ++ai)
#pragma unroll
            for (int m = 0; m < 4; ++m) { const int r = 128 * ai + 64 * wr + 16 * m + fr;
#pragma unroll
                for (int bj = 0; bj < 2; ++bj) { const f32x4 v0 = acc[ai][bj][m][0] * (MOE_FP8 ? W8_INV : 1.f) + bv[bj][0], v1 = acc[ai][bj][m][1] * (MOE_FP8 ? W8_INV : 1.f) + bv[bj][1];
                    if constexpr (Y_FP8) { u32x2 w8; w8.x = pk4_fp8(v0[0], v0[1], v0[2], v0[3]); w8.y = pk4_fp8(v1[0], v1[1], v1[2], v1[3]); *(u32x2*)((unsigned char*)y + ((size_t)u.pm * 256 + r) * D + c0 + 128 * bj) = w8; }
                    else { u32x4 w; w.x = cvt_pk_bf16(v0[0], v0[1]); w.y = cvt_pk_bf16(v0[2], v0[3]); w.z = cvt_pk_bf16(v1[0], v1[1]); w.w = cvt_pk_bf16(v1[2], v1[3]);
                    *(u32x4*)(y + ((size_t)u.pm * 256 + r) * D + c0 + 128 * bj) = w; } } }
    }
};

struct EpiProbe { static constexpr bool PERM = true;
    float* sink;
    __device__ __forceinline__ void operator()(const f32x4 (&acc)[2][2][4][2], const pg8::Unit& u, int wr, int wc, int fr, int fq) const {
        float s = 0.f;
#pragma unroll
        for (int ai = 0; ai < 2; ++ai)
#pragma unroll
            for (int bj = 0; bj < 2; ++bj)
#pragma unroll
                for (int m = 0; m < 4; ++m)
#pragma unroll
                    for (int n = 0; n < 2; ++n) s += acc[ai][bj][m][n][0];
        if (s != s) sink[u.pm] = s;
    }
};
template <bool F8 = false> __device__ __forceinline__ void transpose_item64(const float* W, int ldw, int Kd, bf16_t* WT, long dst_row0, const float* g, LAS float* scr, int k0, int srccol, int lane) {
    float v[64];
#pragma unroll
    for (int kk = 0; kk < 64; ++kk) v[kk] = srccol >= 0 ? W[(size_t)(k0 + kk) * ldw + srccol] : 0.f;
    if (g) {
#pragma unroll
        for (int kk = 0; kk < 64; kk += 4) { const f32x4 gg = *(const f32x4*)(g + k0 + kk); v[kk] *= gg[0]; v[kk + 1] *= gg[1]; v[kk + 2] *= gg[2]; v[kk + 3] *= gg[3]; } }
#pragma unroll
    for (int kk = 0; kk < 64; ++kk) scr[lane * 65 + kk] = v[kk];
    LDS_WAIT(); asm volatile("" ::: "memory");
    const int c = lane & 7;
#pragma unroll
    for (int j = 0; j < 8; ++j) { const int n = (lane >> 3) + 8 * j; const LAS float* sp = scr + n * 65 + 8 * c;
        if constexpr (F8) { u32x2 o8; o8.x = pk4_fp8(sp[0] * W8_SCALE, sp[1] * W8_SCALE, sp[2] * W8_SCALE, sp[3] * W8_SCALE); o8.y = pk4_fp8(sp[4] * W8_SCALE, sp[5] * W8_SCALE, sp[6] * W8_SCALE, sp[7] * W8_SCALE);
            *(u32x2*)((unsigned char*)WT + (size_t)(dst_row0 + n) * Kd + k0 + 8 * c) = o8; }
        else { u32x4 o; o.x = pk2(sp[0], sp[1]); o.y = pk2(sp[2], sp[3]); o.z = pk2(sp[4], sp[5]); o.w = pk2(sp[6], sp[7]);
        *(u32x4*)(WT + (size_t)(dst_row0 + n) * Kd + k0 + 8 * c) = o; } }
    LDS_WAIT(); asm volatile("" ::: "memory");
}

__device__ __forceinline__ void moe_weight_convert(const Frame& F, ArgsRef a) {
    LAS float* scr = (LAS float*)(F.wave < 7 ? F.lds + LDS_STAGE + F.wave * 16640 : F.misc + 4096);
    const int gw = F.bid * 8 + F.wave, NGW = F.G * 8;
    const float* gffn = IN(a, I_NORM_FFN_G);
    bf16_t* wgu = (bf16_t*)(WS(a) + WS_WGU); bf16_t* wd = (bf16_t*)(WS(a) + WS_WD);
    constexpr int KB = MOE_FP8 ? 2 : 1, PER = (16 / KB) * 16;
    for (int it = gw; it < 3 * NE * PER; it += NGW) {
        const int mat = it / (NE * PER), r = it % (NE * PER), e = r / PER, q = r % PER, kb0 = (q / 16) * KB, nb = q % 16;
#pragma unroll 1
        for (int kk = 0; kk < KB; ++kk) { const int kb = kb0 + kk;
            if (mat < 2) { const float* W = IN(a, mat == 0 ? I_W_GATE : I_W_UP) + (size_t)e * D * FF;
                const long row = (long)e * 2048 + (nb / 2) * 256 + (mat ? 128 : 0) + (nb % 2) * 64;
                transpose_item64<MOE_FP8>(W, FF, D, wgu, row, gffn, scr, 64 * kb, 64 * nb + F.lane, F.lane);
            } else { const float* W = IN(a, I_W_DOWN) + (size_t)e * FF * D;
                transpose_item64<MOE_FP8>(W, D, FF, wd, (long)e * 1024 + 64 * nb, nullptr, scr, 64 * kb, 64 * nb + F.lane, F.lane); } }
    }
}
__device__ __forceinline__ void router_weight_prep(const Frame& F, ArgsRef a) {
    bf16_t* whi = (bf16_t*)(WS(a) + WS_MISC + MISC_RW_HI); bf16_t* wlo = (bf16_t*)(WS(a) + WS_MISC + MISC_RW_LO);
    const float* wr = IN(a, I_W_ROUTER); const float* g = IN(a, I_NORM_FFN_G);
    for (int i = F.bid * 512 + F.tid; i < NE * D; i += F.G * 512) { const int e = i / D, k = i % D; const float v = g[k] * wr[k * NE + e];
        const unsigned h = f2bf(v); const float r = v - bf2f(h); whi[i] = (bf16_t)h; wlo[i] = (bf16_t)f2bf(r); }
}
__device__ __forceinline__ void copy_x_phase(const Frame& F, ArgsRef a) {
    const int gw = F.bid * 8 + F.wave, NGW = F.G * 8; bf16_t* x2b = (bf16_t*)(WS(a) + WS_X2B);
    for (int t = gw; t < T; t += NGW) { const f32x4* xr = (const f32x4*)(IN(a, I_X) + (size_t)t * D) + F.lane; f32x4* o = (f32x4*)(OUT(a) + (size_t)t * D) + F.lane; u32x2* ob = (u32x2*)(x2b + (size_t)t * D) + F.lane;
#pragma unroll
        for (int j = 0; j < 4; ++j) { const f32x4 v = xr[64 * j]; o[64 * j] = v; u32x2 w; w.x = pk2(v[0], v[1]); w.y = pk2(v[2], v[3]); ob[64 * j] = w; } }
}
__device__ __forceinline__ void router_phase(const Frame& F, ArgsRef a) {
    LAS int* lcnt = (LAS int*)(F.misc + LM_LCNT); LAS int* gbase = (LAS int*)(F.misc + LM_GBASE);
    LAS int* rec_e = (LAS int*)(F.misc + LM_REC); LAS int* rec_p = rec_e + 512; LAS float* rec_w = (LAS float*)(rec_p + 512); LAS float* rec_rs = rec_w + 512; LAS float* scr = (LAS float*)(F.misc + LM_SCR + F.wave * 2304);
    const bf16_t* whi = (const bf16_t*)(WS(a) + WS_MISC + MISC_RW_HI); const bf16_t* wlo = (const bf16_t*)(WS(a) + WS_MISC + MISC_RW_LO);
    unsigned* gcnt = (unsigned*)(WS(a) + WS_CTL) + CW_CNT;
    const float* x2 = X2H ? (const float*)(WS(a) + WS_X2H) : OUT(a); const float* brt = IN(a, I_B_ROUTER);
    const unsigned long long px_ = (unsigned long long)x2; const unsigned long long ux_ = ((unsigned long long)(unsigned)__builtin_amdgcn_readfirstlane((int)(px_ >> 32)) << 32) | (unsigned)__builtin_amdgcn_readfirstlane((int)px_);
    const __amdgpu_buffer_rsrc_t x2rsrc = __builtin_amdgcn_make_buffer_rsrc((void*)ux_, 0, 0x7ffffffc, 0x00020000);
    u32x4* grec = (u32x4*)(WS(a) + WS_REC); int* ltok = (int*)(WS(a) + WS_LTOK); float* lrs = (float*)(WS(a) + WS_LRS);
    const int fr = F.lane & 15, fq = F.lane >> 4;
    LAS unsigned char* wl_lds = F.lds + LDS_STAGE;
    __syncthreads();
    for (int i = F.tid; i < 8192; i += 512) { const int arr = i >> 12, row = (i >> 7) & 31, ch = i & 127; const f32x4 v = *(const f32x4*)((arr ? wlo : whi) + (size_t)row * D + ch * 8);
        *(LAS f32x4*)(wl_lds + arr * 65536 + row * 2048 + ((ch ^ (row & 7)) << 4)) = v; }
    __syncthreads();
#if defined(DIAG2) && (DIAG2 == 29 || DIAG2 == 30 || DIAG2 == 31)
    { unsigned* dbgA = (unsigned*)(WS(a) + WS_CTL + 640 * 1024); unsigned* nb = (unsigned*)(WS(a) + WS_CTL) + 16384; unsigned sm = 0u;
      for (int i = F.lane; i < 4096; i += 64) sm += ((const LAS unsigned*)(wl_lds + F.wave * 16384))[i] * (unsigned)(2 * i + 1);
      for (int o = 1; o < 64; o <<= 1) sm += __shfl_xor(sm, o);
      if (F.lane == 0) { if (a.pass == 0) dbgA[F.bid * 8 + F.wave] = sm; else if (dbgA[F.bid * 8 + F.wave] != sm) atomicAdd(nb + 64 * 1, 1u); } }
#endif
    for (int grp = F.bid; grp < T / 128; grp += F.G) {
        if (F.tid < 32) lcnt[F.tid] = 0;
        __syncthreads();
        const int t0 = grp * 128 + F.wave * 16;
        f32x4 acc0 = {0.f, 0.f, 0.f, 0.f}, acc1 = {0.f, 0.f, 0.f, 0.f}; float ssq = 0.f;
        const float* xr = x2 + (size_t)(t0 + fr) * D + 8 * fq;
#pragma unroll 1
        for (int k8 = 0; k8 < 4; ++k8) {
            f32x4 xa[8], xb[8]; u32x4 xh[8];
#pragma unroll
            for (int u = 0; u < 8; ++u) {
                if constexpr (X2H) { const unsigned vo = (unsigned)(t0 + fr) * 2048u + 16u * fq + 64u * (8 * k8 + u); xh[u] = __builtin_amdgcn_raw_buffer_load_b128(x2rsrc, vo, 0, 16); }
                else { const unsigned vo = (unsigned)(t0 + fr) * 4096u + 32u * fq + 128u * (8 * k8 + u);
                xa[u] = __builtin_bit_cast(f32x4, __builtin_amdgcn_raw_buffer_load_b128(x2rsrc, vo, 0, 16)); xb[u] = __builtin_bit_cast(f32x4, __builtin_amdgcn_raw_buffer_load_b128(x2rsrc, vo + 16u, 0, 16)); } }

#pragma unroll
            for (int u = 0; u < 8; ++u) { const int ks = 8 * k8 + u; bf16x8 ah, al;
                if constexpr (X2H) { const u32x4 hw = xh[u]; const unsigned h0 = hw.x, h1 = hw.y, h2 = hw.z, h3 = hw.w; ah = __builtin_bit_cast(bf16x8, hw);
                    const float e0 = bf2f(h0 & 0xffffu), e1 = bf2f(h0 >> 16), e2 = bf2f(h1 & 0xffffu), e3 = bf2f(h1 >> 16), e4 = bf2f(h2 & 0xffffu), e5 = bf2f(h2 >> 16), e6 = bf2f(h3 & 0xffffu), e7 = bf2f(h3 >> 16);
                    ssq += (e0 * e0 + e1 * e1) + (e2 * e2 + e3 * e3) + (e4 * e4 + e5 * e5) + (e6 * e6 + e7 * e7); al = ah; }
                else { const f32x4 v0 = xa[u], v1 = xb[u];
                ssq += (v0[0] * v0[0] + v0[1] * v0[1]) + (v0[2] * v0[2] + v0[3] * v0[3]) + (v1[0] * v1[0] + v1[1] * v1[1]) + (v1[2] * v1[2] + v1[3] * v1[3]);
                float xv[8] = {v0[0], v0[1], v0[2], v0[3], v1[0], v1[1], v1[2], v1[3]};
#pragma unroll
                for (int j = 0; j < 8; ++j) { const unsigned h = f2bf(xv[j]); ah[j] = (short)h; al[j] = (short)f2bf(xv[j] - bf2f(h)); } }
                const int ch = 4 * ks + fq;
                const LAS unsigned char* w0 = wl_lds + fr * 2048 + ((ch ^ (fr & 7)) << 4); const LAS unsigned char* w1 = wl_lds + (16 + fr) * 2048 + ((ch ^ (fr & 7)) << 4);
                const bf16x8 bh0 = *(const LAS bf16x8*)w0, bh1 = *(const LAS bf16x8*)w1, bl0 = *(const LAS bf16x8*)(w0 + 65536), bl1 = *(const LAS bf16x8*)(w1 + 65536);
                acc0 = __builtin_amdgcn_mfma_f32_16x16x32_bf16(ah, bh0, acc0, 0, 0, 0); if constexpr (!X2H) acc0 = __builtin_amdgcn_mfma_f32_16x16x32_bf16(al, bh0, acc0, 0, 0, 0); acc0 = __builtin_amdgcn_mfma_f32_16x16x32_bf16(ah, bl0, acc0, 0, 0, 0);
                acc1 = __builtin_amdgcn_mfma_f32_16x16x32_bf16(ah, bh1, acc1, 0, 0, 0); if constexpr (!X2H) acc1 = __builtin_amdgcn_mfma_f32_16x16x32_bf16(al, bh1, acc1, 0, 0, 0); acc1 = __builtin_amdgcn_mfma_f32_16x16x32_bf16(ah, bl1, acc1, 0, 0, 0); } }
        ssq += __shfl_xor(ssq, 16); ssq += __shfl_xor(ssq, 32);
#if defined(DIAG2) && (DIAG2 >= 32 && DIAG2 <= 40)
        { float s2 = 0.f; for (int ks = 0; ks < 32; ++ks) for (int j = 0; j < 8; ++j) { const unsigned w = __hip_atomic_load((const unsigned*)(xr + 32 * ks + j), __ATOMIC_RELAXED, DIAG2 == 32 ? __HIP_MEMORY_SCOPE_SYSTEM : __HIP_MEMORY_SCOPE_AGENT); const float f = __uint_as_float(w); s2 += f * f; }
          s2 += __shfl_xor(s2, 16); s2 += __shfl_xor(s2, 32);
          const float rel = fabsf(s2 - ssq) / (fabsf(ssq) + 1e-20f);
          if (F.lane < 16 && !(rel < 1e-3f)) { unsigned* nb_ = (unsigned*)(WS(a) + WS_CTL) + 16384; atomicAdd(nb_ + 64 * 3, 1u); const int t_ = t0 + F.lane;
              if (a.pass == 1) { if (ssq == 0.f) atomicAdd(nb_ + 64 * 11, 1u); else if (s2 == 0.f) atomicAdd(nb_ + 64 * 12, 1u); else atomicAdd(nb_ + 64 * 13, 1u); }
              atomicOr(nb_ + 64 * 4, 1u << (t_ & 15)); atomicOr(nb_ + 64 * 5, 1u << ((t_ >> 4) & 7)); atomicOr(nb_ + 64 * 6, 1u << ((t_ >> 7) & 31)); atomicOr(nb_ + 64 * 7, 1u << ((t_ >> 12) & 7)); } }
#endif
        const float rstd = 1.0f / sqrtf(ssq * (1.0f / D) + RMS_EPS);
#pragma unroll
        for (int r = 0; r < 4; ++r) { scr[(4 * fq + r) * 36 + fr] = acc0[r]; scr[(4 * fq + r) * 36 + 16 + fr] = acc1[r]; }
        LDS_WAIT(); asm volatile("" ::: "memory");
        if (F.lane < 16) {
            float v[32];
#pragma unroll
            for (int e = 0; e < 32; ++e) v[e] = scr[F.lane * 36 + e] * rstd + brt[e];
#if defined(DIAG2) && (DIAG2 == 29 || DIAG2 == 30 || DIAG2 == 31)
            { unsigned* dbgB = (unsigned*)(WS(a) + WS_CTL + 704 * 1024); unsigned* nb = (unsigned*)(WS(a) + WS_CTL) + 16384; unsigned sm = 0u;
              for (int e = 0; e < 32; ++e) sm = sm * 31u + __float_as_uint(v[e]);
              const int t_ = t0 + F.lane; if (a.pass == 0) dbgB[t_] = sm; else if (dbgB[t_] != sm) atomicAdd(nb + 64 * 2, 1u);
              unsigned s2 = __float_as_uint(rstd); unsigned* dbgC = dbgB + 32768; if (a.pass == 0) dbgC[t_] = s2; else if (dbgC[t_] != s2) atomicAdd(nb + 64 * 3, 1u); }
#endif
            float tv[4]; int ti[4];
#pragma unroll
            for (int k = 0; k < 4; ++k) { float best = v[0]; int bi = 0;
#pragma unroll
                for (int e = 1; e < 32; ++e) if (v[e] > best) { best = v[e]; bi = e; }
                tv[k] = best; ti[k] = bi;
#pragma unroll
                for (int e = 0; e < 32; ++e) v[e] = (e == bi) ? -3.0e38f : v[e]; }
            float ex[4], sum = 0.f;
#pragma unroll
            for (int k = 0; k < 4; ++k) { ex[k] = __expf(tv[k] - tv[0]); sum += ex[k]; }
            const float inv = 1.0f / sum;
#pragma unroll
            for (int k = 0; k < 4; ++k) { const int lp = atomicAdd((int*)(lcnt + ti[k]), 1); const int ri = (F.wave * 16 + F.lane) * 4 + k;
                rec_e[ri] = ti[k]; rec_p[ri] = lp; rec_w[ri] = ex[k] * inv; }
            rec_rs[F.wave * 16 + F.lane] = rstd;
        }
        __syncthreads();
        const int half = (grp * 128) / HALF_T;
        if (F.tid < 32) gbase[F.tid] = (int)atomicAdd(gcnt + half * 32 + F.tid, (unsigned)lcnt[F.tid]);
        __syncthreads();
        { const int e = rec_e[F.tid], pos = gbase[e] + rec_p[F.tid], t = grp * 128 + (F.tid >> 2); const float w = rec_w[F.tid], rs = rec_rs[F.tid >> 2];
            float* gr = (float*)(grec + (size_t)t * 4 + (F.tid & 3)); ((int*)gr)[0] = e; ((int*)gr)[1] = pos; gr[2] = w; gr[3] = 0.f;
            const size_t li = ((size_t)half * NE + e) * LIST_CAP + pos; ltok[li] = t; lrs[li] = rs; }
        __syncthreads();
    }
}
__device__ __forceinline__ int moe_tables(const Frame& F, ArgsRef a, int half) {
    LAS int* tend = (LAS int*)(F.misc + LM_TEND); LAS int* cnt = (LAS int*)(F.misc + LM_CNT); LAS int* pstart = (LAS int*)(F.misc + LM_PSTART);
    const unsigned* gcnt = (const unsigned*)(WS(a) + WS_CTL) + CW_CNT + half * 32;
    __syncthreads();
    if (F.tid < 32) cnt[F.tid] = (int)__hip_atomic_load(gcnt + F.tid, __ATOMIC_RELAXED, __HIP_MEMORY_SCOPE_AGENT);
    __syncthreads();
    if (F.tid == 0) { int acc = 0; for (int e = 0; e < NE; ++e) { pstart[e] = acc * 256; acc += (cnt[e] + 255) >> 8; tend[e] = acc; } }
    __syncthreads();
    { LAS int* tile_e = (LAS int*)(F.misc + LM_TILE); for (int ti = F.tid; ti < 576; ti += 512) { int e = 0; while (e < NE - 1 && ti >= tend[e]) ++e; const int t0 = e ? tend[e - 1] : 0; tile_e[ti] = (e << 16) | (ti - t0); } }
    __syncthreads();
    return __builtin_amdgcn_readfirstlane(tend[NE - 1]);
}
__device__ __forceinline__ void combine_phase(const Frame& F, ArgsRef a, int half) {
    const LAS int* pstart = (const LAS int*)(F.misc + LM_PSTART);
    const u32x4* grec = (const u32x4*)(WS(a) + WS_REC); const bf16_t* y = (const bf16_t*)(WS(a) + WS_Y); const float* gfin = IN(a, I_NORM_FINAL_G);
    const int gw = F.bid * 8 + F.wave, NGW = F.G * 8;
    for (int tb2 = half * HALF_T + gw * 2; tb2 < (half + 1) * HALF_T; tb2 += NGW * 2) {
        int slot[2][4]; float rw[2][4];
#pragma unroll
        for (int u = 0; u < 2; ++u)
#pragma unroll
            for (int k = 0; k < 4; ++k) { const int* ri = (const int*)(grec + (size_t)(tb2 + u) * 4 + k); const int re = ri[0], rp = ri[1]; rw[u][k] = ((const float*)ri)[2]; slot[u][k] = pstart[re] + rp; }
        f32x4 v[2][4]; u32x2 yv[2][4][4];
#pragma unroll
        for (int u = 0; u < 2; ++u) {
            if constexpr (X2H) { const u32x2* xh = (const u32x2*)((const bf16_t*)(WS(a) + WS_X2H) + (size_t)(tb2 + u) * D) + F.lane;
#pragma unroll
                for (int j = 0; j < 4; ++j) { const u32x2 hw = xh[64 * j]; const unsigned h0 = hw.x, h1 = hw.y; v[u][j] = (f32x4){bf2f(h0 & 0xffffu), bf2f(h0 >> 16), bf2f(h1 & 0xffffu), bf2f(h1 >> 16)}; } }
            else { const f32x4* xr = (const f32x4*)(OUT(a) + (size_t)(tb2 + u) * D) + F.lane;
#pragma unroll
            for (int j = 0; j < 4; ++j) v[u][j] = xr[64 * j]; }
#pragma unroll
            for (int k = 0; k < 4; ++k) {
                if constexpr (Y_FP8) { const unsigned* yr = (const unsigned*)((const unsigned char*)y + (size_t)slot[u][k] * D) + F.lane;
#pragma unroll
                    for (int j = 0; j < 4; ++j) { yv[u][k][j].x = yr[64 * j]; yv[u][k][j].y = 0u; } }
                else { const u32x2* yr = (const u32x2*)(y + (size_t)slot[u][k] * D) + F.lane;
#pragma unroll
                    for (int j = 0; j < 4; ++j) yv[u][k][j] = yr[64 * j]; } } }
#pragma unroll
        for (int u = 0; u < 2; ++u) {
#pragma unroll
            for (int k = 0; k < 4; ++k) { const float w = rw[u][k];
#pragma unroll
                for (int j = 0; j < 4; ++j) { const u32x2 p = yv[u][k][j];
                    if constexpr (Y_FP8) { const unsigned pw = p.x; const f32x2 lo = __builtin_amdgcn_cvt_pk_f32_fp8(pw, false), hi = __builtin_amdgcn_cvt_pk_f32_fp8(pw, true);
                        v[u][j][0] += w * lo[0]; v[u][j][1] += w * lo[1]; v[u][j][2] += w * hi[0]; v[u][j][3] += w * hi[1]; }
                    else { v[u][j][0] += w * bf2f(p.x & 0xffffu); v[u][j][1] += w * bf2f(p.x >> 16); v[u][j][2] += w * bf2f(p.y & 0xffffu); v[u][j][3] += w * bf2f(p.y >> 16); } } }
            float ss = 0.f;
#pragma unroll
            for (int j = 0; j < 4; ++j) ss += (v[u][j][0] * v[u][j][0] + v[u][j][1] * v[u][j][1]) + (v[u][j][2] * v[u][j][2] + v[u][j][3] * v[u][j][3]);
            const float rstd = 1.0f / sqrtf(wave_sum(ss) * (1.0f / D) + RMS_EPS); f32x4* xo = (f32x4*)(OUT(a) + (size_t)(tb2 + u) * D) + F.lane;
#pragma unroll
            for (int j = 0; j < 4; ++j) { const f32x4 g = ((const f32x4*)gfin)[F.lane + 64 * j]; xo[64 * j] = v[u][j] * rstd * g; } }
    }
}

#ifndef V1TEST
#define V1TEST 0
#endif
#ifndef RT_VAR
#define RT_VAR 0
#endif
constexpr int D_IN = 8648;
__device__ __forceinline__ int win_src_col(int n) {
    if (n < 1024) return 456 + n;
    if (n < 1280) return n - 1024;
    if (n < 1480) return 256 + (n - 1280);
    if (n < 1536) return -1;
    if (n < 2560) return 1480 + (n - 1536);
    if (n < 4608) return 2504 + (n - 2560);
    return 4552 + (n - 4608);
}
template <int PM = 63> __device__ __forceinline__ void mixer_prep_phase(const Frame& F, ArgsRef a) {
    const int gw = F.bid * 8 + F.wave, NGW = F.G * 8, gt = F.bid * 512 + F.tid, NGT = F.G * 512;
    unsigned char* ws = WS(a);
    if (PM & 1) { bf16_t* xb = (bf16_t*)(ws + WS_XB); float* rstd1 = (float*)(ws + WS_MISC + MISC_RSTD1);
      for (int t4 = gw * 4; t4 < T; t4 += NGW * 4) { f32x4 v[4][4];
#pragma unroll
          for (int u = 0; u < 4; ++u) { const f32x4* xr = (const f32x4*)(IN(a, I_X) + (size_t)(t4 + u) * D) + F.lane;
#pragma unroll
              for (int j = 0; j < 4; ++j) v[u][j] = xr[64 * j]; }
#pragma unroll
          for (int u = 0; u < 4; ++u) { u32x2* ob = (u32x2*)(xb + (size_t)(t4 + u) * D) + F.lane; unsigned* o8 = (unsigned*)(ws + WS_XB8 + (size_t)(t4 + u) * D) + F.lane; float ss = 0.f;
#pragma unroll
              for (int j = 0; j < 4; ++j) { const f32x4 x = v[u][j]; ss += (x[0] * x[0] + x[1] * x[1]) + (x[2] * x[2] + x[3] * x[3]); u32x2 w; w.x = pk2(x[0], x[1]); w.y = pk2(x[2], x[3]); ob[64 * j] = w;
                  if constexpr (INC_FP8) o8[64 * j] = pk4_fp8(x[0], x[1], x[2], x[3]); }
              ss = wave_sum(ss); if (F.lane == 0) rstd1[t4 + u] = 1.0f / sqrtf(ss * (1.0f / D) + RMS_EPS); } } }
    if (PM & 2) { LAS float* scr = (LAS float*)(F.wave < 7 ? F.lds + LDS_STAGE + F.wave * 16640 : F.misc + 4096); const float* g = IN(a, I_NORM_MIX_G);
      constexpr int I_WIN = 16 * (NIN / 64), I_WB = 32 * 16, I_WO = 16 * 16;
      for (int it = gw; it < I_WIN + I_WB + I_WO; it += NGW) {
          if (it < I_WIN) { const int kb = it / (NIN / 64), nb = it % (NIN / 64);
              if (INC_FP8 && nb >= 72) transpose_item64<true>(IN(a, I_W_IN), D_IN, D, (bf16_t*)(ws + WS_WIN8), 64 * (nb - 72), g, scr, 64 * kb, win_src_col(64 * nb + F.lane), F.lane);
              else if (INB_FP8 && nb >= 40) transpose_item64<true>(IN(a, I_W_IN), D_IN, D, (bf16_t*)(ws + WS_WIN8 + 4 * MiB), 64 * (nb - 40), g, scr, 64 * kb, win_src_col(64 * nb + F.lane), F.lane);
              else transpose_item64(IN(a, I_W_IN), D_IN, D, (bf16_t*)(ws + WS_WIN), 64 * nb, g, scr, 64 * kb, win_src_col(64 * nb + F.lane), F.lane); }
          else if (it < I_WIN + I_WB) { const int r = it - I_WIN, kb = r / 16, nb = r % 16; transpose_item64(IN(a, I_W_BB), D, 2048, (bf16_t*)(ws + WS_WB), 64 * nb, nullptr, scr, 64 * kb, 64 * nb + F.lane, F.lane); }
          else { const int r = it - I_WIN - I_WB, kb = r / 16, nb = r % 16; transpose_item64(IN(a, I_W_OUT), D, D, (bf16_t*)(ws + WS_WOUT), 64 * nb, nullptr, scr, 64 * kb, 64 * nb + F.lane, F.lane); } } }
    if (PM & 4) { bf16_t* wq = (bf16_t*)(ws + WS_WQ); const float* wuq = IN(a, I_W_UQ); const float* wuk = IN(a, I_W_UK); const float* wqi = IN(a, I_W_QIDX); const float* cg = IN(a, I_CQ_G);
      for (int i = gt; i < 1536 * 32; i += NGT) { const int kk = i / 1536, n = i - kk * 1536;
          float v[8];
          if (n < 1024) { const int h = n >> 7; const float* q = wuk + (size_t)n * 128; const float* p = wuq + (size_t)(8 * kk) * 1024 + h * 128;
#pragma unroll
              for (int jj = 0; jj < 8; ++jj) v[jj] = 0.f;
#pragma unroll 2
              for (int d = 0; d < 128; d += 4) { const f32x4 y = *(const f32x4*)(q + d);
#pragma unroll
                  for (int jj = 0; jj < 8; ++jj) { const f32x4 x = *(const f32x4*)(p + jj * 1024 + d); v[jj] += (x[0] * y[0] + x[1] * y[1]) + (x[2] * y[2] + x[3] * y[3]); } } }
          else {
#pragma unroll
              for (int jj = 0; jj < 8; ++jj) v[jj] = wqi[(size_t)(8 * kk + jj) * 512 + (n - 1024)] * 0.125f; }
          const f32x4 g0 = *(const f32x4*)(cg + 8 * kk), g1 = *(const f32x4*)(cg + 8 * kk + 4);
          u32x4 w; w.x = pk2(v[0] * g0[0], v[1] * g0[1]); w.y = pk2(v[2] * g0[2], v[3] * g0[3]); w.z = pk2(v[4] * g1[0], v[5] * g1[1]); w.w = pk2(v[6] * g1[2], v[7] * g1[3]);
          *(u32x4*)(wq + (size_t)n * 256 + 8 * kk) = w; } }
    if (PM & 8) { bf16_t* wa = (bf16_t*)(ws + WS_WA); const float* wuv = IN(a, I_W_UV); const float* wba = IN(a, I_W_BA);
      for (int i = gt; i < 1024 * 128; i += NGT) { const int kk = i >> 10, n = i & 1023, h = kk >> 4, rr = kk & 15; const float* q = wba + (size_t)(h * 128) * 1024 + n;
          const float* p[8];
#pragma unroll
          for (int jj = 0; jj < 8; ++jj) p[jj] = wuv + (size_t)(MIXA_FP8 ? h * 128 + 32 * (jj & 3) + 2 * rr + (jj >> 2) : 8 * kk + jj) * 128;
          float v[8];
#pragma unroll
          for (int jj = 0; jj < 8; ++jj) v[jj] = 0.f;
#pragma unroll 2
          for (int d = 0; d < 128; d += 4) { const float y0 = q[(size_t)d * 1024], y1 = q[(size_t)(d + 1) * 1024], y2 = q[(size_t)(d + 2) * 1024], y3 = q[(size_t)(d + 3) * 1024];
#pragma unroll
              for (int jj = 0; jj < 8; ++jj) { const f32x4 x = *(const f32x4*)(p[jj] + d); v[jj] += (x[0] * y0 + x[1] * y1) + (x[2] * y2 + x[3] * y3); } }
          if constexpr (MIXA_FP8) { u32x2 w8; w8.x = pk4_fp8(v[0] * W8_SCALE, v[1] * W8_SCALE, v[2] * W8_SCALE, v[3] * W8_SCALE); w8.y = pk4_fp8(v[4] * W8_SCALE, v[5] * W8_SCALE, v[6] * W8_SCALE, v[7] * W8_SCALE);
              *(u32x2*)((unsigned char*)wa + (size_t)n * 1024 + h * 128 + 8 * rr) = w8; }
          else { u32x4 w; w.x = pk2(v[0], v[1]); w.y = pk2(v[2], v[3]); w.z = pk2(v[4], v[5]); w.w = pk2(v[6], v[7]);
          *(u32x4*)(wa + (size_t)n * 1024 + 8 * kk) = w; } } }
    if (PM & 16) { float* cosP = (float*)(ws + WS_COSP); float* sinP = (float*)(ws + WS_SINP); float* cosT = (float*)(ws + WS_COST); float* sinT = (float*)(ws + WS_SINT);
      LAS double* invr = (LAS double*)(F.misc + LM_SCR);
      __syncthreads();
      if (F.tid < 128) invr[F.tid] = exp(-9.210340371976184 * (double)F.tid / 128.0) * 0.15915494309189535;
      __syncthreads();
      for (int i = gt; i < SEQ * 128; i += NGT) { const int pos = i >> 7, j = i & 127; const double rev = (double)pos * invr[j]; const float fr_ = (float)(rev - floor(rev));
          const float c = __builtin_amdgcn_cosf(fr_), sn = __builtin_amdgcn_sinf(fr_); cosP[i] = c; sinP[i] = sn; cosT[j * SEQ + pos] = c; sinT[j * SEQ + pos] = sn; }
      __syncthreads();
      if (gt < 256) { const int h = gt >> 6, i = gt & 63; const double lg = log(1.0 - exp2(-5.0 - (double)h));
          ((float*)(ws + WS_MISC + MISC_DQ))[gt] = (float)exp(lg * (i + 1)); ((float*)(ws + WS_MISC + MISC_DK))[gt] = (float)(exp(-lg * (i + 1)) * 0.0625); ((float*)(ws + WS_MISC + MISC_DZ))[gt] = (float)(exp(lg * (63 - i)) * 0.0625); } }
    if (PM & 32) router_weight_prep(F, a);
}

struct EpiInA { static constexpr bool PERM = true;
    bf16_t* qx; float* small; const float* rstd1; const float* cosP; const float* sinP; const float* dq;
    bf16_t* cqn; bf16_t* ckv; bf16_t* kidx; float* widx; const float* gkv; const float* gki; LAS float* xch;
    __device__ __forceinline__ void small_fused(const f32x4 (&acc)[2][2][4][2], const pg8::Unit& u, int wr, int wc, int fr, int fq) const {
        const int d0 = 32 * wc + 8 * fq;
#pragma unroll
        for (int ai = 0; ai < 2; ++ai) {
#pragma unroll
            for (int m = 0; m < 4; ++m) { int rl_ = 128 * ai + 64 * wr + 16 * m + fr; asm volatile("" : "+v"(rl_)); float p0 = 0.f, p1 = 0.f; const float rsv_ = rstd1[u.pm * 256 + rl_];
#pragma unroll
                for (int n = 0; n < 2; ++n)
#pragma unroll
                    for (int i = 0; i < 4; ++i) { const float x0 = acc[ai][0][m][n][i] * rsv_, x1 = acc[ai][1][m][n][i] * rsv_; p0 += x0 * x0; p1 += x1 * x1; }
                p0 += __shfl_xor(p0, 16); p0 += __shfl_xor(p0, 32); p1 += __shfl_xor(p1, 16); p1 += __shfl_xor(p1, 32);
                if (fq == 0) { xch[rl_ * 8 + wc] = p0; xch[rl_ * 8 + 4 + wc] = p1; } } }
        asm volatile("s_waitcnt lgkmcnt(0)" ::: "memory"); __builtin_amdgcn_s_barrier(); asm volatile("" ::: "memory");
#pragma unroll
        for (int ai = 0; ai < 2; ++ai)
#pragma unroll
            for (int m = 0; m < 4; ++m) { int rl = 128 * ai + 64 * wr + 16 * m + fr; asm volatile("" : "+v"(rl));        const size_t row = (size_t)u.pm * 256 + rl;
                const f32x4 q0 = *(const LAS f32x4*)(xch + rl * 8), q1 = *(const LAS f32x4*)(xch + rl * 8 + 4); const float rsm = rstd1[row];
                if (u.pn == 4) { const float r = rsm * (1.0f / sqrtf(((q0[0] + q0[1]) + (q0[2] + q0[3]) + (q1[0] + q1[1]) + (q1[2] + q1[3])) * (1.f / 256.f) + RMS_EPS));
#pragma unroll
                    for (int bj = 0; bj < 2; ++bj) { const f32x4 v0 = acc[ai][bj][m][0] * r, v1 = acc[ai][bj][m][1] * r; u32x4 w; w.x = cvt_pk_bf16(v0[0], v0[1]); w.y = cvt_pk_bf16(v0[2], v0[3]); w.z = cvt_pk_bf16(v1[0], v1[1]); w.w = cvt_pk_bf16(v1[2], v1[3]);
                        *(u32x4*)(cqn + row * 256 + 128 * bj + d0) = w; } }
                else { const float* gkv_ = gkv; const float* gki_ = gki; asm volatile("" : "+s"(gkv_), "+s"(gki_));
                    { const float r = rsm * (1.0f / sqrtf(((q0[0] + q0[1]) + (q0[2] + q0[3])) * (1.f / 128.f) + RMS_EPS)); const f32x4 g0 = *(const f32x4*)(gkv_ + d0), g1 = *(const f32x4*)(gkv_ + d0 + 4);
                        const f32x4 v0 = acc[ai][0][m][0] * r * g0, v1 = acc[ai][0][m][1] * r * g1; u32x4 w; w.x = cvt_pk_bf16(v0[0], v0[1]); w.y = cvt_pk_bf16(v0[2], v0[3]); w.z = cvt_pk_bf16(v1[0], v1[1]); w.w = cvt_pk_bf16(v1[2], v1[3]);
                        *(u32x4*)(ckv + row * 128 + d0) = w; }
                    if (wc < 2) { const float r = rsm * (1.0f / sqrtf((q1[0] + q1[1]) * (1.f / 64.f) + RMS_EPS)); const f32x4 g0 = *(const f32x4*)(gki_ + d0), g1 = *(const f32x4*)(gki_ + d0 + 4);
                        const f32x4 v0 = acc[ai][1][m][0] * r * g0, v1 = acc[ai][1][m][1] * r * g1; u32x4 w; w.x = cvt_pk_bf16(v0[0], v0[1]); w.y = cvt_pk_bf16(v0[2], v0[3]); w.z = cvt_pk_bf16(v1[0], v1[1]); w.w = cvt_pk_bf16(v1[2], v1[3]);
                        *(u32x4*)(kidx + row * 64 + d0) = w; }
                    else if (wc == 2 && fq == 0) { const float sc = 0.35355339059327373f * rsm; *(f32x4*)(widx + row * 8) = acc[ai][1][m][0] * sc; *(f32x4*)(widx + row * 8 + 4) = acc[ai][1][m][1] * sc; } } }
    }
    __device__ __forceinline__ void operator()(const f32x4 (&acc)[2][2][4][2], const pg8::Unit& u, int wr, int wc, int fr, int fq) const {
        const int d0 = 32 * wc + 8 * fq;
        if (ROWNORM_FUSED && u.pn >= 4) { small_fused(acc, u, wr, wc, fr, fq); return; }
#pragma unroll
        for (int ai = 0; ai < 2; ++ai) { const int row0 = u.pm * 256 + 128 * ai + 64 * wr + fr;
            float rs[4];
#pragma unroll
            for (int m = 0; m < 4; ++m) rs[m] = rstd1[row0 + 16 * m];
            if (u.pn < 4) { f32x4 c4[4][2], s4[4][2]; float sc[4];
#pragma unroll
                for (int m = 0; m < 4; ++m) { const int pos = (row0 + 16 * m) & (SEQ - 1); sc[m] = dq[u.pn * 64 + (pos & 63)];
#pragma unroll
                    for (int n = 0; n < 2; ++n) { c4[m][n] = *(const f32x4*)(cosP + pos * 128 + d0 + 4 * n); s4[m][n] = *(const f32x4*)(sinP + pos * 128 + d0 + 4 * n); } }
#pragma unroll
                for (int m = 0; m < 4; ++m) { const float scm = sc[m] * rs[m]; float o1[8], o2[8];
#pragma unroll
                    for (int n = 0; n < 2; ++n)
#pragma unroll
                        for (int i = 0; i < 4; ++i) { const float v1 = acc[ai][0][m][n][i], v2 = acc[ai][1][m][n][i]; o1[4 * n + i] = (v1 * c4[m][n][i] - v2 * s4[m][n][i]) * scm; o2[4 * n + i] = (v2 * c4[m][n][i] + v1 * s4[m][n][i]) * scm; }
                    u32x4 w1, w2; w1.x = cvt_pk_bf16(o1[0], o1[1]); w1.y = cvt_pk_bf16(o1[2], o1[3]); w1.z = cvt_pk_bf16(o1[4], o1[5]); w1.w = cvt_pk_bf16(o1[6], o1[7]);
                    w2.x = cvt_pk_bf16(o2[0], o2[1]); w2.y = cvt_pk_bf16(o2[2], o2[3]); w2.z = cvt_pk_bf16(o2[4], o2[5]); w2.w = cvt_pk_bf16(o2[6], o2[7]);
                    bf16_t* p = qx + (size_t)(row0 + 16 * m) * 1024 + u.pn * 256 + d0; *(u32x4*)p = w1; *(u32x4*)(p + 128) = w2; }
            } else {
#pragma unroll
                for (int m = 0; m < 4; ++m) { float* p = small + (size_t)(row0 + 16 * m) * 512 + (u.pn - 4) * 256 + d0;
#pragma unroll
                    for (int bj = 0; bj < 2; ++bj)
#pragma unroll
                        for (int n = 0; n < 2; ++n) *(f32x4*)(p + 128 * bj + 4 * n) = acc[ai][bj][m][n] * rs[m]; } } }
    }
};
template <int PN0 = 0, bool F8 = false> struct EpiInB { static constexpr bool PERM = false;
    bf16_t* kzt; bf16_t* vt; const float* rstd1; const float* cosT; const float* sinT; const float* dz;
    __device__ __forceinline__ void operator()(const f32x4 (&acc)[2][2][4][2], const pg8::Unit& u, int wr, int wc, int fr, int fq) const {
#pragma unroll
        for (int ai = 0; ai < 2; ++ai) { const int tokb = u.pm * 256 + 128 * ai + 64 * wr + 16 * fq, b = tokb >> 11, posb = tokb & (SEQ - 1);
            f32x4 rs4[4];
#pragma unroll
            for (int m = 0; m < 4; ++m) rs4[m] = *(const f32x4*)(rstd1 + tokb + 4 * m);
            const int pn = u.pn + PN0;
            if (pn < 4) { const int h = pn;
#pragma unroll
              for (int mg = 0; mg < 2; ++mg) { f32x4 kz4[2], c4[2][2], s4[2][2];
#pragma unroll
                for (int mm = 0; mm < 2; ++mm) { const int m = 2 * mg + mm; kz4[mm] = *(const f32x4*)(dz + h * 64 + ((posb + 4 * m) & 63));
#pragma unroll
                    for (int n = 0; n < 2; ++n) { const int d = 32 * wc + 16 * n + fr; c4[mm][n] = *(const f32x4*)(cosT + d * SEQ + posb + 4 * m); s4[mm][n] = *(const f32x4*)(sinT + d * SEQ + posb + 4 * m); } }
#pragma unroll
                for (int n = 0; n < 2; ++n) { const int d = 32 * wc + 16 * n + fr; float o1[8], o2[8];
#pragma unroll
                    for (int mm = 0; mm < 2; ++mm) { const int m = 2 * mg + mm;
#pragma unroll
                        for (int i = 0; i < 4; ++i) { const float v1 = acc[ai][0][m][n][i] * rs4[m][i], v2 = acc[ai][1][m][n][i] * rs4[m][i]; o1[4 * mm + i] = (v1 * c4[mm][n][i] - v2 * s4[mm][n][i]) * kz4[mm][i]; o2[4 * mm + i] = (v2 * c4[mm][n][i] + v1 * s4[mm][n][i]) * kz4[mm][i]; } }
                    u32x4 z1, z2; z1.x = cvt_pk_bf16(o1[0], o1[1]); z1.y = cvt_pk_bf16(o1[2], o1[3]); z1.z = cvt_pk_bf16(o1[4], o1[5]); z1.w = cvt_pk_bf16(o1[6], o1[7]);
                    z2.x = cvt_pk_bf16(o2[0], o2[1]); z2.y = cvt_pk_bf16(o2[2], o2[3]); z2.z = cvt_pk_bf16(o2[4], o2[5]); z2.w = cvt_pk_bf16(o2[6], o2[7]);
                    bf16_t* q = kzt + ((size_t)((b * 4 + h) * 256 + d)) * SEQ + posb + 8 * mg; *(u32x4*)q = z1; *(u32x4*)(q + (size_t)128 * SEQ) = z2; } }
            } else { const int j = pn - 4, hd = j >> 1;
#pragma unroll
                for (int bj = 0; bj < 2; ++bj)
#pragma unroll
                    for (int n = 0; n < 2; ++n) { const int v = (j & 1) * 256 + 128 * bj + 32 * wc + 16 * n + fr; bf16_t* q = vt + ((size_t)((b * 4 + hd) * 512 + v)) * SEQ + posb;
#pragma unroll
                        for (int mg = 0; mg < 2; ++mg) { const f32x4 x0 = acc[ai][bj][2 * mg][n] * rs4[2 * mg] * (F8 ? W8_INV : 1.f), x1 = acc[ai][bj][2 * mg + 1][n] * rs4[2 * mg + 1] * (F8 ? W8_INV : 1.f);
                            u32x4 z; z.x = cvt_pk_bf16(x0[0], x0[1]); z.y = cvt_pk_bf16(x0[2], x0[3]); z.z = cvt_pk_bf16(x1[0], x1[1]); z.w = cvt_pk_bf16(x1[2], x1[3]); *(u32x4*)(q + 8 * mg) = z; } } } }
    }
};
struct EpiInC { static constexpr bool PERM = true;
    bf16_t* oret; bf16_t* ga; bf16_t* gb; const float* rstd1; const float* rn;
    __device__ __forceinline__ void operator()(const f32x4 (&acc)[2][2][4][2], const pg8::Unit& u, int wr, int wc, int fr, int fq) const {
        const int c0 = 32 * wc + 8 * fq;
#pragma unroll
        for (int ai = 0; ai < 2; ++ai) { const int row0 = u.pm * 256 + 128 * ai + 64 * wr + fr;
            float rs[4], rr[4]; unsigned ow[4][2][4];
#pragma unroll
            for (int m = 0; m < 4; ++m) { rs[m] = rstd1[row0 + 16 * m] * (INC_FP8 ? W8_INV : 1.f); rr[m] = 1.f; }
            if (u.pn < 8) {
#pragma unroll
                for (int m = 0; m < 4; ++m) { rr[m] = rn[(row0 + 16 * m) * 4 + (u.pn >> 1)];
#pragma unroll
                    for (int bj = 0; bj < 2; ++bj) ld4u(oret + (size_t)(row0 + 16 * m) * 2048 + u.pn * 256 + 128 * bj + c0, ow[m][bj]); } }
#pragma unroll
            for (int m = 0; m < 4; ++m)
#pragma unroll
                for (int bj = 0; bj < 2; ++bj) { float v[8];
#pragma unroll
                    for (int n = 0; n < 2; ++n)
#pragma unroll
                        for (int i = 0; i < 4; ++i) { const float x = acc[ai][bj][m][n][i] * rs[m]; v[4 * n + i] = __builtin_amdgcn_rcpf(1.f + __builtin_amdgcn_exp2f(-1.4426950408889634f * x)) * (u.pn < 8 ? x : 1.f); }
                    bf16_t* p;
                    if (u.pn < 8) { p = oret + (size_t)(row0 + 16 * m) * 2048 + u.pn * 256 + 128 * bj + c0;
#pragma unroll
                        for (int q = 0; q < 4; ++q) { v[2 * q] *= bf2f(ow[m][bj][q] & 0xffffu) * rr[m]; v[2 * q + 1] *= bf2f(ow[m][bj][q] >> 16) * rr[m]; } }
                    else if (u.pn < 12) { p = ga + (size_t)(row0 + 16 * m) * 1024 + (u.pn - 8) * 256 + 128 * bj + c0;
                        if constexpr (GA8) { u32x2 w8; w8.x = pk4_fp8(v[0], v[1], v[2], v[3]); w8.y = pk4_fp8(v[4], v[5], v[6], v[7]); *(u32x2*)((unsigned char*)ga + (size_t)(row0 + 16 * m) * 1024 + (u.pn - 8) * 256 + 128 * bj + c0) = w8; continue; } }
                    else p = gb + (size_t)(row0 + 16 * m) * 1024 + (u.pn - 12) * 256 + 128 * bj + c0;
                    u32x4 w; w.x = cvt_pk_bf16(v[0], v[1]); w.y = cvt_pk_bf16(v[2], v[3]); w.z = cvt_pk_bf16(v[4], v[5]); w.w = cvt_pk_bf16(v[6], v[7]); *(u32x4*)p = w; } }
    }
};
template <int MODE, bool F8S = false> struct EpiMix { static constexpr bool PERM = true;
    const bf16_t* gate; bf16_t* mixa; bf16_t* mix;
    static constexpr bool G8 = GA8 && MODE == 0, M8 = GA8;
    __device__ static __forceinline__ void ld8(const void* base, size_t eoff, bool f8, unsigned (&w)[4]) { if (f8) { const u32x2 t = *(const u32x2*)((const unsigned char*)base + eoff); w[0] = t.x; w[1] = t.y; w[2] = 0u; w[3] = 0u; } else ld4u((const bf16_t*)base + eoff, w); }
    __device__ static __forceinline__ void un8(const unsigned (&w)[4], bool f8, float (&f)[8]) {
        if (f8) { const f32x2 a0 = __builtin_amdgcn_cvt_pk_f32_fp8(w[0], false), a1 = __builtin_amdgcn_cvt_pk_f32_fp8(w[0], true), a2 = __builtin_amdgcn_cvt_pk_f32_fp8(w[1], false), a3 = __builtin_amdgcn_cvt_pk_f32_fp8(w[1], true);
            f[0] = a0[0]; f[1] = a0[1]; f[2] = a1[0]; f[3] = a1[1]; f[4] = a2[0]; f[5] = a2[1]; f[6] = a3[0]; f[7] = a3[1]; }
        else {
#pragma unroll
            for (int q = 0; q < 4; ++q) { f[2 * q] = bf2f(w[q] & 0xffffu); f[2 * q + 1] = bf2f(w[q] >> 16); } } }
    __device__ __forceinline__ void operator()(const f32x4 (&acc)[2][2][4][2], const pg8::Unit& u, int wr, int wc, int fr, int fq) const {
#pragma unroll
        for (int ai = 0; ai < 2; ++ai) { const size_t off0 = (size_t)(u.pm * 256 + 128 * ai + 64 * wr + fr) * 1024 + u.pn * 256 + 32 * wc + 8 * fq;
            unsigned gw[4][2][4], mw[4][2][4];
#pragma unroll
            for (int m = 0; m < 4; ++m)
#pragma unroll
                for (int bj = 0; bj < 2; ++bj) { ld8(gate, off0 + (size_t)m * 16 * 1024 + 128 * bj, G8, gw[m][bj]); if (MODE == 1) ld8(mixa, off0 + (size_t)m * 16 * 1024 + 128 * bj, M8, mw[m][bj]); }
#pragma unroll
            for (int m = 0; m < 4; ++m)
#pragma unroll
                for (int bj = 0; bj < 2; ++bj) { float v[8], g[8]; un8(gw[m][bj], G8, g);
#pragma unroll
                    for (int q = 0; q < 8; ++q) v[q] = g[q] * acc[ai][bj][m][q >> 2][q & 3] * (F8S ? W8_INV * 0.25f : 1.f);
                    if (MODE == 1) { float mm[8]; un8(mw[m][bj], M8, mm);
#pragma unroll
                        for (int q = 0; q < 8; ++q) v[q] += mm[q]; }
                    const size_t off = off0 + (size_t)m * 16 * 1024 + 128 * bj;
                    if (MODE == 0 && M8) { u32x2 w8; w8.x = pk4_fp8(v[0], v[1], v[2], v[3]); w8.y = pk4_fp8(v[4], v[5], v[6], v[7]); *(u32x2*)((unsigned char*)mixa + off) = w8; }
                    else { u32x4 w; w.x = cvt_pk_bf16(v[0], v[1]); w.y = cvt_pk_bf16(v[2], v[3]); w.z = cvt_pk_bf16(v[4], v[5]); w.w = cvt_pk_bf16(v[6], v[7]);
                        *(u32x4*)((MODE == 0 ? mixa : mix) + off) = w; } } }
    }
};
struct EpiOut { static constexpr bool PERM = true;
    const bf16_t* x; float* out; bf16_t* x2b;
    __device__ __forceinline__ void operator()(const f32x4 (&acc)[2][2][4][2], const pg8::Unit& u, int wr, int wc, int fr, int fq) const {
#pragma unroll
        for (int ai = 0; ai < 2; ++ai) { const size_t off0 = (size_t)(u.pm * 256 + 128 * ai + 64 * wr + fr) * 1024 + u.pn * 256 + 32 * wc + 8 * fq;
            f32x4 xv[4][2][2];
#pragma unroll
            for (int m = 0; m < 4; ++m)
#pragma unroll
                for (int bj = 0; bj < 2; ++bj) { unsigned xw[4]; ld4u(x + off0 + (size_t)m * 16 * 1024 + 128 * bj, xw);
                    xv[m][bj][0] = (f32x4){bf2f(xw[0] & 0xffffu), bf2f(xw[0] >> 16), bf2f(xw[1] & 0xffffu), bf2f(xw[1] >> 16)}; xv[m][bj][1] = (f32x4){bf2f(xw[2] & 0xffffu), bf2f(xw[2] >> 16), bf2f(xw[3] & 0xffffu), bf2f(xw[3] >> 16)}; }
#pragma unroll
            for (int m = 0; m < 4; ++m)
#pragma unroll
                for (int bj = 0; bj < 2; ++bj) { const size_t off = off0 + (size_t)m * 16 * 1024 + 128 * bj; const f32x4 r0 = xv[m][bj][0] + acc[ai][bj][m][0], r1 = xv[m][bj][1] + acc[ai][bj][m][1];
                    if constexpr (X2H) { u32x4 wh; wh.x = cvt_pk_bf16(r0[0], r0[1]); wh.y = cvt_pk_bf16(r0[2], r0[3]); wh.z = cvt_pk_bf16(r1[0], r1[1]); wh.w = cvt_pk_bf16(r1[2], r1[3]); *(u32x4*)((bf16_t*)out + off) = wh; }
                    else { *(f32x4*)(out + off) = r0; *(f32x4*)(out + off + 4) = r1; }
                    if constexpr (MOE_FP8) { u32x2 w8; w8.x = pk4_fp8(r0[0], r0[1], r0[2], r0[3]); w8.y = pk4_fp8(r1[0], r1[1], r1[2], r1[3]); *(u32x2*)((unsigned char*)x2b + off) = w8; }
                    else { u32x4 w; w.x = cvt_pk_bf16(r0[0], r0[1]); w.y = cvt_pk_bf16(r0[2], r0[3]); w.z = cvt_pk_bf16(r1[0], r1[1]); w.w = cvt_pk_bf16(r1[2], r1[3]); *(u32x4*)(x2b + off) = w; } } }
    }
};

constexpr int RT_QX = 0, RT_KP = 33280, RT_KZT = 66560, RT_VT = 103424, RT_S = 121856, RT_PART = RT_KP, RT_QS = 520, RT_TS = 144;
__device__ __forceinline__ int crow32(int reg, int hh) { return (reg & 3) + 8 * (reg >> 2) + 4 * hh; }
__device__ __forceinline__ bf16x8 lds_frag2x8(const LAS unsigned char* p) { const s16x4 lo = *(const LAS s16x4*)p, hi = *(const LAS s16x4*)(p + 16); return __builtin_shufflevector(lo, hi, 0, 1, 2, 3, 4, 5, 6, 7); }
__device__ __forceinline__ bf16x8 lds_frag8x2(const LAS unsigned char* p) { const s16x4 lo = *(const LAS s16x4*)p, hi = *(const LAS s16x4*)(p + 8); return __builtin_shufflevector(lo, hi, 0, 1, 2, 3, 4, 5, 6, 7); }
template <int OFF> __device__ __forceinline__ s16x4 lds_tr_read(int vb) { s16x4 r; asm volatile("ds_read_b64_tr_b16 %0, %1 offset:%2" : "=&v"(r) : "v"(vb), "i"(OFF) : "memory"); return r; }
__device__ __forceinline__ bf16x8 lds_frag16(const LAS unsigned char* p) { return *(const LAS bf16x8*)p; }
__device__ __forceinline__ bf16x8 pack8(const f32x16& x, int s8) { u32x4 p; p.x = cvt_pk_bf16(x[s8 + 0], x[s8 + 1]); p.y = cvt_pk_bf16(x[s8 + 2], x[s8 + 3]); p.z = cvt_pk_bf16(x[s8 + 4], x[s8 + 5]); p.w = cvt_pk_bf16(x[s8 + 6], x[s8 + 7]); return __builtin_bit_cast(bf16x8, p); }
#define MFMA32(a, b, c) __builtin_amdgcn_mfma_f32_32x32x16_bf16((a), (b), (c), 0, 0, 0)
__device__ __forceinline__ void retention_phase(const Frame& F, ArgsRef a) {
    const bf16_t* QX = (const bf16_t*)(WS(a) + WS_QX); const bf16_t* KZT = (const bf16_t*)(WS(a) + WS_KZT); const bf16_t* VT = (const bf16_t*)(WS(a) + WS_VT);
    bf16_t* ORET = (bf16_t*)OUT(a);
    LAS unsigned char* L = F.lds + LDS_STAGE;
    const int tid = F.tid, lane = F.lane, w = F.wave, wd = w >> 2, wv = w & 3, r = lane & 31, hh = lane >> 5;
    for (int item = F.bid; item < 256; item += F.G) {
        const int xcd = item & 7, index = item >> 3, q = (index >> 2) * 8 + xcd, vs = index & 3, b = q >> 2, h = q & 3, tb = b * SEQ;
        const float g64 = (float)exp(64.0 * log(1.0 - exp2(-5.0 - (double)h))), g64inv = (float)exp(-64.0 * log(1.0 - exp2(-5.0 - (double)h)));
        f32x16 Racc[4];
#pragma unroll
        for (int i = 0; i < 4; ++i) { for (int j = 0; j < 16; ++j) Racc[i][j] = 0.f; }
        f32x4 pq[4], pz[4], pv[2];
        unsigned gq = (unsigned)(((tb + (tid >> 5)) * 1024 + h * 256 + (tid & 31) * 8) * 2), gz = (unsigned)((((b * 4 + h) * 256 + (tid >> 3)) * SEQ + (tid & 7) * 8) * 2), gv = (unsigned)((((b * 4 + h) * 512 + vs * 128 + (tid >> 3)) * SEQ + (tid & 7) * 8) * 2);
        unsigned lq = (unsigned)(uintptr_t)(L + RT_QX + (tid >> 5) * RT_QS + (tid & 31) * 16), lz = (unsigned)(uintptr_t)(L + RT_KZT + (tid >> 3) * RT_TS + (tid & 7) * 16), lv = (unsigned)(uintptr_t)(L + RT_VT + (tid >> 3) * RT_TS + (tid & 7) * 16);
#define RT_LOADG(c) do { unsigned _q = gq + (unsigned)(c) * (64u * 1024u * 2u), _z = gz + (unsigned)(c) * 128u, _v = gv + (unsigned)(c) * 128u; asm volatile("" : "+v"(_q), "+v"(_z), "+v"(_v)); \
        _Pragma("unroll") for (int i = 0; i < 4; ++i) { pq[i] = *(const f32x4*)((const char*)QX + _q + i * (16 * 1024 * 2)); pz[i] = *(const f32x4*)((const char*)KZT + _z + i * (64 * SEQ * 2)); } \
        _Pragma("unroll") for (int i = 0; i < 2; ++i) pv[i] = *(const f32x4*)((const char*)VT + _v + i * (64 * SEQ * 2)); } while (0)
#define RT_STOREL() do { unsigned _q = lq, _z = lz, _v = lv; asm volatile("" : "+v"(_q), "+v"(_z), "+v"(_v)); \
        _Pragma("unroll") for (int i = 0; i < 4; ++i) { LAS unsigned char* dq_ = (LAS unsigned char*)(uintptr_t)_q + i * (16 * RT_QS); \
            *(LAS f32x2*)(dq_) = (f32x2){pq[i][0], pq[i][1]}; *(LAS f32x2*)(dq_ + 8) = (f32x2){pq[i][2], pq[i][3]}; \
            *(LAS f32x4*)((LAS unsigned char*)(uintptr_t)_z + i * (64 * RT_TS)) = pz[i]; } \
        _Pragma("unroll") for (int i = 0; i < 2; ++i) *(LAS f32x4*)((LAS unsigned char*)(uintptr_t)_v + i * (64 * RT_TS)) = pv[i]; } while (0)
        __syncthreads();
        RT_LOADG(0); RT_STOREL(); __syncthreads();
        const int ti = wv >> 1, tj = wv & 1;
        unsigned bQa = (unsigned)(uintptr_t)(L + RT_QX + (32 * ti + r) * RT_QS + 16 * hh), bKb = (unsigned)(uintptr_t)(L + RT_KZT + (8 * hh + ((lane & 15) >> 2)) * RT_TS + (32 * tj + 16 * ((lane >> 4) & 1) + 4 * (lane & 3)) * 2);
        unsigned bSw = (unsigned)(uintptr_t)(L + RT_S + (32 * ti + 4 * hh) * RT_TS + (32 * tj + r) * 2), bQr = (unsigned)(uintptr_t)(L + RT_QX + r * RT_QS + (128 * wd + 4 * hh) * 2);
        unsigned bV = (unsigned)(uintptr_t)(L + RT_VT + (32 * wv + r) * RT_TS + 16 * hh), bSr = (unsigned)(uintptr_t)(L + RT_S + r * RT_TS + 16 * hh);
        unsigned bP = (unsigned)(uintptr_t)(L + RT_PART + wv * 8192 + 4 * hh * 128 + r * 4), bZ = (unsigned)(uintptr_t)(L + RT_KZT + (128 * wd + r) * RT_TS + 16 * hh);
        asm volatile("" : "+v"(bQa), "+v"(bKb), "+v"(bSw), "+v"(bQr)); asm volatile("" : "+v"(bV), "+v"(bSr), "+v"(bP), "+v"(bZ));
#define RT_SYNC() do { asm volatile("s_waitcnt lgkmcnt(0)" ::: "memory"); __builtin_amdgcn_s_barrier(); asm volatile("" ::: "memory"); } while (0)
#define LP(x) ((const LAS unsigned char*)(uintptr_t)(x))
#define LPW(x) ((LAS unsigned char*)(uintptr_t)(x))
        for (int c = 0; c < 32; ++c) {
            if (c + 1 < 32) RT_LOADG(c + 1);
            f32x16 o[2];
#pragma unroll
            for (int j = 0; j < 16; ++j) { o[0][j] = 0.f; o[1][j] = 0.f; }
            if (wd == 1 && wv != 1) { f32x16 sacc;
#pragma unroll
                for (int j = 0; j < 16; ++j) sacc[j] = 0.f;
#define RT_KQ(KQ) { s16x4 tl0 = lds_tr_read<(4 * (KQ) + 0) * 16 * RT_TS>((int)bKb), th0 = lds_tr_read<(4 * (KQ) + 0) * 16 * RT_TS + 4 * RT_TS>((int)bKb), tl1 = lds_tr_read<(4 * (KQ) + 1) * 16 * RT_TS>((int)bKb), th1 = lds_tr_read<(4 * (KQ) + 1) * 16 * RT_TS + 4 * RT_TS>((int)bKb); \
                    s16x4 tl2 = lds_tr_read<(4 * (KQ) + 2) * 16 * RT_TS>((int)bKb), th2 = lds_tr_read<(4 * (KQ) + 2) * 16 * RT_TS + 4 * RT_TS>((int)bKb), tl3 = lds_tr_read<(4 * (KQ) + 3) * 16 * RT_TS>((int)bKb), th3 = lds_tr_read<(4 * (KQ) + 3) * 16 * RT_TS + 4 * RT_TS>((int)bKb); \
                    asm volatile("s_waitcnt lgkmcnt(0)" ::: "memory"); __builtin_amdgcn_sched_barrier(0); \
                    sacc = MFMA32(lds_frag8x2(LP(bQa) + 32 * (4 * (KQ) + 0)), ((bf16x8){tl0[0], tl0[1], tl0[2], tl0[3], th0[0], th0[1], th0[2], th0[3]}), sacc); \
                    sacc = MFMA32(lds_frag8x2(LP(bQa) + 32 * (4 * (KQ) + 1)), ((bf16x8){tl1[0], tl1[1], tl1[2], tl1[3], th1[0], th1[1], th1[2], th1[3]}), sacc); \
                    sacc = MFMA32(lds_frag8x2(LP(bQa) + 32 * (4 * (KQ) + 2)), ((bf16x8){tl2[0], tl2[1], tl2[2], tl2[3], th2[0], th2[1], th2[2], th2[3]}), sacc); \
                    sacc = MFMA32(lds_frag8x2(LP(bQa) + 32 * (4 * (KQ) + 3)), ((bf16x8){tl3[0], tl3[1], tl3[2], tl3[3], th3[0], th3[1], th3[2], th3[3]}), sacc); }
                RT_KQ(0) RT_KQ(1) RT_KQ(2) RT_KQ(3)
#undef RT_KQ
#pragma unroll
                for (int j = 0; j < 16; ++j) sacc[j] *= g64inv;
#pragma unroll
                for (int j = 0; j < 16; ++j) { const int cl = (j & 3) + 8 * (j >> 2); float v = (ti != tj || cl + 4 * hh >= r) ? sacc[j] : 0.f; if (RT_VAR == 6) v = (ti == tj && cl + 4 * hh == r) ? 1.f : 0.f; *(LAS bf16_t*)(LPW(bSw) + cl * RT_TS) = (bf16_t)f2bf(v); } }
            if (RT_VAR != 5 && RT_VAR != 6 && RT_VAR != 9 && RT_VAR != 10)
#pragma unroll
            for (int s = 0; s < 8; ++s) { const bf16x8 rb = pack8(Racc[s >> 1], 8 * (s & 1));
#pragma unroll
                for (int m = 0; m < 2; ++m) { const bf16x8 af = lds_frag2x8(LP(bQr) + 32 * m * RT_QS + (32 * (s >> 1) + 16 * (s & 1)) * 2); o[m] = MFMA32(af, rb, o[m]); } }
            RT_SYNC();
            bf16x8 Bv[4];
#pragma unroll
            for (int ks = 0; ks < 4; ++ks) Bv[ks] = lds_frag16(LP(bV) + 32 * ks);
            if (wd == 0) {
#pragma unroll
                for (int ks = 0; ks < 4; ++ks) { if (RT_VAR == 4) continue; if (ks < 2) { const bf16x8 a0 = lds_frag16(LP(bSr) + 32 * ks); o[0] = MFMA32(a0, Bv[ks], o[0]); }
                    const bf16x8 a1 = lds_frag16(LP(bSr) + 32 * RT_TS + 32 * ks); o[1] = MFMA32(a1, Bv[ks], o[1]); }
            } else {
#pragma unroll
                for (int m = 0; m < 2; ++m)
#pragma unroll
                    for (int j = 0; j < 16; ++j) *(LAS float*)(LPW(bP) + (32 * m + (j & 3) + 8 * (j >> 2)) * 128) = o[m][j];
            }
            RT_SYNC();
            if (wd == 0) { bf16_t* op = ORET + (size_t)(tb + c * 64 + 4 * hh) * 2048 + h * 512 + vs * 128 + 32 * wv + r;
#pragma unroll
                for (int m = 0; m < 2; ++m)
#pragma unroll
                    for (int j = 0; j < 16; ++j) { const int cl = 32 * m + (j & 3) + 8 * (j >> 2); const float v = o[m][j] + *(const LAS float*)(LP(bP) + cl * 128); op[(size_t)cl * 2048] = (bf16_t)f2bf(v); }
            }
#pragma unroll
            for (int t4 = 0; t4 < 4; ++t4) {
#pragma unroll
                for (int j = 0; j < 16; ++j) Racc[t4][j] *= g64;
#pragma unroll
                for (int ks = 0; ks < 4; ++ks) { const bf16x8 af = lds_frag16(LP(bZ) + 32 * t4 * RT_TS + 32 * ks); Racc[t4] = MFMA32(af, Bv[ks], Racc[t4]); }
            }
            RT_SYNC();
            if (c + 1 < 32) RT_STOREL();
            RT_SYNC();
        }
    }
#undef RT_LOADG
#undef RT_STOREL
#undef LP
#undef LPW
}
__device__ __forceinline__ void retnorm_phase(const Frame& F, ArgsRef a) {
    const bf16_t* oret = (const bf16_t*)OUT(a); float* rn = (float*)(WS(a) + WS_MISC + MISC_RN);
    const int gw = F.bid * 8 + F.wave, NGW = F.G * 8;
    for (int i0 = gw * 8; i0 < T * 4; i0 += NGW * 8) {
        unsigned w4[8][4];
#pragma unroll
        for (int u = 0; u < 8; ++u) ld4u(oret + (size_t)(i0 + u) * 512 + F.lane * 8, w4[u]);
#pragma unroll
        for (int u = 0; u < 8; ++u) { float s = 0.f;
#pragma unroll
            for (int qq = 0; qq < 4; ++qq) { const float lo = bf2f(w4[u][qq] & 0xffffu), hi = bf2f(w4[u][qq] >> 16); s += lo * lo + hi * hi; }
            s = wave_sum(s); if (F.lane == 0) rn[i0 + u] = 1.0f / sqrtf(s * (1.0f / 512.f) + RMS_EPS); } }
}

__device__ __forceinline__ void rownorm_phase(const Frame& F, ArgsRef a) {
    const float* small = (const float*)(WS(a) + WS_SMALL); bf16_t* cqn = (bf16_t*)(WS(a) + WS_CQN); bf16_t* ckv = (bf16_t*)(WS(a) + WS_CKV); bf16_t* kidx = (bf16_t*)(WS(a) + WS_KIDX); float* widx = (float*)(WS(a) + WS_WIDX);
    const float* gkv = IN(a, I_CKV_G); const float* gki = IN(a, I_KIDX_G);
    const int gw = F.bid * 8 + F.wave, NGW = F.G * 8, l = F.lane;
    for (int tb4 = gw * 4; tb4 < T; tb4 += NGW * 4) { f32x4 va[4], vb[4];
#pragma unroll
      for (int u = 0; u < 4; ++u) { va[u] = *(const f32x4*)(small + (size_t)(tb4 + u) * 512 + 8 * l); vb[u] = *(const f32x4*)(small + (size_t)(tb4 + u) * 512 + 8 * l + 4); }
#pragma unroll
      for (int u = 0; u < 4; ++u) { const int t = tb4 + u; const f32x4 v0 = va[u], v1 = vb[u];
        const float ss = (v0[0] * v0[0] + v0[1] * v0[1]) + (v0[2] * v0[2] + v0[3] * v0[3]) + (v1[0] * v1[0] + v1[1] * v1[1]) + (v1[2] * v1[2] + v1[3] * v1[3]);
        const float sq = wave_sum(l < 32 ? ss : 0.f), skv = wave_sum((l >= 32 && l < 48) ? ss : 0.f), ski = wave_sum((l >= 48 && l < 56) ? ss : 0.f);
        float x[8] = {v0[0], v0[1], v0[2], v0[3], v1[0], v1[1], v1[2], v1[3]};
        if (l < 32) { const float r = 1.0f / sqrtf(sq * (1.f / 256.f) + RMS_EPS); u32x4 w; w.x = cvt_pk_bf16(x[0] * r, x[1] * r); w.y = cvt_pk_bf16(x[2] * r, x[3] * r); w.z = cvt_pk_bf16(x[4] * r, x[5] * r); w.w = cvt_pk_bf16(x[6] * r, x[7] * r); *(u32x4*)(cqn + (size_t)t * 256 + 8 * l) = w; }
        else if (l < 48) { const float r = 1.0f / sqrtf(skv * (1.f / 128.f) + RMS_EPS); const int c = 8 * (l - 32); const f32x4 g0 = *(const f32x4*)(gkv + c), g1 = *(const f32x4*)(gkv + c + 4);
            u32x4 w; w.x = cvt_pk_bf16(x[0] * r * g0[0], x[1] * r * g0[1]); w.y = cvt_pk_bf16(x[2] * r * g0[2], x[3] * r * g0[3]); w.z = cvt_pk_bf16(x[4] * r * g1[0], x[5] * r * g1[1]); w.w = cvt_pk_bf16(x[6] * r * g1[2], x[7] * r * g1[3]); *(u32x4*)(ckv + (size_t)t * 128 + c) = w; }
        else if (l < 56) { const float r = 1.0f / sqrtf(ski * (1.f / 64.f) + RMS_EPS); const int c = 8 * (l - 48); const f32x4 g0 = *(const f32x4*)(gki + c), g1 = *(const f32x4*)(gki + c + 4);
            u32x4 w; w.x = cvt_pk_bf16(x[0] * r * g0[0], x[1] * r * g0[1]); w.y = cvt_pk_bf16(x[2] * r * g0[2], x[3] * r * g0[3]); w.z = cvt_pk_bf16(x[4] * r * g1[0], x[5] * r * g1[1]); w.w = cvt_pk_bf16(x[6] * r * g1[2], x[7] * r * g1[3]); *(u32x4*)(kidx + (size_t)t * 64 + c) = w; }
        else if (l == 56) { const float sc = 0.35355339059327373f; *(f32x4*)(widx + (size_t)t * 8) = v0 * sc; *(f32x4*)(widx + (size_t)t * 8 + 4) = v1 * sc; }
      } }
}
struct EpiQ { static constexpr bool PERM = true;
    bf16_t* qlat; bf16_t* qidx;
    __device__ __forceinline__ void operator()(const f32x4 (&acc)[2][2][4][2], const pg8::Unit& u, int wr, int wc, int fr, int fq) const {
#pragma unroll
        for (int ai = 0; ai < 2; ++ai)
#pragma unroll
            for (int m = 0; m < 4; ++m) { const int row = u.pm * 256 + 128 * ai + 64 * wr + 16 * m + fr;
#pragma unroll
                for (int bj = 0; bj < 2; ++bj) { const int c = 128 * bj + 32 * wc + 8 * fq; bf16_t* p = u.pn < 4 ? qlat + (size_t)row * 1024 + u.pn * 256 + c : qidx + (size_t)row * 512 + (u.pn - 4) * 256 + c;
                    const f32x4 v0 = acc[ai][bj][m][0], v1 = acc[ai][bj][m][1]; u32x4 w; w.x = cvt_pk_bf16(v0[0], v0[1]); w.y = cvt_pk_bf16(v0[2], v0[3]); w.z = cvt_pk_bf16(v1[0], v1[1]); w.w = cvt_pk_bf16(v1[2], v1[3]); *(u32x4*)p = w; } }
    }
};
#define DPP_STEP_(op, ctrl, rmask) { const unsigned t_ = (unsigned)__builtin_amdgcn_update_dpp((int)v, (int)v, ctrl, rmask, 0xf, false); v = op(v, t_); }
__device__ __forceinline__ unsigned umax_(unsigned a, unsigned b) { return a > b ? a : b; }
__device__ __forceinline__ unsigned umin_(unsigned a, unsigned b) { return a < b ? a : b; }
__device__ __forceinline__ unsigned wave_umax(unsigned v) { DPP_STEP_(umax_, 0x111, 0xf) DPP_STEP_(umax_, 0x112, 0xf) DPP_STEP_(umax_, 0x114, 0xf) DPP_STEP_(umax_, 0x118, 0xf) DPP_STEP_(umax_, 0x142, 0xa) DPP_STEP_(umax_, 0x143, 0xc) return (unsigned)__builtin_amdgcn_readlane((int)v, 63); }
__device__ __forceinline__ unsigned wave_umin(unsigned v) { DPP_STEP_(umin_, 0x111, 0xf) DPP_STEP_(umin_, 0x112, 0xf) DPP_STEP_(umin_, 0x114, 0xf) DPP_STEP_(umin_, 0x118, 0xf) DPP_STEP_(umin_, 0x142, 0xa) DPP_STEP_(umin_, 0x143, 0xc) return (unsigned)__builtin_amdgcn_readlane((int)v, 63); }
template <int MODE> __device__ __forceinline__ void indexer_phase(const Frame& F, ArgsRef a) {
    const bf16_t* qidx = (const bf16_t*)(WS(a) + WS_QIDX); const bf16_t* kidx = (const bf16_t*)(WS(a) + WS_KIDX); const float* widx = (const float*)(WS(a) + WS_WIDX);
    unsigned long long* mask = (unsigned long long*)(WS(a) + WS_MASK);
    LAS float* sc = (LAS float*)(F.lds + LDS_STAGE); LAS float* wl = (LAS float*)(F.misc + LM_REC);
    const int lane = F.lane, w = F.wave, r = lane & 31, hh = lane >> 5;
    const int rq = 2 * (r >> 4) + ((r >> 2) & 1), rh = 4 * ((r >> 3) & 1) + (r & 3);
    for (int k8 = 0; k8 < 8; ++k8) {
        const int u = F.bid + F.G * k8; if (u >= NB * 128) break;
        const int b = u & 15, j = u >> 4, kk = j >> 4, cc = j & 15, blk = (kk & 1) ? 127 - 16 * (kk >> 1) - cc : 16 * (kk >> 1) + cc, qc = blk >> 2,     NK = 64 * (qc + 1), t0 = b * SEQ + 16 * blk;
        if (qc <= 3) {
            if (MODE == 0) for (int i = F.tid; i < 16 * 32; i += 512) { const int q = i >> 5, wi = i & 31; mask[(size_t)(t0 + q) * 32 + wi] = wi <= qc ? ~0ull : 0ull; }
            continue; }
        __syncthreads();
        if (F.tid < 128) wl[F.tid] = widx[(size_t)t0 * 8 + F.tid];
        bf16x8 A[4][4];
#pragma unroll
        for (int rt = 0; rt < 4; ++rt)
#pragma unroll
            for (int ks = 0; ks < 4; ++ks) A[rt][ks] = *(const bf16x8*)(qidx + (size_t)(t0 + 4 * rt + rq) * 512 + rh * 64 + 16 * ks + 8 * hh);
        __syncthreads();
        bf16x8 Bn[4];
#pragma unroll
        for (int ks = 0; ks < 4; ++ks) Bn[ks] = *(const bf16x8*)(kidx + (size_t)(b * SEQ + 32 * w + r) * 64 + 16 * ks + 8 * hh);
        if (MODE != 2) for (int kt = w; kt < NK / 32; kt += 8) {
            bf16x8 B[4];
#pragma unroll
            for (int ks = 0; ks < 4; ++ks) B[ks] = Bn[ks];
            if (kt + 8 < NK / 32) {
#pragma unroll
                for (int ks = 0; ks < 4; ++ks) Bn[ks] = *(const bf16x8*)(kidx + (size_t)(b * SEQ + 32 * (kt + 8) + r) * 64 + 16 * ks + 8 * hh); }
#pragma unroll
            for (int rt = 0; rt < 4; ++rt) { f32x16 c;
#pragma unroll
                for (int i = 0; i < 16; ++i) c[i] = 0.f;
#pragma unroll
                for (int ks = 0; ks < 4; ++ks) c = MFMA32(A[rt][ks], B[ks], c);
#pragma unroll
                for (int aa = 0; aa < 2; ++aa) { const int q = 4 * rt + 2 * aa + hh; const f32x4 w0 = *(const LAS f32x4*)(wl + q * 8), w1 = *(const LAS f32x4*)(wl + q * 8 + 4);
                    float s = 0.f;
#pragma unroll
                    for (int d = 0; d < 4; ++d) { s += fmaxf(c[8 * aa + d], 0.f) * w0[d]; s += fmaxf(c[8 * aa + 4 + d], 0.f) * w1[d]; }
                    sc[q * 2048 + 32 * kt + r] = s; } }
        }
        __syncthreads();
        if (MODE != 1)
#pragma unroll 1
        for (int qq = 0; qq < 2; ++qq) { const int q = 2 * w + qq; unsigned uu[32]; int nk = NK; asm volatile("" : "+s"(nk));
#pragma unroll
            for (int i = 0; i < 32; ++i) { const float f = sc[q * 2048 + 64 * i + lane]; const unsigned bits = __builtin_bit_cast(unsigned, f); const unsigned vm = (unsigned)((64 * i + lane - nk) >> 31); uu[i] = (bits ^ ((bits >> 31) ? 0xffffffffu : 0x80000000u)) & vm; }
            unsigned lo = 0xffffffffu, hi = 0u;
#pragma unroll
            for (int i = 0; i < 32; ++i) { const unsigned v = uu[i]; hi = v > hi ? v : hi; const unsigned vv = v ? v : 0xffffffffu; lo = vv < lo ? vv : lo; }
            lo = wave_umin(lo); hi = wave_umax(hi);
            unsigned theta = lo; bool exact = false; int chi = 0;
#pragma unroll 1
            while (lo < hi) { const unsigned mid = lo + ((hi - lo) >> 1) + 1u;
                int cnt = 0;
#pragma unroll
                for (int i8 = 0; i8 < 32; i8 += 8) { unsigned long long mk[8];
#pragma unroll
                    for (int i = 0; i < 8; ++i) mk[i] = __ballot(uu[i8 + i] >= mid);
                    __builtin_amdgcn_sched_barrier(0);
#pragma unroll
                    for (int i = 0; i < 8; ++i) cnt += __builtin_popcountll(mk[i]);
                    __builtin_amdgcn_sched_barrier(0); }
                if (cnt == 256) { theta = mid; exact = true; break; }
                if (cnt > 256) lo = mid; else { hi = mid - 1u; chi = cnt; }
                theta = lo; }
            unsigned wlo_ = 0u, whi_ = 0u;
            if (exact) {
#pragma unroll
                for (int i = 0; i < 32; ++i) { const unsigned long long word = __ballot(uu[i] >= theta); wlo_ = lane == i ? (unsigned)word : wlo_; whi_ = lane == i ? (unsigned)(word >> 32) : whi_; }
            } else { const int need = 256 - chi; int run = 0;
#pragma unroll
                for (int i = 0; i < 32; ++i) { const unsigned long long m = __ballot(uu[i] == theta); const int pre = run + __builtin_popcountll(m & ((1ull << lane) - 1ull));
                    const bool sel = (uu[i] > theta) || (uu[i] == theta && pre < need); run += __builtin_popcountll(m);
                    const unsigned long long word = __ballot(sel); wlo_ = lane == i ? (unsigned)word : wlo_; whi_ = lane == i ? (unsigned)(word >> 32) : whi_; } }
            if (MODE == 0 && lane < 32) { u32x2 w2; w2.x = wlo_; w2.y = whi_; *(u32x2*)(mask + (size_t)(t0 + q) * 32 + lane) = w2; }
            if (MODE == 2) asm volatile("" :: "v"(wlo_), "v"(whi_));
        }
    }
}

namespace att {
constexpr int SHM_V = 64 * 128 * 2, SHM_K = 64 * 128 * 2, LDS_MSK = 3 * SHM_V + 3 * SHM_K, LDS_BT = LDS_MSK + 8192, LDS_WS = LDS_BT + 8 * 320 * 4, LDS_END = LDS_WS + 8 * 64 * 4;
#define KSWZ(row, colB) ((row) * 256 + ((colB) ^ (((row) & 7) << 4)))
#define SBAR() __builtin_amdgcn_sched_barrier(0)
__device__ __forceinline__ int crow(int r, int hi) { return (r & 3) + 8 * (r >> 2) + 4 * hi; }
__device__ __forceinline__ int v_st(int k, int c) { const int kk = (k & ~0xC) | ((k & 4) << 1) | ((k & 8) >> 1); return ((kk >> 3) * 4 + (c >> 5)) * 512 + ((kk & 7) * 32 + (c & 31)) * 2; }
__device__ __forceinline__ int v_rd_base(int lane) { return ((lane & 3) << 3) | (((lane >> 2) & 3) << 6) | (((lane >> 4) & 1) << 5) | (((lane >> 5) & 1) << 8); }
constexpr int v_rd_off(int d0, int ks, int half) { return d0 * 512 + ks * 4096 + half * 2048; }
template <int OFF> __device__ __forceinline__ s16x4 tr_read(int vb) { s16x4 r; asm volatile("ds_read_b64_tr_b16 %0, %1 offset:%2" : "=&v"(r) : "v"(vb), "i"(OFF) : "memory"); return r; }
template <int D0> __device__ __forceinline__ void pv_one(f32x16& od, int vb, bf16x8 pa0, bf16x8 pa1, bf16x8 pa2, bf16x8 pa3) {
    const s16x4 l0 = tr_read<v_rd_off(D0, 0, 0)>(vb), h0 = tr_read<v_rd_off(D0, 0, 1)>(vb), l1 = tr_read<v_rd_off(D0, 1, 0)>(vb), h1 = tr_read<v_rd_off(D0, 1, 1)>(vb);
    const s16x4 l2 = tr_read<v_rd_off(D0, 2, 0)>(vb), h2 = tr_read<v_rd_off(D0, 2, 1)>(vb), l3 = tr_read<v_rd_off(D0, 3, 0)>(vb), h3 = tr_read<v_rd_off(D0, 3, 1)>(vb);
    asm volatile("s_waitcnt lgkmcnt(0)" ::: "memory"); SBAR();
#define PK(L, H) (bf16x8){L[0], L[1], L[2], L[3], H[0], H[1], H[2], H[3]}
    od = MFMA32(pa0, PK(l0, h0), od); od = MFMA32(pa1, PK(l1, h1), od); od = MFMA32(pa2, PK(l2, h2), od); od = MFMA32(pa3, PK(l3, h3), od);
#undef PK
}
__device__ __forceinline__ void pv_d0(f32x16* o, int vb, bf16x8 pa0, bf16x8 pa1, bf16x8 pa2, bf16x8 pa3) {
    pv_one<0>(o[0], vb, pa0, pa1, pa2, pa3); pv_one<1>(o[1], vb, pa0, pa1, pa2, pa3); pv_one<2>(o[2], vb, pa0, pa1, pa2, pa3); pv_one<3>(o[3], vb, pa0, pa1, pa2, pa3);
}
__device__ __forceinline__ void qkt(f32x16& p0, f32x16& p1, const LAS unsigned char* Ks, const bf16x8* qr, int r32, int hi) {
#pragma unroll
    for (int i = 0; i < 16; ++i) { p0[i] = 0.f; p1[i] = 0.f; }
#pragma unroll
    for (int d0 = 0; d0 < 8; ++d0) { const int cb = (d0 * 16 + hi * 8) * 2;
        const bf16x8 b0 = *(const LAS bf16x8*)(Ks + KSWZ(r32, cb)), b1 = *(const LAS bf16x8*)(Ks + KSWZ(32 + r32, cb));
        p0 = MFMA32(b0, qr[d0], p0); p1 = MFMA32(b1, qr[d0], p1); }
}
template <bool NEAR> __device__ __forceinline__ void bias_mask(f32x16& p0, f32x16& p1, unsigned wlo, unsigned whi, float bfar, const LAS float* bt, int relbase) {
    constexpr float C = 0.088388347648318440f * 1.4426950408889634f;
    asm volatile("" : "+v"(wlo), "+v"(whi));
#pragma unroll
    for (int r = 0; r < 16; ++r) { const int cr = (r & 3) + 8 * (r >> 2);
        const float b0 = NEAR ? bt[relbase + cr] : bfar, b1 = NEAR ? bt[relbase + 32 + cr] : bfar;
        const float s0 = fmaf(p0[r], C, b0), s1 = fmaf(p1[r], C, b1);
        p0[r] = (wlo & (1u << cr)) ? s0 : -INFINITY; p1[r] = (whi & (1u << cr)) ? s1 : -INFINITY; }
}
__device__ __forceinline__ void partialSM(f32x16& p0, f32x16& p1, float& m_reg, float& mn, float& alpha) {
    float pmax = p0[0];
#pragma unroll
    for (int r = 1; r < 16; ++r) pmax = fmaxf(pmax, p0[r]);
#pragma unroll
    for (int r = 0; r < 16; ++r) pmax = fmaxf(pmax, p1[r]);
    { auto rr = __builtin_amdgcn_permlane32_swap(__float_as_uint(pmax), __float_as_uint(pmax), false, false); pmax = fmaxf(__uint_as_float(rr[0]), __uint_as_float(rr[1])); }
    if (__all(pmax <= m_reg)) { mn = m_reg; alpha = 1.f; }
    else { mn = fmaxf(m_reg, pmax); alpha = __builtin_amdgcn_exp2f(m_reg - mn); m_reg = mn; }
#pragma unroll
    for (int r = 0; r < 16; ++r) p0[r] = __builtin_amdgcn_exp2f(p0[r] - mn);
}
__device__ __forceinline__ void finishSM(f32x16& p0, f32x16& p1, float mn, float alpha, float& l_reg, bf16x8& pa0, bf16x8& pa1, bf16x8& pa2, bf16x8& pa3) {
#pragma unroll
    for (int r = 0; r < 16; ++r) p1[r] = __builtin_amdgcn_exp2f(p1[r] - mn);
    float ps = 0;
#pragma unroll
    for (int r = 0; r < 16; ++r) ps += p0[r];
#pragma unroll
    for (int r = 0; r < 16; ++r) ps += p1[r];
    { auto rr = __builtin_amdgcn_permlane32_swap(__float_as_uint(ps), __float_as_uint(ps), false, false); ps = __uint_as_float(rr[0]) + __uint_as_float(rr[1]); }
    l_reg = l_reg * alpha + ps;
#define PK4(P, BASE, OUT) do { unsigned a0 = cvt_pk_bf16(P[BASE + 0], P[BASE + 1]), a1 = cvt_pk_bf16(P[BASE + 2], P[BASE + 3]); \
    unsigned b0 = cvt_pk_bf16(P[BASE + 4], P[BASE + 5]), b1 = cvt_pk_bf16(P[BASE + 6], P[BASE + 7]); \
    auto r0 = __builtin_amdgcn_permlane32_swap(a0, b0, false, false); auto r1 = __builtin_amdgcn_permlane32_swap(a1, b1, false, false); \
    u32x4 w = {r0[0], r1[0], r0[1], r1[1]}; OUT = __builtin_bit_cast(bf16x8, w); } while (0)
    PK4(p0, 0, pa0); PK4(p0, 8, pa1); PK4(p1, 0, pa2); PK4(p1, 8, pa3);
#undef PK4
}
}
__device__ __forceinline__ int t5_bucket_abs(int n) { return n < 8 ? n : n < 12 ? 8 : n < 16 ? 9 : n < 23 ? 10 : n < 32 ? 11 : n < 46 ? 12 : n < 64 ? 13 : n < 91 ? 14 : 15; }
__device__ __forceinline__ void attention_phase(const Frame& F, ArgsRef a) {
    using namespace att;
    const bf16_t* qlat = (const bf16_t*)(WS(a) + WS_QLAT); const bf16_t* ckv = (const bf16_t*)(WS(a) + WS_CKV); const unsigned* mask = (const unsigned*)(WS(a) + WS_MASK); bf16_t* olat = (bf16_t*)(WS(a) + WS_OLAT);
    LAS unsigned char* L = F.lds + LDS_STAGE; LAS unsigned char* V_lds = L; LAS unsigned char* K_lds = L + 3 * SHM_V;
    LAS unsigned* msk = (LAS unsigned*)(L + LDS_MSK); LAS float* bt = (LAS float*)(L + LDS_BT);
    const int tid = F.tid, wid = F.wave, lane = F.lane, r32 = lane & 31, hi = lane >> 5, hd = r32 & 7;
    LAS float* wsx = (LAS float*)(L + LDS_WS) + wid * 64; LAS float* li_l = wsx; LAS float* al_l = wsx + 32;
    __syncthreads();
    for (int i = tid; i < 8 * 320; i += 512) { const int h = i / 320, rel = (i % 320) - 255; const int n = rel < 0 ? -rel : rel; bt[i] = IN(a, I_T5)[h * 32 + (rel > 0 ? 16 : 0) + t5_bucket_abs(n)] * 1.4426950408889634f; }
    const float bfar = IN(a, I_T5)[hd * 32 + 15] * 1.4426950408889634f;
    for (int k4 = 0; k4 < 4; ++k4) {
        const int u = F.bid + F.G * k4; if (u >= NB * 64) break;
        const int b = u & 15, j = u >> 4, kk = j >> 4, cc = j & 15, blk = (kk & 1) ? 63 - 16 * (kk >> 1) - cc : 16 * (kk >> 1) + cc, qc = blk >> 1,     t0 = b * SEQ + 32 * blk, NT = qc + 1;
        __syncthreads();
        for (int i = tid; i < 32 * 64; i += 512) msk[i] = mask[(size_t)t0 * 64 + i];
        const bf16_t* Kh = ckv + (size_t)b * SEQ * 128;
        const int qi = 4 * wid + (r32 >> 3), qpos = 32 * blk + qi;
        float m_reg = -1e30f, l_reg = 0.f; f32x16 o[4]; bf16x8 qr[8];
#pragma unroll
        for (int d = 0; d < 4; ++d)
#pragma unroll
            for (int i = 0; i < 16; ++i) o[d][i] = 0.f;
        const bf16_t* Qw = qlat + (size_t)(t0 * 8 + wid * 32 + r32) * 128 + hi * 8;
#pragma unroll
        for (int d0 = 0; d0 < 8; ++d0) qr[d0] = *(const bf16x8*)(Qw + d0 * 16);
        const int sr = tid >> 4, scol = (tid & 15) * 8, vst0 = v_st(sr, scol), vst1 = v_st(32 + sr, scol);
        const int vb0 = (int)(uintptr_t)V_lds + v_rd_base(lane);
        bf16x8 st0[1], st1[1];
#define SLOAD(i, k0) do { st0[i] = *(const bf16x8*)(Kh + (size_t)((k0) + sr) * 128 + scol); st1[i] = *(const bf16x8*)(Kh + (size_t)((k0) + 32 + sr) * 128 + scol); } while (0)
#define SWRITE(bb, i) do { *(LAS bf16x8*)(V_lds + (bb) * SHM_V + vst0) = st0[i]; *(LAS bf16x8*)(V_lds + (bb) * SHM_V + vst1) = st1[i]; const int kc = scol * 2; \
        *(LAS bf16x8*)(K_lds + (bb) * SHM_K + KSWZ(sr, kc)) = st0[i]; *(LAS bf16x8*)(K_lds + (bb) * SHM_K + KSWZ(32 + sr, kc)) = st1[i]; } while (0)
#define SWAIT() asm volatile("s_waitcnt vmcnt(2)" ::: "memory")
#define RESC(al) do { if (__any((al) < 1.f)) { if (hi == 0) al_l[r32] = (al); asm volatile("s_waitcnt lgkmcnt(0)" ::: "memory"); \
        _Pragma("unroll") for (int d = 0; d < 4; ++d) _Pragma("unroll") for (int r = 0; r < 16; ++r) o[d][r] *= al_l[crow(r, hi)]; } } while (0)
#define BIASMASK(P0, P1, jt) do { const unsigned wl_ = msk[qi * 64 + 2 * (jt)] >> (4 * hi), wh_ = msk[qi * 64 + 2 * (jt) + 1] >> (4 * hi); \
        if (64 * (jt) + 63 - 32 * blk > -128) bias_mask<true>(P0, P1, wl_, wh_, bfar, bt + hd * 320, 64 * (jt) + 4 * hi - qpos + 255); else bias_mask<false>(P0, P1, wl_, wh_, bfar, bt, 0); } while (0)
        f32x16 p0, p1; float mn, al; bf16x8 pa0, pa1, pa2, pa3;
        SLOAD(0, 0); asm volatile("s_waitcnt vmcnt(0)" ::: "memory"); SWRITE(0, 0); __syncthreads();
        for (int jt = 0, bb = 0; jt < NT; ++jt) { const int nb = bb == 2 ? 0 : bb + 1;
            if (jt + 1 < NT) SLOAD(0, (jt + 1) * 64);
            qkt(p0, p1, K_lds + bb * SHM_K, qr, r32, hi); BIASMASK(p0, p1, jt);
            partialSM(p0, p1, m_reg, mn, al); finishSM(p0, p1, mn, al, l_reg, pa0, pa1, pa2, pa3); SBAR();
            RESC(al);
            pv_d0(o, vb0 + bb * SHM_V, pa0, pa1, pa2, pa3);
            if (jt + 1 < NT) SWRITE(nb, 0);
            __syncthreads();
            bb = nb;
        }
        if (hi == 0) li_l[r32] = l_reg; asm volatile("s_waitcnt lgkmcnt(0)" ::: "memory");
        float rli[16];
#pragma unroll
        for (int r = 0; r < 16; ++r) rli[r] = __builtin_amdgcn_rcpf(li_l[crow(r, hi)]);
        if constexpr (MIXA_FP8) { unsigned char* O8 = (unsigned char*)olat + (size_t)(t0 * 8 + wid * 32) * 128 + 4 * r32;
#pragma unroll
            for (int r = 0; r < 16; ++r) { const float sc_ = rli[r] * 4.f; *(unsigned*)(O8 + (size_t)crow(r, hi) * 128) = pk4_fp8(o[0][r] * sc_, o[1][r] * sc_, o[2][r] * sc_, o[3][r] * sc_); } }
        else { bf16_t* Ow = olat + (size_t)(t0 * 8 + wid * 32) * 128;
#pragma unroll
        for (int r = 0; r < 16; ++r) { const int orow = crow(r, hi);
#pragma unroll
            for (int d0 = 0; d0 < 4; ++d0) Ow[(size_t)orow * 128 + d0 * 32 + r32] = (bf16_t)f2bf(o[d0][r] * rli[r]); } }
#undef SLOAD
#undef SWRITE
#undef SWAIT
#undef RESC
#undef BIASMASK
    }
}
#undef KSWZ
#undef SBAR

__device__ __forceinline__ void grid_bar(unsigned char* lds_raw) {
    ArgsRef a = phase_args(); XcdBarrier b; b.bar = (unsigned*)(WS(a) + WS_CTL) + CW_BAR; b.x = xb_xcc_id(); b.st = (volatile LAS unsigned*)((LAS unsigned char*)lds_raw + LDS_MISC + LM_BAR);
    xcd_barrier(b);
}
template <int HALFI> __device__ __forceinline__ void moe_gateup_phase(unsigned char* lds_raw) {
    ArgsRef a = phase_args(); const Frame F = make_frame(lds_raw);
    const int ntiles = moe_tables(F, a, HALFI);
    const int* lists = (const int*)(WS(a) + WS_LTOK) + (size_t)HALFI * NE * LIST_CAP; const float* lrs = (const float*)(WS(a) + WS_LRS) + (size_t)HALFI * NE * LIST_CAP;
    typedef MoeOrder<8, true, MOE_FP8 ? 1024 : 2048> Ord;
    Ord S{(const LAS int*)(F.misc + LM_TILE), (const LAS int*)(F.misc + LM_CNT), lists, ntiles, F.G, F.bid};
    EpiGateUp E{(bf16_t*)(WS(a) + WS_ACT), IN(a, I_B_GATE), IN(a, I_B_UP), lrs, (const LAS int*)(F.misc + LM_CNT)};
    pg8::gemm_phase<EpiGateUp, Ord, false, true, MOE_FP8 ? D / 2 : D, MOE_FP8>(F.lds + LDS_STAGE, F.tid, (const bf16_t*)(WS(a) + WS_X2B), (const bf16_t*)(WS(a) + WS_WGU), S, E, (LAS u32x4*)(F.misc + LM_SLOTS));
}
template <int HALFI> __device__ __forceinline__ void moe_down_phase(unsigned char* lds_raw) {
    ArgsRef a = phase_args(); const Frame F = make_frame(lds_raw);
    const int ntiles = moe_tables(F, a, HALFI);
    typedef MoeOrder<4, false, MOE_FP8 ? 1024 : 2048> Ord;
    Ord S{(const LAS int*)(F.misc + LM_TILE), (const LAS int*)(F.misc + LM_CNT), nullptr, ntiles, F.G, F.bid};
    EpiDown E{(bf16_t*)(WS(a) + WS_Y), IN(a, I_B_DOWN)};
    pg8::gemm_phase<EpiDown, Ord, false, false, MOE_FP8 ? FF / 2 : FF, MOE_FP8>(F.lds + LDS_STAGE, F.tid, (const bf16_t*)(WS(a) + WS_ACT), (const bf16_t*)(WS(a) + WS_WD), S, E);
}
template <int HALFI> __device__ __forceinline__ void moe_gateup_probe(unsigned char* lds_raw) {
    ArgsRef a = phase_args(); const Frame F = make_frame(lds_raw);
    const int ntiles = moe_tables(F, a, HALFI);
    const int* lists = (const int*)(WS(a) + WS_LTOK) + (size_t)HALFI * NE * LIST_CAP;
    typedef MoeOrder<8, true, MOE_FP8 ? 1024 : 2048> Ord;
    Ord S{(const LAS int*)(F.misc + LM_TILE), (const LAS int*)(F.misc + LM_CNT), lists, ntiles, F.G, F.bid};
    EpiProbe E{(float*)(WS(a) + WS_Y)};
    pg8::gemm_phase<EpiProbe, Ord, false, true, MOE_FP8 ? D / 2 : D, MOE_FP8>(F.lds + LDS_STAGE, F.tid, (const bf16_t*)(WS(a) + WS_X2B), (const bf16_t*)(WS(a) + WS_WGU), S, E, (LAS u32x4*)(F.misc + LM_SLOTS));
}
template <int HALFI> __device__ __forceinline__ void moe_down_probe(unsigned char* lds_raw) {
    ArgsRef a = phase_args(); const Frame F = make_frame(lds_raw);
    const int ntiles = moe_tables(F, a, HALFI);
    typedef MoeOrder<4, false, MOE_FP8 ? 1024 : 2048> Ord;
    Ord S{(const LAS int*)(F.misc + LM_TILE), (const LAS int*)(F.misc + LM_CNT), nullptr, ntiles, F.G, F.bid};
    EpiProbe E{(float*)(WS(a) + WS_X2B)};
    pg8::gemm_phase<EpiProbe, Ord, false, false, MOE_FP8 ? FF / 2 : FF, MOE_FP8>(F.lds + LDS_STAGE, F.tid, (const bf16_t*)(WS(a) + WS_ACT), (const bf16_t*)(WS(a) + WS_WD), S, E);
}
template <int HALFI> __device__ __forceinline__ void moe_combine_phase(unsigned char* lds_raw) {
    ArgsRef a = phase_args(); const Frame F = make_frame(lds_raw);
    (void)moe_tables(F, a, HALFI);
    combine_phase(F, a, HALFI);
}
__device__ __forceinline__ void prep_phase(unsigned char* lds_raw) { ArgsRef a = phase_args(); const Frame F = make_frame(lds_raw); mixer_prep_phase(F, a); }
#ifndef PREP2MASK
#define PREP2MASK 63
#endif
__device__ __forceinline__ void prep2_phase(unsigned char* lds_raw) { ArgsRef a = phase_args(); const Frame F = make_frame(lds_raw); mixer_prep_phase<PREP2MASK>(F, a); }
__device__ __forceinline__ void inproj_a_phase(unsigned char* lds_raw) {
    ArgsRef a = phase_args(); const Frame F = make_frame(lds_raw); const float* misc = (const float*)(WS(a) + WS_MISC);
    { DenseOrder S; S.init(T, 6 * 256, D, F.G, F.bid, 0, 0);
      EpiInA E{(bf16_t*)(WS(a) + WS_QX), (float*)(WS(a) + WS_SMALL), misc + MISC_RSTD1 / 4, (const float*)(WS(a) + WS_COSP), (const float*)(WS(a) + WS_SINP), misc + MISC_DQ / 4,
               (bf16_t*)(WS(a) + WS_CQN), (bf16_t*)(WS(a) + WS_CKV), (bf16_t*)(WS(a) + WS_KIDX), (float*)(WS(a) + WS_WIDX), IN(a, I_CKV_G), IN(a, I_KIDX_G), (LAS float*)(F.misc + 17408)};
      pg8::gemm_phase<EpiInA, DenseOrder, false, false, D>(F.lds + LDS_STAGE, F.tid, (const bf16_t*)(WS(a) + WS_XB), (const bf16_t*)(WS(a) + WS_WIN), S, E); }
}
__device__ __forceinline__ void inproj_b_phase(unsigned char* lds_raw) {
    ArgsRef a = phase_args(); const Frame F = make_frame(lds_raw); const float* misc = (const float*)(WS(a) + WS_MISC);
    if constexpr (INB_FP8) {
      { DenseOrder S; S.init(T, 4 * 256, D, F.G, F.bid, 0, (size_t)6 * 256 * D * 2);
        EpiInB<0, false> E{(bf16_t*)(WS(a) + WS_KZT), (bf16_t*)(WS(a) + WS_VT), misc + MISC_RSTD1 / 4, (const float*)(WS(a) + WS_COST), (const float*)(WS(a) + WS_SINT), misc + MISC_DZ / 4};
        pg8::gemm_phase<EpiInB<0, false>, DenseOrder, true, false, D>(F.lds + LDS_STAGE, F.tid, (const bf16_t*)(WS(a) + WS_XB), (const bf16_t*)(WS(a) + WS_WIN), S, E); }
      { DenseOrder S; S.init(T, 8 * 256, D / 2, F.G, F.bid, 0, 0);
        EpiInB<4, true> E{(bf16_t*)(WS(a) + WS_KZT), (bf16_t*)(WS(a) + WS_VT), misc + MISC_RSTD1 / 4, (const float*)(WS(a) + WS_COST), (const float*)(WS(a) + WS_SINT), misc + MISC_DZ / 4};
        pg8::gemm_phase<EpiInB<4, true>, DenseOrder, true, false, D / 2, true>(F.lds + LDS_STAGE, F.tid, (const bf16_t*)(WS(a) + WS_XB8), (const bf16_t*)(WS(a) + WS_WIN8 + 4 * MiB), S, E); }
    } else {
      DenseOrder S; S.init(T, 12 * 256, D, F.G, F.bid, 0, (size_t)6 * 256 * D * 2);
      EpiInB<0, false> E{(bf16_t*)(WS(a) + WS_KZT), (bf16_t*)(WS(a) + WS_VT), misc + MISC_RSTD1 / 4, (const float*)(WS(a) + WS_COST), (const float*)(WS(a) + WS_SINT), misc + MISC_DZ / 4};
      pg8::gemm_phase<EpiInB<0, false>, DenseOrder, true, false, D>(F.lds + LDS_STAGE, F.tid, (const bf16_t*)(WS(a) + WS_XB), (const bf16_t*)(WS(a) + WS_WIN), S, E); }
}
__device__ __forceinline__ void inproj_c_phase(unsigned char* lds_raw) {
    ArgsRef a = phase_args(); const Frame F = make_frame(lds_raw); const float* misc = (const float*)(WS(a) + WS_MISC);
    DenseOrder S; S.init(T, 16 * 256, INC_FP8 ? D / 2 : D, F.G, F.bid, 0, INC_FP8 ? (size_t)0 : (size_t)18 * 256 * D * 2);
    EpiInC E{(bf16_t*)OUT(a), (bf16_t*)(WS(a) + WS_GA), (bf16_t*)(WS(a) + WS_GB), misc + MISC_RSTD1 / 4, misc + MISC_RN / 4};
    pg8::gemm_phase<EpiInC, DenseOrder, false, false, INC_FP8 ? D / 2 : D, INC_FP8>(F.lds + LDS_STAGE, F.tid, (const bf16_t*)(WS(a) + (INC_FP8 ? WS_XB8 : WS_XB)), (const bf16_t*)(WS(a) + (INC_FP8 ? WS_WIN8 : WS_WIN)), S, E);
}
__device__ __forceinline__ void retention_phase_w(unsigned char* lds_raw) { ArgsRef a = phase_args(); const Frame F = make_frame(lds_raw); retention_phase(F, a); }
__device__ __forceinline__ void retnorm_phase_w(unsigned char* lds_raw) { ArgsRef a = phase_args(); const Frame F = make_frame(lds_raw); retnorm_phase(F, a); }
__device__ __forceinline__ void mix_a_phase(unsigned char* lds_raw) {
    ArgsRef a = phase_args(); const Frame F = make_frame(lds_raw);
    DenseOrder S; S.init(T, D, MIXA_FP8 ? D / 2 : D, F.G, F.bid, 0, 0);
    EpiMix<0, MIXA_FP8> E{(const bf16_t*)(WS(a) + WS_GA), (bf16_t*)(WS(a) + WS_MIXA), (bf16_t*)(WS(a) + WS_MIX)};
    pg8::gemm_phase<EpiMix<0, MIXA_FP8>, DenseOrder, false, false, MIXA_FP8 ? D / 2 : D, MIXA_FP8>(F.lds + LDS_STAGE, F.tid, (const bf16_t*)(WS(a) + WS_OLAT), (const bf16_t*)(WS(a) + WS_WA), S, E);
}
__device__ __forceinline__ void mix_b_phase(unsigned char* lds_raw) {
    ArgsRef a = phase_args(); const Frame F = make_frame(lds_raw);
    DenseOrder S; S.init(T, D, 2048, F.G, F.bid, 0, 0);
    EpiMix<1> E{(const bf16_t*)(WS(a) + WS_GB), (bf16_t*)(WS(a) + WS_MIXA), (bf16_t*)(WS(a) + WS_MIX)};
    pg8::gemm_phase<EpiMix<1>, DenseOrder, false, false, 2048>(F.lds + LDS_STAGE, F.tid, (const bf16_t*)OUT(a), (const bf16_t*)(WS(a) + WS_WB), S, E);
}
__device__ __forceinline__ void rownorm_phase_w(unsigned char* lds_raw) { ArgsRef a = phase_args(); const Frame F = make_frame(lds_raw); rownorm_phase(F, a); }
__device__ __forceinline__ void qproj_phase(unsigned char* lds_raw) {
    ArgsRef a = phase_args(); const Frame F = make_frame(lds_raw);
    DenseOrder S; S.init(T, 1536, 256, F.G, F.bid, 0, 0);
    EpiQ E{(bf16_t*)(WS(a) + WS_QLAT), (bf16_t*)(WS(a) + WS_QIDX)};
    pg8::gemm_phase<EpiQ, DenseOrder, false, false, 256>(F.lds + LDS_STAGE, F.tid, (const bf16_t*)(WS(a) + WS_CQN), (const bf16_t*)(WS(a) + WS_WQ), S, E);
}
__device__ __forceinline__ void indexer_phase_w(unsigned char* lds_raw) { ArgsRef a = phase_args(); const Frame F = make_frame(lds_raw); indexer_phase<0>(F, a); }
template <int MODE> __device__ __forceinline__ void indexer_probe_w(unsigned char* lds_raw) { ArgsRef a = phase_args(); const Frame F = make_frame(lds_raw); indexer_phase<MODE>(F, a); }
__device__ __forceinline__ void attention_phase_w(unsigned char* lds_raw) { ArgsRef a = phase_args(); const Frame F = make_frame(lds_raw); attention_phase(F, a); }
__device__ __forceinline__ void out_phase(unsigned char* lds_raw) {
    ArgsRef a = phase_args(); const Frame F = make_frame(lds_raw);
    DenseOrder S; S.init(T, D, D, F.G, F.bid, 0, 0);
    EpiOut E{(const bf16_t*)(WS(a) + WS_XB), X2H ? (float*)(WS(a) + WS_X2H) : OUT(a), (bf16_t*)(WS(a) + WS_X2B)};
    pg8::gemm_phase<EpiOut, DenseOrder, false, false, D>(F.lds + LDS_STAGE, F.tid, (const bf16_t*)(WS(a) + WS_MIX), (const bf16_t*)(WS(a) + WS_WOUT), S, E);
}
__device__ __forceinline__ void convert_only_phase(unsigned char* lds_raw) { ArgsRef a = phase_args(); const Frame F = make_frame(lds_raw); moe_weight_convert(F, a); }
__device__ __forceinline__ void router_phase_w(unsigned char* lds_raw) { ArgsRef a = phase_args(); const Frame F = make_frame(lds_raw); moe_weight_convert(F, a); __syncthreads(); router_phase(F, a); }

#ifdef DIAG2
__device__ __forceinline__ void diag_ck(unsigned char* lds_raw, int k, const void* buf, size_t chunk_bytes) {
    grid_bar(lds_raw);
    ArgsRef a = phase_args(); unsigned* sums = (unsigned*)(WS(a) + WS_CTL + 256 * 1024) + k * 16384; unsigned* nbad = (unsigned*)(WS(a) + WS_CTL) + 16384 + 64 * k; const int gw = blockIdx.x * 8 + (threadIdx.x >> 6), lane = threadIdx.x & 63;
    for (int c = gw; c < 16384; c += gridDim.x * 8) { const unsigned* p = (const unsigned*)((const char*)buf + (size_t)c * chunk_bytes); unsigned sm = 0u; for (size_t i = lane; i < chunk_bytes / 4; i += 64) sm += p[i] * (unsigned)(2 * i + 1);
        for (int o = 1; o < 64; o <<= 1) sm += __shfl_xor(sm, o);
        if (lane == 0) { if (a.pass == 0) sums[c] = sm; else if (sums[c] != sm) atomicAdd(nbad, 1u); } }
    grid_bar(lds_raw);
}
__device__ __forceinline__ void diag_final(unsigned char* lds_raw) {
    grid_bar(lds_raw);
    ArgsRef a = phase_args(); const unsigned* nbad = (const unsigned*)(WS(a) + WS_CTL) + 16384; float c = 0.f;
    if (a.pass == 1) { for (int k = 0; k < 4; ++k) if (__hip_atomic_load(nbad + 64 * k, __ATOMIC_RELAXED, __HIP_MEMORY_SCOPE_AGENT) > 0u) c += (float)(1 << k); }
    grid_bar(lds_raw);
    for (size_t i = (size_t)blockIdx.x * 512 + threadIdx.x; i < (size_t)T * D; i += (size_t)gridDim.x * 512) OUT(a)[i] = c;
}
#endif
__global__ void __launch_bounds__(512, 2) fwd(Args a_unused) {
    extern __shared__ __attribute__((aligned(16))) unsigned char lds_raw[];
    { ArgsRef a = phase_args(); LAS unsigned* st = (LAS unsigned*)((LAS unsigned char*)lds_raw + LDS_MISC + LM_BAR);
      if (threadIdx.x < 4) st[threadIdx.x] = 0u;
      __syncthreads();
      (void)xcd_barrier_post((unsigned*)(WS(a) + WS_CTL) + CW_BAR, (volatile LAS unsigned*)st); }
#ifndef DUP
#define DUP 0u
#endif
#ifndef PHSEL
#define PHSEL 0xffffffffu
#endif
#define GRID_BAR() grid_bar(lds_raw)
#ifdef ZERO_OUT_FIRST
    { float* o_ = OUT(phase_args()); for (size_t i = (size_t)blockIdx.x * 512 + threadIdx.x; i < (size_t)T * D / 4; i += (size_t)gridDim.x * 512) ((f32x4*)o_)[i] = (f32x4){0.f, 0.f, 0.f, 0.f}; }
#endif
    if (PHSEL & (1u << 0)) prep_phase(lds_raw);
    if (DUP & (1u << 0)) { GRID_BAR(); prep2_phase(lds_raw); }
    GRID_BAR();
#if defined(DIAG2) && DIAG2 == 21
    { unsigned char* w_ = WS(phase_args()); diag_ck(lds_raw, 0, w_ + 1 * MiB, 256); diag_ck(lds_raw, 1, w_ + WS_MISC, 64); diag_ck(lds_raw, 2, w_ + WS_XB, 4096); diag_ck(lds_raw, 3, w_ + WS_WIN, 1024); diag_final(lds_raw); return; }
#endif
    if (PHSEL & (1u << 1)) inproj_a_phase(lds_raw);
    if (DUP & (1u << 1)) { GRID_BAR(); inproj_a_phase(lds_raw); }
    if (PHSEL & (1u << 2)) inproj_b_phase(lds_raw);
    if (DUP & (1u << 2)) { GRID_BAR(); inproj_b_phase(lds_raw); }
#if defined(DIAG2) && DIAG2 == 22
    { unsigned char* w_ = WS(phase_args()); diag_ck(lds_raw, 0, w_ + WS_QX, 4096); diag_ck(lds_raw, 1, w_ + WS_SMALL, 4096); diag_ck(lds_raw, 2, w_ + WS_KZT, 4096); diag_ck(lds_raw, 3, w_ + WS_VT, 8192); diag_final(lds_raw); return; }
#endif
#if defined(DIAG2) && DIAG2 == 10
    diag_ck(lds_raw, 0, WS(phase_args()) + WS_QX, 4096); diag_final(lds_raw); return;
#endif
    GRID_BAR();
    if (!ROWNORM_FUSED && (PHSEL & (1u << 16))) rownorm_phase_w(lds_raw);
    if (PHSEL & (1u << 3)) retention_phase_w(lds_raw);
    if (DUP & (1u << 3)) { GRID_BAR(); retention_phase_w(lds_raw); }
#if defined(DIAG2) && DIAG2 == 23
    diag_ck(lds_raw, 0, OUT(phase_args()), 8192);
#endif
#if defined(DIAG2) && DIAG2 == 11
    diag_ck(lds_raw, 1, OUT(phase_args()), 8192); diag_final(lds_raw); return;
#endif
    GRID_BAR();
    if (PHSEL & (1u << 4)) retnorm_phase_w(lds_raw);
    if (PHSEL & (1u << 17)) qproj_phase(lds_raw);
    if (DUP & (1u << 17)) { GRID_BAR(); qproj_phase(lds_raw); }
    GRID_BAR();
#if defined(DIAG2) && DIAG2 == 23
    diag_ck(lds_raw, 1, WS(phase_args()) + WS_QLAT, 4096);
#endif
    if (PHSEL & (1u << 18)) indexer_phase_w(lds_raw);
    __syncthreads();
    if (PHSEL & (1u << 5)) inproj_c_phase(lds_raw);
    if (DUP & (1u << 18)) { GRID_BAR(); indexer_phase_w(lds_raw); }
    if (DUP & (1u << 22)) { GRID_BAR(); indexer_probe_w<1>(lds_raw); }
    if (DUP & (1u << 23)) { GRID_BAR(); indexer_probe_w<2>(lds_raw); }
#if defined(DIAG2) && DIAG2 == 23
    diag_ck(lds_raw, 2, WS(phase_args()) + WS_MASK, 512);
#endif
#if defined(DIAG2) && DIAG2 == 12
    diag_ck(lds_raw, 2, WS(phase_args()) + WS_MASK, 512); diag_final(lds_raw); return;
#endif
    GRID_BAR();
    if (PHSEL & (1u << 19)) attention_phase_w(lds_raw);
    if (DUP & (1u << 19)) { GRID_BAR(); attention_phase_w(lds_raw); }
#if defined(DIAG2) && DIAG2 == 23
    diag_ck(lds_raw, 3, WS(phase_args()) + WS_OLAT, 4096); diag_final(lds_raw); return;
#endif
#if defined(DIAG2) && DIAG2 == 13
    diag_ck(lds_raw, 3, WS(phase_args()) + WS_QLAT, 4096); diag_final(lds_raw); return;
#endif
#if defined(DIAG2) && DIAG2 == 24
    diag_ck(lds_raw, 0, OUT(phase_args()), 8192);
#endif
    GRID_BAR();
    if (PHSEL & (1u << 20)) mix_a_phase(lds_raw);
    if (DUP & (1u << 20)) { GRID_BAR(); mix_a_phase(lds_raw); }
    if (PHSEL & (1u << 6)) mix_b_phase(lds_raw);
    if (DUP & (1u << 6)) { GRID_BAR(); mix_b_phase(lds_raw); }
#if defined(DIAG2) && DIAG2 == 24
    diag_ck(lds_raw, 1, WS(phase_args()) + WS_MIX, 4096);
#endif
#if defined(DIAG2) && DIAG2 == 28
    diag_ck(lds_raw, 3, WS(phase_args()) + WS_MIX, 4096);
#endif
    GRID_BAR();
    if (PHSEL & (1u << 7)) out_phase(lds_raw);
    if (DUP & (1u << 7)) { GRID_BAR(); out_phase(lds_raw); }
#if defined(DIAG2) && (DIAG2 == 38 || DIAG2 == 39)
    { asm volatile("s_waitcnt vmcnt(0)" ::: "memory"); __syncthreads(); if (threadIdx.x == 0) atomicAdd((unsigned*)(WS(phase_args()) + WS_CTL) + 16384 + 64 * 9, 1u); }
#endif
    GRID_BAR();
#if defined(DIAG2) && (DIAG2 == 38 || DIAG2 == 39)
    { if (threadIdx.x == 0) { unsigned* nb_ = (unsigned*)(WS(phase_args()) + WS_CTL) + 16384; const unsigned d_ = __hip_atomic_load(nb_ + 64 * 9, __ATOMIC_RELAXED, __HIP_MEMORY_SCOPE_AGENT); if (d_ != gridDim.x * (unsigned)(phase_args().pass + 1)) atomicAdd(nb_ + 64 * 10, 1u); } }
#endif
#if defined(DIAG2) && DIAG2 == 24
    diag_ck(lds_raw, 2, OUT(phase_args()), 8192); diag_ck(lds_raw, 3, WS(phase_args()) + WS_X2B, 2048); diag_final(lds_raw); return;
#endif
#if defined(DIAG2) && DIAG2 == 28
    diag_ck(lds_raw, 0, OUT(phase_args()), 8192); diag_ck(lds_raw, 1, WS(phase_args()) + WS_X2B, 2048);
#endif
    if (DUP & (1u << 21)) { convert_only_phase(lds_raw); GRID_BAR(); }
#if defined(DIAG2) && (DIAG2 == 29 || DIAG2 == 30 || DIAG2 == 31)
    diag_ck(lds_raw, 0, WS(phase_args()) + WS_MISC, 8);
#endif
    if (PHSEL & (1u << 8)) router_phase_w(lds_raw);
    GRID_BAR();
#if defined(DIAG2) && DIAG2 == 25
    diag_ck(lds_raw, 0, WS(phase_args()) + WS_WGU, 4096); diag_ck(lds_raw, 1, WS(phase_args()) + WS_WD, 2048);
#endif
#if defined(DIAG2) && DIAG2 == 26
    diag_ck(lds_raw, 0, WS(phase_args()) + WS_WGU, 4096); diag_ck(lds_raw, 1, WS(phase_args()) + WS_WD, 2048); diag_final(lds_raw); return;
#endif
#if defined(DIAG2) && DIAG2 == 29
    diag_final(lds_raw); return;
#endif
#if defined(DIAG2) && (DIAG2 >= 30 && DIAG2 <= 40)
    { grid_bar(lds_raw); ArgsRef a = phase_args(); const unsigned* nb = (const unsigned*)(WS(a) + WS_CTL) + 16384; float c = 0.f;
      if (a.pass == 1) { unsigned n = __hip_atomic_load(nb + 64 * 3, __ATOMIC_RELAXED, __HIP_MEMORY_SCOPE_AGENT);
#if DIAG2 == 31
        n = n >> 5;
#endif
#if DIAG2 == 38
        n = __hip_atomic_load(nb + 64 * 10, __ATOMIC_RELAXED, __HIP_MEMORY_SCOPE_AGENT);
#endif
#if DIAG2 == 40
        n = (__hip_atomic_load(nb + 64 * 11, __ATOMIC_RELAXED, __HIP_MEMORY_SCOPE_AGENT) ? 1u : 0u) + (__hip_atomic_load(nb + 64 * 12, __ATOMIC_RELAXED, __HIP_MEMORY_SCOPE_AGENT) ? 2u : 0u) + (__hip_atomic_load(nb + 64 * 13, __ATOMIC_RELAXED, __HIP_MEMORY_SCOPE_AGENT) ? 4u : 0u);
#endif
#if DIAG2 == 39
        n = (__hip_atomic_load(nb + 64 * 10, __ATOMIC_RELAXED, __HIP_MEMORY_SCOPE_AGENT) ? 1u : 0u) + (n ? 2u : 0u);
#endif
#if DIAG2 >= 34 && DIAG2 <= 37
        n = __builtin_popcount(__hip_atomic_load(nb + 64 * (DIAG2 - 30), __ATOMIC_RELAXED, __HIP_MEMORY_SCOPE_AGENT));
#endif
        c = (float)(n > 30u ? 30u : n); }
      grid_bar(lds_raw);
      for (size_t i = (size_t)blockIdx.x * 512 + threadIdx.x; i < (size_t)T * D; i += (size_t)gridDim.x * 512) OUT(a)[i] = c; return; }
#endif
#if defined(DIAG2) && (DIAG2 == 27 || DIAG2 == 28)
    { grid_bar(lds_raw); ArgsRef a = phase_args(); unsigned* sums = (unsigned*)(WS(a) + WS_CTL + 256 * 1024); unsigned* nbad = (unsigned*)(WS(a) + WS_CTL) + 16384;
      const unsigned* rec = (const unsigned*)(WS(a) + WS_REC); const unsigned* gc = (const unsigned*)(WS(a) + WS_CTL) + CW_CNT;
      for (int t = blockIdx.x * 512 + threadIdx.x; t < T; t += gridDim.x * 512) { unsigned sm = 0u; for (int k = 0; k < 4; ++k) { sm = sm * 31u + rec[(size_t)t * 16 + 4 * k]; sm = sm * 31u + rec[(size_t)t * 16 + 4 * k + 2]; sm = sm * 31u + rec[(size_t)t * 16 + 4 * k + 3]; }
          if (a.pass == 0) sums[2 * 16384 + t] = sm; else if (sums[2 * 16384 + t] != sm) atomicAdd(nbad + 64 * 2, 1u); }
      if (blockIdx.x == 0 && threadIdx.x < 64) { const unsigned v = gc[threadIdx.x]; if (a.pass == 0) sums[65536 + threadIdx.x] = v; else if (sums[65536 + threadIdx.x] != v) atomicAdd(nbad + 64 * 2, 1u); }
      grid_bar(lds_raw);
#if DIAG2 == 27
      diag_final(lds_raw); return;
#endif
    }
#endif
    if (PHSEL & (1u << 9)) moe_gateup_phase<0>(lds_raw);
    if (DUP & (1u << 9)) { GRID_BAR(); moe_gateup_phase<0>(lds_raw); }
    if (DUP & (1u << 24)) { GRID_BAR(); moe_gateup_probe<0>(lds_raw); }
    GRID_BAR();
    if (PHSEL & (1u << 10)) moe_down_phase<0>(lds_raw);
    if (DUP & (1u << 10)) { GRID_BAR(); moe_down_phase<0>(lds_raw); }
    if (DUP & (1u << 25)) { GRID_BAR(); moe_down_probe<0>(lds_raw); }
    GRID_BAR();
    if (PHSEL & (1u << 11)) moe_combine_phase<0>(lds_raw);
#if defined(DIAG2) && DIAG2 == 20
    diag_ck(lds_raw, 0, OUT(phase_args()), 8192); diag_final(lds_raw);
#endif
#if defined(DIAG2) && DIAG2 == 28
    diag_final(lds_raw);
#endif
}

extern "C" void kernel_launch(void* const* d_in, const int* in_sizes, int n_in, void* d_out, int out_size, void* d_ws, size_t ws_size, hipStream_t stream) {
    static int grid = 0;
    if (grid == 0) {
        if (n_in != 24 || out_size != T * D || ws_size < WS_END2) { fprintf(stderr, "kernel_launch: unexpected shapes n_in %d out %d ws %zu (need %zu)\n", n_in, out_size, ws_size, (size_t)WS_END2); grid = -1; return; }
        int dev = 0, cus = 0, per_cu = 0;
        if (hipGetDevice(&dev) != hipSuccess || hipDeviceGetAttribute(&cus, hipDeviceAttributeMultiprocessorCount, dev) != hipSuccess) { grid = -1; return; }
        if (hipFuncSetAttribute((const void*)fwd, hipFuncAttributeMaxDynamicSharedMemorySize, LDS_BYTES) != hipSuccess) { fprintf(stderr, "kernel_launch: hipFuncSetAttribute failed\n"); grid = -1; return; }
        if (hipOccupancyMaxActiveBlocksPerMultiprocessor(&per_cu, (const void*)fwd, 512, LDS_BYTES) != hipSuccess || per_cu < 1) fprintf(stderr, "kernel_launch: occupancy query reports %d\n", per_cu);
        (void)hipGetLastError();
        grid = cus;
    }
    if (grid < 0) return;
    if (hipMemsetAsync((char*)d_ws + WS_CTL, 0, CTL_BYTES, stream) != hipSuccess) return;
    Args a{};
    for (int i = 0; i < 24; ++i) a.in[i] = (const float*)d_in[i];
    a.out = (float*)d_out; a.ws = (unsigned char*)d_ws; a.pass = 0;
    hipLaunchKernelGGL(fwd, dim3(grid), dim3(512), LDS_BYTES, stream, a);
#ifdef DIAG2
    if (hipMemsetAsync((char*)d_ws + WS_CTL, 0, 49152, stream) != hipSuccess) return;
    a.pass = 1;
    hipLaunchKernelGGL(fwd, dim3(grid), dim3(512), LDS_BYTES, stream, a);
#endif
}
```

```cpp
#include <hip/hip_runtime.h>
#include <cstdio>
#include <cstdint>

#define LAS __attribute__((address_space(3)))
#define GAS __attribute__((address_space(1)))
typedef unsigned short bf16_t;
typedef short bf16x8 __attribute__((ext_vector_type(8)));
typedef short s16x4 __attribute__((ext_vector_type(4)));
typedef float f32x4 __attribute__((ext_vector_type(4)));
typedef float f32x2 __attribute__((ext_vector_type(2)));
typedef float f32x16 __attribute__((ext_vector_type(16)));
typedef unsigned u32x4 __attribute__((ext_vector_type(4)));
typedef unsigned u32x2 __attribute__((ext_vector_type(2)));
typedef int i32x4 __attribute__((ext_vector_type(4)));
typedef int i32x8 __attribute__((ext_vector_type(8)));

constexpr int NB = 16, SEQ = 2048, T = NB * SEQ, D = 1024;
constexpr int NE = 32, FF = 1024, TOPK_E = 4;
constexpr int HALF_T = T;
constexpr int LIST_CAP = HALF_T;
constexpr int PAD_ROWS = HALF_T * TOPK_E + NE * 256;
constexpr float RMS_EPS = 1e-6f;

constexpr size_t MiB = 1u << 20;
constexpr size_t WS_CTL = 0, CTL_BYTES = 1 * MiB;
constexpr size_t WS_MISC = 5 * MiB;
constexpr size_t MISC_RW_HI = 0, MISC_RW_LO = 65536, MISC_RSTD2 = 131072, MISC_RSTD1 = 262144;
constexpr bool MOE_FP8 = true;
constexpr float W8_SCALE = 32.f, W8_INV = 1.f / 32.f;
constexpr bool X2H = true;
constexpr bool ROWNORM_FUSED = true;
constexpr bool GA8 = true;
constexpr bool MIXA_FP8 = true;
constexpr bool Y_FP8 = true;
constexpr bool INB_FP8 = true;
constexpr bool INC_FP8 = true;
constexpr size_t WS_REC = 6 * MiB, WS_LTOK = 8 * MiB, WS_LRS = 12 * MiB, WS_WD = 48 * MiB, WS_X2B = 96 * MiB, WS_WGU = 144 * MiB, WS_ACT = 208 * MiB, WS_Y = 344 * MiB, WS_X2H = 480 * MiB, WS_END = 552 * MiB;
static_assert(MOE_FP8 && WS_ACT + (size_t)PAD_ROWS * FF <= WS_Y && WS_Y + (size_t)PAD_ROWS * D * (Y_FP8 ? 1 : 2) <= WS_END, "ws map (single-pass MoE needs the fp8 sizes)");
constexpr size_t WS_COSP = 1 * MiB, WS_SINP = 2 * MiB, WS_COST = 3 * MiB, WS_SINT = 4 * MiB;
constexpr size_t MISC_DQ = 393216, MISC_DK = 394240, MISC_DZ = 395264, MISC_RN = 524288;
constexpr size_t WS_WIN = 6 * MiB, WS_XB = 32 * MiB, WS_SMALL = 96 * MiB, WS_QX = 160 * MiB, WS_KP = 224 * MiB, WS_KZT = 288 * MiB, WS_VT = 352 * MiB;
constexpr size_t WS_CKV = 480 * MiB, WS_KIDX = 488 * MiB, WS_WIDX = 492 * MiB, WS_CQN = 493 * MiB, WS_QIDX = 509 * MiB, WS_MASK = 541 * MiB;
constexpr size_t WS_WQ = 552 * MiB, WS_WA = 553 * MiB, WS_WB = 555 * MiB, WS_WOUT = 559 * MiB, WS_END2 = 561 * MiB;
constexpr size_t WS_XB8 = 224 * MiB, WS_WIN8 = 256 * MiB;
constexpr size_t WS_GA = WS_QX, WS_GB = INC_FP8 ? WS_VT : WS_KP,        WS_MIXA = WS_KZT, WS_MIX = WS_VT, WS_QLAT = WS_SMALL, WS_OLAT = WS_VT + 64 * MiB;
constexpr int NIN = 8704;
constexpr int CW_BAR = 1024;
constexpr int CW_CNT = 8192;

__device__ __forceinline__ unsigned f2bf(float f) { unsigned u = __builtin_bit_cast(unsigned, f); return (u + 0x7fffu + ((u >> 16) & 1u)) >> 16; }
__device__ __forceinline__ unsigned pk2(float lo, float hi) { return f2bf(lo) | (f2bf(hi) << 16); }
__device__ __forceinline__ float bf2f(unsigned b) { return __builtin_bit_cast(float, b << 16); }
typedef __bf16 bf16v2_t __attribute__((ext_vector_type(2)));
__device__ __forceinline__ unsigned cvt_pk_bf16(float lo, float hi) { f32x2 v = {lo, hi}; bf16v2_t r = __builtin_convertvector(v, bf16v2_t); return __builtin_bit_cast(unsigned, r); }
__device__ __forceinline__ float wave_sum(float v) {
#pragma unroll
    for (int o = 1; o < 64; o <<= 1) v += __shfl_xor(v, o);
    return v;
}
__device__ __forceinline__ void ld4u(const void* p, unsigned (&w)[4]) { const f32x4 t = *(const f32x4*)p; const float t0 = t[0], t1 = t[1], t2 = t[2], t3 = t[3];
    w[0] = __builtin_bit_cast(unsigned, t0); w[1] = __builtin_bit_cast(unsigned, t1); w[2] = __builtin_bit_cast(unsigned, t2); w[3] = __builtin_bit_cast(unsigned, t3); }
__device__ __forceinline__ unsigned pk4_fp8(float a, float b, float c, float d) { unsigned w = 0u; w = __builtin_amdgcn_cvt_pk_fp8_f32(a, b, w, false); w = __builtin_amdgcn_cvt_pk_fp8_f32(c, d, w, true); return w; }
#define LDS_WAIT() asm volatile("s_waitcnt lgkmcnt(0)" ::: "memory")
#define VM_WAIT() asm volatile("s_waitcnt vmcnt(0)" ::: "memory")

#define XB_TMO      128
#define XB_XCNT(j)  (256  + 64 * (j))
#define XB_XSUB(j)  (1280 + 64 * (j))
#define XB_XGEN(j)  (2304 + 64 * (j))
#define XB_TOP      3328
#define XB_TOPGEN   3392
#define XCD_BAR_WORDS 3456
#define XB_SPIN_CAP (1u << 22)
__device__ __forceinline__ unsigned xb_ld(unsigned* p)              { return __hip_atomic_load(p, __ATOMIC_RELAXED, __HIP_MEMORY_SCOPE_AGENT); }
__device__ __forceinline__ unsigned xb_add(unsigned* p, unsigned v) { return __hip_atomic_fetch_add(p, v, __ATOMIC_RELAXED, __HIP_MEMORY_SCOPE_AGENT); }
__device__ __forceinline__ unsigned xb_xcc_id() { return (unsigned)__builtin_amdgcn_s_getreg((3 << 11) | 20) & 0xFu; }
#define XB_SPIN(cond, bar) do { unsigned _sp = 0; while (cond) { __builtin_amdgcn_s_sleep(1); \
    if ((++_sp & 255u) == 0u) { if (xb_ld(&(bar)[XB_TMO])) break; if (_sp > XB_SPIN_CAP) { atomicAdd(&(bar)[XB_TMO], 1u); break; } } } } while (0)
struct XcdBarrier { unsigned* bar; unsigned x; volatile LAS unsigned* st; };
__device__ __forceinline__ XcdBarrier xcd_barrier_post(unsigned* bar, volatile LAS unsigned* st) {
    XcdBarrier b; b.bar = bar; b.x = xb_xcc_id(); b.st = st;
    if (threadIdx.x == 0) (void)xb_add(&bar[XB_XCNT(b.x)], 1u);
    return b;
}
__device__ __forceinline__ void xcd_barrier_complete(unsigned* bar, unsigned x, unsigned& nloc, unsigned& nx) {
    const unsigned G = gridDim.x * gridDim.y * gridDim.z;
    unsigned sum, cnt, mine, sp = 0u;
    for (;;) {
        sum = 0u; cnt = 0u; mine = 0u;
#pragma unroll
        for (unsigned j = 0; j < 16; ++j) { const unsigned c = xb_ld(&bar[XB_XCNT(j)]); sum += c; cnt += (c > 0u) ? 1u : 0u; mine = (j == x) ? c : mine; }
        if (sum == G) break;
        __builtin_amdgcn_s_sleep(1);
        if ((++sp & 255u) == 0u) { if (xb_ld(&bar[XB_TMO])) break; if (sp > XB_SPIN_CAP) { atomicAdd(&bar[XB_TMO], 1u); break; } }
    }
    nloc = mine > 0u ? mine : 1u; nx = cnt > 0u ? cnt : 1u;
}
__device__ __forceinline__ void xcd_barrier(const XcdBarrier& b) {
    asm volatile("s_waitcnt vmcnt(0)" ::: "memory");
    __syncthreads();
    if (threadIdx.x == 0) {
        unsigned* bar = b.bar;
        __builtin_amdgcn_s_waitcnt(0);
        unsigned nloc = b.st[0], nx = b.st[1];
        if (nloc == 0u) { xcd_barrier_complete(bar, b.x, nloc, nx); b.st[0] = nloc; b.st[1] = nx; }
        const unsigned old = xb_add(&bar[XB_XSUB(b.x)], 1u);
        const unsigned gen = old / nloc;
        if (old + 1u == (gen + 1u) * nloc) {
            __builtin_amdgcn_fence(__ATOMIC_RELEASE, "agent");
            asm volatile("s_waitcnt vmcnt(0)" ::: "memory");
            const unsigned og = xb_add(&bar[XB_TOP], 1u);
            const unsigned tg = og / nx;
            if (og + 1u == (tg + 1u) * nx) xb_add(&bar[XB_TOPGEN], 1u);
            else XB_SPIN(xb_ld(&bar[XB_TOPGEN]) == tg, bar);
            __builtin_amdgcn_fence(__ATOMIC_ACQUIRE, "agent");
            xb_add(&bar[XB_XGEN(b.x)], 1u);
            asm volatile("s_waitcnt vmcnt(0)" ::: "memory");
        } else {
            XB_SPIN(xb_ld(&bar[XB_XGEN(b.x)]) == gen, bar);
            __builtin_amdgcn_fence(__ATOMIC_ACQUIRE, "agent");
            asm volatile("s_waitcnt vmcnt(0)" ::: "memory");
        }
    }
    __syncthreads();
#ifdef ALLWAVE_INV
    __builtin_amdgcn_fence(__ATOMIC_ACQUIRE, "agent"); asm volatile("s_waitcnt vmcnt(0)" ::: "memory");
#endif
}

namespace pg8 {
constexpr int BM = 256, BK = 64, HALF = 128, HTB = HALF * BK * 2, STAGE_BYTES = 8 * HTB;
__host__ __device__ __forceinline__ int lds_byte(int r, int c) { const int st = (r >> 4) * 2 + (c >> 5), rr = r & 15, cc = c & 31, ob = rr * 64 + cc * 2; return st * 1024 + (ob ^ (((ob >> 9) & 1) << 5)); }
__host__ __device__ __forceinline__ void stage_rc(int b, int& R, int& C) { const int st = b / 1024, sb = b % 1024, swz = sb ^ (((sb >> 9) & 1) << 5); R = (st >> 1) * 16 + swz / 64; C = (st & 1) * 32 + (swz % 64) / 2; }
__host__ __device__ __forceinline__ int perm32(int rho) { const int n = rho >> 4, i = rho & 15; return 8 * (i >> 2) + 4 * n + (i & 3); }

struct Unit { int pm, pn, e, j; };

#define PG8_SA(b, h) (((b) * 2 + (h)) * HTB)
#define PG8_SB(b, h) ((4 + (b) * 2 + (h)) * HTB)
#define PG8_STAGE(bufoff, rsrc, soff, voff) do { _Pragma("unroll") for (int _i = 0; _i < 2; ++_i) \
        __builtin_amdgcn_raw_ptr_buffer_load_lds(rsrc, (LAS void*)(lds + (bufoff) + ldsw + _i * 8192), 16, (int)(voff)[_i], (int)(soff), 0, 0); } while (0)
#define PG8_LDA(dst, b, h) do { _Pragma("unroll") for (int m = 0; m < 4; ++m) _Pragma("unroll") for (int k = 0; k < 2; ++k) dst[m][k] = *(const LAS bf16x8*)(lds + PG8_SA(b, h) + aoff + m * 2048 + k * 1024); } while (0)
#define PG8_LDB(dst, b, h) do { _Pragma("unroll") for (int n = 0; n < 2; ++n) _Pragma("unroll") for (int k = 0; k < 2; ++k) dst[n][k] = *(const LAS bf16x8*)(lds + PG8_SB(b, h) + boff + n * 2048 + k * 1024); } while (0)
#define PG8_CAT(x) __builtin_shufflevector(__builtin_bit_cast(i32x4, (x)[0]), __builtin_bit_cast(i32x4, (x)[1]), 0, 1, 2, 3, 4, 5, 6, 7)
#define PG8_MMA(ai, bj, At, Bt) do { __builtin_amdgcn_s_setprio(1); if constexpr (F8) { asm volatile("s_nop 1"); _Pragma("unroll") for (int m = 0; m < 4; ++m) _Pragma("unroll") for (int n = 0; n < 2; ++n) { \
        const i32x8 _b8 = PG8_CAT(Bt[n]), _a8 = PG8_CAT(At[m]); if constexpr (SWAP) asm volatile("v_mfma_f32_16x16x128_f8f6f4 %0, %1, %2, %0" : "+v"(acc[ai][bj][m][n]) : "v"(_a8), "v"(_b8)); \
        else asm volatile("v_mfma_f32_16x16x128_f8f6f4 %0, %1, %2, %0" : "+v"(acc[ai][bj][m][n]) : "v"(_b8), "v"(_a8)); } } else { \
        _Pragma("unroll") for (int m = 0; m < 4; ++m) _Pragma("unroll") for (int n = 0; n < 2; ++n) _Pragma("unroll") for (int k = 0; k < 2; ++k) \
        acc[ai][bj][m][n] = SWAP ? __builtin_amdgcn_mfma_f32_16x16x32_bf16(At[m][k], Bt[n][k], acc[ai][bj][m][n], 0, 0, 0) : __builtin_amdgcn_mfma_f32_16x16x32_bf16(Bt[n][k], At[m][k], acc[ai][bj][m][n], 0, 0, 0); } __builtin_amdgcn_s_setprio(0); } while (0)
#define PG8_ACC_SETTLE() do { _Pragma("unroll") for (int _a = 0; _a < 2; ++_a) _Pragma("unroll") for (int _b = 0; _b < 2; ++_b) \
        asm volatile("s_nop 15\n\ts_nop 7" : "+v"(acc[_a][_b][0][0]), "+v"(acc[_a][_b][0][1]), "+v"(acc[_a][_b][1][0]), "+v"(acc[_a][_b][1][1]), "+v"(acc[_a][_b][2][0]), "+v"(acc[_a][_b][2][1]), "+v"(acc[_a][_b][3][0]), "+v"(acc[_a][_b][3][1])); } while (0)
#define PG8_WAIT_V(n) asm volatile("s_waitcnt vmcnt(" #n ")" ::: "memory")
#define PG8_WAIT_L(n) asm volatile("s_waitcnt lgkmcnt(" #n ")" ::: "memory")
#define PG8_BAR __builtin_amdgcn_s_barrier()
#define PG8_SCHED __builtin_amdgcn_sched_barrier(0)
#define PG8_TRIP(a1, a2, a3, V1h1, V2h0, V2h1, b2, b3) do { \
            PG8_LDB(B0, 0, 0); PG8_SCHED; PG8_LDA(At, 0, 0); PG8_STAGE(PG8_SA(1, 1), rA, (a1) + ahstep, V1h1); \
            PG8_WAIT_L(8); PG8_BAR; PG8_WAIT_L(0); PG8_MMA(0, 0, At, B0); PG8_BAR; PG8_SCHED; \
            PG8_LDB(B1, 0, 1); PG8_STAGE(PG8_SB(0, 0), rB, b2, voffB); \
            PG8_BAR; PG8_WAIT_L(0); PG8_MMA(0, 1, At, B1); PG8_BAR; \
            PG8_LDA(At, 0, 1); PG8_STAGE(PG8_SA(0, 0), rA, a2, V2h0); \
            PG8_BAR; PG8_WAIT_L(0); PG8_MMA(1, 0, At, B0); PG8_BAR; PG8_SCHED; \
            PG8_STAGE(PG8_SB(0, 1), rB, (b2) + hstep, voffB); \
            PG8_WAIT_V(6); PG8_BAR; PG8_MMA(1, 1, At, B1); PG8_BAR; \
            PG8_LDB(B0, 1, 0); PG8_SCHED; PG8_LDA(At, 1, 0); PG8_STAGE(PG8_SA(0, 1), rA, (a2) + ahstep, V2h1); \
            PG8_WAIT_L(8); PG8_BAR; PG8_WAIT_L(0); PG8_MMA(0, 0, At, B0); PG8_BAR; PG8_SCHED; \
            PG8_LDB(B1, 1, 1); PG8_STAGE(PG8_SB(1, 0), rB, b3, voffB); \
            PG8_BAR; PG8_WAIT_L(0); PG8_MMA(0, 1, At, B1); PG8_BAR; \
            PG8_LDA(At, 1, 1); PG8_STAGE(PG8_SA(1, 0), rA, a3, V2h0); \
            PG8_BAR; PG8_WAIT_L(0); PG8_MMA(1, 0, At, B0); PG8_BAR; PG8_SCHED; \
            PG8_STAGE(PG8_SB(1, 1), rB, (b3) + hstep, voffB); \
            PG8_WAIT_V(6); PG8_BAR; PG8_MMA(1, 1, At, B1); PG8_BAR; } while (0)
template <class Epi, class Sched, bool SWAP, bool GATHER, int K, bool F8 = false>
__device__ __forceinline__ void gemm_phase(LAS unsigned char* lds, const int tid, const bf16_t* Abase, const bf16_t* Bbase, const Sched& S, const Epi& E, LAS u32x4* gslots = nullptr) {
    static_assert(!(SWAP && Epi::PERM), "SWAP needs natural B row order");
    const int wid = __builtin_amdgcn_readfirstlane(tid >> 6), lane = tid & 63, wr = wid >> 2, wc = wid & 3, fr = lane & 15, fq = lane >> 4;
    constexpr int nt = K / BK;
    const unsigned long long pa_ = (unsigned long long)Abase, pb_ = (unsigned long long)Bbase;
    const unsigned long long ua_ = ((unsigned long long)(unsigned)__builtin_amdgcn_readfirstlane((int)(pa_ >> 32)) << 32) | (unsigned)__builtin_amdgcn_readfirstlane((int)pa_);
    const unsigned long long ub_ = ((unsigned long long)(unsigned)__builtin_amdgcn_readfirstlane((int)(pb_ >> 32)) << 32) | (unsigned)__builtin_amdgcn_readfirstlane((int)pb_);
    const __amdgpu_buffer_rsrc_t rA = __builtin_amdgcn_make_buffer_rsrc((void*)ua_, 0, 0x7ffffffc, 0x00020000);
    const __amdgpu_buffer_rsrc_t rB = __builtin_amdgcn_make_buffer_rsrc((void*)ub_, 0, 0x7ffffffc, 0x00020000);
    unsigned voffB[2], vA0[2], vA1[2];
#pragma unroll
    for (int i = 0; i < 2; ++i) { int R, C; stage_rc(tid * 16 + i * 8192, R, C); const int Rb = Epi::PERM ? ((R & ~31) + perm32(R & 31)) : R;
        const int Ra = SWAP ? ((R & ~63) | (16 * ((R >> 2) & 3) + 4 * ((R >> 4) & 3) + (R & 3))) : R;
        voffB[i] = (unsigned)(Rb * K + C) * 2u; vA0[i] = (unsigned)(Ra * K + C) * 2u; vA1[i] = vA0[i]; }
    constexpr unsigned kstep = (unsigned)(BK * 2);
    constexpr unsigned hstep = (unsigned)HALF * K * 2;
    constexpr unsigned ahstep = GATHER ? 0u : hstep;
    const unsigned ldsw = (unsigned)wid * 1024u;
    const int aoff = lds_byte(wr * 64 + fr, fq * 8), boff = lds_byte(wc * 32 + fr, fq * 8);
#define PG8_ROWS(d0, d1, u) do { int _t = tid; asm volatile("" : "+v"(_t)); _Pragma("unroll") for (int _i = 0; _i < 2; ++_i) { int _R, _C; stage_rc(_t * 16 + _i * 8192, _R, _C); \
        const int _nr = S.nrows(u); int _x0 = _R < _nr ? _R : _nr - 1, _x1 = (_R + HALF) < _nr ? (_R + HALF) : _nr - 1; const int* _l = S.rows + S.lo(u); \
        d0[_i] = (unsigned)(_l[_x0] * K + _C) * 2u; d1[_i] = (unsigned)(_l[_x1] * K + _C) * 2u; } } while (0)
    Unit cur, nxt; int ui = 0;
    if (!S.next(0, cur)) return;
    f32x4 acc[2][2][4][2];
#pragma unroll
    for (int a = 0; a < 2; ++a)
#pragma unroll
        for (int b = 0; b < 2; ++b)
#pragma unroll
            for (int m = 0; m < 4; ++m)
#pragma unroll
                for (int n = 0; n < 2; ++n) acc[a][b][m][n] = (f32x4){0.f, 0.f, 0.f, 0.f};
    bf16x8 At[4][2], B0[2][2], B1[2][2];
    unsigned cA = S.aoff(cur), cB = S.boff(cur);
    if constexpr (GATHER) { PG8_ROWS(vA0, vA1, cur); gslots[tid] = (u32x4){vA0[0], vA0[1], vA1[0], vA1[1]}; }
    PG8_STAGE(PG8_SB(0, 0), rB, cB, voffB); PG8_STAGE(PG8_SA(0, 0), rA, cA, vA0); PG8_STAGE(PG8_SB(0, 1), rB, cB + hstep, voffB); PG8_STAGE(PG8_SA(0, 1), rA, cA + ahstep, vA1);
    if (wr == 1) PG8_BAR;
    PG8_WAIT_V(4); PG8_BAR;
    PG8_STAGE(PG8_SB(1, 0), rB, cB + kstep, voffB); PG8_STAGE(PG8_SA(1, 0), rA, cA + kstep, vA0); PG8_STAGE(PG8_SB(1, 1), rB, cB + hstep + kstep, voffB);
    PG8_WAIT_V(6); PG8_BAR;
    for (;;) {
        const bool has_next = S.next(ui + 1, nxt);
        const unsigned nA = has_next ? S.aoff(nxt) : cA, nB = has_next ? S.boff(nxt) : cB;
        int nrow0[2] = {0, 0}, nrow1[2] = {0, 0};
        if constexpr (GATHER) { if (has_next) { int _t = tid; asm volatile("" : "+v"(_t)); _Pragma("unroll") for (int _i = 0; _i < 2; ++_i) { int _R, _C; stage_rc(_t * 16 + _i * 8192, _R, _C);
            const int _nr = S.nrows(nxt); const int _x0 = _R < _nr ? _R : _nr - 1, _x1 = (_R + HALF) < _nr ? (_R + HALF) : _nr - 1; const int* _l = S.rows + S.lo(nxt); nrow0[_i] = _l[_x0]; nrow1[_i] = _l[_x1]; } } }
#pragma unroll 1
        for (int t = 0; t < nt; t += 2) {
            const bool last = (t == nt - 2);
            const unsigned a1 = cA + (unsigned)(t + 1) * kstep;
            const unsigned a2 = last ? nA : cA + (unsigned)(t + 2) * kstep, b2 = last ? nB : cB + (unsigned)(t + 2) * kstep;
            if constexpr (!GATHER) {
                PG8_TRIP(a1, a2, a2 + kstep, vA0, vA0, vA0, b2, b2 + kstep);
            } else {
                const int par = ui & 1;
                if (last && has_next) { unsigned n0[2], n1[2]; int _t = tid; asm volatile("" : "+v"(_t));
                    _Pragma("unroll") for (int _i = 0; _i < 2; ++_i) { int _R, _C; stage_rc(_t * 16 + _i * 8192, _R, _C); n0[_i] = (unsigned)(nrow0[_i] * K + _C) * 2u; n1[_i] = (unsigned)(nrow1[_i] * K + _C) * 2u; }
                    gslots[(par ^ 1) * 512 + tid] = (u32x4){n0[0], n0[1], n1[0], n1[1]}; }
                const u32x4 vc = gslots[par * 512 + tid], vn = gslots[((last && has_next) ? (par ^ 1) : par) * 512 + tid];
                const unsigned c1[2] = {vc.z, vc.w}, n0[2] = {vn.x, vn.y}, n1[2] = {vn.z, vn.w};
                PG8_TRIP(a1, a2, a2 + kstep, c1, n0, n1, b2, b2 + kstep);
            }
        }
        if constexpr (F8) PG8_ACC_SETTLE();
        E(acc, cur, wr, wc, fr, fq);
        if (!has_next) break;
#pragma unroll
        for (int a = 0; a < 2; ++a)
#pragma unroll
            for (int b = 0; b < 2; ++b)
#pragma unroll
                for (int m = 0; m < 4; ++m)
#pragma unroll
                    for (int n = 0; n < 2; ++n) acc[a][b][m][n] = (f32x4){0.f, 0.f, 0.f, 0.f};
        cur = nxt; cA = nA; cB = nB; ++ui;
    }
    PG8_WAIT_V(0);
    if (wr == 0) PG8_BAR;
    PG8_BAR;
#undef PG8_ROWS
}
}

struct Args { const float* in[24]; float* out; unsigned char* ws; long long pass; };
enum { I_X = 0, I_NORM_MIX_G, I_W_IN, I_CQ_G, I_CKV_G, I_KIDX_G, I_W_UQ, I_W_QIDX, I_W_UK, I_W_UV, I_T5, I_W_BA, I_W_BB, I_W_OUT, I_NORM_FFN_G, I_W_ROUTER, I_B_ROUTER,
       I_W_GATE, I_B_GATE, I_W_UP, I_B_UP, I_W_DOWN, I_B_DOWN, I_NORM_FINAL_G };

constexpr int LDS_STAGE = 0, LDS_MISC = 131072, LDS_BYTES = 163840;
constexpr int LM_BAR = 0;
constexpr int LM_TEND = 64;
constexpr int LM_CNT = 192;
constexpr int LM_PSTART = 320;
constexpr int LM_LCNT = 448;
constexpr int LM_GBASE = 576;
constexpr int LM_REC = 1024;
constexpr int LM_SCR = 9216;
constexpr int LM_SLOTS = 1024;
constexpr int LM_TILE = 27648;

struct Frame { LAS unsigned char* lds; LAS unsigned char* misc; int tid, lane, wave, G, bid; };
#define GAS __attribute__((address_space(1)))
typedef const __attribute__((address_space(4))) Args CArgs;
typedef CArgs& ArgsRef;
#define WS(a) ((unsigned char*)(GAS unsigned char*)(a).ws)
#define OUT(a) ((float*)(GAS float*)(a).out)
#define IN(a, i) ((const float*)(GAS const float*)(a).in[i])
__device__ __forceinline__ ArgsRef phase_args() { CArgs* ap = (CArgs*)__builtin_amdgcn_kernarg_segment_ptr(); asm volatile("" : "+s"(ap)); return *ap; }
__device__ __forceinline__ Frame make_frame(unsigned char* lds_raw) {
    Frame F; int tid = threadIdx.x; asm volatile("" : "+v"(tid)); int bid = blockIdx.x; asm volatile("" : "+s"(bid)); int G = gridDim.x; asm volatile("" : "+s"(G));
    F.lds = (LAS unsigned char*)lds_raw; F.misc = F.lds + LDS_MISC; F.tid = tid; F.lane = tid & 63; F.wave = __builtin_amdgcn_readfirstlane(tid >> 6); F.G = G; F.bid = bid; return F;
}

struct DenseOrder {
    int nM, nN, nwg, G, c, K; size_t a0, b0;
    __device__ __forceinline__ void init(int M, int N, int K_, int G_, int c_, size_t a0_ = 0, size_t b0_ = 0) { nM = M / 256; nN = N / 256; nwg = nM * nN; G = G_; c = c_; K = K_; a0 = a0_; b0 = b0_; }
    __device__ __forceinline__ bool next(int i, pg8::Unit& u) const {
        const long L = (long)i * G + c; if (L >= nwg) return false;
        int wgid = (int)L; { const int q = nwg / 8, r = nwg % 8, xcd = wgid % 8, off = wgid / 8; wgid = (xcd < r ? xcd * (q + 1) : r * (q + 1) + (xcd - r) * q) + off; }
        const int nig = 8 * nN, gid = wgid / nig, fm = gid * 8, gsz = (nM - fm) < 8 ? (nM - fm) : 8;
        u.pm = fm + ((wgid % nig) % gsz); u.pn = (wgid % nig) / gsz; u.e = 0; u.j = 0; return true;
    }
    __device__ __forceinline__ unsigned aoff(const pg8::Unit& u) const { return (unsigned)(a0 + (size_t)u.pm * 256 * K * 2); }
    __device__ __forceinline__ unsigned boff(const pg8::Unit& u) const { return (unsigned)(b0 + (size_t)u.pn * 256 * K * 2); }
};
template <int NPN, bool GATHER, int ROWB = 2048> struct MoeOrder {
    const LAS int* tile_e; const LAS int* cnt; const int* rows; int ntiles, G, c;
    __device__ __forceinline__ bool next(int i, pg8::Unit& u) const {
        int pm, pn;
        if (G == 256) {
            constexpr int PMG = 32 / NPN; const int xcd = c & 7, slot = c >> 3;
            pm = (i * 8 + xcd) * PMG + slot / NPN; pn = slot % NPN; if (pm >= ntiles) return false; }
        else { const int L = i * G + c; if (L >= ntiles * NPN) return false; pm = L / NPN; pn = L % NPN; }
        const int ej = __builtin_amdgcn_readfirstlane(tile_e[pm]);
        u.pm = pm; u.pn = pn; u.e = ej >> 16; u.j = ej & 0xffff; return true;
    }
    __device__ __forceinline__ int nrows(const pg8::Unit& u) const { int nr = __builtin_amdgcn_readfirstlane(cnt[u.e]) - 256 * u.j; return nr > 256 ? 256 : nr; }
    __device__ __forceinline__ int lo(const pg8::Unit& u) const { return u.e * LIST_CAP + 256 * u.j; }
    __device__ __forceinline__ unsigned aoff(const pg8::Unit& u) const { return GATHER ? 0u : (unsigned)u.pm * 256u * (unsigned)ROWB; }
    __device__ __forceinline__ unsigned boff(const pg8::Unit& u) const { return (unsigned)(u.e * NPN + u.pn) * 256u * (unsigned)ROWB; }
};

struct EpiGateUp { static constexpr bool PERM = true;
    bf16_t* act; const float* bgate; const float* bup; const float* lrs; const LAS int* cnt;
    __device__ __forceinline__ void operator()(const f32x4 (&acc)[2][2][4][2], const pg8::Unit& u, int wr, int wc, int fr, int fq) const {
        const int f0 = 128 * u.pn + 32 * wc + 8 * fq; const float* rsl = lrs + u.e * LIST_CAP + 256 * u.j; const int nrows = cnt[u.e] - 256 * u.j;
        f32x4 bg[2], bu[2]; float rsv[2][4];
#pragma unroll
        for (int n = 0; n < 2; ++n) { bg[n] = *(const f32x4*)(bgate + u.e * FF + f0 + 4 * n); bu[n] = *(const f32x4*)(bup + u.e * FF + f0 + 4 * n); }
#pragma unroll
        for (int ai = 0; ai < 2; ++ai)
#pragma unroll
            for (int m = 0; m < 4; ++m) rsv[ai][m] = rsl[128 * ai + 64 * wr + 16 * m + fr];
#pragma unroll
        for (int ai = 0; ai < 2; ++ai)
#pragma unroll
            for (int m = 0; m < 4; ++m) { const int r = 128 * ai + 64 * wr + 16 * m + fr; const float rs = r < nrows ? rsv[ai][m] * (MOE_FP8 ? W8_INV : 1.f) : 0.f;
                float a[8];
#pragma unroll
                for (int n = 0; n < 2; ++n)
#pragma unroll
                    for (int i = 0; i < 4; ++i) { float g = acc[ai][0][m][n][i] * rs + bg[n][i], up = acc[ai][1][m][n][i] * rs + bu[n][i];
                        g = fminf(g, 7.f); up = fminf(fmaxf(up, -7.f), 7.f);
                        const float sg = __builtin_amdgcn_rcpf(1.f + __builtin_amdgcn_exp2f(-1.702f * 1.4426950408889634f * g));
                        a[4 * n + i] = g * sg * (up + 1.f); }
                if constexpr (MOE_FP8) { u32x2 w8; w8.x = pk4_fp8(a[0], a[1], a[2], a[3]); w8.y = pk4_fp8(a[4], a[5], a[6], a[7]); *(u32x2*)((unsigned char*)act + ((size_t)u.pm * 256 + r) * FF + f0) = w8; }
                else { u32x4 w; w.x = cvt_pk_bf16(a[0], a[1]); w.y = cvt_pk_bf16(a[2], a[3]); w.z = cvt_pk_bf16(a[4], a[5]); w.w = cvt_pk_bf16(a[6], a[7]);
                *(u32x4*)(act + ((size_t)u.pm * 256 + r) * FF + f0) = w; } }
    }
};
struct EpiDown { static constexpr bool PERM = true;
    bf16_t* y; const float* bdown;
    __device__ __forceinline__ void operator()(const f32x4 (&acc)[2][2][4][2], const pg8::Unit& u, int wr, int wc, int fr, int fq) const {
        const int c0 = 256 * u.pn + 32 * wc + 8 * fq;
        f32x4 bv[2][2];
#pragma unroll
        for (int bj = 0; bj < 2; ++bj)
#pragma unroll
            for (int n = 0; n < 2; ++n) bv[bj][n] = *(const f32x4*)(bdown + u.e * D + c0 + 128 * bj + 4 * n);
#pragma unroll
        for (int ai = 0; ai < 2; ++ai)
#pragma unroll
            for (int m = 0; m < 4; ++m) { const int r = 128 * ai + 64 * wr + 16 * m + fr;
#pragma unroll
                for (int bj = 0; bj < 2; ++bj) { const f32x4 v0 = acc[ai][bj][m][0] * (MOE_FP8 ? W8_INV : 1.f) + bv[bj][0], v1 = acc[ai][bj][m][1] * (MOE_FP8 ? W8_INV : 1.f) + bv[bj][1];
                    if constexpr (Y_FP8) { u32x2 w8; w8.x = pk4_fp8(v0[0], v0[1], v0[2], v0[3]); w8.y = pk4_fp8(v1[0], v1[1], v1[2], v1[3]); *(u32x2*)((unsigned char*)y + ((size_t)u.pm * 256 + r) * D + c0 + 128 * bj) = w8; }
                    else { u32x4 w; w.x = cvt_pk_bf16(v0[0], v0[1]); w.y = cvt_pk_bf16(v0[2], v0[3]); w.z = cvt_pk_bf16(v1[0], v1[1]); w.w = cvt_pk_bf16(v1[2], v1[3]);
                    *(u32x4*)(y + ((size_t)u.pm * 256 + r) * D + c0 + 128 * bj) = w; } } }
    }
};

struct EpiProbe { static constexpr bool PERM = true;
    float* sink;
    __device__ __forceinline__ void operator()(const f32x4 (&acc)[2][2][4][2], const pg8::Unit& u, int wr, int wc, int fr, int fq) const {
        float s = 0.f;
#pragma unroll
        for (int ai = 0; ai < 2; ++ai)
#pragma unroll
            for (int bj = 0; bj < 2; ++bj)
#pragma unroll
                for (int m = 0; m < 4; ++m)
#pragma unroll
                    for (int n = 0; n < 2; ++n) s += acc[ai][bj][m][n][0];
        if (s != s) sink[u.pm] = s;
    }
};
template <bool F8 = false> __device__ __forceinline__ void transpose_item64(const float* W, int ldw, int Kd, bf16_t* WT, long dst_row0, const float* g, LAS float* scr, int k0, int srccol, int lane) {
    float v[64];
#pragma unroll
    for (int kk = 0; kk < 64; ++kk) v[kk] = srccol >= 0 ? W[(size_t)(k0 + kk) * ldw + srccol] : 0.f;
    if (g) {
#pragma unroll
        for (int kk = 0; kk < 64; kk += 4) { const f32x4 gg = *(const f32x4*)(g + k0 + kk); v[kk] *= gg[0]; v[kk + 1] *= gg[1]; v[kk + 2] *= gg[2]; v[kk + 3] *= gg[3]; } }
#pragma unroll
    for (int kk = 0; kk < 64; ++kk) scr[lane * 65 + kk] = v[kk];
    LDS_WAIT(); asm volatile("" ::: "memory");
    const int c = lane & 7;
#pragma unroll
    for (int j = 0; j < 8; ++j) { const int n = (lane >> 3) + 8 * j; const LAS float* sp = scr + n * 65 + 8 * c;
        if constexpr (F8) { u32x2 o8; o8.x = pk4_fp8(sp[0] * W8_SCALE, sp[1] * W8_SCALE, sp[2] * W8_SCALE, sp[3] * W8_SCALE); o8.y = pk4_fp8(sp[4] * W8_SCALE, sp[5] * W8_SCALE, sp[6] * W8_SCALE, sp[7] * W8_SCALE);
            *(u32x2*)((unsigned char*)WT + (size_t)(dst_row0 + n) * Kd + k0 + 8 * c) = o8; }
        else { u32x4 o; o.x = pk2(sp[0], sp[1]); o.y = pk2(sp[2], sp[3]); o.z = pk2(sp[4], sp[5]); o.w = pk2(sp[6], sp[7]);
        *(u32x4*)(WT + (size_t)(dst_row0 + n) * Kd + k0 + 8 * c) = o; } }
    LDS_WAIT(); asm volatile("" ::: "memory");
}

__device__ __forceinline__ void moe_weight_convert(const Frame& F, ArgsRef a) {
    LAS float* scr = (LAS float*)(F.wave < 7 ? F.lds + LDS_STAGE + F.wave * 16640 : F.misc + 4096);
    const int gw = F.bid * 8 + F.wave, NGW = F.G * 8;
    const float* gffn = IN(a, I_NORM_FFN_G);
    bf16_t* wgu = (bf16_t*)(WS(a) + WS_WGU); bf16_t* wd = (bf16_t*)(WS(a) + WS_WD);
    constexpr int KB = MOE_FP8 ? 2 : 1, PER = (16 / KB) * 16;
    for (int it = gw; it < 3 * NE * PER; it += NGW) {
        const int mat = it / (NE * PER), r = it % (NE * PER), e = r / PER, q = r % PER, kb0 = (q / 16) * KB, nb = q % 16;
#pragma unroll 1
        for (int kk = 0; kk < KB; ++kk) { const int kb = kb0 + kk;
            if (mat < 2) { const float* W = IN(a, mat == 0 ? I_W_GATE : I_W_UP) + (size_t)e * D * FF;
                const long row = (long)e * 2048 + (nb / 2) * 256 + (mat ? 128 : 0) + (nb % 2) * 64;
                transpose_item64<MOE_FP8>(W, FF, D, wgu, row, gffn, scr, 64 * kb, 64 * nb + F.lane, F.lane);
            } else { const float* W = IN(a, I_W_DOWN) + (size_t)e * FF * D;
                transpose_item64<MOE_FP8>(W, D, FF, wd, (long)e * 1024 + 64 * nb, nullptr, scr, 64 * kb, 64 * nb + F.lane, F.lane); } }
    }
}
__device__ __forceinline__ void router_weight_prep(const Frame& F, ArgsRef a) {
    bf16_t* whi = (bf16_t*)(WS(a) + WS_MISC + MISC_RW_HI); bf16_t* wlo = (bf16_t*)(WS(a) + WS_MISC + MISC_RW_LO);
    const float* wr = IN(a, I_W_ROUTER); const float* g = IN(a, I_NORM_FFN_G);
    for (int i = F.bid * 512 + F.tid; i < NE * D; i += F.G * 512) { const int e = i / D, k = i % D; const float v = g[k] * wr[k * NE + e];
        const unsigned h = f2bf(v); const float r = v - bf2f(h); whi[i] = (bf16_t)h; wlo[i] = (bf16_t)f2bf(r); }
}
__device__ __forceinline__ void copy_x_phase(const Frame& F, ArgsRef a) {
    const int gw = F.bid * 8 + F.wave, NGW = F.G * 8; bf16_t* x2b = (bf16_t*)(WS(a) + WS_X2B);
    for (int t = gw; t < T; t += NGW) { const f32x4* xr = (const f32x4*)(IN(a, I_X) + (size_t)t * D) + F.lane; f32x4* o = (f32x4*)(OUT(a) + (size_t)t * D) + F.lane; u32x2* ob = (u32x2*)(x2b + (size_t)t * D) + F.lane;
#pragma unroll
        for (int j = 0; j < 4; ++j) { const f32x4 v = xr[64 * j]; o[64 * j] = v; u32x2 w; w.x = pk2(v[0], v[1]); w.y = pk2(v[2], v[3]); ob[64 * j] = w; } }
}
__device__ __forceinline__ void router_phase(const Frame& F, ArgsRef a) {
    LAS int* lcnt = (LAS int*)(F.misc + LM_LCNT); LAS int* gbase = (LAS int*)(F.misc + LM_GBASE);
    LAS int* rec_e = (LAS int*)(F.misc + LM_REC); LAS int* rec_p = rec_e + 512; LAS float* rec_w = (LAS float*)(rec_p + 512); LAS float* rec_rs = rec_w + 512; LAS float* scr = (LAS float*)(F.misc + LM_SCR + F.wave * 2304);
    const bf16_t* whi = (const bf16_t*)(WS(a) + WS_MISC + MISC_RW_HI); const bf16_t* wlo = (const bf16_t*)(WS(a) + WS_MISC + MISC_RW_LO);
    unsigned* gcnt = (unsigned*)(WS(a) + WS_CTL) + CW_CNT;
    const float* x2 = X2H ? (const float*)(WS(a) + WS_X2H) : OUT(a); const float* brt = IN(a, I_B_ROUTER);
    const unsigned long long px_ = (unsigned long long)x2; const unsigned long long ux_ = ((unsigned long long)(unsigned)__builtin_amdgcn_readfirstlane((int)(px_ >> 32)) << 32) | (unsigned)__builtin_amdgcn_readfirstlane((int)px_);
    const __amdgpu_buffer_rsrc_t x2rsrc = __builtin_amdgcn_make_buffer_rsrc((void*)ux_, 0, 0x7ffffffc, 0x00020000);
    u32x4* grec = (u32x4*)(WS(a) + WS_REC); int* ltok = (int*)(WS(a) + WS_LTOK); float* lrs = (float*)(WS(a) + WS_LRS);
    const int fr = F.lane & 15, fq = F.lane >> 4;
    LAS unsigned char* wl_lds = F.lds + LDS_STAGE;
    __syncthreads();
    for (int i = F.tid; i < 8192; i += 512) { const int arr = i >> 12, row = (i >> 7) & 31, ch = i & 127; const f32x4 v = *(const f32x4*)((arr ? wlo : whi) + (size_t)row * D + ch * 8);
        *(LAS f32x4*)(wl_lds + arr * 65536 + row * 2048 + ((ch ^ (row & 7)) << 4)) = v; }
    __syncthreads();
#if defined(DIAG2) && (DIAG2 == 29 || DIAG2 == 30 || DIAG2 == 31)
    { unsigned* dbgA = (unsigned*)(WS(a) + WS_CTL + 640 * 1024); unsigned* nb = (unsigned*)(WS(a) + WS_CTL) + 16384; unsigned sm = 0u;
      for (int i = F.lane; i < 4096; i += 64) sm += ((const LAS unsigned*)(wl_lds + F.wave * 16384))[i] * (unsigned)(2 * i + 1);
      for (int o = 1; o < 64; o <<= 1) sm += __shfl_xor(sm, o);
      if (F.lane == 0) { if (a.pass == 0) dbgA[F.bid * 8 + F.wave] = sm; else if (dbgA[F.bid * 8 + F.wave] != sm) atomicAdd(nb + 64 * 1, 1u); } }
#endif
    for (int grp = F.bid; grp < T / 128; grp += F.G) {
        if (F.tid < 32) lcnt[F.tid] = 0;
        __syncthreads();
        const int t0 = grp * 128 + F.wave * 16;
        f32x4 acc0 = {0.f, 0.f, 0.f, 0.f}, acc1 = {0.f, 0.f, 0.f, 0.f}; float ssq = 0.f;
        const float* xr = x2 + (size_t)(t0 + fr) * D + 8 * fq;
#pragma unroll 1
        for (int k8 = 0; k8 < 4; ++k8) {
            f32x4 xa[8], xb[8]; u32x4 xh[8];
#pragma unroll
            for (int u = 0; u < 8; ++u) {
                if constexpr (X2H) { const unsigned vo = (unsigned)(t0 + fr) * 2048u + 16u * fq + 64u * (8 * k8 + u); xh[u] = __builtin_amdgcn_raw_buffer_load_b128(x2rsrc, vo, 0, 16); }
                else { const unsigned vo = (unsigned)(t0 + fr) * 4096u + 32u * fq + 128u * (8 * k8 + u);
                xa[u] = __builtin_bit_cast(f32x4, __builtin_amdgcn_raw_buffer_load_b128(x2rsrc, vo, 0, 16)); xb[u] = __builtin_bit_cast(f32x4, __builtin_amdgcn_raw_buffer_load_b128(x2rsrc, vo + 16u, 0, 16)); } }

#pragma unroll
            for (int u = 0; u < 8; ++u) { const int ks = 8 * k8 + u; bf16x8 ah, al;
                if constexpr (X2H) { const u32x4 hw = xh[u]; const unsigned h0 = hw.x, h1 = hw.y, h2 = hw.z, h3 = hw.w; ah = __builtin_bit_cast(bf16x8, hw);
                    const float e0 = bf2f(h0 & 0xffffu), e1 = bf2f(h0 >> 16), e2 = bf2f(h1 & 0xffffu), e3 = bf2f(h1 >> 16), e4 = bf2f(h2 & 0xffffu), e5 = bf2f(h2 >> 16), e6 = bf2f(h3 & 0xffffu), e7 = bf2f(h3 >> 16);
                    ssq += (e0 * e0 + e1 * e1) + (e2 * e2 + e3 * e3) + (e4 * e4 + e5 * e5) + (e6 * e6 + e7 * e7); al = ah; }
                else { const f32x4 v0 = xa[u], v1 = xb[u];
                ssq += (v0[0] * v0[0] + v0[1] * v0[1]) + (v0[2] * v0[2] + v0[3] * v0[3]) + (v1[0] * v1[0] + v1[1] * v1[1]) + (v1[2] * v1[2] + v1[3] * v1[3]);
                float xv[8] = {v0[0], v0[1], v0[2], v0[3], v1[0], v1[1], v1[2], v1[3]};
#pragma unroll
                for (int j = 0; j < 8; ++j) { const unsigned h = f2bf(xv[j]); ah[j] = (short)h; al[j] = (short)f2bf(xv[j] - bf2f(h)); } }
                const int ch = 4 * ks + fq;
                const LAS unsigned char* w0 = wl_lds + fr * 2048 + ((ch ^ (fr & 7)) << 4); const LAS unsigned char* w1 = wl_lds + (16 + fr) * 2048 + ((ch ^ (fr & 7)) << 4);
                const bf16x8 bh0 = *(const LAS bf16x8*)w0, bh1 = *(const LAS bf16x8*)w1, bl0 = *(const LAS bf16x8*)(w0 + 65536), bl1 = *(const LAS bf16x8*)(w1 + 65536);
                acc0 = __builtin_amdgcn_mfma_f32_16x16x32_bf16(ah, bh0, acc0, 0, 0, 0); if constexpr (!X2H) acc0 = __builtin_amdgcn_mfma_f32_16x16x32_bf16(al, bh0, acc0, 0, 0, 0); acc0 = __builtin_amdgcn_mfma_f32_16x16x32_bf16(ah, bl0, acc0, 0, 0, 0);
                acc1 = __builtin_amdgcn_mfma_f32_16x16x32_bf16(ah, bh1, acc1, 0, 0, 0); if constexpr (!X2H) acc1 = __builtin_amdgcn_mfma_f32_16x16x32_bf16(al, bh1, acc1, 0, 0, 0); acc1 = __builtin_amdgcn_mfma_f32_16x16x32_bf16(ah, bl1, acc1, 0, 0, 0); } }
        ssq += __shfl_xor(ssq, 16); ssq += __shfl_xor(ssq, 32);
#if defined(DIAG2) && (DIAG2 >= 32 && DIAG2 <= 40)
        { float s2 = 0.f; for (int ks = 0; ks < 32; ++ks) for (int j = 0; j < 8; ++j) { const unsigned w = __hip_atomic_load((const unsigned*)(xr + 32 * ks + j), __ATOMIC_RELAXED, DIAG2 == 32 ? __HIP_MEMORY_SCOPE_SYSTEM : __HIP_MEMORY_SCOPE_AGENT); const float f = __uint_as_float(w); s2 += f * f; }
          s2 += __shfl_xor(s2, 16); s2 += __shfl_xor(s2, 32);
          const float rel = fabsf(s2 - ssq) / (fabsf(ssq) + 1e-20f);
          if (F.lane < 16 && !(rel < 1e-3f)) { unsigned* nb_ = (unsigned*)(WS(a) + WS_CTL) + 16384; atomicAdd(nb_ + 64 * 3, 1u); const int t_ = t0 + F.lane;
              if (a.pass == 1) { if (ssq == 0.f) atomicAdd(nb_ + 64 * 11, 1u); else if (s2 == 0.f) atomicAdd(nb_ + 64 * 12, 1u); else atomicAdd(nb_ + 64 * 13, 1u); }
              atomicOr(nb_ + 64 * 4, 1u << (t_ & 15)); atomicOr(nb_ + 64 * 5, 1u << ((t_ >> 4) & 7)); atomicOr(nb_ + 64 * 6, 1u << ((t_ >> 7) & 31)); atomicOr(nb_ + 64 * 7, 1u << ((t_ >> 12) & 7)); } }
#endif
        const float rstd = 1.0f / sqrtf(ssq * (1.0f / D) + RMS_EPS);
#pragma unroll
        for (int r = 0; r < 4; ++r) { scr[(4 * fq + r) * 36 + fr] = acc0[r]; scr[(4 * fq + r) * 36 + 16 + fr] = acc1[r]; }
        LDS_WAIT(); asm volatile("" ::: "memory");
        if (F.lane < 16) {
            float v[32];
#pragma unroll
            for (int e = 0; e < 32; ++e) v[e] = scr[F.lane * 36 + e] * rstd + brt[e];
#if defined(DIAG2) && (DIAG2 == 29 || DIAG2 == 30 || DIAG2 == 31)
            { unsigned* dbgB = (unsigned*)(WS(a) + WS_CTL + 704 * 1024); unsigned* nb = (unsigned*)(WS(a) + WS_CTL) + 16384; unsigned sm = 0u;
              for (int e = 0; e < 32; ++e) sm = sm * 31u + __float_as_uint(v[e]);
              const int t_ = t0 + F.lane; if (a.pass == 0) dbgB[t_] = sm; else if (dbgB[t_] != sm) atomicAdd(nb + 64 * 2, 1u);
              unsigned s2 = __float_as_uint(rstd); unsigned* dbgC = dbgB + 32768; if (a.pass == 0) dbgC[t_] = s2; else if (dbgC[t_] != s2) atomicAdd(nb + 64 * 3, 1u); }
#endif
            float tv[4]; int ti[4];
#pragma unroll
            for (int k = 0; k < 4; ++k) { float best = v[0]; int bi = 0;
#pragma unroll
                for (int e = 1; e < 32; ++e) if (v[e] > best) { best = v[e]; bi = e; }
                tv[k] = best; ti[k] = bi;
#pragma unroll
                for (int e = 0; e < 32; ++e) v[e] = (e == bi) ? -3.0e38f : v[e]; }
            float ex[4], sum = 0.f;
#pragma unroll
            for (int k = 0; k < 4; ++k) { ex[k] = __expf(tv[k] - tv[0]); sum += ex[k]; }
            const float inv = 1.0f / sum;
#pragma unroll
            for (int k = 0; k < 4; ++k) { const int lp = atomicAdd((int*)(lcnt + ti[k]), 1); const int ri = (F.wave * 16 + F.lane) * 4 + k;
                rec_e[ri] = ti[k]; rec_p[ri] = lp; rec_w[ri] = ex[k] * inv; }
            rec_rs[F.wave * 16 + F.lane] = rstd;
        }
        __syncthreads();
        const int half = (grp * 128) / HALF_T;
        if (F.tid < 32) gbase[F.tid] = (int)atomicAdd(gcnt + half * 32 + F.tid, (unsigned)lcnt[F.tid]);
        __syncthreads();
        { const int e = rec_e[F.tid], pos = gbase[e] + rec_p[F.tid], t = grp * 128 + (F.tid >> 2); const float w = rec_w[F.tid], rs = rec_rs[F.tid >> 2];
            float* gr = (float*)(grec + (size_t)t * 4 + (F.tid & 3)); ((int*)gr)[0] = e; ((int*)gr)[1] = pos; gr[2] = w; gr[3] = 0.f;
            const size_t li = ((size_t)half * NE + e) * LIST_CAP + pos; ltok[li] = t; lrs[li] = rs; }
        __syncthreads();
    }
}
__device__ __forceinline__ int moe_tables(const Frame& F, ArgsRef a, int half) {
    LAS int* tend = (LAS int*)(F.misc + LM_TEND); LAS int* cnt = (LAS int*)(F.misc + LM_CNT); LAS int* pstart = (LAS int*)(F.misc + LM_PSTART);
    const unsigned* gcnt = (const unsigned*)(WS(a) + WS_CTL) + CW_CNT + half * 32;
    __syncthreads();
    if (F.tid < 32) cnt[F.tid] = (int)__hip_atomic_load(gcnt + F.tid, __ATOMIC_RELAXED, __HIP_MEMORY_SCOPE_AGENT);
    __syncthreads();
    if (F.tid == 0) { int acc = 0; for (int e = 0; e < NE; ++e) { pstart[e] = acc * 256; acc += (cnt[e] + 255) >> 8; tend[e] = acc; } }
    __syncthreads();
    { LAS int* tile_e = (LAS int*)(F.misc + LM_TILE); for (int ti = F.tid; ti < 576; ti += 512) { int e = 0; while (e < NE - 1 && ti >= tend[e]) ++e; const int t0 = e ? tend[e - 1] : 0; tile_e[ti] = (e << 16) | (ti - t0); } }
    __syncthreads();
    return __builtin_amdgcn_readfirstlane(tend[NE - 1]);
}
__device__ __forceinline__ void combine_phase(const Frame& F, ArgsRef a, int half) {
    const LAS int* pstart = (const LAS int*)(F.misc + LM_PSTART);
    const u32x4* grec = (const u32x4*)(WS(a) + WS_REC); const bf16_t* y = (const bf16_t*)(WS(a) + WS_Y); const float* gfin = IN(a, I_NORM_FINAL_G);
    const int gw = F.bid * 8 + F.wave, NGW = F.G * 8;
    for (int tb2 = half * HALF_T + gw * 2; tb2 < (half + 1) * HALF_T; tb2 += NGW * 2) {
        int slot[2][4]; float rw[2][4];
#pragma unroll
        for (int u = 0; u < 2; ++u)
#pragma unroll
            for (int k = 0; k < 4; ++k) { const int* ri = (const int*)(grec + (size_t)(tb2 + u) * 4 + k); const int re = ri[0], rp = ri[1]; rw[u][k] = ((const float*)ri)[2]; slot[u][k] = pstart[re] + rp; }
        f32x4 v[2][4]; u32x2 yv[2][4][4];
#pragma unroll
        for (int u = 0; u < 2; ++u) {
            if constexpr (X2H) { const u32x2* xh = (const u32x2*)((const bf16_t*)(WS(a) + WS_X2H) + (size_t)(tb2 + u) * D) + F.lane;
#pragma unroll
                for (int j = 0; j < 4; ++j) { const u32x2 hw = xh[64 * j]; const unsigned h0 = hw.x, h1 = hw.y; v[u][j] = (f32x4){bf2f(h0 & 0xffffu), bf2f(h0 >> 16), bf2f(h1 & 0xffffu), bf2f(h1 >> 16)}; } }
            else { const f32x4* xr = (const f32x4*)(OUT(a) + (size_t)(tb2 + u) * D) + F.lane;
#pragma unroll
            for (int j = 0; j < 4; ++j) v[u][j] = xr[64 * j]; }
#pragma unroll
            for (int k = 0; k < 4; ++k) {
                if constexpr (Y_FP8) { const unsigned* yr = (const unsigned*)((const unsigned char*)y + (size_t)slot[u][k] * D) + F.lane;
#pragma unroll
                    for (int j = 0; j < 4; ++j) { yv[u][k][j].x = yr[64 * j]; yv[u][k][j].y = 0u; } }
                else { const u32x2* yr = (const u32x2*)(y + (size_t)slot[u][k] * D) + F.lane;
#pragma unroll
                    for (int j = 0; j < 4; ++j) yv[u][k][j] = yr[64 * j]; } } }
#pragma unroll
        for (int u = 0; u < 2; ++u) {
#pragma unroll
            for (int k = 0; k < 4; ++k) { const float w = rw[u][k];
#pragma unroll
                for (int j = 0; j < 4; ++j) { const u32x2 p = yv[u][k][j];
                    if constexpr (Y_FP8) { const unsigned pw = p.x; const f32x2 lo = __builtin_amdgcn_cvt_pk_f32_fp8(pw, false), hi = __builtin_amdgcn_cvt_pk_f32_fp8(pw, true);
                        v[u][j][0] += w * lo[0]; v[u][j][1] += w * lo[1]; v[u][j][2] += w * hi[0]; v[u][j][3] += w * hi[1]; }
                    else { v[u][j][0] += w * bf2f(p.x & 0xffffu); v[u][j][1] += w * bf2f(p.x >> 16); v[u][j][2] += w * bf2f(p.y & 0xffffu); v[u][j][3] += w * bf2f(p.y >> 16); } } }
            float ss = 0.f;
#pragma unroll
            for (int j = 0; j < 4; ++j) ss += (v[u][j][0] * v[u][j][0] + v[u][j][1] * v[u][j][1]) + (v[u][j][2] * v[u][j][2] + v[u][j][3] * v[u][j][3]);
            const float rstd = 1.0f / sqrtf(wave_sum(ss) * (1.0f / D) + RMS_EPS); f32x4* xo = (f32x4*)(OUT(a) + (size_t)(tb2 + u) * D) + F.lane;
#pragma unroll
            for (int j = 0; j < 4; ++j) { const f32x4 g = ((const f32x4*)gfin)[F.lane + 64 * j]; xo[64 * j] = v[u][j] * rstd * g; } }
    }
}

#ifndef V1TEST
#define V1TEST 0
#endif
#ifndef RT_VAR
#define RT_VAR 0
#endif
constexpr int D_IN = 8648;
__device__ __forceinline__ int win_src_col(int n) {
    if (n < 1024) return 456 + n;
    if (n < 1280) return n - 1024;
    if (n < 1480) return 256 + (n - 1280);
    if (n < 1536) return -1;
    if (n < 2560) return 1480 + (n - 1536);
    if (n < 4608) return 2504 + (n - 2560);
    return 4552 + (n - 4608);
}
template <int PM = 63> __device__ __forceinline__ void mixer_prep_phase(const Frame& F, ArgsRef a) {
    const int gw = F.bid * 8 + F.wave, NGW = F.G * 8, gt = F.bid * 512 + F.tid, NGT = F.G * 512;
    unsigned char* ws = WS(a);
    if (PM & 1) { bf16_t* xb = (bf16_t*)(ws + WS_XB); float* rstd1 = (float*)(ws + WS_MISC + MISC_RSTD1);
      for (int t4 = gw * 4; t4 < T; t4 += NGW * 4) { f32x4 v[4][4];
#pragma unroll
          for (int u = 0; u < 4; ++u) { const f32x4* xr = (const f32x4*)(IN(a, I_X) + (size_t)(t4 + u) * D) + F.lane;
#pragma unroll
              for (int j = 0; j < 4; ++j) v[u][j] = xr[64 * j]; }
#pragma unroll
          for (int u = 0; u < 4; ++u) { u32x2* ob = (u32x2*)(xb + (size_t)(t4 + u) * D) + F.lane; unsigned* o8 = (unsigned*)(ws + WS_XB8 + (size_t)(t4 + u) * D) + F.lane; float ss = 0.f;
#pragma unroll
              for (int j = 0; j < 4; ++j) { const f32x4 x = v[u][j]; ss += (x[0] * x[0] + x[1] * x[1]) + (x[2] * x[2] + x[3] * x[3]); u32x2 w; w.x = pk2(x[0], x[1]); w.y = pk2(x[2], x[3]); ob[64 * j] = w;
                  if constexpr (INC_FP8) o8[64 * j] = pk4_fp8(x[0], x[1], x[2], x[3]); }
              ss = wave_sum(ss); if (F.lane == 0) rstd1[t4 + u] = 1.0f / sqrtf(ss * (1.0f / D) + RMS_EPS); } } }
    if (PM & 2) { LAS float* scr = (LAS float*)(F.wave < 7 ? F.lds + LDS_STAGE + F.wave * 16640 : F.misc + 4096); const float* g = IN(a, I_NORM_MIX_G);
      constexpr int I_WIN = 16 * (NIN / 64), I_WB = 32 * 16, I_WO = 16 * 16;
      for (int it = gw; it < I_WIN + I_WB + I_WO; it += NGW) {
          if (it < I_WIN) { const int kb = it / (NIN / 64), nb = it % (NIN / 64);
              if (INC_FP8 && nb >= 72) transpose_item64<true>(IN(a, I_W_IN), D_IN, D, (bf16_t*)(ws + WS_WIN8), 64 * (nb - 72), g, scr, 64 * kb, win_src_col(64 * nb + F.lane), F.lane);
              else if (INB_FP8 && nb >= 40) transpose_item64<true>(IN(a, I_W_IN), D_IN, D, (bf16_t*)(ws + WS_WIN8 + 4 * MiB), 64 * (nb - 40), g, scr, 64 * kb, win_src_col(64 * nb + F.lane), F.lane);
              else transpose_item64(IN(a, I_W_IN), D_IN, D, (bf16_t*)(ws + WS_WIN), 64 * nb, g, scr, 64 * kb, win_src_col(64 * nb + F.lane), F.lane); }
          else if (it < I_WIN + I_WB) { const int r = it - I_WIN, kb = r / 16, nb = r % 16; transpose_item64(IN(a, I_W_BB), D, 2048, (bf16_t*)(ws + WS_WB), 64 * nb, nullptr, scr, 64 * kb, 64 * nb + F.lane, F.lane); }
          else { const int r = it - I_WIN - I_WB, kb = r / 16, nb = r % 16; transpose_item64(IN(a, I_W_OUT), D, D, (bf16_t*)(ws + WS_WOUT), 64 * nb, nullptr, scr, 64 * kb, 64 * nb + F.lane, F.lane); } } }
    if (PM & 4) { bf16_t* wq = (bf16_t*)(ws + WS_WQ); const float* wuq = IN(a, I_W_UQ); const float* wuk = IN(a, I_W_UK); const float* wqi = IN(a, I_W_QIDX); const float* cg = IN(a, I_CQ_G);
      for (int i = gt; i < 1536 * 32; i += NGT) { const int kk = i / 1536, n = i - kk * 1536;
          float v[8];
          if (n < 1024) { const int h = n >> 7; const float* q = wuk + (size_t)n * 128; const float* p = wuq + (size_t)(8 * kk) * 1024 + h * 128;
#pragma unroll
              for (int jj = 0; jj < 8; ++jj) v[jj] = 0.f;
#pragma unroll 2
              for (int d = 0; d < 128; d += 4) { const f32x4 y = *(const f32x4*)(q + d);
#pragma unroll
                  for (int jj = 0; jj < 8; ++jj) { const f32x4 x = *(const f32x4*)(p + jj * 1024 + d); v[jj] += (x[0] * y[0] + x[1] * y[1]) + (x[2] * y[2] + x[3] * y[3]); } } }
          else {
#pragma unroll
              for (int jj = 0; jj < 8; ++jj) v[jj] = wqi[(size_t)(8 * kk + jj) * 512 + (n - 1024)] * 0.125f; }
          const f32x4 g0 = *(const f32x4*)(cg + 8 * kk), g1 = *(const f32x4*)(cg + 8 * kk + 4);
          u32x4 w; w.x = pk2(v[0] * g0[0], v[1] * g0[1]); w.y = pk2(v[2] * g0[2], v[3] * g0[3]); w.z = pk2(v[4] * g1[0], v[5] * g1[1]); w.w = pk2(v[6] * g1[2], v[7] * g1[3]);
          *(u32x4*)(wq + (size_t)n * 256 + 8 * kk) = w; } }
    if (PM & 8) { bf16_t* wa = (bf16_t*)(ws + WS_WA); const float* wuv = IN(a, I_W_UV); const float* wba = IN(a, I_W_BA);
      for (int i = gt; i < 1024 * 128; i += NGT) { const int kk = i >> 10, n = i & 1023, h = kk >> 4, rr = kk & 15; const float* q = wba + (size_t)(h * 128) * 1024 + n;
          const float* p[8];
#pragma unroll
          for (int jj = 0; jj < 8; ++jj) p[jj] = wuv + (size_t)(MIXA_FP8 ? h * 128 + 32 * (jj & 3) + 2 * rr + (jj >> 2) : 8 * kk + jj) * 128;
          float v[8];
#pragma unroll
          for (int jj = 0; jj < 8; ++jj) v[jj] = 0.f;
#pragma unroll 2
          for (int d = 0; d < 128; d += 4) { const float y0 = q[(size_t)d * 1024], y1 = q[(size_t)(d + 1) * 1024], y2 = q[(size_t)(d + 2) * 1024], y3 = q[(size_t)(d + 3) * 1024];
#pragma unroll
              for (int jj = 0; jj < 8; ++jj) { const f32x4 x = *(const f32x4*)(p[jj] + d); v[jj] += (x[0] * y0 + x[1] * y1) + (x[2] * y2 + x[3] * y3); } }
          if constexpr (MIXA_FP8) { u32x2 w8; w8.x = pk4_fp8(v[0] * W8_SCALE, v[1] * W8_SCALE, v[2] * W8_SCALE, v[3] * W8_SCALE); w8.y = pk4_fp8(v[4] * W8_SCALE, v[5] * W8_SCALE, v[6] * W8_SCALE, v[7] * W8_SCALE);
              *(u32x2*)((unsigned char*)wa + (size_t)n * 1024 + h * 128 + 8 * rr) = w8; }
          else { u32x4 w; w.x = pk2(v[0], v[1]); w.y = pk2(v[2], v[3]); w.z = pk2(v[4], v[5]); w.w = pk2(v[6], v[7]);
          *(u32x4*)(wa + (size_t)n * 1024 + 8 * kk) = w; } } }
    if (PM & 16) { float* cosP = (float*)(ws + WS_COSP); float* sinP = (float*)(ws + WS_SINP); float* cosT = (float*)(ws + WS_COST); float* sinT = (float*)(ws + WS_SINT);
      LAS double* invr = (LAS double*)(F.misc + LM_SCR);
      __syncthreads();
      if (F.tid < 128) invr[F.tid] = exp(-9.210340371976184 * (double)F.tid / 128.0) * 0.15915494309189535;
      __syncthreads();
      for (int i = gt; i < SEQ * 128; i += NGT) { const int pos = i >> 7, j = i & 127; const double rev = (double)pos * invr[j]; const float fr_ = (float)(rev - floor(rev));
          const float c = __builtin_amdgcn_cosf(fr_), sn = __builtin_amdgcn_sinf(fr_); cosP[i] = c; sinP[i] = sn; cosT[j * SEQ + pos] = c; sinT[j * SEQ + pos] = sn; }
      __syncthreads();
      if (gt < 256) { const int h = gt >> 6, i = gt & 63; const double lg = log(1.0 - exp2(-5.0 - (double)h));
          ((float*)(ws + WS_MISC + MISC_DQ))[gt] = (float)exp(lg * (i + 1)); ((float*)(ws + WS_MISC + MISC_DK))[gt] = (float)(exp(-lg * (i + 1)) * 0.0625); ((float*)(ws + WS_MISC + MISC_DZ))[gt] = (float)(exp(lg * (63 - i)) * 0.0625); } }
    if (PM & 32) router_weight_prep(F, a);
}

struct EpiInA { static constexpr bool PERM = true;
    bf16_t* qx; float* small; const float* rstd1; const float* cosP; const float* sinP; const float* dq;
    bf16_t* cqn; bf16_t* ckv; bf16_t* kidx; float* widx; const float* gkv; const float* gki; LAS float* xch;
    __device__ __forceinline__ void small_fused(const f32x4 (&acc)[2][2][4][2], const pg8::Unit& u, int wr, int wc, int fr, int fq) const {
        const int d0 = 32 * wc + 8 * fq;
#pragma unroll
        for (int ai = 0; ai < 2; ++ai) {
#pragma unroll
            for (int m = 0; m < 4; ++m) { int rl_ = 128 * ai + 64 * wr + 16 * m + fr; asm volatile("" : "+v"(rl_)); float p0 = 0.f, p1 = 0.f; const float rsv_ = rstd1[u.pm * 256 + rl_];
#pragma unroll
                for (int n = 0; n < 2; ++n)
#pragma unroll
                    for (int i = 0; i < 4; ++i) { const float x0 = acc[ai][0][m][n][i] * rsv_, x1 = acc[ai][1][m][n][i] * rsv_; p0 += x0 * x0; p1 += x1 * x1; }
                p0 += __shfl_xor(p0, 16); p0 += __shfl_xor(p0, 32); p1 += __shfl_xor(p1, 16); p1 += __shfl_xor(p1, 32);
                if (fq == 0) { xch[rl_ * 8 + wc] = p0; xch[rl_ * 8 + 4 + wc] = p1; } } }
        asm volatile("s_waitcnt lgkmcnt(0)" ::: "memory"); __builtin_amdgcn_s_barrier(); asm volatile("" ::: "memory");
#pragma unroll
        for (int ai = 0; ai < 2; ++ai)
#pragma unroll
            for (int m = 0; m < 4; ++m) { int rl = 128 * ai + 64 * wr + 16 * m + fr; asm volatile("" : "+v"(rl));        const size_t row = (size_t)u.pm * 256 + rl;
                const f32x4 q0 = *(const LAS f32x4*)(xch + rl * 8), q1 = *(const LAS f32x4*)(xch + rl * 8 + 4); const float rsm = rstd1[row];
                if (u.pn == 4) { const float r = rsm * (1.0f / sqrtf(((q0[0] + q0[1]) + (q0[2] + q0[3]) + (q1[0] + q1[1]) + (q1[2] + q1[3])) * (1.f / 256.f) + RMS_EPS));
#pragma unroll
                    for (int bj = 0; bj < 2; ++bj) { const f32x4 v0 = acc[ai][bj][m][0] * r, v1 = acc[ai][bj][m][1] * r; u32x4 w; w.x = cvt_pk_bf16(v0[0], v0[1]); w.y = cvt_pk_bf16(v0[2], v0[3]); w.z = cvt_pk_bf16(v1[0], v1[1]); w.w = cvt_pk_bf16(v1[2], v1[3]);
                        *(u32x4*)(cqn + row * 256 + 128 * bj + d0) = w; } }
                else { const float* gkv_ = gkv; const float* gki_ = gki; asm volatile("" : "+s"(gkv_), "+s"(gki_));
                    { const float r = rsm * (1.0f / sqrtf(((q0[0] + q0[1]) + (q0[2] + q0[3])) * (1.f / 128.f) + RMS_EPS)); const f32x4 g0 = *(const f32x4*)(gkv_ + d0), g1 = *(const f32x4*)(gkv_ + d0 + 4);
                        const f32x4 v0 = acc[ai][0][m][0] * r * g0, v1 = acc[ai][0][m][1] * r * g1; u32x4 w; w.x = cvt_pk_bf16(v0[0], v0[1]); w.y = cvt_pk_bf16(v0[2], v0[3]); w.z = cvt_pk_bf16(v1[0], v1[1]); w.w = cvt_pk_bf16(v1[2], v1[3]);
                        *(u32x4*)(ckv + row * 128 + d0) = w; }
                    if (wc < 2) { const float r = rsm * (1.0f / sqrtf((q1[0] + q1[1]) * (1.f / 64.f) + RMS_EPS)); const f32x4 g0 = *(const f32x4*)(gki_ + d0), g1 = *(const f32x4*)(gki_ + d0 + 4);
                        const f32x4 v0 = acc[ai][1][m][0] * r * g0, v1 = acc[ai][1][m][1] * r * g1; u32x4 w; w.x = cvt_pk_bf16(v0[0], v0[1]); w.y = cvt_pk_bf16(v0[2], v0[3]); w.z = cvt_pk_bf16(v1[0], v1[1]); w.w = cvt_pk_bf16(v1[2], v1[3]);
                        *(u32x4*)(kidx + row * 64 + d0) = w; }
                    else if (wc == 2 && fq == 0) { const float sc = 0.35355339059327373f * rsm; *(f32x4*)(widx + row * 8) = acc[ai][1][m][0] * sc; *(f32x4*)(widx + row * 8 + 4) = acc[ai][1][m][1] * sc; } } }
    }
    __device__ __forceinline__ void operator()(const f32x4 (&acc)[2][2][4][2], const pg8::Unit& u, int wr, int wc, int fr, int fq) const {
        const int d0 = 32 * wc + 8 * fq;
        if (ROWNORM_FUSED && u.pn >= 4) { small_fused(acc, u, wr, wc, fr, fq); return; }
#pragma unroll
        for (int ai = 0; ai < 2; ++ai) { const int row0 = u.pm * 256 + 128 * ai + 64 * wr + fr;
            float rs[4];
#pragma unroll
            for (int m = 0; m < 4; ++m) rs[m] = rstd1[row0 + 16 * m];
            if (u.pn < 4) { f32x4 c4[4][2], s4[4][2]; float sc[4];
#pragma unroll
                for (int m = 0; m < 4; ++m) { const int pos = (row0 + 16 * m) & (SEQ - 1); sc[m] = dq[u.pn * 64 + (pos & 63)];
#pragma unroll
                    for (int n = 0; n < 2; ++n) { c4[m][n] = *(const f32x4*)(cosP + pos * 128 + d0 + 4 * n); s4[m][n] = *(const f32x4*)(sinP + pos * 128 + d0 + 4 * n); } }
#pragma unroll
                for (int m = 0; m < 4; ++m) { const float scm = sc[m] * rs[m]; float o1[8], o2[8];
#pragma unroll
                    for (int n = 0; n < 2; ++n)
#pragma unroll
                        for (int i = 0; i < 4; ++i) { const float v1 = acc[ai][0][m][n][i], v2 = acc[ai][1][m][n][i]; o1[4 * n + i] = (v1 * c4[m][n][i] - v2 * s4[m][n][i]) * scm; o2[4 * n + i] = (v2 * c4[m][n][i] + v1 * s4[m][n][i]) * scm; }
                    u32x4 w1, w2; w1.x = cvt_pk_bf16(o1[0], o1[1]); w1.y = cvt_pk_bf16(o1[2], o1[3]); w1.z = cvt_pk_bf16(o1[4], o1[5]); w1.w = cvt_pk_bf16(o1[6], o1[7]);
                    w2.x = cvt_pk_bf16(o2[0], o2[1]); w2.y = cvt_pk_bf16(o2[2], o2[3]); w2.z = cvt_pk_bf16(o2[4], o2[5]); w2.w = cvt_pk_bf16(o2[6], o2[7]);
                    bf16_t* p = qx + (size_t)(row0 + 16 * m) * 1024 + u.pn * 256 + d0; *(u32x4*)p = w1; *(u32x4*)(p + 128) = w2; }
            } else {
#pragma unroll
                for (int m = 0; m < 4; ++m) { float* p = small + (size_t)(row0 + 16 * m) * 512 + (u.pn - 4) * 256 + d0;
#pragma unroll
                    for (int bj = 0; bj < 2; ++bj)
#pragma unroll
                        for (int n = 0; n < 2; ++n) *(f32x4*)(p + 128 * bj + 4 * n) = acc[ai][bj][m][n] * rs[m]; } } }
    }
};
template <int PN0 = 0, bool F8 = false> struct EpiInB { static constexpr bool PERM = false;
    bf16_t* kzt; bf16_t* vt; const float* rstd1; const float* cosT; const float* sinT; const float* dz;
    __device__ __forceinline__ void operator()(const f32x4 (&acc)[2][2][4][2], const pg8::Unit& u, int wr, int wc, int fr, int fq) const {
#pragma unroll
        for (int ai = 0; ai < 2; ++ai) { const int tokb = u.pm * 256 + 128 * ai + 64 * wr + 16 * fq, b = tokb >> 11, posb = tokb & (SEQ - 1);
            f32x4 rs4[4];
#pragma unroll
            for (int m = 0; m < 4; ++m) rs4[m] = *(const f32x4*)(rstd1 + tokb + 4 * m);
            const int pn = u.pn + PN0;
            if (pn < 4) { const int h = pn;
#pragma unroll
              for (int mg = 0; mg < 2; ++mg) { f32x4 kz4[2], c4[2][2], s4[2][2];
#pragma unroll
                for (int mm = 0; mm < 2; ++mm) { const int m = 2 * mg + mm; kz4[mm] = *(const f32x4*)(dz + h * 64 + ((posb + 4 * m) & 63));
#pragma unroll
                    for (int n = 0; n < 2; ++n) { const int d = 32 * wc + 16 * n + fr; c4[mm][n] = *(const f32x4*)(cosT + d * SEQ + posb + 4 * m); s4[mm][n] = *(const f32x4*)(sinT + d * SEQ + posb + 4 * m); } }
#pragma unroll
                for (int n = 0; n < 2; ++n) { const int d = 32 * wc + 16 * n + fr; float o1[8], o2[8];
#pragma unroll
                    for (int mm = 0; mm < 2; ++mm) { const int m = 2 * mg + mm;
#pragma unroll
                        for (int i = 0; i < 4; ++i) { const float v1 = acc[ai][0][m][n][i] * rs4[m][i], v2 = acc[ai][1][m][n][i] * rs4[m][i]; o1[4 * mm + i] = (v1 * c4[mm][n][i] - v2 * s4[mm][n][i]) * kz4[mm][i]; o2[4 * mm + i] = (v2 * c4[mm][n][i] + v1 * s4[mm][n][i]) * kz4[mm][i]; } }
                    u32x4 z1, z2; z1.x = cvt_pk_bf16(o1[0], o1[1]); z1.y = cvt_pk_bf16(o1[2], o1[3]); z1.z = cvt_pk_bf16(o1[4], o1[5]); z1.w = cvt_pk_bf16(o1[6], o1[7]);
                    z2.x = cvt_pk_bf16(o2[0], o2[1]); z2.y = cvt_pk_bf16(o2[2], o2[3]); z2.z = cvt_pk_bf16(o2[4], o2[5]); z2.w = cvt_pk_bf16(o2[6], o2[7]);
                    bf16_t* q = kzt + ((size_t)((b * 4 + h) * 256 + d)) * SEQ + posb + 8 * mg; *(u32x4*)q = z1; *(u32x4*)(q + (size_t)128 * SEQ) = z2; } }
            } else { const int j = pn - 4, hd = j >> 1;
#pragma unroll
                for (int bj = 0; bj < 2; ++bj)
#pragma unroll
                    for (int n = 0; n < 2; ++n) { const int v = (j & 1) * 256 + 128 * bj + 32 * wc + 16 * n + fr; bf16_t* q = vt + ((size_t)((b * 4 + hd) * 512 + v)) * SEQ + posb;
#pragma unroll
                        for (int mg = 0; mg < 2; ++mg) { const f32x4 x0 = acc[ai][bj][2 * mg][n] * rs4[2 * mg] * (F8 ? W8_INV : 1.f), x1 = acc[ai][bj][2 * mg + 1][n] * rs4[2 * mg + 1] * (F8 ? W8_INV : 1.f);
                            u32x4 z; z.x = cvt_pk_bf16(x0[0], x0[1]); z.y = cvt_pk_bf16(x0[2], x0[3]); z.z = cvt_pk_bf16(x1[0], x1[1]); z.w = cvt_pk_bf16(x1[2], x1[3]); *(u32x4*)(q + 8 * mg) = z; } } } }
    }
};
struct EpiInC { static constexpr bool PERM = true;
    bf16_t* oret; bf16_t* ga; bf16_t* gb; const float* rstd1; const float* rn;
    __device__ __forceinline__ void operator()(const f32x4 (&acc)[2][2][4][2], const pg8::Unit& u, int wr, int wc, int fr, int fq) const {
        const int c0 = 32 * wc + 8 * fq;
#pragma unroll
        for (int ai = 0; ai < 2; ++ai) { const int row0 = u.pm * 256 + 128 * ai + 64 * wr + fr;
            float rs[4], rr[4]; unsigned ow[4][2][4];
#pragma unroll
            for (int m = 0; m < 4; ++m) { rs[m] = rstd1[row0 + 16 * m] * (INC_FP8 ? W8_INV : 1.f); rr[m] = 1.f; }
            if (u.pn < 8) {
#pragma unroll
                for (int m = 0; m < 4; ++m) { rr[m] = rn[(row0 + 16 * m) * 4 + (u.pn >> 1)];
#pragma unroll
                    for (int bj = 0; bj < 2; ++bj) ld4u(oret + (size_t)(row0 + 16 * m) * 2048 + u.pn * 256 + 128 * bj + c0, ow[m][bj]); } }
#pragma unroll
            for (int m = 0; m < 4; ++m)
#pragma unroll
                for (int bj = 0; bj < 2; ++bj) { float v[8];
#pragma unroll
                    for (int n = 0; n < 2; ++n)
#pragma unroll
                        for (int i = 0; i < 4; ++i) { const float x = acc[ai][bj][m][n][i] * rs[m]; v[4 * n + i] = __builtin_amdgcn_rcpf(1.f + __builtin_amdgcn_exp2f(-1.4426950408889634f * x)) * (u.pn < 8 ? x : 1.f); }
                    bf16_t* p;
                    if (u.pn < 8) { p = oret + (size_t)(row0 + 16 * m) * 2048 + u.pn * 256 + 128 * bj + c0;
#pragma unroll
                        for (int q = 0; q < 4; ++q) { v[2 * q] *= bf2f(ow[m][bj][q] & 0xffffu) * rr[m]; v[2 * q + 1] *= bf2f(ow[m][bj][q] >> 16) * rr[m]; } }
                    else if (u.pn < 12) { p = ga + (size_t)(row0 + 16 * m) * 1024 + (u.pn - 8) * 256 + 128 * bj + c0;
                        if constexpr (GA8) { u32x2 w8; w8.x = pk4_fp8(v[0], v[1], v[2], v[3]); w8.y = pk4_fp8(v[4], v[5], v[6], v[7]); *(u32x2*)((unsigned char*)ga + (size_t)(row0 + 16 * m) * 1024 + (u.pn - 8) * 256 + 128 * bj + c0) = w8; continue; } }
                    else p = gb + (size_t)(row0 + 16 * m) * 1024 + (u.pn - 12) * 256 + 128 * bj + c0;
                    u32x4 w; w.x = cvt_pk_bf16(v[0], v[1]); w.y = cvt_pk_bf16(v[2], v[3]); w.z = cvt_pk_bf16(v[4], v[5]); w.w = cvt_pk_bf16(v[6], v[7]); *(u32x4*)p = w; } }
    }
};
template <int MODE, bool F8S = false> struct EpiMix { static constexpr bool PERM = true;
    const bf16_t* gate; bf16_t* mixa; bf16_t* mix;
    static constexpr bool G8 = GA8 && MODE == 0, M8 = GA8;
    __device__ static __forceinline__ void ld8(const void* base, size_t eoff, bool f8, unsigned (&w)[4]) { if (f8) { const u32x2 t = *(const u32x2*)((const unsigned char*)base + eoff); w[0] = t.x; w[1] = t.y; w[2] = 0u; w[3] = 0u; } else ld4u((const bf16_t*)base + eoff, w); }
    __device__ static __forceinline__ void un8(const unsigned (&w)[4], bool f8, float (&f)[8]) {
        if (f8) { const f32x2 a0 = __builtin_amdgcn_cvt_pk_f32_fp8(w[0], false), a1 = __builtin_amdgcn_cvt_pk_f32_fp8(w[0], true), a2 = __builtin_amdgcn_cvt_pk_f32_fp8(w[1], false), a3 = __builtin_amdgcn_cvt_pk_f32_fp8(w[1], true);
            f[0] = a0[0]; f[1] = a0[1]; f[2] = a1[0]; f[3] = a1[1]; f[4] = a2[0]; f[5] = a2[1]; f[6] = a3[0]; f[7] = a3[1]; }
        else {
#pragma unroll
            for (int q = 0; q < 4; ++q) { f[2 * q] = bf2f(w[q] & 0xffffu); f[2 * q + 1] = bf2f(w[q] >> 16); } } }
    __device__ __forceinline__ void operator()(const f32x4 (&acc)[2][2][4][2], const pg8::Unit& u, int wr, int wc, int fr, int fq) const {
#pragma unroll
        for (int ai = 0; ai < 2; ++ai) { const size_t off0 = (size_t)(u.pm * 256 + 128 * ai + 64 * wr + fr) * 1024 + u.pn * 256 + 32 * wc + 8 * fq;
            unsigned gw[4][2][4], mw[4][2][4];
#pragma unroll
            for (int m = 0; m < 4; ++m)
#pragma unroll
                for (int bj = 0; bj < 2; ++bj) { ld8(gate, off0 + (size_t)m * 16 * 1024 + 128 * bj, G8, gw[m][bj]); if (MODE == 1) ld8(mixa, off0 + (size_t)m * 16 * 1024 + 128 * bj, M8, mw[m][bj]); }
#pragma unroll
            for (int m = 0; m < 4; ++m)
#pragma unroll
                for (int bj = 0; bj < 2; ++bj) { float v[8], g[8]; un8(gw[m][bj], G8, g);
#pragma unroll
                    for (int q = 0; q < 8; ++q) v[q] = g[q] * acc[ai][bj][m][q >> 2][q & 3] * (F8S ? W8_INV * 0.25f : 1.f);
                    if (MODE == 1) { float mm[8]; un8(mw[m][bj], M8, mm);
#pragma unroll
                        for (int q = 0; q < 8; ++q) v[q] += mm[q]; }
                    const size_t off = off0 + (size_t)m * 16 * 1024 + 128 * bj;
                    if (MODE == 0 && M8) { u32x2 w8; w8.x = pk4_fp8(v[0], v[1], v[2], v[3]); w8.y = pk4_fp8(v[4], v[5], v[6], v[7]); *(u32x2*)((unsigned char*)mixa + off) = w8; }
                    else { u32x4 w; w.x = cvt_pk_bf16(v[0], v[1]); w.y = cvt_pk_bf16(v[2], v[3]); w.z = cvt_pk_bf16(v[4], v[5]); w.w = cvt_pk_bf16(v[6], v[7]);
                        *(u32x4*)((MODE == 0 ? mixa : mix) + off) = w; } } }
    }
};
struct EpiOut { static constexpr bool PERM = true;
    const bf16_t* x; float* out; bf16_t* x2b;
    __device__ __forceinline__ void operator()(const f32x4 (&acc)[2][2][4][2], const pg8::Unit& u, int wr, int wc, int fr, int fq) const {
#pragma unroll
        for (int ai = 0; ai < 2; ++ai) { const size_t off0 = (size_t)(u.pm * 256 + 128 * ai + 64 * wr + fr) * 1024 + u.pn * 256 + 32 * wc + 8 * fq;
            f32x4 xv[4][2][2];
#pragma unroll
            for (int m = 0; m < 4; ++m)
#pragma unroll
                for (int bj = 0; bj < 2; ++bj) { unsigned xw[4]; ld4u(x + off0 + (size_t)m * 16 * 1024 + 128 * bj, xw);
                    xv[m][bj][0] = (f32x4){bf2f(xw[0] & 0xffffu), bf2f(xw[0] >> 16), bf2f(xw[1] & 0xffffu), bf2f(xw[1] >> 16)}; xv[m][bj][1] = (f32x4){bf2f(xw[2] & 0xffffu), bf2f(xw[2] >> 16), bf2f(xw[3] & 0xffffu), bf2f(xw[3] >> 16)}; }
#pragma unroll
            for (int m = 0; m < 4; ++m)
#pragma unroll
                for (int bj = 0; bj < 2; ++bj) { const size_t off = off0 + (size_t)m * 16 * 1024 + 128 * bj; const f32x4 r0 = xv[m][bj][0] + acc[ai][bj][m][0], r1 = xv[m][bj][1] + acc[ai][bj][m][1];
                    if constexpr (X2H) { u32x4 wh; wh.x = cvt_pk_bf16(r0[0], r0[1]); wh.y = cvt_pk_bf16(r0[2], r0[3]); wh.z = cvt_pk_bf16(r1[0], r1[1]); wh.w = cvt_pk_bf16(r1[2], r1[3]); *(u32x4*)((bf16_t*)out + off) = wh; }
                    else { *(f32x4*)(out + off) = r0; *(f32x4*)(out + off + 4) = r1; }
                    if constexpr (MOE_FP8) { u32x2 w8; w8.x = pk4_fp8(r0[0], r0[1], r0[2], r0[3]); w8.y = pk4_fp8(r1[0], r1[1], r1[2], r1[3]); *(u32x2*)((unsigned char*)x2b + off) = w8; }
                    else { u32x4 w; w.x = cvt_pk_bf16(r0[0], r0[1]); w.y = cvt_pk_bf16(r0[2], r0[3]); w.z = cvt_pk_bf16(r1[0], r1[1]); w.w = cvt_pk_bf16(r1[2], r1[3]); *(u32x4*)(x2b + off) = w; } } }
    }
};

constexpr int RT_QX = 0, RT_KP = 33280, RT_KZT = 66560, RT_VT = 103424, RT_S = 121856, RT_PART = RT_KP, RT_QS = 520, RT_TS = 144;
__device__ __forceinline__ int crow32(int reg, int hh) { return (reg & 3) + 8 * (reg >> 2) + 4 * hh; }
__device__ __forceinline__ bf16x8 lds_frag2x8(const LAS unsigned char* p) { const s16x4 lo = *(const LAS s16x4*)p, hi = *(const LAS s16x4*)(p + 16); return __builtin_shufflevector(lo, hi, 0, 1, 2, 3, 4, 5, 6, 7); }
__device__ __forceinline__ bf16x8 lds_frag8x2(const LAS unsigned char* p) { const s16x4 lo = *(const LAS s16x4*)p, hi = *(const LAS s16x4*)(p + 8); return __builtin_shufflevector(lo, hi, 0, 1, 2, 3, 4, 5, 6, 7); }
template <int OFF> __device__ __forceinline__ s16x4 lds_tr_read(int vb) { s16x4 r; asm volatile("ds_read_b64_tr_b16 %0, %1 offset:%2" : "=&v"(r) : "v"(vb), "i"(OFF) : "memory"); return r; }
__device__ __forceinline__ bf16x8 lds_frag16(const LAS unsigned char* p) { return *(const LAS bf16x8*)p; }
__device__ __forceinline__ bf16x8 pack8(const f32x16& x, int s8) { u32x4 p; p.x = cvt_pk_bf16(x[s8 + 0], x[s8 + 1]); p.y = cvt_pk_bf16(x[s8 + 2], x[s8 + 3]); p.z = cvt_pk_bf16(x[s8 + 4], x[s8 + 5]); p.w = cvt_pk_bf16(x[s8 + 6], x[s8 + 7]); return __builtin_bit_cast(bf16x8, p); }
#define MFMA32(a, b, c) __builtin_amdgcn_mfma_f32_32x32x16_bf16((a), (b), (c), 0, 0, 0)
__device__ __forceinline__ void retention_phase(const Frame& F, ArgsRef a) {
    const bf16_t* QX = (const bf16_t*)(WS(a) + WS_QX); const bf16_t* KZT = (const bf16_t*)(WS(a) + WS_KZT); const bf16_t* VT = (const bf16_t*)(WS(a) + WS_VT);
    bf16_t* ORET = (bf16_t*)OUT(a);
    LAS unsigned char* L = F.lds + LDS_STAGE;
    const int tid = F.tid, lane = F.lane, w = F.wave, wd = w >> 2, wv = w & 3, r = lane & 31, hh = lane >> 5;
    for (int item = F.bid; item < 256; item += F.G) {
        const int xcd = item & 7, index = item >> 3, q = (index >> 2) * 8 + xcd, vs = index & 3, b = q >> 2, h = q & 3, tb = b * SEQ;
        const float g64 = (float)exp(64.0 * log(1.0 - exp2(-5.0 - (double)h))), g64inv = (float)exp(-64.0 * log(1.0 - exp2(-5.0 - (double)h)));
        f32x16 Racc[4];
#pragma unroll
        for (int i = 0; i < 4; ++i) { for (int j = 0; j < 16; ++j) Racc[i][j] = 0.f; }
        f32x4 pq[4], pz[4], pv[2];
        unsigned gq = (unsigned)(((tb + (tid >> 5)) * 1024 + h * 256 + (tid & 31) * 8) * 2), gz = (unsigned)((((b * 4 + h) * 256 + (tid >> 3)) * SEQ + (tid & 7) * 8) * 2), gv = (unsigned)((((b * 4 + h) * 512 + vs * 128 + (tid >> 3)) * SEQ + (tid & 7) * 8) * 2);
        unsigned lq = (unsigned)(uintptr_t)(L + RT_QX + (tid >> 5) * RT_QS + (tid & 31) * 16), lz = (unsigned)(uintptr_t)(L + RT_KZT + (tid >> 3) * RT_TS + (tid & 7) * 16), lv = (unsigned)(uintptr_t)(L + RT_VT + (tid >> 3) * RT_TS + (tid & 7) * 16);
#define RT_LOADG(c) do { unsigned _q = gq + (unsigned)(c) * (64u * 1024u * 2u), _z = gz + (unsigned)(c) * 128u, _v = gv + (unsigned)(c) * 128u; asm volatile("" : "+v"(_q), "+v"(_z), "+v"(_v)); \
        _Pragma("unroll") for (int i = 0; i < 4; ++i) { pq[i] = *(const f32x4*)((const char*)QX + _q + i * (16 * 1024 * 2)); pz[i] = *(const f32x4*)((const char*)KZT + _z + i * (64 * SEQ * 2)); } \
        _Pragma("unroll") for (int i = 0; i < 2; ++i) pv[i] = *(const f32x4*)((const char*)VT + _v + i * (64 * SEQ * 2)); } while (0)
#define RT_STOREL() do { unsigned _q = lq, _z = lz, _v = lv; asm volatile("" : "+v"(_q), "+v"(_z), "+v"(_v)); \
        _Pragma("unroll") for (int i = 0; i < 4; ++i) { LAS unsigned char* dq_ = (LAS unsigned char*)(uintptr_t)_q + i * (16 * RT_QS); \
            *(LAS f32x2*)(dq_) = (f32x2){pq[i][0], pq[i][1]}; *(LAS f32x2*)(dq_ + 8) = (f32x2){pq[i][2], pq[i][3]}; \
            *(LAS f32x4*)((LAS unsigned char*)(uintptr_t)_z + i * (64 * RT_TS)) = pz[i]; } \
        _Pragma("unroll") for (int i = 0; i < 2; ++i) *(LAS f32x4*)((LAS unsigned char*)(uintptr_t)_v + i * (64 * RT_TS)) = pv[i]; } while (0)
        __syncthreads();
        RT_LOADG(0); RT_STOREL(); __syncthreads();
        const int ti = wv >> 1, tj = wv & 1;
        unsigned bQa = (unsigned)(uintptr_t)(L + RT_QX + (32 * ti + r) * RT_QS + 16 * hh), bKb = (unsigned)(uintptr_t)(L + RT_KZT + (8 * hh + ((lane & 15) >> 2)) * RT_TS + (32 * tj + 16 * ((lane >> 4) & 1) + 4 * (lane & 3)) * 2);
        unsigned bSw = (unsigned)(uintptr_t)(L + RT_S + (32 * ti + 4 * hh) * RT_TS + (32 * tj + r) * 2), bQr = (unsigned)(uintptr_t)(L + RT_QX + r * RT_QS + (128 * wd + 4 * hh) * 2);
        unsigned bV = (unsigned)(uintptr_t)(L + RT_VT + (32 * wv + r) * RT_TS + 16 * hh), bSr = (unsigned)(uintptr_t)(L + RT_S + r * RT_TS + 16 * hh);
        unsigned bP = (unsigned)(uintptr_t)(L + RT_PART + wv * 8192 + 4 * hh * 128 + r * 4), bZ = (unsigned)(uintptr_t)(L + RT_KZT + (128 * wd + r) * RT_TS + 16 * hh);
        asm volatile("" : "+v"(bQa), "+v"(bKb), "+v"(bSw), "+v"(bQr)); asm volatile("" : "+v"(bV), "+v"(bSr), "+v"(bP), "+v"(bZ));
#define LP(x) ((const LAS unsigned char*)(uintptr_t)(x))
#define LPW(x) ((LAS unsigned char*)(uintptr_t)(x))
        for (int c = 0; c < 32; ++c) {
            if (c + 1 < 32) RT_LOADG(c + 1);
            f32x16 o[2];
#pragma unroll
            for (int j = 0; j < 16; ++j) { o[0][j] = 0.f; o[1][j] = 0.f; }
            if (wd == 1 && wv != 1) { f32x16 sacc;
#pragma unroll
                for (int j = 0; j < 16; ++j) sacc[j] = 0.f;
#define RT_KQ(KQ) { s16x4 tl0 = lds_tr_read<(4 * (KQ) + 0) * 16 * RT_TS>((int)bKb), th0 = lds_tr_read<(4 * (KQ) + 0) * 16 * RT_TS + 4 * RT_TS>((int)bKb), tl1 = lds_tr_read<(4 * (KQ) + 1) * 16 * RT_TS>((int)bKb), th1 = lds_tr_read<(4 * (KQ) + 1) * 16 * RT_TS + 4 * RT_TS>((int)bKb); \
                    s16x4 tl2 = lds_tr_read<(4 * (KQ) + 2) * 16 * RT_TS>((int)bKb), th2 = lds_tr_read<(4 * (KQ) + 2) * 16 * RT_TS + 4 * RT_TS>((int)bKb), tl3 = lds_tr_read<(4 * (KQ) + 3) * 16 * RT_TS>((int)bKb), th3 = lds_tr_read<(4 * (KQ) + 3) * 16 * RT_TS + 4 * RT_TS>((int)bKb); \
                    asm volatile("s_waitcnt lgkmcnt(0)" ::: "memory"); __builtin_amdgcn_sched_barrier(0); \
                    sacc = MFMA32(lds_frag8x2(LP(bQa) + 32 * (4 * (KQ) + 0)), ((bf16x8){tl0[0], tl0[1], tl0[2], tl0[3], th0[0], th0[1], th0[2], th0[3]}), sacc); \
                    sacc = MFMA32(lds_frag8x2(LP(bQa) + 32 * (4 * (KQ) + 1)), ((bf16x8){tl1[0], tl1[1], tl1[2], tl1[3], th1[0], th1[1], th1[2], th1[3]}), sacc); \
                    sacc = MFMA32(lds_frag8x2(LP(bQa) + 32 * (4 * (KQ) + 2)), ((bf16x8){tl2[0], tl2[1], tl2[2], tl2[3], th2[0], th2[1], th2[2], th2[3]}), sacc); \
                    sacc = MFMA32(lds_frag8x2(LP(bQa) + 32 * (4 * (KQ) + 3)), ((bf16x8){tl3[0], tl3[1], tl3[2], tl3[3], th3[0], th3[1], th3[2], th3[3]}), sacc); }
                RT_KQ(0) RT_KQ(1) RT_KQ(2) RT_KQ(3)
#undef RT_KQ
#pragma unroll
                for (int j = 0; j < 16; ++j) sacc[j] *= g64inv;
#pragma unroll
                for (int j = 0; j < 16; ++j) { const int cl = (j & 3) + 8 * (j >> 2); float v = (ti != tj || cl + 4 * hh >= r) ? sacc[j] : 0.f; if (RT_VAR == 6) v = (ti == tj && cl + 4 * hh == r) ? 1.f : 0.f; *(LAS bf16_t*)(LPW(bSw) + cl * RT_TS) = (bf16_t)f2bf(v); } }
            if (RT_VAR != 5 && RT_VAR != 6 && RT_VAR != 9 && RT_VAR != 10)
#pragma unroll
            for (int s = 0; s < 8; ++s) { const bf16x8 rb = pack8(Racc[s >> 1], 8 * (s & 1));
#pragma unroll
                for (int m = 0; m < 2; ++m) { const bf16x8 af = lds_frag2x8(LP(bQr) + 32 * m * RT_QS + (32 * (s >> 1) + 16 * (s & 1)) * 2); o[m] = MFMA32(af, rb, o[m]); } }
            __syncthreads();
            bf16x8 Bv[4];
#pragma unroll
            for (int ks = 0; ks < 4; ++ks) Bv[ks] = lds_frag16(LP(bV) + 32 * ks);
            if (wd == 0) {
#pragma unroll
                for (int ks = 0; ks < 4; ++ks) { if (RT_VAR == 4) continue; if (ks < 2) { const bf16x8 a0 = lds_frag16(LP(bSr) + 32 * ks); o[0] = MFMA32(a0, Bv[ks], o[0]); }
                    const bf16x8 a1 = lds_frag16(LP(bSr) + 32 * RT_TS + 32 * ks); o[1] = MFMA32(a1, Bv[ks], o[1]); }
            } else {
#pragma unroll
                for (int m = 0; m < 2; ++m)
#pragma unroll
                    for (int j = 0; j < 16; ++j) *(LAS float*)(LPW(bP) + (32 * m + (j & 3) + 8 * (j >> 2)) * 128) = o[m][j];
            }
            __syncthreads();
            if (wd == 0) { bf16_t* op = ORET + (size_t)(tb + c * 64 + 4 * hh) * 2048 + h * 512 + vs * 128 + 32 * wv + r;
#pragma unroll
                for (int m = 0; m < 2; ++m)
#pragma unroll
                    for (int j = 0; j < 16; ++j) { const int cl = 32 * m + (j & 3) + 8 * (j >> 2); const float v = o[m][j] + *(const LAS float*)(LP(bP) + cl * 128); op[(size_t)cl * 2048] = (bf16_t)f2bf(v); }
            }
#pragma unroll
            for (int t4 = 0; t4 < 4; ++t4) {
#pragma unroll
                for (int j = 0; j < 16; ++j) Racc[t4][j] *= g64;
#pragma unroll
                for (int ks = 0; ks < 4; ++ks) { const bf16x8 af = lds_frag16(LP(bZ) + 32 * t4 * RT_TS + 32 * ks); Racc[t4] = MFMA32(af, Bv[ks], Racc[t4]); }
            }
            __syncthreads();
            if (c + 1 < 32) RT_STOREL();
            __syncthreads();
        }
    }
#undef RT_LOADG
#undef RT_STOREL
#undef LP
#undef LPW
}
__device__ __forceinline__ void retnorm_phase(const Frame& F, ArgsRef a) {
    const bf16_t* oret = (const bf16_t*)OUT(a); float* rn = (float*)(WS(a) + WS_MISC + MISC_RN);
    const int gw = F.bid * 8 + F.wave, NGW = F.G * 8;
    for (int i0 = gw * 8; i0 < T * 4; i0 += NGW * 8) {
        unsigned w4[8][4];
#pragma unroll
        for (int u = 0; u < 8; ++u) ld4u(oret + (size_t)(i0 + u) * 512 + F.lane * 8, w4[u]);
#pragma unroll
        for (int u = 0; u < 8; ++u) { float s = 0.f;
#pragma unroll
            for (int qq = 0; qq < 4; ++qq) { const float lo = bf2f(w4[u][qq] & 0xffffu), hi = bf2f(w4[u][qq] >> 16); s += lo * lo + hi * hi; }
            s = wave_sum(s); if (F.lane == 0) rn[i0 + u] = 1.0f / sqrtf(s * (1.0f / 512.f) + RMS_EPS); } }
}

__device__ __forceinline__ void rownorm_phase(const Frame& F, ArgsRef a) {
    const float* small = (const float*)(WS(a) + WS_SMALL); bf16_t* cqn = (bf16_t*)(WS(a) + WS_CQN); bf16_t* ckv = (bf16_t*)(WS(a) + WS_CKV); bf16_t* kidx = (bf16_t*)(WS(a) + WS_KIDX); float* widx = (float*)(WS(a) + WS_WIDX);
    const float* gkv = IN(a, I_CKV_G); const float* gki = IN(a, I_KIDX_G);
    const int gw = F.bid * 8 + F.wave, NGW = F.G * 8, l = F.lane;
    for (int tb4 = gw * 4; tb4 < T; tb4 += NGW * 4) { f32x4 va[4], vb[4];
#pragma unroll
      for (int u = 0; u < 4; ++u) { va[u] = *(const f32x4*)(small + (size_t)(tb4 + u) * 512 + 8 * l); vb[u] = *(const f32x4*)(small + (size_t)(tb4 + u) * 512 + 8 * l + 4); }
#pragma unroll
      for (int u = 0; u < 4; ++u) { const int t = tb4 + u; const f32x4 v0 = va[u], v1 = vb[u];
        const float ss = (v0[0] * v0[0] + v0[1] * v0[1]) + (v0[2] * v0[2] + v0[3] * v0[3]) + (v1[0] * v1[0] + v1[1] * v1[1]) + (v1[2] * v1[2] + v1[3] * v1[3]);
        const float sq = wave_sum(l < 32 ? ss : 0.f), skv = wave_sum((l >= 32 && l < 48) ? ss : 0.f), ski = wave_sum((l >= 48 && l < 56) ? ss : 0.f);
        float x[8] = {v0[0], v0[1], v0[2], v0[3], v1[0], v1[1], v1[2], v1[3]};
        if (l < 32) { const float r = 1.0f / sqrtf(sq * (1.f / 256.f) + RMS_EPS); u32x4 w; w.x = cvt_pk_bf16(x[0] * r, x[1] * r); w.y = cvt_pk_bf16(x[2] * r, x[3] * r); w.z = cvt_pk_bf16(x[4] * r, x[5] * r); w.w = cvt_pk_bf16(x[6] * r, x[7] * r); *(u32x4*)(cqn + (size_t)t * 256 + 8 * l) = w; }
        else if (l < 48) { const float r = 1.0f / sqrtf(skv * (1.f / 128.f) + RMS_EPS); const int c = 8 * (l - 32); const f32x4 g0 = *(const f32x4*)(gkv + c), g1 = *(const f32x4*)(gkv + c + 4);
            u32x4 w; w.x = cvt_pk_bf16(x[0] * r * g0[0], x[1] * r * g0[1]); w.y = cvt_pk_bf16(x[2] * r * g0[2], x[3] * r * g0[3]); w.z = cvt_pk_bf16(x[4] * r * g1[0], x[5] * r * g1[1]); w.w = cvt_pk_bf16(x[6] * r * g1[2], x[7] * r * g1[3]); *(u32x4*)(ckv + (size_t)t * 128 + c) = w; }
        else if (l < 56) { const float r = 1.0f / sqrtf(ski * (1.f / 64.f) + RMS_EPS); const int c = 8 * (l - 48); const f32x4 g0 = *(const f32x4*)(gki + c), g1 = *(const f32x4*)(gki + c + 4);
            u32x4 w; w.x = cvt_pk_bf16(x[0] * r * g0[0], x[1] * r * g0[1]); w.y = cvt_pk_bf16(x[2] * r * g0[2], x[3] * r * g0[3]); w.z = cvt_pk_bf16(x[4] * r * g1[0], x[5] * r * g1[1]); w.w = cvt_pk_bf16(x[6] * r * g1[2], x[7] * r * g1[3]); *(u32x4*)(kidx + (size_t)t * 64 + c) = w; }
        else if (l == 56) { const float sc = 0.35355339059327373f; *(f32x4*)(widx + (size_t)t * 8) = v0 * sc; *(f32x4*)(widx + (size_t)t * 8 + 4) = v1 * sc; }
      } }
}
struct EpiQ { static constexpr bool PERM = true;
    bf16_t* qlat; bf16_t* qidx;
    __device__ __forceinline__ void operator()(const f32x4 (&acc)[2][2][4][2], const pg8::Unit& u, int wr, int wc, int fr, int fq) const {
#pragma unroll
        for (int ai = 0; ai < 2; ++ai)
#pragma unroll
            for (int m = 0; m < 4; ++m) { const int row = u.pm * 256 + 128 * ai + 64 * wr + 16 * m + fr;
#pragma unroll
                for (int bj = 0; bj < 2; ++bj) { const int c = 128 * bj + 32 * wc + 8 * fq; bf16_t* p = u.pn < 4 ? qlat + (size_t)row * 1024 + u.pn * 256 + c : qidx + (size_t)row * 512 + (u.pn - 4) * 256 + c;
                    const f32x4 v0 = acc[ai][bj][m][0], v1 = acc[ai][bj][m][1]; u32x4 w; w.x = cvt_pk_bf16(v0[0], v0[1]); w.y = cvt_pk_bf16(v0[2], v0[3]); w.z = cvt_pk_bf16(v1[0], v1[1]); w.w = cvt_pk_bf16(v1[2], v1[3]); *(u32x4*)p = w; } }
    }
};
#define DPP_STEP_(op, ctrl, rmask) { const unsigned t_ = (unsigned)__builtin_amdgcn_update_dpp((int)v, (int)v, ctrl, rmask, 0xf, false); v = op(v, t_); }
__device__ __forceinline__ unsigned umax_(unsigned a, unsigned b) { return a > b ? a : b; }
__device__ __forceinline__ unsigned umin_(unsigned a, unsigned b) { return a < b ? a : b; }
__device__ __forceinline__ unsigned wave_umax(unsigned v) { DPP_STEP_(umax_, 0x111, 0xf) DPP_STEP_(umax_, 0x112, 0xf) DPP_STEP_(umax_, 0x114, 0xf) DPP_STEP_(umax_, 0x118, 0xf) DPP_STEP_(umax_, 0x142, 0xa) DPP_STEP_(umax_, 0x143, 0xc) return (unsigned)__builtin_amdgcn_readlane((int)v, 63); }
__device__ __forceinline__ unsigned wave_umin(unsigned v) { DPP_STEP_(umin_, 0x111, 0xf) DPP_STEP_(umin_, 0x112, 0xf) DPP_STEP_(umin_, 0x114, 0xf) DPP_STEP_(umin_, 0x118, 0xf) DPP_STEP_(umin_, 0x142, 0xa) DPP_STEP_(umin_, 0x143, 0xc) return (unsigned)__builtin_amdgcn_readlane((int)v, 63); }
template <int MODE> __device__ __forceinline__ void indexer_phase(const Frame& F, ArgsRef a) {
    const bf16_t* qidx = (const bf16_t*)(WS(a) + WS_QIDX); const bf16_t* kidx = (const bf16_t*)(WS(a) + WS_KIDX); const float* widx = (const float*)(WS(a) + WS_WIDX);
    unsigned long long* mask = (unsigned long long*)(WS(a) + WS_MASK);
    LAS float* sc = (LAS float*)(F.lds + LDS_STAGE); LAS float* wl = (LAS float*)(F.misc + LM_REC);
    const int lane = F.lane, w = F.wave, r = lane & 31, hh = lane >> 5;
    const int rq = 2 * (r >> 4) + ((r >> 2) & 1), rh = 4 * ((r >> 3) & 1) + (r & 3);
    for (int k8 = 0; k8 < 8; ++k8) {
        const int u = F.bid + F.G * k8; if (u >= NB * 128) break;
        const int b = u & 15, j = u >> 4, kk = j >> 4, cc = j & 15, blk = (kk & 1) ? 127 - 16 * (kk >> 1) - cc : 16 * (kk >> 1) + cc, qc = blk >> 2,     NK = 64 * (qc + 1), t0 = b * SEQ + 16 * blk;
        if (qc <= 3) {
            if (MODE == 0) for (int i = F.tid; i < 16 * 32; i += 512) { const int q = i >> 5, wi = i & 31; mask[(size_t)(t0 + q) * 32 + wi] = wi <= qc ? ~0ull : 0ull; }
            continue; }
        __syncthreads();
        if (F.tid < 128) wl[F.tid] = widx[(size_t)t0 * 8 + F.tid];
        bf16x8 A[4][4];
#pragma unroll
        for (int rt = 0; rt < 4; ++rt)
#pragma unroll
            for (int ks = 0; ks < 4; ++ks) A[rt][ks] = *(const bf16x8*)(qidx + (size_t)(t0 + 4 * rt + rq) * 512 + rh * 64 + 16 * ks + 8 * hh);
        __syncthreads();
        bf16x8 Bn[4];
#pragma unroll
        for (int ks = 0; ks < 4; ++ks) Bn[ks] = *(const bf16x8*)(kidx + (size_t)(b * SEQ + 32 * w + r) * 64 + 16 * ks + 8 * hh);
        if (MODE != 2) for (int kt = w; kt < NK / 32; kt += 8) {
            bf16x8 B[4];
#pragma unroll
            for (int ks = 0; ks < 4; ++ks) B[ks] = Bn[ks];
            if (kt + 8 < NK / 32) {
#pragma unroll
                for (int ks = 0; ks < 4; ++ks) Bn[ks] = *(const bf16x8*)(kidx + (size_t)(b * SEQ + 32 * (kt + 8) + r) * 64 + 16 * ks + 8 * hh); }
#pragma unroll
            for (int rt = 0; rt < 4; ++rt) { f32x16 c;
#pragma unroll
                for (int i = 0; i < 16; ++i) c[i] = 0.f;
#pragma unroll
                for (int ks = 0; ks < 4; ++ks) c = MFMA32(A[rt][ks], B[ks], c);
#pragma unroll
                for (int aa = 0; aa < 2; ++aa) { const int q = 4 * rt + 2 * aa + hh; const f32x4 w0 = *(const LAS f32x4*)(wl + q * 8), w1 = *(const LAS f32x4*)(wl + q * 8 + 4);
                    float s = 0.f;
#pragma unroll
                    for (int d = 0; d < 4; ++d) { s += fmaxf(c[8 * aa + d], 0.f) * w0[d]; s += fmaxf(c[8 * aa + 4 + d], 0.f) * w1[d]; }
                    sc[q * 2048 + 32 * kt + r] = s; } }
        }
        __syncthreads();
        if (MODE != 1)
#pragma unroll 1
        for (int qq = 0; qq < 2; ++qq) { const int q = 2 * w + qq; unsigned uu[32]; int nk = NK; asm volatile("" : "+s"(nk));
#pragma unroll
            for (int i = 0; i < 32; ++i) { const float f = sc[q * 2048 + 64 * i + lane]; const unsigned bits = __builtin_bit_cast(unsigned, f); const unsigned vm = (unsigned)((64 * i + lane - nk) >> 31); uu[i] = (bits ^ ((bits >> 31) ? 0xffffffffu : 0x80000000u)) & vm; }
            unsigned lo = 0xffffffffu, hi = 0u;
#pragma unroll
            for (int i = 0; i < 32; ++i) { const unsigned v = uu[i]; hi = v > hi ? v : hi; const unsigned vv = v ? v : 0xffffffffu; lo = vv < lo ? vv : lo; }
            lo = wave_umin(lo); hi = wave_umax(hi);
            unsigned theta = lo; bool exact = false; int chi = 0;
#pragma unroll 1
            while (lo < hi) { const unsigned mid = lo + ((hi - lo) >> 1) + 1u;
                int cnt = 0;
#pragma unroll
                for (int i8 = 0; i8 < 32; i8 += 8) { unsigned long long mk[8];
#pragma unroll
                    for (int i = 0; i < 8; ++i) mk[i] = __ballot(uu[i8 + i] >= mid);
                    __builtin_amdgcn_sched_barrier(0);
#pragma unroll
                    for (int i = 0; i < 8; ++i) cnt += __builtin_popcountll(mk[i]);
                    __builtin_amdgcn_sched_barrier(0); }
                if (cnt == 256) { theta = mid; exact = true; break; }
                if (cnt > 256) lo = mid; else { hi = mid - 1u; chi = cnt; }
                theta = lo; }
            unsigned wlo_ = 0u, whi_ = 0u;
            if (exact) {
#pragma unroll
                for (int i = 0; i < 32; ++i) { const unsigned long long word = __ballot(uu[i] >= theta); wlo_ = lane == i ? (unsigned)word : wlo_; whi_ = lane == i ? (unsigned)(word >> 32) : whi_; }
            } else { const int need = 256 - chi; int run = 0;
#pragma unroll
                for (int i = 0; i < 32; ++i) { const unsigned long long m = __ballot(uu[i] == theta); const int pre = run + __builtin_popcountll(m & ((1ull << lane) - 1ull));
                    const bool sel = (uu[i] > theta) || (uu[i] == theta && pre < need); run += __builtin_popcountll(m);
                    const unsigned long long word = __ballot(sel); wlo_ = lane == i ? (unsigned)word : wlo_; whi_ = lane == i ? (unsigned)(word >> 32) : whi_; } }
            if (MODE == 0 && lane < 32) { u32x2 w2; w2.x = wlo_; w2.y = whi_; *(u32x2*)(mask + (size_t)(t0 + q) * 32 + lane) = w2; }
            if (MODE == 2) asm volatile("" :: "v"(wlo_), "v"(whi_));
        }
    }
}

namespace att {
constexpr int SHM_V = 64 * 128 * 2, SHM_K = 64 * 128 * 2, LDS_MSK = 3 * SHM_V + 3 * SHM_K, LDS_BT = LDS_MSK + 8192, LDS_WS = LDS_BT + 8 * 320 * 4, LDS_END = LDS_WS + 8 * 64 * 4;
#define KSWZ(row, colB) ((row) * 256 + ((colB) ^ (((row) & 7) << 4)))
#define SBAR() __builtin_amdgcn_sched_barrier(0)
__device__ __forceinline__ int crow(int r, int hi) { return (r & 3) + 8 * (r >> 2) + 4 * hi; }
__device__ __forceinline__ int v_st(int k, int c) { const int kk = (k & ~0xC) | ((k & 4) << 1) | ((k & 8) >> 1); return ((kk >> 3) * 4 + (c >> 5)) * 512 + ((kk & 7) * 32 + (c & 31)) * 2; }
__device__ __forceinline__ int v_rd_base(int lane) { return ((lane & 3) << 3) | (((lane >> 2) & 3) << 6) | (((lane >> 4) & 1) << 5) | (((lane >> 5) & 1) << 8); }
constexpr int v_rd_off(int d0, int ks, int half) { return d0 * 512 + ks * 4096 + half * 2048; }
template <int OFF> __device__ __forceinline__ s16x4 tr_read(int vb) { s16x4 r; asm volatile("ds_read_b64_tr_b16 %0, %1 offset:%2" : "=&v"(r) : "v"(vb), "i"(OFF) : "memory"); return r; }
template <int D0> __device__ __forceinline__ void pv_one(f32x16& od, int vb, bf16x8 pa0, bf16x8 pa1, bf16x8 pa2, bf16x8 pa3) {
    const s16x4 l0 = tr_read<v_rd_off(D0, 0, 0)>(vb), h0 = tr_read<v_rd_off(D0, 0, 1)>(vb), l1 = tr_read<v_rd_off(D0, 1, 0)>(vb), h1 = tr_read<v_rd_off(D0, 1, 1)>(vb);
    const s16x4 l2 = tr_read<v_rd_off(D0, 2, 0)>(vb), h2 = tr_read<v_rd_off(D0, 2, 1)>(vb), l3 = tr_read<v_rd_off(D0, 3, 0)>(vb), h3 = tr_read<v_rd_off(D0, 3, 1)>(vb);
    asm volatile("s_waitcnt lgkmcnt(0)" ::: "memory"); SBAR();
#define PK(L, H) (bf16x8){L[0], L[1], L[2], L[3], H[0], H[1], H[2], H[3]}
    od = MFMA32(pa0, PK(l0, h0), od); od = MFMA32(pa1, PK(l1, h1), od); od = MFMA32(pa2, PK(l2, h2), od); od = MFMA32(pa3, PK(l3, h3), od);
#undef PK
}
__device__ __forceinline__ void pv_d0(f32x16* o, int vb, bf16x8 pa0, bf16x8 pa1, bf16x8 pa2, bf16x8 pa3) {
    pv_one<0>(o[0], vb, pa0, pa1, pa2, pa3); pv_one<1>(o[1], vb, pa0, pa1, pa2, pa3); pv_one<2>(o[2], vb, pa0, pa1, pa2, pa3); pv_one<3>(o[3], vb, pa0, pa1, pa2, pa3);
}
__device__ __forceinline__ void qkt(f32x16& p0, f32x16& p1, const LAS unsigned char* Ks, const bf16x8* qr, int r32, int hi) {
#pragma unroll
    for (int i = 0; i < 16; ++i) { p0[i] = 0.f; p1[i] = 0.f; }
#pragma unroll
    for (int d0 = 0; d0 < 8; ++d0) { const int cb = (d0 * 16 + hi * 8) * 2;
        const bf16x8 b0 = *(const LAS bf16x8*)(Ks + KSWZ(r32, cb)), b1 = *(const LAS bf16x8*)(Ks + KSWZ(32 + r32, cb));
        p0 = MFMA32(b0, qr[d0], p0); p1 = MFMA32(b1, qr[d0], p1); }
}
template <bool NEAR> __device__ __forceinline__ void bias_mask(f32x16& p0, f32x16& p1, unsigned wlo, unsigned whi, float bfar, const LAS float* bt, int relbase) {
    constexpr float C = 0.088388347648318440f * 1.4426950408889634f;
    asm volatile("" : "+v"(wlo), "+v"(whi));
#pragma unroll
    for (int r = 0; r < 16; ++r) { const int cr = (r & 3) + 8 * (r >> 2);
        const float b0 = NEAR ? bt[relbase + cr] : bfar, b1 = NEAR ? bt[relbase + 32 + cr] : bfar;
        const float s0 = fmaf(p0[r], C, b0), s1 = fmaf(p1[r], C, b1);
        p0[r] = (wlo & (1u << cr)) ? s0 : -INFINITY; p1[r] = (whi & (1u << cr)) ? s1 : -INFINITY; }
}
__device__ __forceinline__ void partialSM(f32x16& p0, f32x16& p1, float& m_reg, float& mn, float& alpha) {
    float pmax = p0[0];
#pragma unroll
    for (int r = 1; r < 16; ++r) pmax = fmaxf(pmax, p0[r]);
#pragma unroll
    for (int r = 0; r < 16; ++r) pmax = fmaxf(pmax, p1[r]);
    { auto rr = __builtin_amdgcn_permlane32_swap(__float_as_uint(pmax), __float_as_uint(pmax), false, false); pmax = fmaxf(__uint_as_float(rr[0]), __uint_as_float(rr[1])); }
    if (__all(pmax - m_reg <= 8.f)) { mn = m_reg; alpha = 1.f; }
    else { mn = fmaxf(m_reg, pmax); alpha = __builtin_amdgcn_exp2f(m_reg - mn); m_reg = mn; }
#pragma unroll
    for (int r = 0; r < 16; ++r) p0[r] = __builtin_amdgcn_exp2f(p0[r] - mn);
}
__device__ __forceinline__ void finishSM(f32x16& p0, f32x16& p1, float mn, float alpha, float& l_reg, bf16x8& pa0, bf16x8& pa1, bf16x8& pa2, bf16x8& pa3) {
#pragma unroll
    for (int r = 0; r < 16; ++r) p1[r] = __builtin_amdgcn_exp2f(p1[r] - mn);
    float ps = 0;
#pragma unroll
    for (int r = 0; r < 16; ++r) ps += p0[r];
#pragma unroll
    for (int r = 0; r < 16; ++r) ps += p1[r];
    { auto rr = __builtin_amdgcn_permlane32_swap(__float_as_uint(ps), __float_as_uint(ps), false, false); ps = __uint_as_float(rr[0]) + __uint_as_float(rr[1]); }
    l_reg = l_reg * alpha + ps;
#define PK4(P, BASE, OUT) do { unsigned a0 = cvt_pk_bf16(P[BASE + 0], P[BASE + 1]), a1 = cvt_pk_bf16(P[BASE + 2], P[BASE + 3]); \
    unsigned b0 = cvt_pk_bf16(P[BASE + 4], P[BASE + 5]), b1 = cvt_pk_bf16(P[BASE + 6], P[BASE + 7]); \
    auto r0 = __builtin_amdgcn_permlane32_swap(a0, b0, false, false); auto r1 = __builtin_amdgcn_permlane32_swap(a1, b1, false, false); \
    u32x4 w = {r0[0], r1[0], r0[1], r1[1]}; OUT = __builtin_bit_cast(bf16x8, w); } while (0)
    PK4(p0, 0, pa0); PK4(p0, 8, pa1); PK4(p1, 0, pa2); PK4(p1, 8, pa3);
#undef PK4
}
}
__device__ __forceinline__ int t5_bucket_abs(int n) { return n < 8 ? n : n < 12 ? 8 : n < 16 ? 9 : n < 23 ? 10 : n < 32 ? 11 : n < 46 ? 12 : n < 64 ? 13 : n < 91 ? 14 : 15; }
__device__ __forceinline__ void attention_phase(const Frame& F, ArgsRef a) {
    using namespace att;
    const bf16_t* qlat = (const bf16_t*)(WS(a) + WS_QLAT); const bf16_t* ckv = (const bf16_t*)(WS(a) + WS_CKV); const unsigned* mask = (const unsigned*)(WS(a) + WS_MASK); bf16_t* olat = (bf16_t*)(WS(a) + WS_OLAT);
    LAS unsigned char* L = F.lds + LDS_STAGE; LAS unsigned char* V_lds = L; LAS unsigned char* K_lds = L + 3 * SHM_V;
    LAS unsigned* msk = (LAS unsigned*)(L + LDS_MSK); LAS float* bt = (LAS float*)(L + LDS_BT);
    const int tid = F.tid, wid = F.wave, lane = F.lane, r32 = lane & 31, hi = lane >> 5, hd = r32 & 7;
    LAS float* wsx = (LAS float*)(L + LDS_WS) + wid * 64; LAS float* li_l = wsx; LAS float* al_l = wsx + 32;
    __syncthreads();
    for (int i = tid; i < 8 * 320; i += 512) { const int h = i / 320, rel = (i % 320) - 255; const int n = rel < 0 ? -rel : rel; bt[i] = IN(a, I_T5)[h * 32 + (rel > 0 ? 16 : 0) + t5_bucket_abs(n)] * 1.4426950408889634f; }
    const float bfar = IN(a, I_T5)[hd * 32 + 15] * 1.4426950408889634f;
    for (int k4 = 0; k4 < 4; ++k4) {
        const int u = F.bid + F.G * k4; if (u >= NB * 64) break;
        const int b = u & 15, j = u >> 4, kk = j >> 4, cc = j & 15, blk = (kk & 1) ? 63 - 16 * (kk >> 1) - cc : 16 * (kk >> 1) + cc, qc = blk >> 1,     t0 = b * SEQ + 32 * blk, NT = qc + 1;
        __syncthreads();
        for (int i = tid; i < 32 * 64; i += 512) msk[i] = mask[(size_t)t0 * 64 + i];
        const bf16_t* Kh = ckv + (size_t)b * SEQ * 128;
        const int qi = 4 * wid + (r32 >> 3), qpos = 32 * blk + qi;
        float m_reg = -1e30f, l_reg = 0.f; f32x16 o[4]; bf16x8 qr[8];
#pragma unroll
        for (int d = 0; d < 4; ++d)
#pragma unroll
            for (int i = 0; i < 16; ++i) o[d][i] = 0.f;
        const bf16_t* Qw = qlat + (size_t)(t0 * 8 + wid * 32 + r32) * 128 + hi * 8;
#pragma unroll
        for (int d0 = 0; d0 < 8; ++d0) qr[d0] = *(const bf16x8*)(Qw + d0 * 16);
        const int sr = tid >> 4, scol = (tid & 15) * 8, vst0 = v_st(sr, scol), vst1 = v_st(32 + sr, scol);
        const int vb0 = (int)(uintptr_t)V_lds + v_rd_base(lane);
        bf16x8 st0[1], st1[1];
#define SLOAD(i, k0) do { st0[i] = *(const bf16x8*)(Kh + (size_t)((k0) + sr) * 128 + scol); st1[i] = *(const bf16x8*)(Kh + (size_t)((k0) + 32 + sr) * 128 + scol); } while (0)
#define SWRITE(bb, i) do { *(LAS bf16x8*)(V_lds + (bb) * SHM_V + vst0) = st0[i]; *(LAS bf16x8*)(V_lds + (bb) * SHM_V + vst1) = st1[i]; const int kc = scol * 2; \
        *(LAS bf16x8*)(K_lds + (bb) * SHM_K + KSWZ(sr, kc)) = st0[i]; *(LAS bf16x8*)(K_lds + (bb) * SHM_K + KSWZ(32 + sr, kc)) = st1[i]; } while (0)
#define SWAIT() asm volatile("s_waitcnt vmcnt(2)" ::: "memory")
#define RESC(al) do { if (__any((al) < 1.f)) { if (hi == 0) al_l[r32] = (al); asm volatile("s_waitcnt lgkmcnt(0)" ::: "memory"); \
        _Pragma("unroll") for (int d = 0; d < 4; ++d) _Pragma("unroll") for (int r = 0; r < 16; ++r) o[d][r] *= al_l[crow(r, hi)]; } } while (0)
#define BIASMASK(P0, P1, jt) do { const unsigned wl_ = msk[qi * 64 + 2 * (jt)] >> (4 * hi), wh_ = msk[qi * 64 + 2 * (jt) + 1] >> (4 * hi); \
        if (64 * (jt) + 63 - 32 * blk > -128) bias_mask<true>(P0, P1, wl_, wh_, bfar, bt + hd * 320, 64 * (jt) + 4 * hi - qpos + 255); else bias_mask<false>(P0, P1, wl_, wh_, bfar, bt, 0); } while (0)
        f32x16 p0, p1; float mn, al; bf16x8 pa0, pa1, pa2, pa3;
        SLOAD(0, 0); asm volatile("s_waitcnt vmcnt(0)" ::: "memory"); SWRITE(0, 0); __syncthreads();
        for (int jt = 0, bb = 0; jt < NT; ++jt) { const int nb = bb == 2 ? 0 : bb + 1;
            if (jt + 1 < NT) SLOAD(0, (jt + 1) * 64);
            qkt(p0, p1, K_lds + bb * SHM_K, qr, r32, hi); BIASMASK(p0, p1, jt);
            partialSM(p0, p1, m_reg, mn, al); finishSM(p0, p1, mn, al, l_reg, pa0, pa1, pa2, pa3); SBAR();
            RESC(al);
            pv_d0(o, vb0 + bb * SHM_V, pa0, pa1, pa2, pa3);
            if (jt + 1 < NT) SWRITE(nb, 0);
            __syncthreads();
            bb = nb;
        }
        if (hi == 0) li_l[r32] = l_reg; asm volatile("s_waitcnt lgkmcnt(0)" ::: "memory");
        float rli[16];
#pragma unroll
        for (int r = 0; r < 16; ++r) rli[r] = __builtin_amdgcn_rcpf(li_l[crow(r, hi)]);
        if constexpr (MIXA_FP8) { unsigned char* O8 = (unsigned char*)olat + (size_t)(t0 * 8 + wid * 32) * 128 + 4 * r32;
#pragma unroll
            for (int r = 0; r < 16; ++r) { const float sc_ = rli[r] * 4.f; *(unsigned*)(O8 + (size_t)crow(r, hi) * 128) = pk4_fp8(o[0][r] * sc_, o[1][r] * sc_, o[2][r] * sc_, o[3][r] * sc_); } }
        else { bf16_t* Ow = olat + (size_t)(t0 * 8 + wid * 32) * 128;
#pragma unroll
        for (int r = 0; r < 16; ++r) { const int orow = crow(r, hi);
#pragma unroll
            for (int d0 = 0; d0 < 4; ++d0) Ow[(size_t)orow * 128 + d0 * 32 + r32] = (bf16_t)f2bf(o[d0][r] * rli[r]); } }
#undef SLOAD
#undef SWRITE
#undef SWAIT
#undef RESC
#undef BIASMASK
    }
}
#undef KSWZ
#undef SBAR

__device__ __forceinline__ void grid_bar(unsigned char* lds_raw) {
    ArgsRef a = phase_args(); XcdBarrier b; b.bar = (unsigned*)(WS(a) + WS_CTL) + CW_BAR; b.x = xb_xcc_id(); b.st = (volatile LAS unsigned*)((LAS unsigned char*)lds_raw + LDS_MISC + LM_BAR);
    xcd_barrier(b);
}
template <int HALFI> __device__ __forceinline__ void moe_gateup_phase(unsigned char* lds_raw) {
    ArgsRef a = phase_args(); const Frame F = make_frame(lds_raw);
    const int ntiles = moe_tables(F, a, HALFI);
    const int* lists = (const int*)(WS(a) + WS_LTOK) + (size_t)HALFI * NE * LIST_CAP; const float* lrs = (const float*)(WS(a) + WS_LRS) + (size_t)HALFI * NE * LIST_CAP;
    typedef MoeOrder<8, true, MOE_FP8 ? 1024 : 2048> Ord;
    Ord S{(const LAS int*)(F.misc + LM_TILE), (const LAS int*)(F.misc + LM_CNT), lists, ntiles, F.G, F.bid};
    EpiGateUp E{(bf16_t*)(WS(a) + WS_ACT), IN(a, I_B_GATE), IN(a, I_B_UP), lrs, (const LAS int*)(F.misc + LM_CNT)};
    pg8::gemm_phase<EpiGateUp, Ord, false, true, MOE_FP8 ? D / 2 : D, MOE_FP8>(F.lds + LDS_STAGE, F.tid, (const bf16_t*)(WS(a) + WS_X2B), (const bf16_t*)(WS(a) + WS_WGU), S, E, (LAS u32x4*)(F.misc + LM_SLOTS));
}
template <int HALFI> __device__ __forceinline__ void moe_down_phase(unsigned char* lds_raw) {
    ArgsRef a = phase_args(); const Frame F = make_frame(lds_raw);
    const int ntiles = moe_tables(F, a, HALFI);
    typedef MoeOrder<4, false, MOE_FP8 ? 1024 : 2048> Ord;
    Ord S{(const LAS int*)(F.misc + LM_TILE), (const LAS int*)(F.misc + LM_CNT), nullptr, ntiles, F.G, F.bid};
    EpiDown E{(bf16_t*)(WS(a) + WS_Y), IN(a, I_B_DOWN)};
    pg8::gemm_phase<EpiDown, Ord, false, false, MOE_FP8 ? FF / 2 : FF, MOE_FP8>(F.lds + LDS_STAGE, F.tid, (const bf16_t*)(WS(a) + WS_ACT), (const bf16_t*)(WS(a) + WS_WD), S, E);
}
template <int HALFI> __device__ __forceinline__ void moe_gateup_probe(unsigned char* lds_raw) {
    ArgsRef a = phase_args(); const Frame F = make_frame(lds_raw);
    const int ntiles = moe_tables(F, a, HALFI);
    const int* lists = (const int*)(WS(a) + WS_LTOK) + (size_t)HALFI * NE * LIST_CAP;
    typedef MoeOrder<8, true, MOE_FP8 ? 1024 : 2048> Ord;
    Ord S{(const LAS int*)(F.misc + LM_TILE), (const LAS int*)(F.misc + LM_CNT), lists, ntiles, F.G, F.bid};
    EpiProbe E{(float*)(WS(a) + WS_Y)};
    pg8::gemm_phase<EpiProbe, Ord, false, true, MOE_FP8 ? D / 2 : D, MOE_FP8>(F.lds + LDS_STAGE, F.tid, (const bf16_t*)(WS(a) + WS_X2B), (const bf16_t*)(WS(a) + WS_WGU), S, E, (LAS u32x4*)(F.misc + LM_SLOTS));
}
template <int HALFI> __device__ __forceinline__ void moe_down_probe(unsigned char* lds_raw) {
    ArgsRef a = phase_args(); const Frame F = make_frame(lds_raw);
    const int ntiles = moe_tables(F, a, HALFI);
    typedef MoeOrder<4, false, MOE_FP8 ? 1024 : 2048> Ord;
    Ord S{(const LAS int*)(F.misc + LM_TILE), (const LAS int*)(F.misc + LM_CNT), nullptr, ntiles, F.G, F.bid};
    EpiProbe E{(float*)(WS(a) + WS_X2B)};
    pg8::gemm_phase<EpiProbe, Ord, false, false, MOE_FP8 ? FF / 2 : FF, MOE_FP8>(F.lds + LDS_STAGE, F.tid, (const bf16_t*)(WS(a) + WS_ACT), (const bf16_t*)(WS(a) + WS_WD), S, E);
}
template <int HALFI> __device__ __forceinline__ void moe_combine_phase(unsigned char* lds_raw) {
    ArgsRef a = phase_args(); const Frame F = make_frame(lds_raw);
    (void)moe_tables(F, a, HALFI);
    combine_phase(F, a, HALFI);
}
__device__ __forceinline__ void prep_phase(unsigned char* lds_raw) { ArgsRef a = phase_args(); const Frame F = make_frame(lds_raw); mixer_prep_phase(F, a); }
#ifndef PREP2MASK
#define PREP2MASK 63
#endif
__device__ __forceinline__ void prep2_phase(unsigned char* lds_raw) { ArgsRef a = phase_args(); const Frame F = make_frame(lds_raw); mixer_prep_phase<PREP2MASK>(F, a); }
__device__ __forceinline__ void inproj_a_phase(unsigned char* lds_raw) {
    ArgsRef a = phase_args(); const Frame F = make_frame(lds_raw); const float* misc = (const float*)(WS(a) + WS_MISC);
    { DenseOrder S; S.init(T, 6 * 256, D, F.G, F.bid, 0, 0);
      EpiInA E{(bf16_t*)(WS(a) + WS_QX), (float*)(WS(a) + WS_SMALL), misc + MISC_RSTD1 / 4, (const float*)(WS(a) + WS_COSP), (const float*)(WS(a) + WS_SINP), misc + MISC_DQ / 4,
               (bf16_t*)(WS(a) + WS_CQN), (bf16_t*)(WS(a) + WS_CKV), (bf16_t*)(WS(a) + WS_KIDX), (float*)(WS(a) + WS_WIDX), IN(a, I_CKV_G), IN(a, I_KIDX_G), (LAS float*)(F.misc + 17408)};
      pg8::gemm_phase<EpiInA, DenseOrder, false, false, D>(F.lds + LDS_STAGE, F.tid, (const bf16_t*)(WS(a) + WS_XB), (const bf16_t*)(WS(a) + WS_WIN), S, E); }
}
__device__ __forceinline__ void inproj_b_phase(unsigned char* lds_raw) {
    ArgsRef a = phase_args(); const Frame F = make_frame(lds_raw); const float* misc = (const float*)(WS(a) + WS_MISC);
    if constexpr (INB_FP8) {
      { DenseOrder S; S.init(T, 4 * 256, D, F.G, F.bid, 0, (size_t)6 * 256 * D * 2);
        EpiInB<0, false> E{(bf16_t*)(WS(a) + WS_KZT), (bf16_t*)(WS(a) + WS_VT), misc + MISC_RSTD1 / 4, (const float*)(WS(a) + WS_COST), (const float*)(WS(a) + WS_SINT), misc + MISC_DZ / 4};
        pg8::gemm_phase<EpiInB<0, false>, DenseOrder, true, false, D>(F.lds + LDS_STAGE, F.tid, (const bf16_t*)(WS(a) + WS_XB), (const bf16_t*)(WS(a) + WS_WIN), S, E); }
      { DenseOrder S; S.init(T, 8 * 256, D / 2, F.G, F.bid, 0, 0);
        EpiInB<4, true> E{(bf16_t*)(WS(a) + WS_KZT), (bf16_t*)(WS(a) + WS_VT), misc + MISC_RSTD1 / 4, (const float*)(WS(a) + WS_COST), (const float*)(WS(a) + WS_SINT), misc + MISC_DZ / 4};
        pg8::gemm_phase<EpiInB<4, true>, DenseOrder, true, false, D / 2, true>(F.lds + LDS_STAGE, F.tid, (const bf16_t*)(WS(a) + WS_XB8), (const bf16_t*)(WS(a) + WS_WIN8 + 4 * MiB), S, E); }
    } else {
      DenseOrder S; S.init(T, 12 * 256, D, F.G, F.bid, 0, (size_t)6 * 256 * D * 2);
      EpiInB<0, false> E{(bf16_t*)(WS(a) + WS_KZT), (bf16_t*)(WS(a) + WS_VT), misc + MISC_RSTD1 / 4, (const float*)(WS(a) + WS_COST), (const float*)(WS(a) + WS_SINT), misc + MISC_DZ / 4};
      pg8::gemm_phase<EpiInB<0, false>, DenseOrder, true, false, D>(F.lds + LDS_STAGE, F.tid, (const bf16_t*)(WS(a) + WS_XB), (const bf16_t*)(WS(a) + WS_WIN), S, E); }
}
__device__ __forceinline__ void inproj_c_phase(unsigned char* lds_raw) {
    ArgsRef a = phase_args(); const Frame F = make_frame(lds_raw); const float* misc = (const float*)(WS(a) + WS_MISC);
    DenseOrder S; S.init(T, 16 * 256, INC_FP8 ? D / 2 : D, F.G, F.bid, 0, INC_FP8 ? (size_t)0 : (size_t)18 * 256 * D * 2);
    EpiInC E{(bf16_t*)OUT(a), (bf16_t*)(WS(a) + WS_GA), (bf16_t*)(WS(a) + WS_GB), misc + MISC_RSTD1 / 4, misc + MISC_RN / 4};
    pg8::gemm_phase<EpiInC, DenseOrder, false, false, INC_FP8 ? D / 2 : D, INC_FP8>(F.lds + LDS_STAGE, F.tid, (const bf16_t*)(WS(a) + (INC_FP8 ? WS_XB8 : WS_XB)), (const bf16_t*)(WS(a) + (INC_FP8 ? WS_WIN8 : WS_WIN)), S, E);
}
__device__ __forceinline__ void retention_phase_w(unsigned char* lds_raw) { ArgsRef a = phase_args(); const Frame F = make_frame(lds_raw); retention_phase(F, a); }
__device__ __forceinline__ void retnorm_phase_w(unsigned char* lds_raw) { ArgsRef a = phase_args(); const Frame F = make_frame(lds_raw); retnorm_phase(F, a); }
__device__ __forceinline__ void mix_a_phase(unsigned char* lds_raw) {
    ArgsRef a = phase_args(); const Frame F = make_frame(lds_raw);
    DenseOrder S; S.init(T, D, MIXA_FP8 ? D / 2 : D, F.G, F.bid, 0, 0);
    EpiMix<0, MIXA_FP8> E{(const bf16_t*)(WS(a) + WS_GA), (bf16_t*)(WS(a) + WS_MIXA), (bf16_t*)(WS(a) + WS_MIX)};
    pg8::gemm_phase<EpiMix<0, MIXA_FP8>, DenseOrder, false, false, MIXA_FP8 ? D / 2 : D, MIXA_FP8>(F.lds + LDS_STAGE, F.tid, (const bf16_t*)(WS(a) + WS_OLAT), (const bf16_t*)(WS(a) + WS_WA), S, E);
}
__device__ __forceinline__ void mix_b_phase(unsigned char* lds_raw) {
    ArgsRef a = phase_args(); const Frame F = make_frame(lds_raw);
    DenseOrder S; S.init(T, D, 2048, F.G, F.bid, 0, 0);
    EpiMix<1> E{(const bf16_t*)(WS(a) + WS_GB), (bf16_t*)(WS(a) + WS_MIXA), (bf16_t*)(WS(a) + WS_MIX)};
    pg8::gemm_phase<EpiMix<1>, DenseOrder, false, false, 2048>(F.lds + LDS_STAGE, F.tid, (const bf16_t*)OUT(a), (const bf16_t*)(WS(a) + WS_WB), S, E);
}
__device__ __forceinline__ void rownorm_phase_w(unsigned char* lds_raw) { ArgsRef a = phase_args(); const Frame F = make_frame(lds_raw); rownorm_phase(F, a); }
__device__ __forceinline__ void qproj_phase(unsigned char* lds_raw) {
    ArgsRef a = phase_args(); const Frame F = make_frame(lds_raw);
    DenseOrder S; S.init(T, 1536, 256, F.G, F.bid, 0, 0);
    EpiQ E{(bf16_t*)(WS(a) + WS_QLAT), (bf16_t*)(WS(a) + WS_QIDX)};
    pg8::gemm_phase<EpiQ, DenseOrder, false, false, 256>(F.lds + LDS_STAGE, F.tid, (const bf16_t*)(WS(a) + WS_CQN), (const bf16_t*)(WS(a) + WS_WQ), S, E);
}
__device__ __forceinline__ void indexer_phase_w(unsigned char* lds_raw) { ArgsRef a = phase_args(); const Frame F = make_frame(lds_raw); indexer_phase<0>(F, a); }
template <int MODE> __device__ __forceinline__ void indexer_probe_w(unsigned char* lds_raw) { ArgsRef a = phase_args(); const Frame F = make_frame(lds_raw); indexer_phase<MODE>(F, a); }
__device__ __forceinline__ void attention_phase_w(unsigned char* lds_raw) { ArgsRef a = phase_args(); const Frame F = make_frame(lds_raw); attention_phase(F, a); }
__device__ __forceinline__ void out_phase(unsigned char* lds_raw) {
    ArgsRef a = phase_args(); const Frame F = make_frame(lds_raw);
    DenseOrder S; S.init(T, D, D, F.G, F.bid, 0, 0);
    EpiOut E{(const bf16_t*)(WS(a) + WS_XB), X2H ? (float*)(WS(a) + WS_X2H) : OUT(a), (bf16_t*)(WS(a) + WS_X2B)};
    pg8::gemm_phase<EpiOut, DenseOrder, false, false, D>(F.lds + LDS_STAGE, F.tid, (const bf16_t*)(WS(a) + WS_MIX), (const bf16_t*)(WS(a) + WS_WOUT), S, E);
}
__device__ __forceinline__ void convert_only_phase(unsigned char* lds_raw) { ArgsRef a = phase_args(); const Frame F = make_frame(lds_raw); moe_weight_convert(F, a); }
__device__ __forceinline__ void router_phase_w(unsigned char* lds_raw) { ArgsRef a = phase_args(); const Frame F = make_frame(lds_raw); moe_weight_convert(F, a); __syncthreads(); router_phase(F, a); }

#ifdef DIAG2
__device__ __forceinline__ void diag_ck(unsigned char* lds_raw, int k, const void* buf, size_t chunk_bytes) {
    grid_bar(lds_raw);
    ArgsRef a = phase_args(); unsigned* sums = (unsigned*)(WS(a) + WS_CTL + 256 * 1024) + k * 16384; unsigned* nbad = (unsigned*)(WS(a) + WS_CTL) + 16384 + 64 * k; const int gw = blockIdx.x * 8 + (threadIdx.x >> 6), lane = threadIdx.x & 63;
    for (int c = gw; c < 16384; c += gridDim.x * 8) { const unsigned* p = (const unsigned*)((const char*)buf + (size_t)c * chunk_bytes); unsigned sm = 0u; for (size_t i = lane; i < chunk_bytes / 4; i += 64) sm += p[i] * (unsigned)(2 * i + 1);
        for (int o = 1; o < 64; o <<= 1) sm += __shfl_xor(sm, o);
        if (lane == 0) { if (a.pass == 0) sums[c] = sm; else if (sums[c] != sm) atomicAdd(nbad, 1u); } }
    grid_bar(lds_raw);
}
__device__ __forceinline__ void diag_final(unsigned char* lds_raw) {
    grid_bar(lds_raw);
    ArgsRef a = phase_args(); const unsigned* nbad = (const unsigned*)(WS(a) + WS_CTL) + 16384; float c = 0.f;
    if (a.pass == 1) { for (int k = 0; k < 4; ++k) if (__hip_atomic_load(nbad + 64 * k, __ATOMIC_RELAXED, __HIP_MEMORY_SCOPE_AGENT) > 0u) c += (float)(1 << k); }
    grid_bar(lds_raw);
    for (size_t i = (size_t)blockIdx.x * 512 + threadIdx.x; i < (size_t)T * D; i += (size_t)gridDim.x * 512) OUT(a)[i] = c;
}
#endif
__global__ void __launch_bounds__(512, 2) fwd(Args a_unused) {
    extern __shared__ __attribute__((aligned(16))) unsigned char lds_raw[];
    { ArgsRef a = phase_args(); LAS unsigned* st = (LAS unsigned*)((LAS unsigned char*)lds_raw + LDS_MISC + LM_BAR);
      if (threadIdx.x < 4) st[threadIdx.x] = 0u;
      __syncthreads();
      (void)xcd_barrier_post((unsigned*)(WS(a) + WS_CTL) + CW_BAR, (volatile LAS unsigned*)st); }
#ifndef DUP
#define DUP 0u
#endif
#ifndef PHSEL
#define PHSEL 0xffffffffu
#endif
#define GRID_BAR() grid_bar(lds_raw)
#ifdef ZERO_OUT_FIRST
    { float* o_ = OUT(phase_args()); for (size_t i = (size_t)blockIdx.x * 512 + threadIdx.x; i < (size_t)T * D / 4; i += (size_t)gridDim.x * 512) ((f32x4*)o_)[i] = (f32x4){0.f, 0.f, 0.f, 0.f}; }
#endif
    if (PHSEL & (1u << 0)) prep_phase(lds_raw);
    if (DUP & (1u << 0)) { GRID_BAR(); prep2_phase(lds_raw); }
    GRID_BAR();
#if defined(DIAG2) && DIAG2 == 21
    { unsigned char* w_ = WS(phase_args()); diag_ck(lds_raw, 0, w_ + 1 * MiB, 256); diag_ck(lds_raw, 1, w_ + WS_MISC, 64); diag_ck(lds_raw, 2, w_ + WS_XB, 4096); diag_ck(lds_raw, 3, w_ + WS_WIN, 1024); diag_final(lds_raw); return; }
#endif
    if (PHSEL & (1u << 1)) inproj_a_phase(lds_raw);
    if (DUP & (1u << 1)) { GRID_BAR(); inproj_a_phase(lds_raw); }
    if (PHSEL & (1u << 2)) inproj_b_phase(lds_raw);
    if (DUP & (1u << 2)) { GRID_BAR(); inproj_b_phase(lds_raw); }
#if defined(DIAG2) && DIAG2 == 22
    { unsigned char* w_ = WS(phase_args()); diag_ck(lds_raw, 0, w_ + WS_QX, 4096); diag_ck(lds_raw, 1, w_ + WS_SMALL, 4096); diag_ck(lds_raw, 2, w_ + WS_KZT, 4096); diag_ck(lds_raw, 3, w_ + WS_VT, 8192); diag_final(lds_raw); return; }
#endif
#if defined(DIAG2) && DIAG2 == 10
    diag_ck(lds_raw, 0, WS(phase_args()) + WS_QX, 4096); diag_final(lds_raw); return;
#endif
    GRID_BAR();
    if (!ROWNORM_FUSED && (PHSEL & (1u << 16))) rownorm_phase_w(lds_raw);
    if (PHSEL & (1u << 3)) retention_phase_w(lds_raw);
    if (DUP & (1u << 3)) { GRID_BAR(); retention_phase_w(lds_raw); }
#if defined(DIAG2) && DIAG2 == 23
    diag_ck(lds_raw, 0, OUT(phase_args()), 8192);
#endif
#if defined(DIAG2) && DIAG2 == 11
    diag_ck(lds_raw, 1, OUT(phase_args()), 8192); diag_final(lds_raw); return;
#endif
    GRID_BAR();
    if (PHSEL & (1u << 4)) retnorm_phase_w(lds_raw);
    if (PHSEL & (1u << 17)) qproj_phase(lds_raw);
    if (DUP & (1u << 17)) { GRID_BAR(); qproj_phase(lds_raw); }
    GRID_BAR();
#if defined(DIAG2) && DIAG2 == 23
    diag_ck(lds_raw, 1, WS(phase_args()) + WS_QLAT, 4096);
#endif
    if (PHSEL & (1u << 18)) indexer_phase_w(lds_raw);
    __syncthreads();
    if (PHSEL & (1u << 5)) inproj_c_phase(lds_raw);
    if (DUP & (1u << 18)) { GRID_BAR(); indexer_phase_w(lds_raw); }
    if (DUP & (1u << 22)) { GRID_BAR(); indexer_probe_w<1>(lds_raw); }
    if (DUP & (1u << 23)) { GRID_BAR(); indexer_probe_w<2>(lds_raw); }
#if defined(DIAG2) && DIAG2 == 23
    diag_ck(lds_raw, 2, WS(phase_args()) + WS_MASK, 512);
#endif
#if defined(DIAG2) && DIAG2 == 12
    diag_ck(lds_raw, 2, WS(phase_args()) + WS_MASK, 512); diag_final(lds_raw); return;
#endif
    GRID_BAR();
    if (PHSEL & (1u << 19)) attention_phase_w(lds_raw);
    if (DUP & (1u << 19)) { GRID_BAR(); attention_phase_w(lds_raw); }
#if defined(DIAG2) && DIAG2 == 23
    diag_ck(lds_raw, 3, WS(phase_args()) + WS_OLAT, 4096); diag_final(lds_raw); return;
#endif
#if defined(DIAG2) && DIAG2 == 13
    diag_ck(lds_raw, 3, WS(phase_args()) + WS_QLAT, 4096); diag_final(lds_raw); return;
#endif
#if defined(DIAG2) && DIAG2 == 24
    diag_ck(lds_raw, 0, OUT(phase_args()), 8192);
#endif
    GRID_BAR();
    if (PHSEL & (1u << 20)) mix_a_phase(lds_raw);
    if (DUP & (1u << 20)) { GRID_BAR(); mix_a_phase(lds_raw); }
    if (PHSEL & (1u << 6)) mix_b_phase(lds_raw);
    if (DUP & (1u << 6)) { GRID_BAR(); mix_b_phase(lds_raw); }
#if defined(DIAG2) && DIAG2 == 24
    diag_ck(lds_raw, 1, WS(phase_args()) + WS_MIX, 4096);
#endif
#if defined(DIAG2) && DIAG2 == 28
    diag_ck(lds_raw, 3, WS(phase_args()) + WS_MIX, 4096);
#endif
    GRID_BAR();
    if (PHSEL & (1u << 7)) out_phase(lds_raw);
    if (DUP & (1u << 7)) { GRID_BAR(); out_phase(lds_raw); }
#if defined(DIAG2) && (DIAG2 == 38 || DIAG2 == 39)
    { asm volatile("s_waitcnt vmcnt(0)" ::: "memory"); __syncthreads(); if (threadIdx.x == 0) atomicAdd((unsigned*)(WS(phase_args()) + WS_CTL) + 16384 + 64 * 9, 1u); }
#endif
    GRID_BAR();
#if defined(DIAG2) && (DIAG2 == 38 || DIAG2 == 39)
    { if (threadIdx.x == 0) { unsigned* nb_ = (unsigned*)(WS(phase_args()) + WS_CTL) + 16384; const unsigned d_ = __hip_atomic_load(nb_ + 64 * 9, __ATOMIC_RELAXED, __HIP_MEMORY_SCOPE_AGENT); if (d_ != gridDim.x * (unsigned)(phase_args().pass + 1)) atomicAdd(nb_ + 64 * 10, 1u); } }
#endif
#if defined(DIAG2) && DIAG2 == 24
    diag_ck(lds_raw, 2, OUT(phase_args()), 8192); diag_ck(lds_raw, 3, WS(phase_args()) + WS_X2B, 2048); diag_final(lds_raw); return;
#endif
#if defined(DIAG2) && DIAG2 == 28
    diag_ck(lds_raw, 0, OUT(phase_args()), 8192); diag_ck(lds_raw, 1, WS(phase_args()) + WS_X2B, 2048);
#endif
    if (DUP & (1u << 21)) { convert_only_phase(lds_raw); GRID_BAR(); }
#if defined(DIAG2) && (DIAG2 == 29 || DIAG2 == 30 || DIAG2 == 31)
    diag_ck(lds_raw, 0, WS(phase_args()) + WS_MISC, 8);
#endif
    if (PHSEL & (1u << 8)) router_phase_w(lds_raw);
    GRID_BAR();
#if defined(DIAG2) && DIAG2 == 25
    diag_ck(lds_raw, 0, WS(phase_args()) + WS_WGU, 4096); diag_ck(lds_raw, 1, WS(phase_args()) + WS_WD, 2048);
#endif
#if defined(DIAG2) && DIAG2 == 26
    diag_ck(lds_raw, 0, WS(phase_args()) + WS_WGU, 4096); diag_ck(lds_raw, 1, WS(phase_args()) + WS_WD, 2048); diag_final(lds_raw); return;
#endif
#if defined(DIAG2) && DIAG2 == 29
    diag_final(lds_raw); return;
#endif
#if defined(DIAG2) && (DIAG2 >= 30 && DIAG2 <= 40)
    { grid_bar(lds_raw); ArgsRef a = phase_args(); const unsigned* nb = (const unsigned*)(WS(a) + WS_CTL) + 16384; float c = 0.f;
      if (a.pass == 1) { unsigned n = __hip_atomic_load(nb + 64 * 3, __ATOMIC_RELAXED, __HIP_MEMORY_SCOPE_AGENT);
#if DIAG2 == 31
        n = n >> 5;
#endif
#if DIAG2 == 38
        n = __hip_atomic_load(nb + 64 * 10, __ATOMIC_RELAXED, __HIP_MEMORY_SCOPE_AGENT);
#endif
#if DIAG2 == 40
        n = (__hip_atomic_load(nb + 64 * 11, __ATOMIC_RELAXED, __HIP_MEMORY_SCOPE_AGENT) ? 1u : 0u) + (__hip_atomic_load(nb + 64 * 12, __ATOMIC_RELAXED, __HIP_MEMORY_SCOPE_AGENT) ? 2u : 0u) + (__hip_atomic_load(nb + 64 * 13, __ATOMIC_RELAXED, __HIP_MEMORY_SCOPE_AGENT) ? 4u : 0u);
#endif
#if DIAG2 == 39
        n = (__hip_atomic_load(nb + 64 * 10, __ATOMIC_RELAXED, __HIP_MEMORY_SCOPE_AGENT) ? 1u : 0u) + (n ? 2u : 0u);
#endif
#if DIAG2 >= 34 && DIAG2 <= 37
        n = __builtin_popcount(__hip_atomic_load(nb + 64 * (DIAG2 - 30), __ATOMIC_RELAXED, __HIP_MEMORY_SCOPE_AGENT));
#endif
        c = (float)(n > 30u ? 30u : n); }
      grid_bar(lds_raw);
      for (size_t i = (size_t)blockIdx.x * 512 + threadIdx.x; i < (size_t)T * D; i += (size_t)gridDim.x * 512) OUT(a)[i] = c; return; }
#endif
#if defined(DIAG2) && (DIAG2 == 27 || DIAG2 == 28)
    { grid_bar(lds_raw); ArgsRef a = phase_args(); unsigned* sums = (unsigned*)(WS(a) + WS_CTL + 256 * 1024); unsigned* nbad = (unsigned*)(WS(a) + WS_CTL) + 16384;
      const unsigned* rec = (const unsigned*)(WS(a) + WS_REC); const unsigned* gc = (const unsigned*)(WS(a) + WS_CTL) + CW_CNT;
      for (int t = blockIdx.x * 512 + threadIdx.x; t < T; t += gridDim.x * 512) { unsigned sm = 0u; for (int k = 0; k < 4; ++k) { sm = sm * 31u + rec[(size_t)t * 16 + 4 * k]; sm = sm * 31u + rec[(size_t)t * 16 + 4 * k + 2]; sm = sm * 31u + rec[(size_t)t * 16 + 4 * k + 3]; }
          if (a.pass == 0) sums[2 * 16384 + t] = sm; else if (sums[2 * 16384 + t] != sm) atomicAdd(nbad + 64 * 2, 1u); }
      if (blockIdx.x == 0 && threadIdx.x < 64) { const unsigned v = gc[threadIdx.x]; if (a.pass == 0) sums[65536 + threadIdx.x] = v; else if (sums[65536 + threadIdx.x] != v) atomicAdd(nbad + 64 * 2, 1u); }
      grid_bar(lds_raw);
#if DIAG2 == 27
      diag_final(lds_raw); return;
#endif
    }
#endif
    if (PHSEL & (1u << 9)) moe_gateup_phase<0>(lds_raw);
    if (DUP & (1u << 9)) { GRID_BAR(); moe_gateup_phase<0>(lds_raw); }
    if (DUP & (1u << 24)) { GRID_BAR(); moe_gateup_probe<0>(lds_raw); }
    GRID_BAR();
    if (PHSEL & (1u << 10)) moe_down_phase<0>(lds_raw);
    if (DUP & (1u << 10)) { GRID_BAR(); moe_down_phase<0>(lds_raw); }
    if (DUP & (1u << 25)) { GRID_BAR(); moe_down_probe<0>(lds_raw); }
    GRID_BAR();
    if (PHSEL & (1u << 11)) moe_combine_phase<0>(lds_raw);
#if defined(DIAG2) && DIAG2 == 20
    diag_ck(lds_raw, 0, OUT(phase_args()), 8192); diag_final(lds_raw);
#endif
#if defined(DIAG2) && DIAG2 == 28
    diag_final(lds_raw);
#endif
}

extern "C" void kernel_launch(void* const* d_in, const int* in_sizes, int n_in, void* d_out, int out_size, void* d_ws, size_t ws_size, hipStream_t stream) {
    static int grid = 0;
    if (grid == 0) {
        if (n_in != 24 || out_size != T * D || ws_size < WS_END2) { fprintf(stderr, "kernel_launch: unexpected shapes n_in %d out %d ws %zu (need %zu)\n", n_in, out_size, ws_size, (size_t)WS_END2); grid = -1; return; }
        int dev = 0, cus = 0, per_cu = 0;
        if (hipGetDevice(&dev) != hipSuccess || hipDeviceGetAttribute(&cus, hipDeviceAttributeMultiprocessorCount, dev) != hipSuccess) { grid = -1; return; }
        if (hipFuncSetAttribute((const void*)fwd, hipFuncAttributeMaxDynamicSharedMemorySize, LDS_BYTES) != hipSuccess) { fprintf(stderr, "kernel_launch: hipFuncSetAttribute failed\n"); grid = -1; return; }
        if (hipOccupancyMaxActiveBlocksPerMultiprocessor(&per_cu, (const void*)fwd, 512, LDS_BYTES) != hipSuccess || per_cu < 1) fprintf(stderr, "kernel_launch: occupancy query reports %d\n", per_cu);
        (void)hipGetLastError();
        grid = cus;
    }
    if (grid < 0) return;
    if (hipMemsetAsync((char*)d_ws + WS_CTL, 0, CTL_BYTES, stream) != hipSuccess) return;
    Args a{};
    for (int i = 0; i < 24; ++i) a.in[i] = (const float*)d_in[i];
    a.out = (float*)d_out; a.ws = (unsigned char*)d_ws; a.pass = 0;
    hipLaunchKernelGGL(fwd, dim3(grid), dim3(512), LDS_BYTES, stream, a);
#ifdef DIAG2
    if (hipMemsetAsync((char*)d_ws + WS_CTL, 0, 49152, stream) != hipSuccess) return;
    a.pass = 1;
    hipLaunchKernelGGL(fwd, dim3(grid), dim3(512), LDS_BYTES, stream, a);
#endif
}
```

```cpp
#include <hip/hip_runtime.h>
#include <cstdio>
#include <cstdint>

#define LAS __attribute__((address_space(3)))
#define GAS __attribute__((address_space(1)))
typedef unsigned short bf16_t;
typedef short bf16x8 __attribute__((ext_vector_type(8)));
typedef short s16x4 __attribute__((ext_vector_type(4)));
typedef float f32x4 __attribute__((ext_vector_type(4)));
typedef float f32x2 __attribute__((ext_vector_type(2)));
typedef float f32x16 __attribute__((ext_vector_type(16)));
typedef unsigned u32x4 __attribute__((ext_vector_type(4)));
typedef unsigned u32x2 __attribute__((ext_vector_type(2)));
typedef int i32x4 __attribute__((ext_vector_type(4)));
typedef int i32x8 __attribute__((ext_vector_type(8)));

constexpr int NB = 16, SEQ = 2048, T = NB * SEQ, D = 1024;
constexpr int NE = 32, FF = 1024, TOPK_E = 4;
constexpr int HALF_T = T;
constexpr int LIST_CAP = HALF_T;
constexpr int PAD_ROWS = HALF_T * TOPK_E + NE * 256;
constexpr float RMS_EPS = 1e-6f;

constexpr size_t MiB = 1u << 20;
constexpr size_t WS_CTL = 0, CTL_BYTES = 1 * MiB;
constexpr size_t WS_MISC = 5 * MiB;
constexpr size_t MISC_RW_HI = 0, MISC_RW_LO = 65536, MISC_RSTD2 = 131072, MISC_RSTD1 = 262144;
constexpr bool MOE_FP8 = true;
constexpr float W8_SCALE = 32.f, W8_INV = 1.f / 32.f;
constexpr bool X2H = true;
constexpr bool ROWNORM_FUSED = true;
constexpr bool GA8 = true;
constexpr bool MIXA_FP8 = true;
constexpr bool Y_FP8 = true;
constexpr bool INB_FP8 = true;
constexpr bool INC_FP8 = true;
constexpr size_t WS_REC = 6 * MiB, WS_LTOK = 8 * MiB, WS_LRS = 12 * MiB, WS_WD = 48 * MiB, WS_X2B = 96 * MiB, WS_WGU = 144 * MiB, WS_ACT = 208 * MiB, WS_Y = 344 * MiB, WS_X2H = 480 * MiB, WS_END = 552 * MiB;
static_assert(MOE_FP8 && WS_ACT + (size_t)PAD_ROWS * FF <= WS_Y && WS_Y + (size_t)PAD_ROWS * D * (Y_FP8 ? 1 : 2) <= WS_END, "ws map (single-pass MoE needs the fp8 sizes)");
constexpr size_t WS_COSP = 1 * MiB, WS_SINP = 2 * MiB, WS_COST = 3 * MiB, WS_SINT = 4 * MiB;
constexpr size_t MISC_DQ = 393216, MISC_DK = 394240, MISC_DZ = 395264, MISC_RN = 524288;
constexpr size_t WS_WIN = 6 * MiB, WS_XB = 32 * MiB, WS_SMALL = 96 * MiB, WS_QX = 160 * MiB, WS_KP = 224 * MiB, WS_KZT = 288 * MiB, WS_VT = 352 * MiB;
constexpr size_t WS_CKV = 480 * MiB, WS_KIDX = 488 * MiB, WS_WIDX = 492 * MiB, WS_CQN = 493 * MiB, WS_QIDX = 509 * MiB, WS_MASK = 541 * MiB;
constexpr size_t WS_WQ = 552 * MiB, WS_WA = 553 * MiB, WS_WB = 555 * MiB, WS_WOUT = 559 * MiB, WS_END2 = 561 * MiB;
constexpr size_t WS_XB8 = 224 * MiB, WS_WIN8 = 256 * MiB;
constexpr size_t WS_GA = WS_QX, WS_GB = INC_FP8 ? WS_VT : WS_KP,        WS_MIXA = WS_KZT, WS_MIX = WS_VT, WS_QLAT = WS_SMALL, WS_OLAT = WS_VT + 64 * MiB;
constexpr int NIN = 8704;
constexpr int CW_BAR = 1024;
constexpr int CW_CNT = 8192;

__device__ __forceinline__ unsigned f2bf(float f) { unsigned u = __builtin_bit_cast(unsigned, f); return (u + 0x7fffu + ((u >> 16) & 1u)) >> 16; }
__device__ __forceinline__ unsigned pk2(float lo, float hi) { return f2bf(lo) | (f2bf(hi) << 16); }
__device__ __forceinline__ float bf2f(unsigned b) { return __builtin_bit_cast(float, b << 16); }
typedef __bf16 bf16v2_t __attribute__((ext_vector_type(2)));
__device__ __forceinline__ unsigned cvt_pk_bf16(float lo, float hi) { f32x2 v = {lo, hi}; bf16v2_t r = __builtin_convertvector(v, bf16v2_t); return __builtin_bit_cast(unsigned, r); }
__device__ __forceinline__ float wave_sum(float v) {
#pragma unroll
    for (int o = 1; o < 64; o <<= 1) v += __shfl_xor(v, o);
    return v;
}
__device__ __forceinline__ void ld4u(const void* p, unsigned (&w)[4]) { const f32x4 t = *(const f32x4*)p; const float t0 = t[0], t1 = t[1], t2 = t[2], t3 = t[3];
    w[0] = __builtin_bit_cast(unsigned, t0); w[1] = __builtin_bit_cast(unsigned, t1); w[2] = __builtin_bit_cast(unsigned, t2); w[3] = __builtin_bit_cast(unsigned, t3); }
__device__ __forceinline__ unsigned pk4_fp8(float a, float b, float c, float d) { unsigned w = 0u; w = __builtin_amdgcn_cvt_pk_fp8_f32(a, b, w, false); w = __builtin_amdgcn_cvt_pk_fp8_f32(c, d, w, true); return w; }
#define LDS_WAIT() asm volatile("s_waitcnt lgkmcnt(0)" ::: "memory")
#define VM_WAIT() asm volatile("s_waitcnt vmcnt(0)" ::: "memory")

#define XB_TMO      128
#define XB_XCNT(j)  (256  + 64 * (j))
#define XB_XSUB(j)  (1280 + 64 * (j))
#define XB_XGEN(j)  (2304 + 64 * (j))
#define XB_TOP      3328
#define XB_TOPGEN   3392
#define XCD_BAR_WORDS 3456
#define XB_SPIN_CAP (1u << 22)
__device__ __forceinline__ unsigned xb_ld(unsigned* p)              { return __hip_atomic_load(p, __ATOMIC_RELAXED, __HIP_MEMORY_SCOPE_AGENT); }
__device__ __forceinline__ unsigned xb_add(unsigned* p, unsigned v) { return __hip_atomic_fetch_add(p, v, __ATOMIC_RELAXED, __HIP_MEMORY_SCOPE_AGENT); }
__device__ __forceinline__ unsigned xb_xcc_id() { return (unsigned)__builtin_amdgcn_s_getreg((3 << 11) | 20) & 0xFu; }
#define XB_SPIN(cond, bar) do { unsigned _sp = 0; while (cond) { __builtin_amdgcn_s_sleep(1); \
    if ((++_sp & 255u) == 0u) { if (xb_ld(&(bar)[XB_TMO])) break; if (_sp > XB_SPIN_CAP) { atomicAdd(&(bar)[XB_TMO], 1u); break; } } } } while (0)
struct XcdBarrier { unsigned* bar; unsigned x; volatile LAS unsigned* st; };
__device__ __forceinline__ XcdBarrier xcd_barrier_post(unsigned* bar, volatile LAS unsigned* st) {
    XcdBarrier b; b.bar = bar; b.x = xb_xcc_id(); b.st = st;
    if (threadIdx.x == 0) (void)xb_add(&bar[XB_XCNT(b.x)], 1u);
    return b;
}
__device__ __forceinline__ void xcd_barrier_complete(unsigned* bar, unsigned x, unsigned& nloc, unsigned& nx) {
    const unsigned G = gridDim.x * gridDim.y * gridDim.z;
    unsigned sum, cnt, mine, sp = 0u;
    for (;;) {
        sum = 0u; cnt = 0u; mine = 0u;
#pragma unroll
        for (unsigned j = 0; j < 16; ++j) { const unsigned c = xb_ld(&bar[XB_XCNT(j)]); sum += c; cnt += (c > 0u) ? 1u : 0u; mine = (j == x) ? c : mine; }
        if (sum == G) break;
        __builtin_amdgcn_s_sleep(1);
        if ((++sp & 255u) == 0u) { if (xb_ld(&bar[XB_TMO])) break; if (sp > XB_SPIN_CAP) { atomicAdd(&bar[XB_TMO], 1u); break; } }
    }
    nloc = mine > 0u ? mine : 1u; nx = cnt > 0u ? cnt : 1u;
}
__device__ __forceinline__ void xcd_barrier(const XcdBarrier& b) {
    asm volatile("s_waitcnt vmcnt(0)" ::: "memory");
    __syncthreads();
    if (threadIdx.x == 0) {
        unsigned* bar = b.bar;
        __builtin_amdgcn_s_waitcnt(0);
        unsigned nloc = b.st[0], nx = b.st[1];
        if (nloc == 0u) { xcd_barrier_complete(bar, b.x, nloc, nx); b.st[0] = nloc; b.st[1] = nx; }
        const unsigned old = xb_add(&bar[XB_XSUB(b.x)], 1u);
        const unsigned gen = old / nloc;
        if (old + 1u == (gen + 1u) * nloc) {
            __builtin_amdgcn_fence(__ATOMIC_RELEASE, "agent");
            asm volatile("s_waitcnt vmcnt(0)" ::: "memory");
            const unsigned og = xb_add(&bar[XB_TOP], 1u);
            const unsigned tg = og / nx;
            if (og + 1u == (tg + 1u) * nx) xb_add(&bar[XB_TOPGEN], 1u);
            else XB_SPIN(xb_ld(&bar[XB_TOPGEN]) == tg, bar);
            __builtin_amdgcn_fence(__ATOMIC_ACQUIRE, "agent");
            xb_add(&bar[XB_XGEN(b.x)], 1u);
            asm volatile("s_waitcnt vmcnt(0)" ::: "memory");
        } else {
            XB_SPIN(xb_ld(&bar[XB_XGEN(b.x)]) == gen, bar);
            __builtin_amdgcn_fence(__ATOMIC_ACQUIRE, "agent");
            asm volatile("s_waitcnt vmcnt(0)" ::: "memory");
        }
    }
    __syncthreads();
#ifdef ALLWAVE_INV
    __builtin_amdgcn_fence(__ATOMIC_ACQUIRE, "agent"); asm volatile("s_waitcnt vmcnt(0)" ::: "memory");
#endif
}

namespace pg8 {
constexpr int BM = 256, BK = 64, HALF = 128, HTB = HALF * BK * 2, STAGE_BYTES = 8 * HTB;
__host__ __device__ __forceinline__ int lds_byte(int r, int c) { const int st = (r >> 4) * 2 + (c >> 5), rr = r & 15, cc = c & 31, ob = rr * 64 + cc * 2; return st * 1024 + (ob ^ (((ob >> 9) & 1) << 5)); }
__host__ __device__ __forceinline__ void stage_rc(int b, int& R, int& C) { const int st = b / 1024, sb = b % 1024, swz = sb ^ (((sb >> 9) & 1) << 5); R = (st >> 1) * 16 + swz / 64; C = (st & 1) * 32 + (swz % 64) / 2; }
__host__ __device__ __forceinline__ int perm32(int rho) { const int n = rho >> 4, i = rho & 15; return 8 * (i >> 2) + 4 * n + (i & 3); }

struct Unit { int pm, pn, e, j; };

#define PG8_SA(b, h) (((b) * 2 + (h)) * HTB)
#define PG8_SB(b, h) ((4 + (b) * 2 + (h)) * HTB)
#define PG8_STAGE(bufoff, rsrc, soff, voff) do { _Pragma("unroll") for (int _i = 0; _i < 2; ++_i) \
        __builtin_amdgcn_raw_ptr_buffer_load_lds(rsrc, (LAS void*)(lds + (bufoff) + ldsw + _i * 8192), 16, (int)(voff)[_i], (int)(soff), 0, 0); } while (0)
#define PG8_LDA(dst, b, h) do { _Pragma("unroll") for (int m = 0; m < 4; ++m) _Pragma("unroll") for (int k = 0; k < 2; ++k) dst[m][k] = *(const LAS bf16x8*)(lds + PG8_SA(b, h) + aoff + m * 2048 + k * 1024); } while (0)
#define PG8_LDB(dst, b, h) do { _Pragma("unroll") for (int n = 0; n < 2; ++n) _Pragma("unroll") for (int k = 0; k < 2; ++k) dst[n][k] = *(const LAS bf16x8*)(lds + PG8_SB(b, h) + boff + n * 2048 + k * 1024); } while (0)
#define PG8_CAT(x) __builtin_shufflevector(__builtin_bit_cast(i32x4, (x)[0]), __builtin_bit_cast(i32x4, (x)[1]), 0, 1, 2, 3, 4, 5, 6, 7)
#define PG8_MMA(ai, bj, At, Bt) do { __builtin_amdgcn_s_setprio(1); if constexpr (F8) { asm volatile("s_nop 1"); _Pragma("unroll") for (int m = 0; m < 4; ++m) _Pragma("unroll") for (int n = 0; n < 2; ++n) { \
        const i32x8 _b8 = PG8_CAT(Bt[n]), _a8 = PG8_CAT(At[m]); if constexpr (SWAP) asm volatile("v_mfma_f32_16x16x128_f8f6f4 %0, %1, %2, %0" : "+v"(acc[ai][bj][m][n]) : "v"(_a8), "v"(_b8)); \
        else asm volatile("v_mfma_f32_16x16x128_f8f6f4 %0, %1, %2, %0" : "+v"(acc[ai][bj][m][n]) : "v"(_b8), "v"(_a8)); } } else { \
        _Pragma("unroll") for (int m = 0; m < 4; ++m) _Pragma("unroll") for (int n = 0; n < 2; ++n) _Pragma("unroll") for (int k = 0; k < 2; ++k) \
        acc[ai][bj][m][n] = SWAP ? __builtin_amdgcn_mfma_f32_16x16x32_bf16(At[m][k], Bt[n][k], acc[ai][bj][m][n], 0, 0, 0) : __builtin_amdgcn_mfma_f32_16x16x32_bf16(Bt[n][k], At[m][k], acc[ai][bj][m][n], 0, 0, 0); } __builtin_amdgcn_s_setprio(0); } while (0)
#define PG8_ACC_SETTLE() do { _Pragma("unroll") for (int _a = 0; _a < 2; ++_a) _Pragma("unroll") for (int _b = 0; _b < 2; ++_b) \
        asm volatile("s_nop 15\n\ts_nop 7" : "+v"(acc[_a][_b][0][0]), "+v"(acc[_a][_b][0][1]), "+v"(acc[_a][_b][1][0]), "+v"(acc[_a][_b][1][1]), "+v"(acc[_a][_b][2][0]), "+v"(acc[_a][_b][2][1]), "+v"(acc[_a][_b][3][0]), "+v"(acc[_a][_b][3][1])); } while (0)
#define PG8_WAIT_V(n) asm volatile("s_waitcnt vmcnt(" #n ")" ::: "memory")
#define PG8_WAIT_L(n) asm volatile("s_waitcnt lgkmcnt(" #n ")" ::: "memory")
#define PG8_BAR __builtin_amdgcn_s_barrier()
#define PG8_SCHED __builtin_amdgcn_sched_barrier(0)
#define PG8_TRIP(a1, a2, a3, V1h1, V2h0, V2h1, b2, b3) do { \
            PG8_LDB(B0, 0, 0); PG8_SCHED; PG8_LDA(At, 0, 0); PG8_STAGE(PG8_SA(1, 1), rA, (a1) + ahstep, V1h1); \
            PG8_WAIT_L(8); PG8_BAR; PG8_WAIT_L(0); PG8_MMA(0, 0, At, B0); PG8_BAR; PG8_SCHED; \
            PG8_LDB(B1, 0, 1); PG8_STAGE(PG8_SB(0, 0), rB, b2, voffB); \
            PG8_BAR; PG8_WAIT_L(0); PG8_MMA(0, 1, At, B1); PG8_BAR; \
            PG8_LDA(At, 0, 1); PG8_STAGE(PG8_SA(0, 0), rA, a2, V2h0); \
            PG8_BAR; PG8_WAIT_L(0); PG8_MMA(1, 0, At, B0); PG8_BAR; PG8_SCHED; \
            PG8_STAGE(PG8_SB(0, 1), rB, (b2) + hstep, voffB); \
            PG8_WAIT_V(6); PG8_BAR; PG8_MMA(1, 1, At, B1); PG8_BAR; \
            PG8_LDB(B0, 1, 0); PG8_SCHED; PG8_LDA(At, 1, 0); PG8_STAGE(PG8_SA(0, 1), rA, (a2) + ahstep, V2h1); \
            PG8_WAIT_L(8); PG8_BAR; PG8_WAIT_L(0); PG8_MMA(0, 0, At, B0); PG8_BAR; PG8_SCHED; \
            PG8_LDB(B1, 1, 1); PG8_STAGE(PG8_SB(1, 0), rB, b3, voffB); \
            PG8_BAR; PG8_WAIT_L(0); PG8_MMA(0, 1, At, B1); PG8_BAR; \
            PG8_LDA(At, 1, 1); PG8_STAGE(PG8_SA(1, 0), rA, a3, V2h0); \
            PG8_BAR; PG8_WAIT_L(0); PG8_MMA(1, 0, At, B0); PG8_BAR; PG8_SCHED; \
            PG8_STAGE(PG8_SB(1, 1), rB, (b3) + hstep, voffB); \
            PG8_WAIT_V(6); PG8_BAR; PG8_MMA(1, 1, At, B1); PG8_BAR; } while (0)
template <class Epi, class Sched, bool SWAP, bool GATHER, int K, bool F8 = false>
__device__ __forceinline__ void gemm_phase(LAS unsigned char* lds, const int tid, const bf16_t* Abase, const bf16_t* Bbase, const Sched& S, const Epi& E, LAS u32x4* gslots = nullptr) {
    static_assert(!(SWAP && Epi::PERM), "SWAP needs natural B row order");
    const int wid = __builtin_amdgcn_readfirstlane(tid >> 6), lane = tid & 63, wr = wid >> 2, wc = wid & 3, fr = lane & 15, fq = lane >> 4;
    constexpr int nt = K / BK;
    const unsigned long long pa_ = (unsigned long long)Abase, pb_ = (unsigned long long)Bbase;
    const unsigned long long ua_ = ((unsigned long long)(unsigned)__builtin_amdgcn_readfirstlane((int)(pa_ >> 32)) << 32) | (unsigned)__builtin_amdgcn_readfirstlane((int)pa_);
    const unsigned long long ub_ = ((unsigned long long)(unsigned)__builtin_amdgcn_readfirstlane((int)(pb_ >> 32)) << 32) | (unsigned)__builtin_amdgcn_readfirstlane((int)pb_);
    const __amdgpu_buffer_rsrc_t rA = __builtin_amdgcn_make_buffer_rsrc((void*)ua_, 0, 0x7ffffffc, 0x00020000);
    const __amdgpu_buffer_rsrc_t rB = __builtin_amdgcn_make_buffer_rsrc((void*)ub_, 0, 0x7ffffffc, 0x00020000);
    unsigned voffB[2], vA0[2], vA1[2];
#pragma unroll
    for (int i = 0; i < 2; ++i) { int R, C; stage_rc(tid * 16 + i * 8192, R, C); const int Rb = Epi::PERM ? ((R & ~31) + perm32(R & 31)) : R;
        const int Ra = SWAP ? ((R & ~63) | (16 * ((R >> 2) & 3) + 4 * ((R >> 4) & 3) + (R & 3))) : R;
        voffB[i] = (unsigned)(Rb * K + C) * 2u; vA0[i] = (unsigned)(Ra * K + C) * 2u; vA1[i] = vA0[i]; }
    constexpr unsigned kstep = (unsigned)(BK * 2);
    constexpr unsigned hstep = (unsigned)HALF * K * 2;
    constexpr unsigned ahstep = GATHER ? 0u : hstep;
    const unsigned ldsw = (unsigned)wid * 1024u;
    const int aoff = lds_byte(wr * 64 + fr, fq * 8), boff = lds_byte(wc * 32 + fr, fq * 8);
#define PG8_ROWS(d0, d1, u) do { int _t = tid; asm volatile("" : "+v"(_t)); _Pragma("unroll") for (int _i = 0; _i < 2; ++_i) { int _R, _C; stage_rc(_t * 16 + _i * 8192, _R, _C); \
        const int _nr = S.nrows(u); int _x0 = _R < _nr ? _R : _nr - 1, _x1 = (_R + HALF) < _nr ? (_R + HALF) : _nr - 1; const int* _l = S.rows + S.lo(u); \
        d0[_i] = (unsigned)(_l[_x0] * K + _C) * 2u; d1[_i] = (unsigned)(_l[_x1] * K + _C) * 2u; } } while (0)
    Unit cur, nxt; int ui = 0;
    if (!S.next(0, cur)) return;
    f32x4 acc[2][2][4][2];
#pragma unroll
    for (int a = 0; a < 2; ++a)
#pragma unroll
        for (int b = 0; b < 2; ++b)
#pragma unroll
            for (int m = 0; m < 4; ++m)
#pragma unroll
                for (int n = 0; n < 2; ++n) acc[a][b][m][n] = (f32x4){0.f, 0.f, 0.f, 0.f};
    bf16x8 At[4][2], B0[2][2], B1[2][2];
    unsigned cA = S.aoff(cur), cB = S.boff(cur);
    if constexpr (GATHER) { PG8_ROWS(vA0, vA1, cur); gslots[tid] = (u32x4){vA0[0], vA0[1], vA1[0], vA1[1]}; }
    PG8_STAGE(PG8_SB(0, 0), rB, cB, voffB); PG8_STAGE(PG8_SA(0, 0), rA, cA, vA0); PG8_STAGE(PG8_SB(0, 1), rB, cB + hstep, voffB); PG8_STAGE(PG8_SA(0, 1), rA, cA + ahstep, vA1);
    if (wr == 1) PG8_BAR;
    PG8_WAIT_V(4); PG8_BAR;
    PG8_STAGE(PG8_SB(1, 0), rB, cB + kstep, voffB); PG8_STAGE(PG8_SA(1, 0), rA, cA + kstep, vA0); PG8_STAGE(PG8_SB(1, 1), rB, cB + hstep + kstep, voffB);
    PG8_WAIT_V(6); PG8_BAR;
    for (;;) {
        const bool has_next = S.next(ui + 1, nxt);
        const unsigned nA = has_next ? S.aoff(nxt) : cA, nB = has_next ? S.boff(nxt) : cB;
        int nrow0[2] = {0, 0}, nrow1[2] = {0, 0};
        if constexpr (GATHER) { if (has_next) { int _t = tid; asm volatile("" : "+v"(_t)); _Pragma("unroll") for (int _i = 0; _i < 2; ++_i) { int _R, _C; stage_rc(_t * 16 + _i * 8192, _R, _C);
            const int _nr = S.nrows(nxt); const int _x0 = _R < _nr ? _R : _nr - 1, _x1 = (_R + HALF) < _nr ? (_R + HALF) : _nr - 1; const int* _l = S.rows + S.lo(nxt); nrow0[_i] = _l[_x0]; nrow1[_i] = _l[_x1]; } } }
#pragma unroll 1
        for (int t = 0; t < nt; t += 2) {
            const bool last = (t == nt - 2);
            const unsigned a1 = cA + (unsigned)(t + 1) * kstep;
            const unsigned a2 = last ? nA : cA + (unsigned)(t + 2) * kstep, b2 = last ? nB : cB + (unsigned)(t + 2) * kstep;
            if constexpr (!GATHER) {
                PG8_TRIP(a1, a2, a2 + kstep, vA0, vA0, vA0, b2, b2 + kstep);
            } else {
                const int par = ui & 1;
                if (last && has_next) { unsigned n0[2], n1[2]; int _t = tid; asm volatile("" : "+v"(_t));
                    _Pragma("unroll") for (int _i = 0; _i < 2; ++_i) { int _R, _C; stage_rc(_t * 16 + _i * 8192, _R, _C); n0[_i] = (unsigned)(nrow0[_i] * K + _C) * 2u; n1[_i] = (unsigned)(nrow1[_i] * K + _C) * 2u; }
                    gslots[(par ^ 1) * 512 + tid] = (u32x4){n0[0], n0[1], n1[0], n1[1]}; }
                const u32x4 vc = gslots[par * 512 + tid], vn = gslots[((last && has_next) ? (par ^ 1) : par) * 512 + tid];
                const unsigned c1[2] = {vc.z, vc.w}, n0[2] = {vn.x, vn.y}, n1[2] = {vn.z, vn.w};
                PG8_TRIP(a1, a2, a2 + kstep, c1, n0, n1, b2, b2 + kstep);
            }
        }
        if constexpr (F8) PG8_ACC_SETTLE();
        E(acc, cur, wr, wc, fr, fq);
        if (!has_next) break;
#pragma unroll
        for (int a = 0; a < 2; ++a)
#pragma unroll
            for (int b = 0; b < 2; ++b)
#pragma unroll
                for (int m = 0; m < 4; ++m)
#pragma unroll
                    for (int n = 0; n < 2; ++n) acc[a][b][m][n] = (f32x4){0.f, 0.f, 0.f, 0.f};
        cur = nxt; cA = nA; cB = nB; ++ui;
    }
    PG8_WAIT_V(0);
    if (wr == 0) PG8_BAR;
    PG8_BAR;
#undef PG8_ROWS
}
}

struct Args { const float* in[24]; float* out; unsigned char* ws; long long pass; };
enum { I_X = 0, I_NORM_MIX_G, I_W_IN, I_CQ_G, I_CKV_G, I_KIDX_G, I_W_UQ, I_W_QIDX, I_W_UK, I_W_UV, I_T5, I_W_BA, I_W_BB, I_W_OUT, I_NORM_FFN_G, I_W_ROUTER, I_B_ROUTER,
       I_W_GATE, I_B_GATE, I_W_UP, I_B_UP, I_W_DOWN, I_B_DOWN, I_NORM_FINAL_G };

constexpr int LDS_STAGE = 0, LDS_MISC = 131072, LDS_BYTES = 163840;
constexpr int LM_BAR = 0;
constexpr int LM_TEND = 64;
constexpr int LM_CNT = 192;
constexpr int LM_PSTART = 320;
constexpr int LM_LCNT = 448;
constexpr int LM_GBASE = 576;
constexpr int LM_REC = 1024;
constexpr int LM_SCR = 9216;
constexpr int LM_SLOTS = 1024;
constexpr int LM_TILE = 27648;

struct Frame { LAS unsigned char* lds; LAS unsigned char* misc; int tid, lane, wave, G, bid; };
#define GAS __attribute__((address_space(1)))
typedef const __attribute__((address_space(4))) Args CArgs;
typedef CArgs& ArgsRef;
#define WS(a) ((unsigned char*)(GAS unsigned char*)(a).ws)
#define OUT(a) ((float*)(GAS float*)(a).out)
#define IN(a, i) ((const float*)(GAS const float*)(a).in[i])
__device__ __forceinline__ ArgsRef phase_args() { CArgs* ap = (CArgs*)__builtin_amdgcn_kernarg_segment_ptr(); asm volatile("" : "+s"(ap)); return *ap; }
__device__ __forceinline__ Frame make_frame(unsigned char* lds_raw) {
    Frame F; int tid = threadIdx.x; asm volatile("" : "+v"(tid)); int bid = blockIdx.x; asm volatile("" : "+s"(bid)); int G = gridDim.x; asm volatile("" : "+s"(G));
    F.lds = (LAS unsigned char*)lds_raw; F.misc = F.lds + LDS_MISC; F.tid = tid; F.lane = tid & 63; F.wave = __builtin_amdgcn_readfirstlane(tid >> 6); F.G = G; F.bid = bid; return F;
}

struct DenseOrder {
    int nM, nN, nwg, G, c, K; size_t a0, b0;
    __device__ __forceinline__ void init(int M, int N, int K_, int G_, int c_, size_t a0_ = 0, size_t b0_ = 0) { nM = M / 256; nN = N / 256; nwg = nM * nN; G = G_; c = c_; K = K_; a0 = a0_; b0 = b0_; }
    __device__ __forceinline__ bool next(int i, pg8::Unit& u) const {
        const long L = (long)i * G + c; if (L >= nwg) return false;
        int wgid = (int)L; { const int q = nwg / 8, r = nwg % 8, xcd = wgid % 8, off = wgid / 8; wgid = (xcd < r ? xcd * (q + 1) : r * (q + 1) + (xcd - r) * q) + off; }
        const int nig = 8 * nN, gid = wgid / nig, fm = gid * 8, gsz = (nM - fm) < 8 ? (nM - fm) : 8;
        u.pm = fm + ((wgid % nig) % gsz); u.pn = (wgid % nig) / gsz; u.e = 0; u.j = 0; return true;
    }
    __device__ __forceinline__ unsigned aoff(const pg8::Unit& u) const { return (unsigned)(a0 + (size_t)u.pm * 256 * K * 2); }
    __device__ __forceinline__ unsigned boff(const pg8::Unit& u) const { return (unsigned)(b0 + (size_t)u.pn * 256 * K * 2); }
};
template <int NPN, bool GATHER, int ROWB = 2048> struct MoeOrder {
    const LAS int* tile_e; const LAS int* cnt; const int* rows; int ntiles, G, c;
    __device__ __forceinline__ bool next(int i, pg8::Unit& u) const {
        int pm, pn;
        if (G == 256) {
            constexpr int PMG = 32 / NPN; const int xcd = c & 7, slot = c >> 3;
            pm = (i * 8 + xcd) * PMG + slot / NPN; pn = slot % NPN; if (pm >= ntiles) return false; }
        else { const int L = i * G + c; if (L >= ntiles * NPN) return false; pm = L / NPN; pn = L % NPN; }
        const int ej = __builtin_amdgcn_readfirstlane(tile_e[pm]);
        u.pm = pm; u.pn = pn; u.e = ej >> 16; u.j = ej & 0xffff; return true;
    }
    __device__ __forceinline__ int nrows(const pg8::Unit& u) const { int nr = __builtin_amdgcn_readfirstlane(cnt[u.e]) - 256 * u.j; return nr > 256 ? 256 : nr; }
    __device__ __forceinline__ int lo(const pg8::Unit& u) const { return u.e * LIST_CAP + 256 * u.j; }
    __device__ __forceinline__ unsigned aoff(const pg8::Unit& u) const { return GATHER ? 0u : (unsigned)u.pm * 256u * (unsigned)ROWB; }
    __device__ __forceinline__ unsigned boff(const pg8::Unit& u) const { return (unsigned)(u.e * NPN + u.pn) * 256u * (unsigned)ROWB; }
};

struct EpiGateUp { static constexpr bool PERM = true;
    bf16_t* act; const float* bgate; const float* bup; const float* lrs; const LAS int* cnt;
    __device__ __forceinline__ void operator()(const f32x4 (&acc)[2][2][4][2], const pg8::Unit& u, int wr, int wc, int fr, int fq) const {
        const int f0 = 128 * u.pn + 32 * wc + 8 * fq; const float* rsl = lrs + u.e * LIST_CAP + 256 * u.j; const int nrows = cnt[u.e] - 256 * u.j;
        f32x4 bg[2], bu[2]; float rsv[2][4];
#pragma unroll
        for (int n = 0; n < 2; ++n) { bg[n] = *(const f32x4*)(bgate + u.e * FF + f0 + 4 * n); bu[n] = *(const f32x4*)(bup + u.e * FF + f0 + 4 * n); }
#pragma unroll
        for (int ai = 0; ai < 2; ++ai)
#pragma unroll
            for (int m = 0; m < 4; ++m) rsv[ai][m] = rsl[128 * ai + 64 * wr + 16 * m + fr];
#pragma unroll
        for (int ai = 0; ai < 2; ++ai)
#pragma unroll
            for (int m = 0; m < 4; ++m) { const int r = 128 * ai + 64 * wr + 16 * m + fr; const float rs = r < nrows ? rsv[ai][m] * (MOE_FP8 ? W8_INV : 1.f) : 0.f;
                float a[8];
#pragma unroll
                for (int n = 0; n < 2; ++n)
#pragma unroll
                    for (int i = 0; i < 4; i += 2) {
                        const f32x2 ag = {acc[ai][0][m][n][i], acc[ai][0][m][n][i + 1]}, au = {acc[ai][1][m][n][i], acc[ai][1][m][n][i + 1]};
                        const f32x2 bg2 = {bg[n][i], bg[n][i + 1]}, bu2 = {bu[n][i], bu[n][i + 1]}, rs2 = {rs, rs};
                        f32x2 g = ag * rs2 + bg2, up = au * rs2 + bu2;
                        g[0] = fminf(g[0], 7.f); g[1] = fminf(g[1], 7.f); up[0] = fminf(fmaxf(up[0], -7.f), 7.f); up[1] = fminf(fmaxf(up[1], -7.f), 7.f);
                        const f32x2 ar = g * (f32x2){-1.702f * 1.4426950408889634f, -1.702f * 1.4426950408889634f};
                        f32x2 den = {__builtin_amdgcn_exp2f(ar[0]), __builtin_amdgcn_exp2f(ar[1])}; den = den + (f32x2){1.f, 1.f};
                        const f32x2 sg = {__builtin_amdgcn_rcpf(den[0]), __builtin_amdgcn_rcpf(den[1])};
                        const f32x2 res = (g * sg) * (up + (f32x2){1.f, 1.f});
                        a[4 * n + i] = res[0]; a[4 * n + i + 1] = res[1]; }
                if constexpr (MOE_FP8) { u32x2 w8; w8.x = pk4_fp8(a[0], a[1], a[2], a[3]); w8.y = pk4_fp8(a[4], a[5], a[6], a[7]); *(u32x2*)((unsigned char*)act + ((size_t)u.pm * 256 + r) * FF + f0) = w8; }
                else { u32x4 w; w.x = cvt_pk_bf16(a[0], a[1]); w.y = cvt_pk_bf16(a[2], a[3]); w.z = cvt_pk_bf16(a[4], a[5]); w.w = cvt_pk_bf16(a[6], a[7]);
                *(u32x4*)(act + ((size_t)u.pm * 256 + r) * FF + f0) = w; } }
    }
};
struct EpiDown { static constexpr bool PERM = true;
    bf16_t* y; const float* bdown;
    __device__ __forceinline__ void operator()(const f32x4 (&acc)[2][2][4][2], const pg8::Unit& u, int wr, int wc, int fr, int fq) const {
        const int c0 = 256 * u.pn + 32 * wc + 8 * fq;
        f32x4 bv[2][2];
#pragma unroll
        for (int bj = 0; bj < 2; ++bj)
#pragma unroll
            for (int n = 0; n < 2; ++n) bv[bj][n] = *(const f32x4*)(bdown + u.e * D + c0 + 128 * bj + 4 * n);
#pragma unroll
        for (int ai = 0; ai < 2; ++ai)
#pragma unroll
            for (int m = 0; m < 4; ++m) { const int r = 128 * ai + 64 * wr + 16 * m + fr;
#pragma unroll
                for (int bj = 0; bj < 2; ++bj) { const f32x4 v0 = acc[ai][bj][m][0] * (MOE_FP8 ? W8_INV : 1.f) + bv[bj][0], v1 = acc[ai][bj][m][1] * (MOE_FP8 ? W8_INV : 1.f) + bv[bj][1];
                    if constexpr (Y_FP8) { u32x2 w8; w8.x = pk4_fp8(v0[0], v0[1], v0[2], v0[3]); w8.y = pk4_fp8(v1[0], v1[1], v1[2], v1[3]); *(u32x2*)((unsigned char*)y + ((size_t)u.pm * 256 + r) * D + c0 + 128 * bj) = w8; }
                    else { u32x4 w; w.x = cvt_pk_bf16(v0[0], v0[1]); w.y = cvt_pk_bf16(v0[2], v0[3]); w.z = cvt_pk_bf16(v1[0], v1[1]); w.w = cvt_pk_bf16(v1[2], v1[3]);
                    *(u32x4*)(y + ((size_t)u.pm * 256 + r) * D + c0 + 128 * bj) = w; } } }
    }
};

struct EpiProbe { static constexpr bool PERM = true;
    float* sink;
    __device__ __forceinline__ void operator()(const f32x4 (&acc)[2][2][4][2], const pg8::Unit& u, int wr, int wc, int fr, int fq) const {
        float s = 0.f;
#pragma unroll
        for (int ai = 0; ai < 2; ++ai)
#pragma unroll
            for (int bj = 0; bj < 2; ++bj)
#pragma unroll
                for (int m = 0; m < 4; ++m)
#pragma unroll
                    for (int n = 0; n < 2; ++n) s += acc[ai][bj][m][n][0];
        if (s != s) sink[u.pm] = s;
    }
};
template <bool F8 = false> __device__ __forceinline__ void transpose_item64(const float* W, int ldw, int Kd, bf16_t* WT, long dst_row0, const float* g, LAS float* scr, int k0, int srccol, int lane) {
    float v[64];
#pragma unroll
    for (int kk = 0; kk < 64; ++kk) v[kk] = srccol >= 0 ? W[(size_t)(k0 + kk) * ldw + srccol] : 0.f;
    if (g) {
#pragma unroll
        for (int kk = 0; kk < 64; kk += 4) { const f32x4 gg = *(const f32x4*)(g + k0 + kk); v[kk] *= gg[0]; v[kk + 1] *= gg[1]; v[kk + 2] *= gg[2]; v[kk + 3] *= gg[3]; } }
#pragma unroll
    for (int kk = 0; kk < 64; ++kk) scr[lane * 65 + kk] = v[kk];
    LDS_WAIT(); asm volatile("" ::: "memory");
    const int c = lane & 7;
#pragma unroll
    for (int j = 0; j < 8; ++j) { const int n = (lane >> 3) + 8 * j; const LAS float* sp = scr + n * 65 + 8 * c;
        if constexpr (F8) { u32x2 o8; o8.x = pk4_fp8(sp[0] * W8_SCALE, sp[1] * W8_SCALE, sp[2] * W8_SCALE, sp[3] * W8_SCALE); o8.y = pk4_fp8(sp[4] * W8_SCALE, sp[5] * W8_SCALE, sp[6] * W8_SCALE, sp[7] * W8_SCALE);
            *(u32x2*)((unsigned char*)WT + (size_t)(dst_row0 + n) * Kd + k0 + 8 * c) = o8; }
        else { u32x4 o; o.x = pk2(sp[0], sp[1]); o.y = pk2(sp[2], sp[3]); o.z = pk2(sp[4], sp[5]); o.w = pk2(sp[6], sp[7]);
        *(u32x4*)(WT + (size_t)(dst_row0 + n) * Kd + k0 + 8 * c) = o; } }
    LDS_WAIT(); asm volatile("" ::: "memory");
}

__device__ __forceinline__ void moe_weight_convert(const Frame& F, ArgsRef a) {
    LAS float* scr = (LAS float*)(F.wave < 7 ? F.lds + LDS_STAGE + F.wave * 16640 : F.misc + 4096);
    const int gw = F.bid * 8 + F.wave, NGW = F.G * 8;
    const float* gffn = IN(a, I_NORM_FFN_G);
    bf16_t* wgu = (bf16_t*)(WS(a) + WS_WGU); bf16_t* wd = (bf16_t*)(WS(a) + WS_WD);
    constexpr int KB = MOE_FP8 ? 2 : 1, PER = (16 / KB) * 16;
    for (int it = gw; it < 3 * NE * PER; it += NGW) {
        const int mat = it / (NE * PER), r = it % (NE * PER), e = r / PER, q = r % PER, kb0 = (q / 16) * KB, nb = q % 16;
#pragma unroll 1
        for (int kk = 0; kk < KB; ++kk) { const int kb = kb0 + kk;
            if (mat < 2) { const float* W = IN(a, mat == 0 ? I_W_GATE : I_W_UP) + (size_t)e * D * FF;
                const long row = (long)e * 2048 + (nb / 2) * 256 + (mat ? 128 : 0) + (nb % 2) * 64;
                transpose_item64<MOE_FP8>(W, FF, D, wgu, row, gffn, scr, 64 * kb, 64 * nb + F.lane, F.lane);
            } else { const float* W = IN(a, I_W_DOWN) + (size_t)e * FF * D;
                transpose_item64<MOE_FP8>(W, D, FF, wd, (long)e * 1024 + 64 * nb, nullptr, scr, 64 * kb, 64 * nb + F.lane, F.lane); } }
    }
}
__device__ __forceinline__ void router_weight_prep(const Frame& F, ArgsRef a) {
    bf16_t* whi = (bf16_t*)(WS(a) + WS_MISC + MISC_RW_HI); bf16_t* wlo = (bf16_t*)(WS(a) + WS_MISC + MISC_RW_LO);
    const float* wr = IN(a, I_W_ROUTER); const float* g = IN(a, I_NORM_FFN_G);
    for (int i = F.bid * 512 + F.tid; i < NE * D; i += F.G * 512) { const int e = i / D, k = i % D; const float v = g[k] * wr[k * NE + e];
        const unsigned h = f2bf(v); const float r = v - bf2f(h); whi[i] = (bf16_t)h; wlo[i] = (bf16_t)f2bf(r); }
}
__device__ __forceinline__ void copy_x_phase(const Frame& F, ArgsRef a) {
    const int gw = F.bid * 8 + F.wave, NGW = F.G * 8; bf16_t* x2b = (bf16_t*)(WS(a) + WS_X2B);
    for (int t = gw; t < T; t += NGW) { const f32x4* xr = (const f32x4*)(IN(a, I_X) + (size_t)t * D) + F.lane; f32x4* o = (f32x4*)(OUT(a) + (size_t)t * D) + F.lane; u32x2* ob = (u32x2*)(x2b + (size_t)t * D) + F.lane;
#pragma unroll
        for (int j = 0; j < 4; ++j) { const f32x4 v = xr[64 * j]; o[64 * j] = v; u32x2 w; w.x = pk2(v[0], v[1]); w.y = pk2(v[2], v[3]); ob[64 * j] = w; } }
}
__device__ __forceinline__ void router_phase(const Frame& F, ArgsRef a) {
    LAS int* lcnt = (LAS int*)(F.misc + LM_LCNT); LAS int* gbase = (LAS int*)(F.misc + LM_GBASE);
    LAS int* rec_e = (LAS int*)(F.misc + LM_REC); LAS int* rec_p = rec_e + 512; LAS float* rec_w = (LAS float*)(rec_p + 512); LAS float* rec_rs = rec_w + 512; LAS float* scr = (LAS float*)(F.misc + LM_SCR + F.wave * 2304);
    const bf16_t* whi = (const bf16_t*)(WS(a) + WS_MISC + MISC_RW_HI); const bf16_t* wlo = (const bf16_t*)(WS(a) + WS_MISC + MISC_RW_LO);
    unsigned* gcnt = (unsigned*)(WS(a) + WS_CTL) + CW_CNT;
    const float* x2 = X2H ? (const float*)(WS(a) + WS_X2H) : OUT(a); const float* brt = IN(a, I_B_ROUTER);
    const unsigned long long px_ = (unsigned long long)x2; const unsigned long long ux_ = ((unsigned long long)(unsigned)__builtin_amdgcn_readfirstlane((int)(px_ >> 32)) << 32) | (unsigned)__builtin_amdgcn_readfirstlane((int)px_);
    const __amdgpu_buffer_rsrc_t x2rsrc = __builtin_amdgcn_make_buffer_rsrc((void*)ux_, 0, 0x7ffffffc, 0x00020000);
    u32x4* grec = (u32x4*)(WS(a) + WS_REC); int* ltok = (int*)(WS(a) + WS_LTOK); float* lrs = (float*)(WS(a) + WS_LRS);
    const int fr = F.lane & 15, fq = F.lane >> 4;
    LAS unsigned char* wl_lds = F.lds + LDS_STAGE;
    __syncthreads();
    for (int i = F.tid; i < 8192; i += 512) { const int arr = i >> 12, row = (i >> 7) & 31, ch = i & 127; const f32x4 v = *(const f32x4*)((arr ? wlo : whi) + (size_t)row * D + ch * 8);
        *(LAS f32x4*)(wl_lds + arr * 65536 + row * 2048 + ((ch ^ (row & 7)) << 4)) = v; }
    __syncthreads();
#if defined(DIAG2) && (DIAG2 == 29 || DIAG2 == 30 || DIAG2 == 31)
    { unsigned* dbgA = (unsigned*)(WS(a) + WS_CTL + 640 * 1024); unsigned* nb = (unsigned*)(WS(a) + WS_CTL) + 16384; unsigned sm = 0u;
      for (int i = F.lane; i < 4096; i += 64) sm += ((const LAS unsigned*)(wl_lds + F.wave * 16384))[i] * (unsigned)(2 * i + 1);
      for (int o = 1; o < 64; o <<= 1) sm += __shfl_xor(sm, o);
      if (F.lane == 0) { if (a.pass == 0) dbgA[F.bid * 8 + F.wave] = sm; else if (dbgA[F.bid * 8 + F.wave] != sm) atomicAdd(nb + 64 * 1, 1u); } }
#endif
    for (int grp = F.bid; grp < T / 128; grp += F.G) {
        if (F.tid < 32) lcnt[F.tid] = 0;
        __syncthreads();
        const int t0 = grp * 128 + F.wave * 16;
        f32x4 acc0 = {0.f, 0.f, 0.f, 0.f}, acc1 = {0.f, 0.f, 0.f, 0.f}; float ssq = 0.f;
        const float* xr = x2 + (size_t)(t0 + fr) * D + 8 * fq;
#pragma unroll 1
        for (int k8 = 0; k8 < 4; ++k8) {
            f32x4 xa[8], xb[8]; u32x4 xh[8];
#pragma unroll
            for (int u = 0; u < 8; ++u) {
                if constexpr (X2H) { const unsigned vo = (unsigned)(t0 + fr) * 2048u + 16u * fq + 64u * (8 * k8 + u); xh[u] = __builtin_amdgcn_raw_buffer_load_b128(x2rsrc, vo, 0, 16); }
                else { const unsigned vo = (unsigned)(t0 + fr) * 4096u + 32u * fq + 128u * (8 * k8 + u);
                xa[u] = __builtin_bit_cast(f32x4, __builtin_amdgcn_raw_buffer_load_b128(x2rsrc, vo, 0, 16)); xb[u] = __builtin_bit_cast(f32x4, __builtin_amdgcn_raw_buffer_load_b128(x2rsrc, vo + 16u, 0, 16)); } }

#pragma unroll
            for (int u = 0; u < 8; ++u) { const int ks = 8 * k8 + u; bf16x8 ah, al;
                if constexpr (X2H) { const u32x4 hw = xh[u]; const unsigned h0 = hw.x, h1 = hw.y, h2 = hw.z, h3 = hw.w; ah = __builtin_bit_cast(bf16x8, hw);
                    const float e0 = bf2f(h0 & 0xffffu), e1 = bf2f(h0 >> 16), e2 = bf2f(h1 & 0xffffu), e3 = bf2f(h1 >> 16), e4 = bf2f(h2 & 0xffffu), e5 = bf2f(h2 >> 16), e6 = bf2f(h3 & 0xffffu), e7 = bf2f(h3 >> 16);
                    ssq += (e0 * e0 + e1 * e1) + (e2 * e2 + e3 * e3) + (e4 * e4 + e5 * e5) + (e6 * e6 + e7 * e7); al = ah; }
                else { const f32x4 v0 = xa[u], v1 = xb[u];
                ssq += (v0[0] * v0[0] + v0[1] * v0[1]) + (v0[2] * v0[2] + v0[3] * v0[3]) + (v1[0] * v1[0] + v1[1] * v1[1]) + (v1[2] * v1[2] + v1[3] * v1[3]);
                float xv[8] = {v0[0], v0[1], v0[2], v0[3], v1[0], v1[1], v1[2], v1[3]};
#pragma unroll
                for (int j = 0; j < 8; ++j) { const unsigned h = f2bf(xv[j]); ah[j] = (short)h; al[j] = (short)f2bf(xv[j] - bf2f(h)); } }
                const int ch = 4 * ks + fq;
                const LAS unsigned char* w0 = wl_lds + fr * 2048 + ((ch ^ (fr & 7)) << 4); const LAS unsigned char* w1 = wl_lds + (16 + fr) * 2048 + ((ch ^ (fr & 7)) << 4);
                const bf16x8 bh0 = *(const LAS bf16x8*)w0, bh1 = *(const LAS bf16x8*)w1, bl0 = *(const LAS bf16x8*)(w0 + 65536), bl1 = *(const LAS bf16x8*)(w1 + 65536);
                acc0 = __builtin_amdgcn_mfma_f32_16x16x32_bf16(ah, bh0, acc0, 0, 0, 0); if constexpr (!X2H) acc0 = __builtin_amdgcn_mfma_f32_16x16x32_bf16(al, bh0, acc0, 0, 0, 0); acc0 = __builtin_amdgcn_mfma_f32_16x16x32_bf16(ah, bl0, acc0, 0, 0, 0);
                acc1 = __builtin_amdgcn_mfma_f32_16x16x32_bf16(ah, bh1, acc1, 0, 0, 0); if constexpr (!X2H) acc1 = __builtin_amdgcn_mfma_f32_16x16x32_bf16(al, bh1, acc1, 0, 0, 0); acc1 = __builtin_amdgcn_mfma_f32_16x16x32_bf16(ah, bl1, acc1, 0, 0, 0); } }
        ssq += __shfl_xor(ssq, 16); ssq += __shfl_xor(ssq, 32);
#if defined(DIAG2) && (DIAG2 >= 32 && DIAG2 <= 40)
        { float s2 = 0.f; for (int ks = 0; ks < 32; ++ks) for (int j = 0; j < 8; ++j) { const unsigned w = __hip_atomic_load((const unsigned*)(xr + 32 * ks + j), __ATOMIC_RELAXED, DIAG2 == 32 ? __HIP_MEMORY_SCOPE_SYSTEM : __HIP_MEMORY_SCOPE_AGENT); const float f = __uint_as_float(w); s2 += f * f; }
          s2 += __shfl_xor(s2, 16); s2 += __shfl_xor(s2, 32);
          const float rel = fabsf(s2 - ssq) / (fabsf(ssq) + 1e-20f);
          if (F.lane < 16 && !(rel < 1e-3f)) { unsigned* nb_ = (unsigned*)(WS(a) + WS_CTL) + 16384; atomicAdd(nb_ + 64 * 3, 1u); const int t_ = t0 + F.lane;
              if (a.pass == 1) { if (ssq == 0.f) atomicAdd(nb_ + 64 * 11, 1u); else if (s2 == 0.f) atomicAdd(nb_ + 64 * 12, 1u); else atomicAdd(nb_ + 64 * 13, 1u); }
              atomicOr(nb_ + 64 * 4, 1u << (t_ & 15)); atomicOr(nb_ + 64 * 5, 1u << ((t_ >> 4) & 7)); atomicOr(nb_ + 64 * 6, 1u << ((t_ >> 7) & 31)); atomicOr(nb_ + 64 * 7, 1u << ((t_ >> 12) & 7)); } }
#endif
        const float rstd = 1.0f / sqrtf(ssq * (1.0f / D) + RMS_EPS);
#pragma unroll
        for (int r = 0; r < 4; ++r) { scr[(4 * fq + r) * 36 + fr] = acc0[r]; scr[(4 * fq + r) * 36 + 16 + fr] = acc1[r]; }
        LDS_WAIT(); asm volatile("" ::: "memory");
        if (F.lane < 16) {
            float v[32];
#pragma unroll
            for (int e = 0; e < 32; ++e) v[e] = scr[F.lane * 36 + e] * rstd + brt[e];
#if defined(DIAG2) && (DIAG2 == 29 || DIAG2 == 30 || DIAG2 == 31)
            { unsigned* dbgB = (unsigned*)(WS(a) + WS_CTL + 704 * 1024); unsigned* nb = (unsigned*)(WS(a) + WS_CTL) + 16384; unsigned sm = 0u;
              for (int e = 0; e < 32; ++e) sm = sm * 31u + __float_as_uint(v[e]);
              const int t_ = t0 + F.lane; if (a.pass == 0) dbgB[t_] = sm; else if (dbgB[t_] != sm) atomicAdd(nb + 64 * 2, 1u);
              unsigned s2 = __float_as_uint(rstd); unsigned* dbgC = dbgB + 32768; if (a.pass == 0) dbgC[t_] = s2; else if (dbgC[t_] != s2) atomicAdd(nb + 64 * 3, 1u); }
#endif
            float tv[4]; int ti[4];
#pragma unroll
            for (int k = 0; k < 4; ++k) { float best = v[0]; int bi = 0;
#pragma unroll
                for (int e = 1; e < 32; ++e) if (v[e] > best) { best = v[e]; bi = e; }
                tv[k] = best; ti[k] = bi;
#pragma unroll
                for (int e = 0; e < 32; ++e) v[e] = (e == bi) ? -3.0e38f : v[e]; }
            float ex[4], sum = 0.f;
#pragma unroll
            for (int k = 0; k < 4; ++k) { ex[k] = __expf(tv[k] - tv[0]); sum += ex[k]; }
            const float inv = 1.0f / sum;
#pragma unroll
            for (int k = 0; k < 4; ++k) { const int lp = atomicAdd((int*)(lcnt + ti[k]), 1); const int ri = (F.wave * 16 + F.lane) * 4 + k;
                rec_e[ri] = ti[k]; rec_p[ri] = lp; rec_w[ri] = ex[k] * inv; }
            rec_rs[F.wave * 16 + F.lane] = rstd;
        }
        __syncthreads();
        const int half = (grp * 128) / HALF_T;
        if (F.tid < 32) gbase[F.tid] = (int)atomicAdd(gcnt + half * 32 + F.tid, (unsigned)lcnt[F.tid]);
        __syncthreads();
        { const int e = rec_e[F.tid], pos = gbase[e] + rec_p[F.tid], t = grp * 128 + (F.tid >> 2); const float w = rec_w[F.tid], rs = rec_rs[F.tid >> 2];
            float* gr = (float*)(grec + (size_t)t * 4 + (F.tid & 3)); ((int*)gr)[0] = e; ((int*)gr)[1] = pos; gr[2] = w; gr[3] = 0.f;
            const size_t li = ((size_t)half * NE + e) * LIST_CAP + pos; ltok[li] = t; lrs[li] = rs; }
        __syncthreads();
    }
}
__device__ __forceinline__ int moe_tables(const Frame& F, ArgsRef a, int half) {
    LAS int* tend = (LAS int*)(F.misc + LM_TEND); LAS int* cnt = (LAS int*)(F.misc + LM_CNT); LAS int* pstart = (LAS int*)(F.misc + LM_PSTART);
    const unsigned* gcnt = (const unsigned*)(WS(a) + WS_CTL) + CW_CNT + half * 32;
    __syncthreads();
    if (F.tid < 32) cnt[F.tid] = (int)__hip_atomic_load(gcnt + F.tid, __ATOMIC_RELAXED, __HIP_MEMORY_SCOPE_AGENT);
    __syncthreads();
    if (F.tid == 0) { int acc = 0; for (int e = 0; e < NE; ++e) { pstart[e] = acc * 256; acc += (cnt[e] + 255) >> 8; tend[e] = acc; } }
    __syncthreads();
    { LAS int* tile_e = (LAS int*)(F.misc + LM_TILE); for (int ti = F.tid; ti < 576; ti += 512) { int e = 0; while (e < NE - 1 && ti >= tend[e]) ++e; const int t0 = e ? tend[e - 1] : 0; tile_e[ti] = (e << 16) | (ti - t0); } }
    __syncthreads();
    return __builtin_amdgcn_readfirstlane(tend[NE - 1]);
}
__device__ __forceinline__ void combine_phase(const Frame& F, ArgsRef a, int half) {
    const LAS int* pstart = (const LAS int*)(F.misc + LM_PSTART);
    const u32x4* grec = (const u32x4*)(WS(a) + WS_REC); const bf16_t* y = (const bf16_t*)(WS(a) + WS_Y); const float* gfin = IN(a, I_NORM_FINAL_G);
    const int gw = F.bid * 8 + F.wave, NGW = F.G * 8;
    for (int tb2 = half * HALF_T + gw * 2; tb2 < (half + 1) * HALF_T; tb2 += NGW * 2) {
        int slot[2][4]; float rw[2][4];
#pragma unroll
        for (int u = 0; u < 2; ++u)
#pragma unroll
            for (int k = 0; k < 4; ++k) { const int* ri = (const int*)(grec + (size_t)(tb2 + u) * 4 + k); const int re = ri[0], rp = ri[1]; rw[u][k] = ((const float*)ri)[2]; slot[u][k] = pstart[re] + rp; }
        f32x4 v[2][4]; u32x2 yv[2][4][4];
#pragma unroll
        for (int u = 0; u < 2; ++u) {
            if constexpr (X2H) { const u32x2* xh = (const u32x2*)((const bf16_t*)(WS(a) + WS_X2H) + (size_t)(tb2 + u) * D) + F.lane;
#pragma unroll
                for (int j = 0; j < 4; ++j) { const u32x2 hw = xh[64 * j]; const unsigned h0 = hw.x, h1 = hw.y; v[u][j] = (f32x4){bf2f(h0 & 0xffffu), bf2f(h0 >> 16), bf2f(h1 & 0xffffu), bf2f(h1 >> 16)}; } }
            else { const f32x4* xr = (const f32x4*)(OUT(a) + (size_t)(tb2 + u) * D) + F.lane;
#pragma unroll
            for (int j = 0; j < 4; ++j) v[u][j] = xr[64 * j]; }
#pragma unroll
            for (int k = 0; k < 4; ++k) {
                if constexpr (Y_FP8) { const unsigned* yr = (const unsigned*)((const unsigned char*)y + (size_t)slot[u][k] * D) + F.lane;
#pragma unroll
                    for (int j = 0; j < 4; ++j) { yv[u][k][j].x = yr[64 * j]; yv[u][k][j].y = 0u; } }
                else { const u32x2* yr = (const u32x2*)(y + (size_t)slot[u][k] * D) + F.lane;
#pragma unroll
                    for (int j = 0; j < 4; ++j) yv[u][k][j] = yr[64 * j]; } } }
#pragma unroll
        for (int u = 0; u < 2; ++u) {
#pragma unroll
            for (int k = 0; k < 4; ++k) { const float w = rw[u][k];
#pragma unroll
                for (int j = 0; j < 4; ++j) { const u32x2 p = yv[u][k][j];
                    if constexpr (Y_FP8) { const unsigned pw = p.x; const f32x2 lo = __builtin_amdgcn_cvt_pk_f32_fp8(pw, false), hi = __builtin_amdgcn_cvt_pk_f32_fp8(pw, true);
                        v[u][j][0] += w * lo[0]; v[u][j][1] += w * lo[1]; v[u][j][2] += w * hi[0]; v[u][j][3] += w * hi[1]; }
                    else { v[u][j][0] += w * bf2f(p.x & 0xffffu); v[u][j][1] += w * bf2f(p.x >> 16); v[u][j][2] += w * bf2f(p.y & 0xffffu); v[u][j][3] += w * bf2f(p.y >> 16); } } }
            float ss = 0.f;
#pragma unroll
            for (int j = 0; j < 4; ++j) ss += (v[u][j][0] * v[u][j][0] + v[u][j][1] * v[u][j][1]) + (v[u][j][2] * v[u][j][2] + v[u][j][3] * v[u][j][3]);
            const float rstd = 1.0f / sqrtf(wave_sum(ss) * (1.0f / D) + RMS_EPS); f32x4* xo = (f32x4*)(OUT(a) + (size_t)(tb2 + u) * D) + F.lane;
#pragma unroll
            for (int j = 0; j < 4; ++j) { const f32x4 g = ((const f32x4*)gfin)[F.lane + 64 * j]; xo[64 * j] = v[u][j] * rstd * g; } }
    }
}

#ifndef V1TEST
#define V1TEST 0
#endif
#ifndef RT_VAR
#define RT_VAR 0
#endif
constexpr int D_IN = 8648;
__device__ __forceinline__ int win_src_col(int n) {
    if (n < 1024) return 456 + n;
    if (n < 1280) return n - 1024;
    if (n < 1480) return 256 + (n - 1280);
    if (n < 1536) return -1;
    if (n < 2560) return 1480 + (n - 1536);
    if (n < 4608) return 2504 + (n - 2560);
    return 4552 + (n - 4608);
}
template <int PM = 63> __device__ __forceinline__ void mixer_prep_phase(const Frame& F, ArgsRef a) {
    const int gw = F.bid * 8 + F.wave, NGW = F.G * 8, gt = F.bid * 512 + F.tid, NGT = F.G * 512;
    unsigned char* ws = WS(a);
    if (PM & 1) { bf16_t* xb = (bf16_t*)(ws + WS_XB); float* rstd1 = (float*)(ws + WS_MISC + MISC_RSTD1);
      for (int t4 = gw * 4; t4 < T; t4 += NGW * 4) { f32x4 v[4][4];
#pragma unroll
          for (int u = 0; u < 4; ++u) { const f32x4* xr = (const f32x4*)(IN(a, I_X) + (size_t)(t4 + u) * D) + F.lane;
#pragma unroll
              for (int j = 0; j < 4; ++j) v[u][j] = xr[64 * j]; }
#pragma unroll
          for (int u = 0; u < 4; ++u) { u32x2* ob = (u32x2*)(xb + (size_t)(t4 + u) * D) + F.lane; unsigned* o8 = (unsigned*)(ws + WS_XB8 + (size_t)(t4 + u) * D) + F.lane; float ss = 0.f;
#pragma unroll
              for (int j = 0; j < 4; ++j) { const f32x4 x = v[u][j]; ss += (x[0] * x[0] + x[1] * x[1]) + (x[2] * x[2] + x[3] * x[3]); u32x2 w; w.x = pk2(x[0], x[1]); w.y = pk2(x[2], x[3]); ob[64 * j] = w;
                  if constexpr (INC_FP8) o8[64 * j] = pk4_fp8(x[0], x[1], x[2], x[3]); }
              ss = wave_sum(ss); if (F.lane == 0) rstd1[t4 + u] = 1.0f / sqrtf(ss * (1.0f / D) + RMS_EPS); } } }
    if (PM & 2) { LAS float* scr = (LAS float*)(F.wave < 7 ? F.lds + LDS_STAGE + F.wave * 16640 : F.misc + 4096); const float* g = IN(a, I_NORM_MIX_G);
      constexpr int I_WIN = 16 * (NIN / 64), I_WB = 32 * 16, I_WO = 16 * 16;
      for (int it = gw; it < I_WIN + I_WB + I_WO; it += NGW) {
          if (it < I_WIN) { const int kb = it / (NIN / 64), nb = it % (NIN / 64);
              if (INC_FP8 && nb >= 72) transpose_item64<true>(IN(a, I_W_IN), D_IN, D, (bf16_t*)(ws + WS_WIN8), 64 * (nb - 72), g, scr, 64 * kb, win_src_col(64 * nb + F.lane), F.lane);
              else if (INB_FP8 && nb >= 40) transpose_item64<true>(IN(a, I_W_IN), D_IN, D, (bf16_t*)(ws + WS_WIN8 + 4 * MiB), 64 * (nb - 40), g, scr, 64 * kb, win_src_col(64 * nb + F.lane), F.lane);
              else transpose_item64(IN(a, I_W_IN), D_IN, D, (bf16_t*)(ws + WS_WIN), 64 * nb, g, scr, 64 * kb, win_src_col(64 * nb + F.lane), F.lane); }
          else if (it < I_WIN + I_WB) { const int r = it - I_WIN, kb = r / 16, nb = r % 16; transpose_item64(IN(a, I_W_BB), D, 2048, (bf16_t*)(ws + WS_WB), 64 * nb, nullptr, scr, 64 * kb, 64 * nb + F.lane, F.lane); }
          else { const int r = it - I_WIN - I_WB, kb = r / 16, nb = r % 16; transpose_item64(IN(a, I_W_OUT), D, D, (bf16_t*)(ws + WS_WOUT), 64 * nb, nullptr, scr, 64 * kb, 64 * nb + F.lane, F.lane); } } }
    if (PM & 4) { bf16_t* wq = (bf16_t*)(ws + WS_WQ); const float* wuq = IN(a, I_W_UQ); const float* wuk = IN(a, I_W_UK); const float* wqi = IN(a, I_W_QIDX); const float* cg = IN(a, I_CQ_G);
      for (int i = gt; i < 1536 * 32; i += NGT) { const int kk = i / 1536, n = i - kk * 1536;
          float v[8];
          if (n < 1024) { const int h = n >> 7; const float* q = wuk + (size_t)n * 128; const float* p = wuq + (size_t)(8 * kk) * 1024 + h * 128;
#pragma unroll
              for (int jj = 0; jj < 8; ++jj) v[jj] = 0.f;
#pragma unroll 2
              for (int d = 0; d < 128; d += 4) { const f32x4 y = *(const f32x4*)(q + d);
#pragma unroll
                  for (int jj = 0; jj < 8; ++jj) { const f32x4 x = *(const f32x4*)(p + jj * 1024 + d); v[jj] += (x[0] * y[0] + x[1] * y[1]) + (x[2] * y[2] + x[3] * y[3]); } } }
          else {
#pragma unroll
              for (int jj = 0; jj < 8; ++jj) v[jj] = wqi[(size_t)(8 * kk + jj) * 512 + (n - 1024)] * 0.125f; }
          const f32x4 g0 = *(const f32x4*)(cg + 8 * kk), g1 = *(const f32x4*)(cg + 8 * kk + 4);
          u32x4 w; w.x = pk2(v[0] * g0[0], v[1] * g0[1]); w.y = pk2(v[2] * g0[2], v[3] * g0[3]); w.z = pk2(v[4] * g1[0], v[5] * g1[1]); w.w = pk2(v[6] * g1[2], v[7] * g1[3]);
          *(u32x4*)(wq + (size_t)n * 256 + 8 * kk) = w; } }
    if (PM & 8) { bf16_t* wa = (bf16_t*)(ws + WS_WA); const float* wuv = IN(a, I_W_UV); const float* wba = IN(a, I_W_BA);
      for (int i = gt; i < 1024 * 128; i += NGT) { const int kk = i >> 10, n = i & 1023, h = kk >> 4, rr = kk & 15; const float* q = wba + (size_t)(h * 128) * 1024 + n;
          const float* p[8];
#pragma unroll
          for (int jj = 0; jj < 8; ++jj) p[jj] = wuv + (size_t)(MIXA_FP8 ? h * 128 + 32 * (jj & 3) + 2 * rr + (jj >> 2) : 8 * kk + jj) * 128;
          float v[8];
#pragma unroll
          for (int jj = 0; jj < 8; ++jj) v[jj] = 0.f;
#pragma unroll 2
          for (int d = 0; d < 128; d += 4) { const float y0 = q[(size_t)d * 1024], y1 = q[(size_t)(d + 1) * 1024], y2 = q[(size_t)(d + 2) * 1024], y3 = q[(size_t)(d + 3) * 1024];
#pragma unroll
              for (int jj = 0; jj < 8; ++jj) { const f32x4 x = *(const f32x4*)(p[jj] + d); v[jj] += (x[0] * y0 + x[1] * y1) + (x[2] * y2 + x[3] * y3); } }
          if constexpr (MIXA_FP8) { u32x2 w8; w8.x = pk4_fp8(v[0] * W8_SCALE, v[1] * W8_SCALE, v[2] * W8_SCALE, v[3] * W8_SCALE); w8.y = pk4_fp8(v[4] * W8_SCALE, v[5] * W8_SCALE, v[6] * W8_SCALE, v[7] * W8_SCALE);
              *(u32x2*)((unsigned char*)wa + (size_t)n * 1024 + h * 128 + 8 * rr) = w8; }
          else { u32x4 w; w.x = pk2(v[0], v[1]); w.y = pk2(v[2], v[3]); w.z = pk2(v[4], v[5]); w.w = pk2(v[6], v[7]);
          *(u32x4*)(wa + (size_t)n * 1024 + 8 * kk) = w; } } }
    if (PM & 16) { float* cosP = (float*)(ws + WS_COSP); float* sinP = (float*)(ws + WS_SINP); float* cosT = (float*)(ws + WS_COST); float* sinT = (float*)(ws + WS_SINT);
      LAS double* invr = (LAS double*)(F.misc + LM_SCR);
      __syncthreads();
      if (F.tid < 128) invr[F.tid] = exp(-9.210340371976184 * (double)F.tid / 128.0) * 0.15915494309189535;
      __syncthreads();
      for (int i = gt; i < SEQ * 128; i += NGT) { const int pos = i >> 7, j = i & 127; const double rev = (double)pos * invr[j]; const float fr_ = (float)(rev - floor(rev));
          const float c = __builtin_amdgcn_cosf(fr_), sn = __builtin_amdgcn_sinf(fr_); cosP[i] = c; sinP[i] = sn; cosT[j * SEQ + pos] = c; sinT[j * SEQ + pos] = sn; }
      __syncthreads();
      if (gt < 256) { const int h = gt >> 6, i = gt & 63; const double lg = log(1.0 - exp2(-5.0 - (double)h));
          ((float*)(ws + WS_MISC + MISC_DQ))[gt] = (float)exp(lg * (i + 1)); ((float*)(ws + WS_MISC + MISC_DK))[gt] = (float)(exp(-lg * (i + 1)) * 0.0625); ((float*)(ws + WS_MISC + MISC_DZ))[gt] = (float)(exp(lg * (63 - i)) * 0.0625); } }
    if (PM & 32) router_weight_prep(F, a);
}

struct EpiInA { static constexpr bool PERM = true;
    bf16_t* qx; float* small; const float* rstd1; const float* cosP; const float* sinP; const float* dq;
    bf16_t* cqn; bf16_t* ckv; bf16_t* kidx; float* widx; const float* gkv; const float* gki; LAS float* xch;
    __device__ __forceinline__ void small_fused(const f32x4 (&acc)[2][2][4][2], const pg8::Unit& u, int wr, int wc, int fr, int fq) const {
        const int d0 = 32 * wc + 8 * fq;
#pragma unroll
        for (int ai = 0; ai < 2; ++ai) {
#pragma unroll
            for (int m = 0; m < 4; ++m) { int rl_ = 128 * ai + 64 * wr + 16 * m + fr; asm volatile("" : "+v"(rl_)); float p0 = 0.f, p1 = 0.f; const float rsv_ = rstd1[u.pm * 256 + rl_];
#pragma unroll
                for (int n = 0; n < 2; ++n)
#pragma unroll
                    for (int i = 0; i < 4; ++i) { const float x0 = acc[ai][0][m][n][i] * rsv_, x1 = acc[ai][1][m][n][i] * rsv_; p0 += x0 * x0; p1 += x1 * x1; }
                p0 += __shfl_xor(p0, 16); p0 += __shfl_xor(p0, 32); p1 += __shfl_xor(p1, 16); p1 += __shfl_xor(p1, 32);
                if (fq == 0) { xch[rl_ * 8 + wc] = p0; xch[rl_ * 8 + 4 + wc] = p1; } } }
        asm volatile("s_waitcnt lgkmcnt(0)" ::: "memory"); __builtin_amdgcn_s_barrier(); asm volatile("" ::: "memory");
#pragma unroll
        for (int ai = 0; ai < 2; ++ai)
#pragma unroll
            for (int m = 0; m < 4; ++m) { int rl = 128 * ai + 64 * wr + 16 * m + fr; asm volatile("" : "+v"(rl));        const size_t row = (size_t)u.pm * 256 + rl;
                const f32x4 q0 = *(const LAS f32x4*)(xch + rl * 8), q1 = *(const LAS f32x4*)(xch + rl * 8 + 4); const float rsm = rstd1[row];
                if (u.pn == 4) { const float r = rsm * (1.0f / sqrtf(((q0[0] + q0[1]) + (q0[2] + q0[3]) + (q1[0] + q1[1]) + (q1[2] + q1[3])) * (1.f / 256.f) + RMS_EPS));
#pragma unroll
                    for (int bj = 0; bj < 2; ++bj) { const f32x4 v0 = acc[ai][bj][m][0] * r, v1 = acc[ai][bj][m][1] * r; u32x4 w; w.x = cvt_pk_bf16(v0[0], v0[1]); w.y = cvt_pk_bf16(v0[2], v0[3]); w.z = cvt_pk_bf16(v1[0], v1[1]); w.w = cvt_pk_bf16(v1[2], v1[3]);
                        *(u32x4*)(cqn + row * 256 + 128 * bj + d0) = w; } }
                else { const float* gkv_ = gkv; const float* gki_ = gki; asm volatile("" : "+s"(gkv_), "+s"(gki_));
                    { const float r = rsm * (1.0f / sqrtf(((q0[0] + q0[1]) + (q0[2] + q0[3])) * (1.f / 128.f) + RMS_EPS)); const f32x4 g0 = *(const f32x4*)(gkv_ + d0), g1 = *(const f32x4*)(gkv_ + d0 + 4);
                        const f32x4 v0 = acc[ai][0][m][0] * r * g0, v1 = acc[ai][0][m][1] * r * g1; u32x4 w; w.x = cvt_pk_bf16(v0[0], v0[1]); w.y = cvt_pk_bf16(v0[2], v0[3]); w.z = cvt_pk_bf16(v1[0], v1[1]); w.w = cvt_pk_bf16(v1[2], v1[3]);
                        *(u32x4*)(ckv + row * 128 + d0) = w; }
                    if (wc < 2) { const float r = rsm * (1.0f / sqrtf((q1[0] + q1[1]) * (1.f / 64.f) + RMS_EPS)); const f32x4 g0 = *(const f32x4*)(gki_ + d0), g1 = *(const f32x4*)(gki_ + d0 + 4);
                        const f32x4 v0 = acc[ai][1][m][0] * r * g0, v1 = acc[ai][1][m][1] * r * g1; u32x4 w; w.x = cvt_pk_bf16(v0[0], v0[1]); w.y = cvt_pk_bf16(v0[2], v0[3]); w.z = cvt_pk_bf16(v1[0], v1[1]); w.w = cvt_pk_bf16(v1[2], v1[3]);
                        *(u32x4*)(kidx + row * 64 + d0) = w; }
                    else if (wc == 2 && fq == 0) { const float sc = 0.35355339059327373f * rsm; *(f32x4*)(widx + row * 8) = acc[ai][1][m][0] * sc; *(f32x4*)(widx + row * 8 + 4) = acc[ai][1][m][1] * sc; } } }
    }
    __device__ __forceinline__ void operator()(const f32x4 (&acc)[2][2][4][2], const pg8::Unit& u, int wr, int wc, int fr, int fq) const {
        const int d0 = 32 * wc + 8 * fq;
        if (ROWNORM_FUSED && u.pn >= 4) { small_fused(acc, u, wr, wc, fr, fq); return; }
#pragma unroll
        for (int ai = 0; ai < 2; ++ai) { const int row0 = u.pm * 256 + 128 * ai + 64 * wr + fr;
            float rs[4];
#pragma unroll
            for (int m = 0; m < 4; ++m) rs[m] = rstd1[row0 + 16 * m];
            if (u.pn < 4) { f32x4 c4[4][2], s4[4][2]; float sc[4];
#pragma unroll
                for (int m = 0; m < 4; ++m) { const int pos = (row0 + 16 * m) & (SEQ - 1); sc[m] = dq[u.pn * 64 + (pos & 63)];
#pragma unroll
                    for (int n = 0; n < 2; ++n) { c4[m][n] = *(const f32x4*)(cosP + pos * 128 + d0 + 4 * n); s4[m][n] = *(const f32x4*)(sinP + pos * 128 + d0 + 4 * n); } }
#pragma unroll
                for (int m = 0; m < 4; ++m) { const float scm = sc[m] * rs[m]; float o1[8], o2[8];
#pragma unroll
                    for (int n = 0; n < 2; ++n)
#pragma unroll
                        for (int i = 0; i < 4; ++i) { const float v1 = acc[ai][0][m][n][i], v2 = acc[ai][1][m][n][i]; o1[4 * n + i] = (v1 * c4[m][n][i] - v2 * s4[m][n][i]) * scm; o2[4 * n + i] = (v2 * c4[m][n][i] + v1 * s4[m][n][i]) * scm; }
                    u32x4 w1, w2; w1.x = cvt_pk_bf16(o1[0], o1[1]); w1.y = cvt_pk_bf16(o1[2], o1[3]); w1.z = cvt_pk_bf16(o1[4], o1[5]); w1.w = cvt_pk_bf16(o1[6], o1[7]);
                    w2.x = cvt_pk_bf16(o2[0], o2[1]); w2.y = cvt_pk_bf16(o2[2], o2[3]); w2.z = cvt_pk_bf16(o2[4], o2[5]); w2.w = cvt_pk_bf16(o2[6], o2[7]);
                    bf16_t* p = qx + (size_t)(row0 + 16 * m) * 1024 + u.pn * 256 + d0; *(u32x4*)p = w1; *(u32x4*)(p + 128) = w2; }
            } else {
#pragma unroll
                for (int m = 0; m < 4; ++m) { float* p = small + (size_t)(row0 + 16 * m) * 512 + (u.pn - 4) * 256 + d0;
#pragma unroll
                    for (int bj = 0; bj < 2; ++bj)
#pragma unroll
                        for (int n = 0; n < 2; ++n) *(f32x4*)(p + 128 * bj + 4 * n) = acc[ai][bj][m][n] * rs[m]; } } }
    }
};
template <int PN0 = 0, bool F8 = false> struct EpiInB { static constexpr bool PERM = false;
    bf16_t* kzt; bf16_t* vt; const float* rstd1; const float* cosT; const float* sinT; const float* dz;
    __device__ __forceinline__ void operator()(const f32x4 (&acc)[2][2][4][2], const pg8::Unit& u, int wr, int wc, int fr, int fq) const {
#pragma unroll
        for (int ai = 0; ai < 2; ++ai) { const int tokb = u.pm * 256 + 128 * ai + 64 * wr + 16 * fq, b = tokb >> 11, posb = tokb & (SEQ - 1);
            f32x4 rs4[4];
#pragma unroll
            for (int m = 0; m < 4; ++m) rs4[m] = *(const f32x4*)(rstd1 + tokb + 4 * m);
            const int pn = u.pn + PN0;
            if (pn < 4) { const int h = pn;
#pragma unroll
              for (int mg = 0; mg < 2; ++mg) { f32x4 kz4[2], c4[2][2], s4[2][2];
#pragma unroll
                for (int mm = 0; mm < 2; ++mm) { const int m = 2 * mg + mm; kz4[mm] = *(const f32x4*)(dz + h * 64 + ((posb + 4 * m) & 63));
#pragma unroll
                    for (int n = 0; n < 2; ++n) { const int d = 32 * wc + 16 * n + fr; c4[mm][n] = *(const f32x4*)(cosT + d * SEQ + posb + 4 * m); s4[mm][n] = *(const f32x4*)(sinT + d * SEQ + posb + 4 * m); } }
#pragma unroll
                for (int n = 0; n < 2; ++n) { const int d = 32 * wc + 16 * n + fr; float o1[8], o2[8];
#pragma unroll
                    for (int mm = 0; mm < 2; ++mm) { const int m = 2 * mg + mm;
#pragma unroll
                        for (int i = 0; i < 4; ++i) { const float v1 = acc[ai][0][m][n][i] * rs4[m][i], v2 = acc[ai][1][m][n][i] * rs4[m][i]; o1[4 * mm + i] = (v1 * c4[mm][n][i] - v2 * s4[mm][n][i]) * kz4[mm][i]; o2[4 * mm + i] = (v2 * c4[mm][n][i] + v1 * s4[mm][n][i]) * kz4[mm][i]; } }
                    u32x4 z1, z2; z1.x = cvt_pk_bf16(o1[0], o1[1]); z1.y = cvt_pk_bf16(o1[2], o1[3]); z1.z = cvt_pk_bf16(o1[4], o1[5]); z1.w = cvt_pk_bf16(o1[6], o1[7]);
                    z2.x = cvt_pk_bf16(o2[0], o2[1]); z2.y = cvt_pk_bf16(o2[2], o2[3]); z2.z = cvt_pk_bf16(o2[4], o2[5]); z2.w = cvt_pk_bf16(o2[6], o2[7]);
                    bf16_t* q = kzt + ((size_t)((b * 4 + h) * 256 + d)) * SEQ + posb + 8 * mg; *(u32x4*)q = z1; *(u32x4*)(q + (size_t)128 * SEQ) = z2; } }
            } else { const int j = pn - 4, hd = j >> 1;
#pragma unroll
                for (int bj = 0; bj < 2; ++bj)
#pragma unroll
                    for (int n = 0; n < 2; ++n) { const int v = (j & 1) * 256 + 128 * bj + 32 * wc + 16 * n + fr; bf16_t* q = vt + ((size_t)((b * 4 + hd) * 512 + v)) * SEQ + posb;
#pragma unroll
                        for (int mg = 0; mg < 2; ++mg) { const f32x4 x0 = acc[ai][bj][2 * mg][n] * rs4[2 * mg] * (F8 ? W8_INV : 1.f), x1 = acc[ai][bj][2 * mg + 1][n] * rs4[2 * mg + 1] * (F8 ? W8_INV : 1.f);
                            u32x4 z; z.x = cvt_pk_bf16(x0[0], x0[1]); z.y = cvt_pk_bf16(x0[2], x0[3]); z.z = cvt_pk_bf16(x1[0], x1[1]); z.w = cvt_pk_bf16(x1[2], x1[3]); *(u32x4*)(q + 8 * mg) = z; } } } }
    }
};
struct EpiInC { static constexpr bool PERM = true;
    bf16_t* oret; bf16_t* ga; bf16_t* gb; const float* rstd1; const float* rn;
    __device__ __forceinline__ void operator()(const f32x4 (&acc)[2][2][4][2], const pg8::Unit& u, int wr, int wc, int fr, int fq) const {
        const int c0 = 32 * wc + 8 * fq;
#pragma unroll
        for (int ai = 0; ai < 2; ++ai) { const int row0 = u.pm * 256 + 128 * ai + 64 * wr + fr;
            float rs[4], rr[4]; unsigned ow[4][2][4];
#pragma unroll
            for (int m = 0; m < 4; ++m) { rs[m] = rstd1[row0 + 16 * m] * (INC_FP8 ? W8_INV : 1.f); rr[m] = 1.f; }
            if (u.pn < 8) {
#pragma unroll
                for (int m = 0; m < 4; ++m) { rr[m] = rn[(row0 + 16 * m) * 4 + (u.pn >> 1)];
#pragma unroll
                    for (int bj = 0; bj < 2; ++bj) ld4u(oret + (size_t)(row0 + 16 * m) * 2048 + u.pn * 256 + 128 * bj + c0, ow[m][bj]); } }
#pragma unroll
            for (int m = 0; m < 4; ++m)
#pragma unroll
                for (int bj = 0; bj < 2; ++bj) { float v[8];
#pragma unroll
                    for (int n = 0; n < 2; ++n)
#pragma unroll
                        for (int i = 0; i < 4; ++i) { const float x = acc[ai][bj][m][n][i] * rs[m]; v[4 * n + i] = __builtin_amdgcn_rcpf(1.f + __builtin_amdgcn_exp2f(-1.4426950408889634f * x)) * (u.pn < 8 ? x : 1.f); }
                    bf16_t* p;
                    if (u.pn < 8) { p = oret + (size_t)(row0 + 16 * m) * 2048 + u.pn * 256 + 128 * bj + c0;
#pragma unroll
                        for (int q = 0; q < 4; ++q) { v[2 * q] *= bf2f(ow[m][bj][q] & 0xffffu) * rr[m]; v[2 * q + 1] *= bf2f(ow[m][bj][q] >> 16) * rr[m]; } }
                    else if (u.pn < 12) { p = ga + (size_t)(row0 + 16 * m) * 1024 + (u.pn - 8) * 256 + 128 * bj + c0;
                        if constexpr (GA8) { u32x2 w8; w8.x = pk4_fp8(v[0], v[1], v[2], v[3]); w8.y = pk4_fp8(v[4], v[5], v[6], v[7]); *(u32x2*)((unsigned char*)ga + (size_t)(row0 + 16 * m) * 1024 + (u.pn - 8) * 256 + 128 * bj + c0) = w8; continue; } }
                    else p = gb + (size_t)(row0 + 16 * m) * 1024 + (u.pn - 12) * 256 + 128 * bj + c0;
                    u32x4 w; w.x = cvt_pk_bf16(v[0], v[1]); w.y = cvt_pk_bf16(v[2], v[3]); w.z = cvt_pk_bf16(v[4], v[5]); w.w = cvt_pk_bf16(v[6], v[7]); *(u32x4*)p = w; } }
    }
};
template <int MODE, bool F8S = false> struct EpiMix { static constexpr bool PERM = true;
    const bf16_t* gate; bf16_t* mixa; bf16_t* mix;
    static constexpr bool G8 = GA8 && MODE == 0, M8 = GA8;
    __device__ static __forceinline__ void ld8(const void* base, size_t eoff, bool f8, unsigned (&w)[4]) { if (f8) { const u32x2 t = *(const u32x2*)((const unsigned char*)base + eoff); w[0] = t.x; w[1] = t.y; w[2] = 0u; w[3] = 0u; } else ld4u((const bf16_t*)base + eoff, w); }
    __device__ static __forceinline__ void un8(const unsigned (&w)[4], bool f8, float (&f)[8]) {
        if (f8) { const f32x2 a0 = __builtin_amdgcn_cvt_pk_f32_fp8(w[0], false), a1 = __builtin_amdgcn_cvt_pk_f32_fp8(w[0], true), a2 = __builtin_amdgcn_cvt_pk_f32_fp8(w[1], false), a3 = __builtin_amdgcn_cvt_pk_f32_fp8(w[1], true);
            f[0] = a0[0]; f[1] = a0[1]; f[2] = a1[0]; f[3] = a1[1]; f[4] = a2[0]; f[5] = a2[1]; f[6] = a3[0]; f[7] = a3[1]; }
        else {
#pragma unroll
            for (int q = 0; q < 4; ++q) { f[2 * q] = bf2f(w[q] & 0xffffu); f[2 * q + 1] = bf2f(w[q] >> 16); } } }
    __device__ __forceinline__ void operator()(const f32x4 (&acc)[2][2][4][2], const pg8::Unit& u, int wr, int wc, int fr, int fq) const {
#pragma unroll
        for (int ai = 0; ai < 2; ++ai) { const size_t off0 = (size_t)(u.pm * 256 + 128 * ai + 64 * wr + fr) * 1024 + u.pn * 256 + 32 * wc + 8 * fq;
            unsigned gw[4][2][4], mw[4][2][4];
#pragma unroll
            for (int m = 0; m < 4; ++m)
#pragma unroll
                for (int bj = 0; bj < 2; ++bj) { ld8(gate, off0 + (size_t)m * 16 * 1024 + 128 * bj, G8, gw[m][bj]); if (MODE == 1) ld8(mixa, off0 + (size_t)m * 16 * 1024 + 128 * bj, M8, mw[m][bj]); }
#pragma unroll
            for (int m = 0; m < 4; ++m)
#pragma unroll
                for (int bj = 0; bj < 2; ++bj) { float v[8], g[8]; un8(gw[m][bj], G8, g);
#pragma unroll
                    for (int q = 0; q < 8; ++q) v[q] = g[q] * acc[ai][bj][m][q >> 2][q & 3] * (F8S ? W8_INV * 0.25f : 1.f);
                    if (MODE == 1) { float mm[8]; un8(mw[m][bj], M8, mm);
#pragma unroll
                        for (int q = 0; q < 8; ++q) v[q] += mm[q]; }
                    const size_t off = off0 + (size_t)m * 16 * 1024 + 128 * bj;
                    if (MODE == 0 && M8) { u32x2 w8; w8.x = pk4_fp8(v[0], v[1], v[2], v[3]); w8.y = pk4_fp8(v[4], v[5], v[6], v[7]); *(u32x2*)((unsigned char*)mixa + off) = w8; }
                    else { u32x4 w; w.x = cvt_pk_bf16(v[0], v[1]); w.y = cvt_pk_bf16(v[2], v[3]); w.z = cvt_pk_bf16(v[4], v[5]); w.w = cvt_pk_bf16(v[6], v[7]);
                        *(u32x4*)((MODE == 0 ? mixa : mix) + off) = w; } } }
    }
};
struct EpiOut { static constexpr bool PERM = true;
    const bf16_t* x; float* out; bf16_t* x2b;
    __device__ __forceinline__ void operator()(const f32x4 (&acc)[2][2][4][2], const pg8::Unit& u, int wr, int wc, int fr, int fq) const {
#pragma unroll
        for (int ai = 0; ai < 2; ++ai) { const size_t off0 = (size_t)(u.pm * 256 + 128 * ai + 64 * wr + fr) * 1024 + u.pn * 256 + 32 * wc + 8 * fq;
            f32x4 xv[4][2][2];
#pragma unroll
            for (int m = 0; m < 4; ++m)
#pragma unroll
                for (int bj = 0; bj < 2; ++bj) { unsigned xw[4]; ld4u(x + off0 + (size_t)m * 16 * 1024 + 128 * bj, xw);
                    xv[m][bj][0] = (f32x4){bf2f(xw[0] & 0xffffu), bf2f(xw[0] >> 16), bf2f(xw[1] & 0xffffu), bf2f(xw[1] >> 16)}; xv[m][bj][1] = (f32x4){bf2f(xw[2] & 0xffffu), bf2f(xw[2] >> 16), bf2f(xw[3] & 0xffffu), bf2f(xw[3] >> 16)}; }
#pragma unroll
            for (int m = 0; m < 4; ++m)
#pragma unroll
                for (int bj = 0; bj < 2; ++bj) { const size_t off = off0 + (size_t)m * 16 * 1024 + 128 * bj; const f32x4 r0 = xv[m][bj][0] + acc[ai][bj][m][0], r1 = xv[m][bj][1] + acc[ai][bj][m][1];
                    if constexpr (X2H) { u32x4 wh; wh.x = cvt_pk_bf16(r0[0], r0[1]); wh.y = cvt_pk_bf16(r0[2], r0[3]); wh.z = cvt_pk_bf16(r1[0], r1[1]); wh.w = cvt_pk_bf16(r1[2], r1[3]); *(u32x4*)((bf16_t*)out + off) = wh; }
                    else { *(f32x4*)(out + off) = r0; *(f32x4*)(out + off + 4) = r1; }
                    if constexpr (MOE_FP8) { u32x2 w8; w8.x = pk4_fp8(r0[0], r0[1], r0[2], r0[3]); w8.y = pk4_fp8(r1[0], r1[1], r1[2], r1[3]); *(u32x2*)((unsigned char*)x2b + off) = w8; }
                    else { u32x4 w; w.x = cvt_pk_bf16(r0[0], r0[1]); w.y = cvt_pk_bf16(r0[2], r0[3]); w.z = cvt_pk_bf16(r1[0], r1[1]); w.w = cvt_pk_bf16(r1[2], r1[3]); *(u32x4*)(x2b + off) = w; } } }
    }
};

constexpr int RT_QX = 0, RT_KP = 33280, RT_KZT = 66560, RT_VT = 103424, RT_S = 121856, RT_PART = RT_KP, RT_QS = 520, RT_TS = 144;
__device__ __forceinline__ int crow32(int reg, int hh) { return (reg & 3) + 8 * (reg >> 2) + 4 * hh; }
__device__ __forceinline__ bf16x8 lds_frag2x8(const LAS unsigned char* p) { const s16x4 lo = *(const LAS s16x4*)p, hi = *(const LAS s16x4*)(p + 16); return __builtin_shufflevector(lo, hi, 0, 1, 2, 3, 4, 5, 6, 7); }
__device__ __forceinline__ bf16x8 lds_frag8x2(const LAS unsigned char* p) { const s16x4 lo = *(const LAS s16x4*)p, hi = *(const LAS s16x4*)(p + 8); return __builtin_shufflevector(lo, hi, 0, 1, 2, 3, 4, 5, 6, 7); }
template <int OFF> __device__ __forceinline__ s16x4 lds_tr_read(int vb) { s16x4 r; asm volatile("ds_read_b64_tr_b16 %0, %1 offset:%2" : "=&v"(r) : "v"(vb), "i"(OFF) : "memory"); return r; }
__device__ __forceinline__ bf16x8 lds_frag16(const LAS unsigned char* p) { return *(const LAS bf16x8*)p; }
__device__ __forceinline__ bf16x8 pack8(const f32x16& x, int s8) { u32x4 p; p.x = cvt_pk_bf16(x[s8 + 0], x[s8 + 1]); p.y = cvt_pk_bf16(x[s8 + 2], x[s8 + 3]); p.z = cvt_pk_bf16(x[s8 + 4], x[s8 + 5]); p.w = cvt_pk_bf16(x[s8 + 6], x[s8 + 7]); return __builtin_bit_cast(bf16x8, p); }
#define MFMA32(a, b, c) __builtin_amdgcn_mfma_f32_32x32x16_bf16((a), (b), (c), 0, 0, 0)
__device__ __forceinline__ void retention_phase(const Frame& F, ArgsRef a) {
    const bf16_t* QX = (const bf16_t*)(WS(a) + WS_QX); const bf16_t* KZT = (const bf16_t*)(WS(a) + WS_KZT); const bf16_t* VT = (const bf16_t*)(WS(a) + WS_VT);
    bf16_t* ORET = (bf16_t*)OUT(a);
    LAS unsigned char* L = F.lds + LDS_STAGE;
    const int tid = F.tid, lane = F.lane, w = F.wave, wd = w >> 2, wv = w & 3, r = lane & 31, hh = lane >> 5;
    for (int item = F.bid; item < 256; item += F.G) {
        const int xcd = item & 7, index = item >> 3, q = (index >> 2) * 8 + xcd, vs = index & 3, b = q >> 2, h = q & 3, tb = b * SEQ;
        const float g64 = (float)exp(64.0 * log(1.0 - exp2(-5.0 - (double)h))), g64inv = (float)exp(-64.0 * log(1.0 - exp2(-5.0 - (double)h)));
        f32x16 Racc[4];
#pragma unroll
        for (int i = 0; i < 4; ++i) { for (int j = 0; j < 16; ++j) Racc[i][j] = 0.f; }
        f32x4 pq[4], pz[4], pv[2];
        unsigned gq = (unsigned)(((tb + (tid >> 5)) * 1024 + h * 256 + (tid & 31) * 8) * 2), gz = (unsigned)((((b * 4 + h) * 256 + (tid >> 3)) * SEQ + (tid & 7) * 8) * 2), gv = (unsigned)((((b * 4 + h) * 512 + vs * 128 + (tid >> 3)) * SEQ + (tid & 7) * 8) * 2);
        unsigned lq = (unsigned)(uintptr_t)(L + RT_QX + (tid >> 5) * RT_QS + (tid & 31) * 16), lz = (unsigned)(uintptr_t)(L + RT_KZT + (tid >> 3) * RT_TS + (tid & 7) * 16), lv = (unsigned)(uintptr_t)(L + RT_VT + (tid >> 3) * RT_TS + (tid & 7) * 16);
#define RT_LOADG(c) do { unsigned _q = gq + (unsigned)(c) * (64u * 1024u * 2u), _z = gz + (unsigned)(c) * 128u, _v = gv + (unsigned)(c) * 128u; asm volatile("" : "+v"(_q), "+v"(_z), "+v"(_v)); \
        _Pragma("unroll") for (int i = 0; i < 4; ++i) { pq[i] = *(const f32x4*)((const char*)QX + _q + i * (16 * 1024 * 2)); pz[i] = *(const f32x4*)((const char*)KZT + _z + i * (64 * SEQ * 2)); } \
        _Pragma("unroll") for (int i = 0; i < 2; ++i) pv[i] = *(const f32x4*)((const char*)VT + _v + i * (64 * SEQ * 2)); } while (0)
#define RT_STOREL() do { unsigned _q = lq, _z = lz, _v = lv; asm volatile("" : "+v"(_q), "+v"(_z), "+v"(_v)); \
        _Pragma("unroll") for (int i = 0; i < 4; ++i) { LAS unsigned char* dq_ = (LAS unsigned char*)(uintptr_t)_q + i * (16 * RT_QS); \
            *(LAS f32x2*)(dq_) = (f32x2){pq[i][0], pq[i][1]}; *(LAS f32x2*)(dq_ + 8) = (f32x2){pq[i][2], pq[i][3]}; \
            *(LAS f32x4*)((LAS unsigned char*)(uintptr_t)_z + i * (64 * RT_TS)) = pz[i]; } \
        _Pragma("unroll") for (int i = 0; i < 2; ++i) *(LAS f32x4*)((LAS unsigned char*)(uintptr_t)_v + i * (64 * RT_TS)) = pv[i]; } while (0)
        __syncthreads();
        RT_LOADG(0); RT_STOREL(); __syncthreads();
        const int ti = wv >> 1, tj = wv & 1;
        unsigned bQa = (unsigned)(uintptr_t)(L + RT_QX + (32 * ti + r) * RT_QS + 16 * hh), bKb = (unsigned)(uintptr_t)(L + RT_KZT + (8 * hh + ((lane & 15) >> 2)) * RT_TS + (32 * tj + 16 * ((lane >> 4) & 1) + 4 * (lane & 3)) * 2);
        unsigned bSw = (unsigned)(uintptr_t)(L + RT_S + (32 * ti + 4 * hh) * RT_TS + (32 * tj + r) * 2), bQr = (unsigned)(uintptr_t)(L + RT_QX + r * RT_QS + (128 * wd + 4 * hh) * 2);
        unsigned bV = (unsigned)(uintptr_t)(L + RT_VT + (32 * wv + r) * RT_TS + 16 * hh), bSr = (unsigned)(uintptr_t)(L + RT_S + r * RT_TS + 16 * hh);
        unsigned bP = (unsigned)(uintptr_t)(L + RT_PART + wv * 8192 + 4 * hh * 128 + r * 4), bZ = (unsigned)(uintptr_t)(L + RT_KZT + (128 * wd + r) * RT_TS + 16 * hh);
        asm volatile("" : "+v"(bQa), "+v"(bKb), "+v"(bSw), "+v"(bQr)); asm volatile("" : "+v"(bV), "+v"(bSr), "+v"(bP), "+v"(bZ));
#define LP(x) ((const LAS unsigned char*)(uintptr_t)(x))
#define LPW(x) ((LAS unsigned char*)(uintptr_t)(x))
        for (int c = 0; c < 32; ++c) {
            if (c + 1 < 32) RT_LOADG(c + 1);
            f32x16 o[2];
#pragma unroll
            for (int j = 0; j < 16; ++j) { o[0][j] = 0.f; o[1][j] = 0.f; }
            if (wd == 1 && wv != 1) { f32x16 sacc;
#pragma unroll
                for (int j = 0; j < 16; ++j) sacc[j] = 0.f;
#define RT_KQ(KQ) { s16x4 tl0 = lds_tr_read<(4 * (KQ) + 0) * 16 * RT_TS>((int)bKb), th0 = lds_tr_read<(4 * (KQ) + 0) * 16 * RT_TS + 4 * RT_TS>((int)bKb), tl1 = lds_tr_read<(4 * (KQ) + 1) * 16 * RT_TS>((int)bKb), th1 = lds_tr_read<(4 * (KQ) + 1) * 16 * RT_TS + 4 * RT_TS>((int)bKb); \
                    s16x4 tl2 = lds_tr_read<(4 * (KQ) + 2) * 16 * RT_TS>((int)bKb), th2 = lds_tr_read<(4 * (KQ) + 2) * 16 * RT_TS + 4 * RT_TS>((int)bKb), tl3 = lds_tr_read<(4 * (KQ) + 3) * 16 * RT_TS>((int)bKb), th3 = lds_tr_read<(4 * (KQ) + 3) * 16 * RT_TS + 4 * RT_TS>((int)bKb); \
                    asm volatile("s_waitcnt lgkmcnt(0)" ::: "memory"); __builtin_amdgcn_sched_barrier(0); \
                    sacc = MFMA32(lds_frag8x2(LP(bQa) + 32 * (4 * (KQ) + 0)), ((bf16x8){tl0[0], tl0[1], tl0[2], tl0[3], th0[0], th0[1], th0[2], th0[3]}), sacc); \
                    sacc = MFMA32(lds_frag8x2(LP(bQa) + 32 * (4 * (KQ) + 1)), ((bf16x8){tl1[0], tl1[1], tl1[2], tl1[3], th1[0], th1[1], th1[2], th1[3]}), sacc); \
                    sacc = MFMA32(lds_frag8x2(LP(bQa) + 32 * (4 * (KQ) + 2)), ((bf16x8){tl2[0], tl2[1], tl2[2], tl2[3], th2[0], th2[1], th2[2], th2[3]}), sacc); \
                    sacc = MFMA32(lds_frag8x2(LP(bQa) + 32 * (4 * (KQ) + 3)), ((bf16x8){tl3[0], tl3[1], tl3[2], tl3[3], th3[0], th3[1], th3[2], th3[3]}), sacc); }
                RT_KQ(0) RT_KQ(1) RT_KQ(2) RT_KQ(3)
#undef RT_KQ
#pragma unroll
                for (int j = 0; j < 16; ++j) sacc[j] *= g64inv;
#pragma unroll
                for (int j = 0; j < 16; ++j) { const int cl = (j & 3) + 8 * (j >> 2); float v = (ti != tj || cl + 4 * hh >= r) ? sacc[j] : 0.f; if (RT_VAR == 6) v = (ti == tj && cl + 4 * hh == r) ? 1.f : 0.f; *(LAS bf16_t*)(LPW(bSw) + cl * RT_TS) = (bf16_t)f2bf(v); } }
            if (RT_VAR != 5 && RT_VAR != 6 && RT_VAR != 9 && RT_VAR != 10)
#pragma unroll
            for (int s = 0; s < 8; ++s) { const bf16x8 rb = pack8(Racc[s >> 1], 8 * (s & 1));
#pragma unroll
                for (int m = 0; m < 2; ++m) { const bf16x8 af = lds_frag2x8(LP(bQr) + 32 * m * RT_QS + (32 * (s >> 1) + 16 * (s & 1)) * 2); o[m] = MFMA32(af, rb, o[m]); } }
            __syncthreads();
            bf16x8 Bv[4];
#pragma unroll
            for (int ks = 0; ks < 4; ++ks) Bv[ks] = lds_frag16(LP(bV) + 32 * ks);
            if (wd == 0) {
#pragma unroll
                for (int ks = 0; ks < 4; ++ks) { if (RT_VAR == 4) continue; if (ks < 2) { const bf16x8 a0 = lds_frag16(LP(bSr) + 32 * ks); o[0] = MFMA32(a0, Bv[ks], o[0]); }
                    const bf16x8 a1 = lds_frag16(LP(bSr) + 32 * RT_TS + 32 * ks); o[1] = MFMA32(a1, Bv[ks], o[1]); }
            } else {
#pragma unroll
                for (int m = 0; m < 2; ++m)
#pragma unroll
                    for (int j = 0; j < 16; ++j) *(LAS float*)(LPW(bP) + (32 * m + (j & 3) + 8 * (j >> 2)) * 128) = o[m][j];
            }
            __syncthreads();
            if (wd == 0) { bf16_t* op = ORET + (size_t)(tb + c * 64 + 4 * hh) * 2048 + h * 512 + vs * 128 + 32 * wv + r;
#pragma unroll
                for (int m = 0; m < 2; ++m)
#pragma unroll
                    for (int j = 0; j < 16; ++j) { const int cl = 32 * m + (j & 3) + 8 * (j >> 2); const float v = o[m][j] + *(const LAS float*)(LP(bP) + cl * 128); op[(size_t)cl * 2048] = (bf16_t)f2bf(v); }
            }
#pragma unroll
            for (int t4 = 0; t4 < 4; ++t4) {
#pragma unroll
                for (int j = 0; j < 16; ++j) Racc[t4][j] *= g64;
#pragma unroll
                for (int ks = 0; ks < 4; ++ks) { const bf16x8 af = lds_frag16(LP(bZ) + 32 * t4 * RT_TS + 32 * ks); Racc[t4] = MFMA32(af, Bv[ks], Racc[t4]); }
            }
            __syncthreads();
            if (c + 1 < 32) RT_STOREL();
            __syncthreads();
        }
    }
#undef RT_LOADG
#undef RT_STOREL
#undef LP
#undef LPW
}
__device__ __forceinline__ void retnorm_phase(const Frame& F, ArgsRef a) {
    const bf16_t* oret = (const bf16_t*)OUT(a); float* rn = (float*)(WS(a) + WS_MISC + MISC_RN);
    const int gw = F.bid * 8 + F.wave, NGW = F.G * 8;
    for (int i0 = gw * 8; i0 < T * 4; i0 += NGW * 8) {
        unsigned w4[8][4];
#pragma unroll
        for (int u = 0; u < 8; ++u) ld4u(oret + (size_t)(i0 + u) * 512 + F.lane * 8, w4[u]);
#pragma unroll
        for (int u = 0; u < 8; ++u) { float s = 0.f;
#pragma unroll
            for (int qq = 0; qq < 4; ++qq) { const float lo = bf2f(w4[u][qq] & 0xffffu), hi = bf2f(w4[u][qq] >> 16); s += lo * lo + hi * hi; }
            s = wave_sum(s); if (F.lane == 0) rn[i0 + u] = 1.0f / sqrtf(s * (1.0f / 512.f) + RMS_EPS); } }
}

__device__ __forceinline__ void rownorm_phase(const Frame& F, ArgsRef a) {
    const float* small = (const float*)(WS(a) + WS_SMALL); bf16_t* cqn = (bf16_t*)(WS(a) + WS_CQN); bf16_t* ckv = (bf16_t*)(WS(a) + WS_CKV); bf16_t* kidx = (bf16_t*)(WS(a) + WS_KIDX); float* widx = (float*)(WS(a) + WS_WIDX);
    const float* gkv = IN(a, I_CKV_G); const float* gki = IN(a, I_KIDX_G);
    const int gw = F.bid * 8 + F.wave, NGW = F.G * 8, l = F.lane;
    for (int tb4 = gw * 4; tb4 < T; tb4 += NGW * 4) { f32x4 va[4], vb[4];
#pragma unroll
      for (int u = 0; u < 4; ++u) { va[u] = *(const f32x4*)(small + (size_t)(tb4 + u) * 512 + 8 * l); vb[u] = *(const f32x4*)(small + (size_t)(tb4 + u) * 512 + 8 * l + 4); }
#pragma unroll
      for (int u = 0; u < 4; ++u) { const int t = tb4 + u; const f32x4 v0 = va[u], v1 = vb[u];
        const float ss = (v0[0] * v0[0] + v0[1] * v0[1]) + (v0[2] * v0[2] + v0[3] * v0[3]) + (v1[0] * v1[0] + v1[1] * v1[1]) + (v1[2] * v1[2] + v1[3] * v1[3]);
        const float sq = wave_sum(l < 32 ? ss : 0.f), skv = wave_sum((l >= 32 && l < 48) ? ss : 0.f), ski = wave_sum((l >= 48 && l < 56) ? ss : 0.f);
        float x[8] = {v0[0], v0[1], v0[2], v0[3], v1[0], v1[1], v1[2], v1[3]};
        if (l < 32) { const float r = 1.0f / sqrtf(sq * (1.f / 256.f) + RMS_EPS); u32x4 w; w.x = cvt_pk_bf16(x[0] * r, x[1] * r); w.y = cvt_pk_bf16(x[2] * r, x[3] * r); w.z = cvt_pk_bf16(x[4] * r, x[5] * r); w.w = cvt_pk_bf16(x[6] * r, x[7] * r); *(u32x4*)(cqn + (size_t)t * 256 + 8 * l) = w; }
        else if (l < 48) { const float r = 1.0f / sqrtf(skv * (1.f / 128.f) + RMS_EPS); const int c = 8 * (l - 32); const f32x4 g0 = *(const f32x4*)(gkv + c), g1 = *(const f32x4*)(gkv + c + 4);
            u32x4 w; w.x = cvt_pk_bf16(x[0] * r * g0[0], x[1] * r * g0[1]); w.y = cvt_pk_bf16(x[2] * r * g0[2], x[3] * r * g0[3]); w.z = cvt_pk_bf16(x[4] * r * g1[0], x[5] * r * g1[1]); w.w = cvt_pk_bf16(x[6] * r * g1[2], x[7] * r * g1[3]); *(u32x4*)(ckv + (size_t)t * 128 + c) = w; }
        else if (l < 56) { const float r = 1.0f / sqrtf(ski * (1.f / 64.f) + RMS_EPS); const int c = 8 * (l - 48); const f32x4 g0 = *(const f32x4*)(gki + c), g1 = *(const f32x4*)(gki + c + 4);
            u32x4 w; w.x = cvt_pk_bf16(x[0] * r * g0[0], x[1] * r * g0[1]); w.y = cvt_pk_bf16(x[2] * r * g0[2], x[3] * r * g0[3]); w.z = cvt_pk_bf16(x[4] * r * g1[0], x[5] * r * g1[1]); w.w = cvt_pk_bf16(x[6] * r * g1[2], x[7] * r * g1[3]); *(u32x4*)(kidx + (size_t)t * 64 + c) = w; }
        else if (l == 56) { const float sc = 0.35355339059327373f; *(f32x4*)(widx + (size_t)t * 8) = v0 * sc; *(f32x4*)(widx + (size_t)t * 8 + 4) = v1 * sc; }
      } }
}
struct EpiQ { static constexpr bool PERM = true;
    bf16_t* qlat; bf16_t* qidx;
    __device__ __forceinline__ void operator()(const f32x4 (&acc)[2][2][4][2], const pg8::Unit& u, int wr, int wc, int fr, int fq) const {
#pragma unroll
        for (int ai = 0; ai < 2; ++ai)
#pragma unroll
            for (int m = 0; m < 4; ++m) { const int row = u.pm * 256 + 128 * ai + 64 * wr + 16 * m + fr;
#pragma unroll
                for (int bj = 0; bj < 2; ++bj) { const int c = 128 * bj + 32 * wc + 8 * fq; bf16_t* p = u.pn < 4 ? qlat + (size_t)row * 1024 + u.pn * 256 + c : qidx + (size_t)row * 512 + (u.pn - 4) * 256 + c;
                    const f32x4 v0 = acc[ai][bj][m][0], v1 = acc[ai][bj][m][1]; u32x4 w; w.x = cvt_pk_bf16(v0[0], v0[1]); w.y = cvt_pk_bf16(v0[2], v0[3]); w.z = cvt_pk_bf16(v1[0], v1[1]); w.w = cvt_pk_bf16(v1[2], v1[3]); *(u32x4*)p = w; } }
    }
};
#define DPP_STEP_(op, ctrl, rmask) { const unsigned t_ = (unsigned)__builtin_amdgcn_update_dpp((int)v, (int)v, ctrl, rmask, 0xf, false); v = op(v, t_); }
__device__ __forceinline__ unsigned umax_(unsigned a, unsigned b) { return a > b ? a : b; }
__device__ __forceinline__ unsigned umin_(unsigned a, unsigned b) { return a < b ? a : b; }
__device__ __forceinline__ unsigned wave_umax(unsigned v) { DPP_STEP_(umax_, 0x111, 0xf) DPP_STEP_(umax_, 0x112, 0xf) DPP_STEP_(umax_, 0x114, 0xf) DPP_STEP_(umax_, 0x118, 0xf) DPP_STEP_(umax_, 0x142, 0xa) DPP_STEP_(umax_, 0x143, 0xc) return (unsigned)__builtin_amdgcn_readlane((int)v, 63); }
__device__ __forceinline__ unsigned wave_umin(unsigned v) { DPP_STEP_(umin_, 0x111, 0xf) DPP_STEP_(umin_, 0x112, 0xf) DPP_STEP_(umin_, 0x114, 0xf) DPP_STEP_(umin_, 0x118, 0xf) DPP_STEP_(umin_, 0x142, 0xa) DPP_STEP_(umin_, 0x143, 0xc) return (unsigned)__builtin_amdgcn_readlane((int)v, 63); }
template <int MODE> __device__ __forceinline__ void indexer_phase(const Frame& F, ArgsRef a) {
    const bf16_t* qidx = (const bf16_t*)(WS(a) + WS_QIDX); const bf16_t* kidx = (const bf16_t*)(WS(a) + WS_KIDX); const float* widx = (const float*)(WS(a) + WS_WIDX);
    unsigned long long* mask = (unsigned long long*)(WS(a) + WS_MASK);
    LAS float* sc = (LAS float*)(F.lds + LDS_STAGE); LAS float* wl = (LAS float*)(F.misc + LM_REC);
    const int lane = F.lane, w = F.wave, r = lane & 31, hh = lane >> 5;
    const int rq = 2 * (r >> 4) + ((r >> 2) & 1), rh = 4 * ((r >> 3) & 1) + (r & 3);
    for (int k8 = 0; k8 < 8; ++k8) {
        const int u = F.bid + F.G * k8; if (u >= NB * 128) break;
        const int b = u & 15, j = u >> 4, kk = j >> 4, cc = j & 15, blk = (kk & 1) ? 127 - 16 * (kk >> 1) - cc : 16 * (kk >> 1) + cc, qc = blk >> 2,     NK = 64 * (qc + 1), t0 = b * SEQ + 16 * blk;
        if (qc <= 3) {
            if (MODE == 0) for (int i = F.tid; i < 16 * 32; i += 512) { const int q = i >> 5, wi = i & 31; mask[(size_t)(t0 + q) * 32 + wi] = wi <= qc ? ~0ull : 0ull; }
            continue; }
        __syncthreads();
        if (F.tid < 128) wl[F.tid] = widx[(size_t)t0 * 8 + F.tid];
        bf16x8 A[4][4];
#pragma unroll
        for (int rt = 0; rt < 4; ++rt)
#pragma unroll
            for (int ks = 0; ks < 4; ++ks) A[rt][ks] = *(const bf16x8*)(qidx + (size_t)(t0 + 4 * rt + rq) * 512 + rh * 64 + 16 * ks + 8 * hh);
        __syncthreads();
        bf16x8 Bn[4];
#pragma unroll
        for (int ks = 0; ks < 4; ++ks) Bn[ks] = *(const bf16x8*)(kidx + (size_t)(b * SEQ + 32 * w + r) * 64 + 16 * ks + 8 * hh);
        if (MODE != 2) for (int kt = w; kt < NK / 32; kt += 8) {
            bf16x8 B[4];
#pragma unroll
            for (int ks = 0; ks < 4; ++ks) B[ks] = Bn[ks];
            if (kt + 8 < NK / 32) {
#pragma unroll
                for (int ks = 0; ks < 4; ++ks) Bn[ks] = *(const bf16x8*)(kidx + (size_t)(b * SEQ + 32 * (kt + 8) + r) * 64 + 16 * ks + 8 * hh); }
#pragma unroll
            for (int rt = 0; rt < 4; ++rt) { f32x16 c;
#pragma unroll
                for (int i = 0; i < 16; ++i) c[i] = 0.f;
#pragma unroll
                for (int ks = 0; ks < 4; ++ks) c = MFMA32(A[rt][ks], B[ks], c);
#pragma unroll
                for (int aa = 0; aa < 2; ++aa) { const int q = 4 * rt + 2 * aa + hh; const f32x4 w0 = *(const LAS f32x4*)(wl + q * 8), w1 = *(const LAS f32x4*)(wl + q * 8 + 4);
                    float s = 0.f;
#pragma unroll
                    for (int d = 0; d < 4; ++d) { s += fmaxf(c[8 * aa + d], 0.f) * w0[d]; s += fmaxf(c[8 * aa + 4 + d], 0.f) * w1[d]; }
                    sc[q * 2048 + 32 * kt + r] = s; } }
        }
        __syncthreads();
        if (MODE != 1)
#pragma unroll 1
        for (int qq = 0; qq < 2; ++qq) { const int q = 2 * w + qq; unsigned uu[32]; int nk = NK; asm volatile("" : "+s"(nk));
#pragma unroll
            for (int i = 0; i < 32; ++i) { const float f = sc[q * 2048 + 64 * i + lane]; const unsigned bits = __builtin_bit_cast(unsigned, f); const unsigned vm = (unsigned)((64 * i + lane - nk) >> 31); uu[i] = (bits ^ ((bits >> 31) ? 0xffffffffu : 0x80000000u)) & vm; }
            unsigned lo = 0xffffffffu, hi = 0u;
#pragma unroll
            for (int i = 0; i < 32; ++i) { const unsigned v = uu[i]; hi = v > hi ? v : hi; const unsigned vv = v ? v : 0xffffffffu; lo = vv < lo ? vv : lo; }
            lo = wave_umin(lo); hi = wave_umax(hi);
            unsigned theta = lo; bool exact = false; int chi = 0;
#pragma unroll 1
            while (lo < hi) { const unsigned mid = lo + ((hi - lo) >> 1) + 1u;
                int cnt = 0;
#pragma unroll
                for (int i8 = 0; i8 < 32; i8 += 8) { unsigned long long mk[8];
#pragma unroll
                    for (int i = 0; i < 8; ++i) mk[i] = __ballot(uu[i8 + i] >= mid);
                    __builtin_amdgcn_sched_barrier(0);
#pragma unroll
                    for (int i = 0; i < 8; ++i) cnt += __builtin_popcountll(mk[i]);
                    __builtin_amdgcn_sched_barrier(0); }
                if (cnt == 256) { theta = mid; exact = true; break; }
                if (cnt > 256) lo = mid; else { hi = mid - 1u; chi = cnt; }
                theta = lo; }
            unsigned wlo_ = 0u, whi_ = 0u;
            if (exact) {
#pragma unroll
                for (int i = 0; i < 32; ++i) { const unsigned long long word = __ballot(uu[i] >= theta); wlo_ = lane == i ? (unsigned)word : wlo_; whi_ = lane == i ? (unsigned)(word >> 32) : whi_; }
            } else { const int need = 256 - chi; int run = 0;
#pragma unroll
                for (int i = 0; i < 32; ++i) { const unsigned long long m = __ballot(uu[i] == theta); const int pre = run + __builtin_popcountll(m & ((1ull << lane) - 1ull));
                    const bool sel = (uu[i] > theta) || (uu[i] == theta && pre < need); run += __builtin_popcountll(m);
                    const unsigned long long word = __ballot(sel); wlo_ = lane == i ? (unsigned)word : wlo_; whi_ = lane == i ? (unsigned)(word >> 32) : whi_; } }
            if (MODE == 0 && lane < 32) { u32x2 w2; w2.x = wlo_; w2.y = whi_; *(u32x2*)(mask + (size_t)(t0 + q) * 32 + lane) = w2; }
            if (MODE == 2) asm volatile("" :: "v"(wlo_), "v"(whi_));
        }
    }
}

namespace att {
constexpr int SHM_V = 64 * 128 * 2, SHM_K = 64 * 128 * 2, LDS_MSK = 3 * SHM_V + 3 * SHM_K, LDS_BT = LDS_MSK + 8192, LDS_WS = LDS_BT + 8 * 320 * 4, LDS_END = LDS_WS + 8 * 64 * 4;
#define KSWZ(row, colB) ((row) * 256 + ((colB) ^ (((row) & 7) << 4)))
#define SBAR() __builtin_amdgcn_sched_barrier(0)
__device__ __forceinline__ int crow(int r, int hi) { return (r & 3) + 8 * (r >> 2) + 4 * hi; }
__device__ __forceinline__ int v_st(int k, int c) { const int kk = (k & ~0xC) | ((k & 4) << 1) | ((k & 8) >> 1); return ((kk >> 3) * 4 + (c >> 5)) * 512 + ((kk & 7) * 32 + (c & 31)) * 2; }
__device__ __forceinline__ int v_rd_base(int lane) { return ((lane & 3) << 3) | (((lane >> 2) & 3) << 6) | (((lane >> 4) & 1) << 5) | (((lane >> 5) & 1) << 8); }
constexpr int v_rd_off(int d0, int ks, int half) { return d0 * 512 + ks * 4096 + half * 2048; }
template <int OFF> __device__ __forceinline__ s16x4 tr_read(int vb) { s16x4 r; asm volatile("ds_read_b64_tr_b16 %0, %1 offset:%2" : "=&v"(r) : "v"(vb), "i"(OFF) : "memory"); return r; }
template <int D0> __device__ __forceinline__ void pv_one(f32x16& od, int vb, bf16x8 pa0, bf16x8 pa1, bf16x8 pa2, bf16x8 pa3) {
    const s16x4 l0 = tr_read<v_rd_off(D0, 0, 0)>(vb), h0 = tr_read<v_rd_off(D0, 0, 1)>(vb), l1 = tr_read<v_rd_off(D0, 1, 0)>(vb), h1 = tr_read<v_rd_off(D0, 1, 1)>(vb);
    const s16x4 l2 = tr_read<v_rd_off(D0, 2, 0)>(vb), h2 = tr_read<v_rd_off(D0, 2, 1)>(vb), l3 = tr_read<v_rd_off(D0, 3, 0)>(vb), h3 = tr_read<v_rd_off(D0, 3, 1)>(vb);
    asm volatile("s_waitcnt lgkmcnt(0)" ::: "memory"); SBAR();
#define PK(L, H) (bf16x8){L[0], L[1], L[2], L[3], H[0], H[1], H[2], H[3]}
    od = MFMA32(pa0, PK(l0, h0), od); od = MFMA32(pa1, PK(l1, h1), od); od = MFMA32(pa2, PK(l2, h2), od); od = MFMA32(pa3, PK(l3, h3), od);
#undef PK
}
__device__ __forceinline__ void pv_d0(f32x16* o, int vb, bf16x8 pa0, bf16x8 pa1, bf16x8 pa2, bf16x8 pa3) {
    pv_one<0>(o[0], vb, pa0, pa1, pa2, pa3); pv_one<1>(o[1], vb, pa0, pa1, pa2, pa3); pv_one<2>(o[2], vb, pa0, pa1, pa2, pa3); pv_one<3>(o[3], vb, pa0, pa1, pa2, pa3);
}
__device__ __forceinline__ void qkt(f32x16& p0, f32x16& p1, const LAS unsigned char* Ks, const bf16x8* qr, int r32, int hi) {
#pragma unroll
    for (int i = 0; i < 16; ++i) { p0[i] = 0.f; p1[i] = 0.f; }
#pragma unroll
    for (int d0 = 0; d0 < 8; ++d0) { const int cb = (d0 * 16 + hi * 8) * 2;
        const bf16x8 b0 = *(const LAS bf16x8*)(Ks + KSWZ(r32, cb)), b1 = *(const LAS bf16x8*)(Ks + KSWZ(32 + r32, cb));
        p0 = MFMA32(b0, qr[d0], p0); p1 = MFMA32(b1, qr[d0], p1); }
}
template <bool NEAR> __device__ __forceinline__ void bias_mask(f32x16& p0, f32x16& p1, unsigned wlo, unsigned whi, float bfar, const LAS float* bt, int relbase) {
    constexpr float C = 0.088388347648318440f * 1.4426950408889634f;
    asm volatile("" : "+v"(wlo), "+v"(whi));
#pragma unroll
    for (int r = 0; r < 16; ++r) { const int cr = (r & 3) + 8 * (r >> 2);
        const float b0 = NEAR ? bt[relbase + cr] : bfar, b1 = NEAR ? bt[relbase + 32 + cr] : bfar;
        const float s0 = fmaf(p0[r], C, b0), s1 = fmaf(p1[r], C, b1);
        p0[r] = (wlo & (1u << cr)) ? s0 : -INFINITY; p1[r] = (whi & (1u << cr)) ? s1 : -INFINITY; }
}
__device__ __forceinline__ void partialSM(f32x16& p0, f32x16& p1, float& m_reg, float& mn, float& alpha) {
    float pmax = p0[0];
#pragma unroll
    for (int r = 1; r < 16; ++r) pmax = fmaxf(pmax, p0[r]);
#pragma unroll
    for (int r = 0; r < 16; ++r) pmax = fmaxf(pmax, p1[r]);
    { auto rr = __builtin_amdgcn_permlane32_swap(__float_as_uint(pmax), __float_as_uint(pmax), false, false); pmax = fmaxf(__uint_as_float(rr[0]), __uint_as_float(rr[1])); }
    if (__all(pmax - m_reg <= 8.f)) { mn = m_reg; alpha = 1.f; }
    else { mn = fmaxf(m_reg, pmax); alpha = __builtin_amdgcn_exp2f(m_reg - mn); m_reg = mn; }
#pragma unroll
    for (int r = 0; r < 16; ++r) p0[r] = __builtin_amdgcn_exp2f(p0[r] - mn);
}
__device__ __forceinline__ void finishSM(f32x16& p0, f32x16& p1, float mn, float alpha, float& l_reg, bf16x8& pa0, bf16x8& pa1, bf16x8& pa2, bf16x8& pa3) {
#pragma unroll
    for (int r = 0; r < 16; ++r) p1[r] = __builtin_amdgcn_exp2f(p1[r] - mn);
    float ps = 0;
#pragma unroll
    for (int r = 0; r < 16; ++r) ps += p0[r];
#pragma unroll
    for (int r = 0; r < 16; ++r) ps += p1[r];
    { auto rr = __builtin_amdgcn_permlane32_swap(__float_as_uint(ps), __float_as_uint(ps), false, false); ps = __uint_as_float(rr[0]) + __uint_as_float(rr[1]); }
    l_reg = l_reg * alpha + ps;
#define PK4(P, BASE, OUT) do { unsigned a0 = cvt_pk_bf16(P[BASE + 0], P[BASE + 1]), a1 = cvt_pk_bf16(P[BASE + 2], P[BASE + 3]); \
    unsigned b0 = cvt_pk_bf16(P[BASE + 4], P[BASE + 5]), b1 = cvt_pk_bf16(P[BASE + 6], P[BASE + 7]); \
    auto r0 = __builtin_amdgcn_permlane32_swap(a0, b0, false, false); auto r1 = __builtin_amdgcn_permlane32_swap(a1, b1, false, false); \
    u32x4 w = {r0[0], r1[0], r0[1], r1[1]}; OUT = __builtin_bit_cast(bf16x8, w); } while (0)
    PK4(p0, 0, pa0); PK4(p0, 8, pa1); PK4(p1, 0, pa2); PK4(p1, 8, pa3);
#undef PK4
}
}
__device__ __forceinline__ int t5_bucket_abs(int n) { return n < 8 ? n : n < 12 ? 8 : n < 16 ? 9 : n < 23 ? 10 : n < 32 ? 11 : n < 46 ? 12 : n < 64 ? 13 : n < 91 ? 14 : 15; }
__device__ __forceinline__ void attention_phase(const Frame& F, ArgsRef a) {
    using namespace att;
    const bf16_t* qlat = (const bf16_t*)(WS(a) + WS_QLAT); const bf16_t* ckv = (const bf16_t*)(WS(a) + WS_CKV); const unsigned* mask = (const unsigned*)(WS(a) + WS_MASK); bf16_t* olat = (bf16_t*)(WS(a) + WS_OLAT);
    LAS unsigned char* L = F.lds + LDS_STAGE; LAS unsigned char* V_lds = L; LAS unsigned char* K_lds = L + 3 * SHM_V;
    LAS unsigned* msk = (LAS unsigned*)(L + LDS_MSK); LAS float* bt = (LAS float*)(L + LDS_BT);
    const int tid = F.tid, wid = F.wave, lane = F.lane, r32 = lane & 31, hi = lane >> 5, hd = r32 & 7;
    LAS float* wsx = (LAS float*)(L + LDS_WS) + wid * 64; LAS float* li_l = wsx; LAS float* al_l = wsx + 32;
    __syncthreads();
    for (int i = tid; i < 8 * 320; i += 512) { const int h = i / 320, rel = (i % 320) - 255; const int n = rel < 0 ? -rel : rel; bt[i] = IN(a, I_T5)[h * 32 + (rel > 0 ? 16 : 0) + t5_bucket_abs(n)] * 1.4426950408889634f; }
    const float bfar = IN(a, I_T5)[hd * 32 + 15] * 1.4426950408889634f;
    for (int k4 = 0; k4 < 4; ++k4) {
        const int u = F.bid + F.G * k4; if (u >= NB * 64) break;
        const int b = u & 15, j = u >> 4, kk = j >> 4, cc = j & 15, blk = (kk & 1) ? 63 - 16 * (kk >> 1) - cc : 16 * (kk >> 1) + cc, qc = blk >> 1,     t0 = b * SEQ + 32 * blk, NT = qc + 1;
        __syncthreads();
        for (int i = tid; i < 32 * 64; i += 512) msk[i] = mask[(size_t)t0 * 64 + i];
        const bf16_t* Kh = ckv + (size_t)b * SEQ * 128;
        const int qi = 4 * wid + (r32 >> 3), qpos = 32 * blk + qi;
        float m_reg = -1e30f, l_reg = 0.f; f32x16 o[4]; bf16x8 qr[8];
#pragma unroll
        for (int d = 0; d < 4; ++d)
#pragma unroll
            for (int i = 0; i < 16; ++i) o[d][i] = 0.f;
        const bf16_t* Qw = qlat + (size_t)(t0 * 8 + wid * 32 + r32) * 128 + hi * 8;
#pragma unroll
        for (int d0 = 0; d0 < 8; ++d0) qr[d0] = *(const bf16x8*)(Qw + d0 * 16);
        const int sr = tid >> 4, scol = (tid & 15) * 8, vst0 = v_st(sr, scol), vst1 = v_st(32 + sr, scol);
        const int vb0 = (int)(uintptr_t)V_lds + v_rd_base(lane);
        bf16x8 st0[1], st1[1];
#define SLOAD(i, k0) do { st0[i] = *(const bf16x8*)(Kh + (size_t)((k0) + sr) * 128 + scol); st1[i] = *(const bf16x8*)(Kh + (size_t)((k0) + 32 + sr) * 128 + scol); } while (0)
#define SWRITE(bb, i) do { *(LAS bf16x8*)(V_lds + (bb) * SHM_V + vst0) = st0[i]; *(LAS bf16x8*)(V_lds + (bb) * SHM_V + vst1) = st1[i]; const int kc = scol * 2; \
        *(LAS bf16x8*)(K_lds + (bb) * SHM_K + KSWZ(sr, kc)) = st0[i]; *(LAS bf16x8*)(K_lds + (bb) * SHM_K + KSWZ(32 + sr, kc)) = st1[i]; } while (0)
#define SWAIT() asm volatile("s_waitcnt vmcnt(2)" ::: "memory")
#define RESC(al) do { if (__any((al) < 1.f)) { if (hi == 0) al_l[r32] = (al); asm volatile("s_waitcnt lgkmcnt(0)" ::: "memory"); \
        _Pragma("unroll") for (int d = 0; d < 4; ++d) _Pragma("unroll") for (int r = 0; r < 16; ++r) o[d][r] *= al_l[crow(r, hi)]; } } while (0)
#define BIASMASK(P0, P1, jt) do { const unsigned wl_ = msk[qi * 64 + 2 * (jt)] >> (4 * hi), wh_ = msk[qi * 64 + 2 * (jt) + 1] >> (4 * hi); \
        if (64 * (jt) + 63 - 32 * blk > -128) bias_mask<true>(P0, P1, wl_, wh_, bfar, bt + hd * 320, 64 * (jt) + 4 * hi - qpos + 255); else bias_mask<false>(P0, P1, wl_, wh_, bfar, bt, 0); } while (0)
        f32x16 p0, p1; float mn, al; bf16x8 pa0, pa1, pa2, pa3;
        SLOAD(0, 0); asm volatile("s_waitcnt vmcnt(0)" ::: "memory"); SWRITE(0, 0); __syncthreads();
        for (int jt = 0, bb = 0; jt < NT; ++jt) { const int nb = bb == 2 ? 0 : bb + 1;
            if (jt + 1 < NT) SLOAD(0, (jt + 1) * 64);
            qkt(p0, p1, K_lds + bb * SHM_K, qr, r32, hi); BIASMASK(p0, p1, jt);
            partialSM(p0, p1, m_reg, mn, al); finishSM(p0, p1, mn, al, l_reg, pa0, pa1, pa2, pa3); SBAR();
            RESC(al);
            pv_d0(o, vb0 + bb * SHM_V, pa0, pa1, pa2, pa3);
            if (jt + 1 < NT) SWRITE(nb, 0);
            __syncthreads();
            bb = nb;
        }
        if (hi == 0) li_l[r32] = l_reg; asm volatile("s_waitcnt lgkmcnt(0)" ::: "memory");
        float rli[16];
#pragma unroll
        for (int r = 0; r < 16; ++r) rli[r] = __builtin_amdgcn_rcpf(li_l[crow(r, hi)]);
        if constexpr (MIXA_FP8) { unsigned char* O8 = (unsigned char*)olat + (size_t)(t0 * 8 + wid * 32) * 128 + 4 * r32;
#pragma unroll
            for (int r = 0; r < 16; ++r) { const float sc_ = rli[r] * 4.f; *(unsigned*)(O8 + (size_t)crow(r, hi) * 128) = pk4_fp8(o[0][r] * sc_, o[1][r] * sc_, o[2][r] * sc_, o[3][r] * sc_); } }
        else { bf16_t* Ow = olat + (size_t)(t0 * 8 + wid * 32) * 128;
#pragma unroll
        for (int r = 0; r < 16; ++r) { const int orow = crow(r, hi);
#pragma unroll
            for (int d0 = 0; d0 < 4; ++d0) Ow[(size_t)orow * 128 + d0 * 32 + r32] = (bf16_t)f2bf(o[d0][r] * rli[r]); } }
#undef SLOAD
#undef SWRITE
#undef SWAIT
#undef RESC
#undef BIASMASK
    }
}
#undef KSWZ
#undef SBAR

__device__ __forceinline__ void grid_bar(unsigned char* lds_raw) {
    ArgsRef a = phase_args(); XcdBarrier b; b.bar = (unsigned*)(WS(a) + WS_CTL) + CW_BAR; b.x = xb_xcc_id(); b.st = (volatile LAS unsigned*)((LAS unsigned char*)lds_raw + LDS_MISC + LM_BAR);
    xcd_barrier(b);
}
template <int HALFI> __device__ __forceinline__ void moe_gateup_phase(unsigned char* lds_raw) {
    ArgsRef a = phase_args(); const Frame F = make_frame(lds_raw);
    const int ntiles = moe_tables(F, a, HALFI);
    const int* lists = (const int*)(WS(a) + WS_LTOK) + (size_t)HALFI * NE * LIST_CAP; const float* lrs = (const float*)(WS(a) + WS_LRS) + (size_t)HALFI * NE * LIST_CAP;
    typedef MoeOrder<8, true, MOE_FP8 ? 1024 : 2048> Ord;
    Ord S{(const LAS int*)(F.misc + LM_TILE), (const LAS int*)(F.misc + LM_CNT), lists, ntiles, F.G, F.bid};
    EpiGateUp E{(bf16_t*)(WS(a) + WS_ACT), IN(a, I_B_GATE), IN(a, I_B_UP), lrs, (const LAS int*)(F.misc + LM_CNT)};
    pg8::gemm_phase<EpiGateUp, Ord, false, true, MOE_FP8 ? D / 2 : D, MOE_FP8>(F.lds + LDS_STAGE, F.tid, (const bf16_t*)(WS(a) + WS_X2B), (const bf16_t*)(WS(a) + WS_WGU), S, E, (LAS u32x4*)(F.misc + LM_SLOTS));
}
template <int HALFI> __device__ __forceinline__ void moe_down_phase(unsigned char* lds_raw) {
    ArgsRef a = phase_args(); const Frame F = make_frame(lds_raw);
    const int ntiles = moe_tables(F, a, HALFI);
    typedef MoeOrder<4, false, MOE_FP8 ? 1024 : 2048> Ord;
    Ord S{(const LAS int*)(F.misc + LM_TILE), (const LAS int*)(F.misc + LM_CNT), nullptr, ntiles, F.G, F.bid};
    EpiDown E{(bf16_t*)(WS(a) + WS_Y), IN(a, I_B_DOWN)};
    pg8::gemm_phase<EpiDown, Ord, false, false, MOE_FP8 ? FF / 2 : FF, MOE_FP8>(F.lds + LDS_STAGE, F.tid, (const bf16_t*)(WS(a) + WS_ACT), (const bf16_t*)(WS(a) + WS_WD), S, E);
}
template <int HALFI> __device__ __forceinline__ void moe_gateup_probe(unsigned char* lds_raw) {
    ArgsRef a = phase_args(); const Frame F = make_frame(lds_raw);
    const int ntiles = moe_tables(F, a, HALFI);
    const int* lists = (const int*)(WS(a) + WS_LTOK) + (size_t)HALFI * NE * LIST_CAP;
    typedef MoeOrder<8, true, MOE_FP8 ? 1024 : 2048> Ord;
    Ord S{(const LAS int*)(F.misc + LM_TILE), (const LAS int*)(F.misc + LM_CNT), lists, ntiles, F.G, F.bid};
    EpiProbe E{(float*)(WS(a) + WS_Y)};
    pg8::gemm_phase<EpiProbe, Ord, false, true, MOE_FP8 ? D / 2 : D, MOE_FP8>(F.lds + LDS_STAGE, F.tid, (const bf16_t*)(WS(a) + WS_X2B), (const bf16_t*)(WS(a) + WS_WGU), S, E, (LAS u32x4*)(F.misc + LM_SLOTS));
}
template <int HALFI> __device__ __forceinline__ void moe_down_probe(unsigned char* lds_raw) {
    ArgsRef a = phase_args(); const Frame F = make_frame(lds_raw);
    const int ntiles = moe_tables(F, a, HALFI);
    typedef MoeOrder<4, false, MOE_FP8 ? 1024 : 2048> Ord;
    Ord S{(const LAS int*)(F.misc + LM_TILE), (const LAS int*)(F.misc + LM_CNT), nullptr, ntiles, F.G, F.bid};
    EpiProbe E{(float*)(WS(a) + WS_X2B)};
    pg8::gemm_phase<EpiProbe, Ord, false, false, MOE_FP8 ? FF / 2 : FF, MOE_FP8>(F.lds + LDS_STAGE, F.tid, (const bf16_t*)(WS(a) + WS_ACT), (const bf16_t*)(WS(a) + WS_WD), S, E);
}
template <int HALFI> __device__ __forceinline__ void moe_combine_phase(unsigned char* lds_raw) {
    ArgsRef a = phase_args(); const Frame F = make_frame(lds_raw);
    (void)moe_tables(F, a, HALFI);
    combine_phase(F, a, HALFI);
}
__device__ __forceinline__ void prep_phase(unsigned char* lds_raw) { ArgsRef a = phase_args(); const Frame F = make_frame(lds_raw); mixer_prep_phase(F, a); }
#ifndef PREP2MASK
#define PREP2MASK 63
#endif
__device__ __forceinline__ void prep2_phase(unsigned char* lds_raw) { ArgsRef a = phase_args(); const Frame F = make_frame(lds_raw); mixer_prep_phase<PREP2MASK>(F, a); }
__device__ __forceinline__ void inproj_a_phase(unsigned char* lds_raw) {
    ArgsRef a = phase_args(); const Frame F = make_frame(lds_raw); const float* misc = (const float*)(WS(a) + WS_MISC);
    { DenseOrder S; S.init(T, 6 * 256, D, F.G, F.bid, 0, 0);
      EpiInA E{(bf16_t*)(WS(a) + WS_QX), (float*)(WS(a) + WS_SMALL), misc + MISC_RSTD1 / 4, (const float*)(WS(a) + WS_COSP), (const float*)(WS(a) + WS_SINP), misc + MISC_DQ / 4,
               (bf16_t*)(WS(a) + WS_CQN), (bf16_t*)(WS(a) + WS_CKV), (bf16_t*)(WS(a) + WS_KIDX), (float*)(WS(a) + WS_WIDX), IN(a, I_CKV_G), IN(a, I_KIDX_G), (LAS float*)(F.misc + 17408)};
      pg8::gemm_phase<EpiInA, DenseOrder, false, false, D>(F.lds + LDS_STAGE, F.tid, (const bf16_t*)(WS(a) + WS_XB), (const bf16_t*)(WS(a) + WS_WIN), S, E); }
}
__device__ __forceinline__ void inproj_b_phase(unsigned char* lds_raw) {
    ArgsRef a = phase_args(); const Frame F = make_frame(lds_raw); const float* misc = (const float*)(WS(a) + WS_MISC);
    if constexpr (INB_FP8) {
      { DenseOrder S; S.init(T, 4 * 256, D, F.G, F.bid, 0, (size_t)6 * 256 * D * 2);
        EpiInB<0, false> E{(bf16_t*)(WS(a) + WS_KZT), (bf16_t*)(WS(a) + WS_VT), misc + MISC_RSTD1 / 4, (const float*)(WS(a) + WS_COST), (const float*)(WS(a) + WS_SINT), misc + MISC_DZ / 4};
        pg8::gemm_phase<EpiInB<0, false>, DenseOrder, true, false, D>(F.lds + LDS_STAGE, F.tid, (const bf16_t*)(WS(a) + WS_XB), (const bf16_t*)(WS(a) + WS_WIN), S, E); }
      { DenseOrder S; S.init(T, 8 * 256, D / 2, F.G, F.bid, 0, 0);
        EpiInB<4, true> E{(bf16_t*)(WS(a) + WS_KZT), (bf16_t*)(WS(a) + WS_VT), misc + MISC_RSTD1 / 4, (const float*)(WS(a) + WS_COST), (const float*)(WS(a) + WS_SINT), misc + MISC_DZ / 4};
        pg8::gemm_phase<EpiInB<4, true>, DenseOrder, true, false, D / 2, true>(F.lds + LDS_STAGE, F.tid, (const bf16_t*)(WS(a) + WS_XB8), (const bf16_t*)(WS(a) + WS_WIN8 + 4 * MiB), S, E); }
    } else {
      DenseOrder S; S.init(T, 12 * 256, D, F.G, F.bid, 0, (size_t)6 * 256 * D * 2);
      EpiInB<0, false> E{(bf16_t*)(WS(a) + WS_KZT), (bf16_t*)(WS(a) + WS_VT), misc + MISC_RSTD1 / 4, (const float*)(WS(a) + WS_COST), (const float*)(WS(a) + WS_SINT), misc + MISC_DZ / 4};
      pg8::gemm_phase<EpiInB<0, false>, DenseOrder, true, false, D>(F.lds + LDS_STAGE, F.tid, (const bf16_t*)(WS(a) + WS_XB), (const bf16_t*)(WS(a) + WS_WIN), S, E); }
}
__device__ __forceinline__ void inproj_c_phase(unsigned char* lds_raw) {
    ArgsRef a = phase_args(); const Frame F = make_frame(lds_raw); const float* misc = (const float*)(WS(a) + WS_MISC);
    DenseOrder S; S.init(T, 16 * 256, INC_FP8 ? D / 2 : D, F.G, F.bid, 0, INC_FP8 ? (size_t)0 : (size_t)18 * 256 * D * 2);
    EpiInC E{(bf16_t*)OUT(a), (bf16_t*)(WS(a) + WS_GA), (bf16_t*)(WS(a) + WS_GB), misc + MISC_RSTD1 / 4, misc + MISC_RN / 4};
    pg8::gemm_phase<EpiInC, DenseOrder, false, false, INC_FP8 ? D / 2 : D, INC_FP8>(F.lds + LDS_STAGE, F.tid, (const bf16_t*)(WS(a) + (INC_FP8 ? WS_XB8 : WS_XB)), (const bf16_t*)(WS(a) + (INC_FP8 ? WS_WIN8 : WS_WIN)), S, E);
}
__device__ __forceinline__ void retention_phase_w(unsigned char* lds_raw) { ArgsRef a = phase_args(); const Frame F = make_frame(lds_raw); retention_phase(F, a); }
__device__ __forceinline__ void retnorm_phase_w(unsigned char* lds_raw) { ArgsRef a = phase_args(); const Frame F = make_frame(lds_raw); retnorm_phase(F, a); }
__device__ __forceinline__ void mix_a_phase(unsigned char* lds_raw) {
    ArgsRef a = phase_args(); const Frame F = make_frame(lds_raw);
    DenseOrder S; S.init(T, D, MIXA_FP8 ? D / 2 : D, F.G, F.bid, 0, 0);
    EpiMix<0, MIXA_FP8> E{(const bf16_t*)(WS(a) + WS_GA), (bf16_t*)(WS(a) + WS_MIXA), (bf16_t*)(WS(a) + WS_MIX)};
    pg8::gemm_phase<EpiMix<0, MIXA_FP8>, DenseOrder, false, false, MIXA_FP8 ? D / 2 : D, MIXA_FP8>(F.lds + LDS_STAGE, F.tid, (const bf16_t*)(WS(a) + WS_OLAT), (const bf16_t*)(WS(a) + WS_WA), S, E);
}
__device__ __forceinline__ void mix_b_phase(unsigned char* lds_raw) {
    ArgsRef a = phase_args(); const Frame F = make_frame(lds_raw);
    DenseOrder S; S.init(T, D, 2048, F.G, F.bid, 0, 0);
    EpiMix<1> E{(const bf16_t*)(WS(a) + WS_GB), (bf16_t*)(WS(a) + WS_MIXA), (bf16_t*)(WS(a) + WS_MIX)};
    pg8::gemm_phase<EpiMix<1>, DenseOrder, false, false, 2048>(F.lds + LDS_STAGE, F.tid, (const bf16_t*)OUT(a), (const bf16_t*)(WS(a) + WS_WB), S, E);
}
__device__ __forceinline__ void rownorm_phase_w(unsigned char* lds_raw) { ArgsRef a = phase_args(); const Frame F = make_frame(lds_raw); rownorm_phase(F, a); }
__device__ __forceinline__ void qproj_phase(unsigned char* lds_raw) {
    ArgsRef a = phase_args(); const Frame F = make_frame(lds_raw);
    DenseOrder S; S.init(T, 1536, 256, F.G, F.bid, 0, 0);
    EpiQ E{(bf16_t*)(WS(a) + WS_QLAT), (bf16_t*)(WS(a) + WS_QIDX)};
    pg8::gemm_phase<EpiQ, DenseOrder, false, false, 256>(F.lds + LDS_STAGE, F.tid, (const bf16_t*)(WS(a) + WS_CQN), (const bf16_t*)(WS(a) + WS_WQ), S, E);
}
__device__ __forceinline__ void indexer_phase_w(unsigned char* lds_raw) { ArgsRef a = phase_args(); const Frame F = make_frame(lds_raw); indexer_phase<0>(F, a); }
template <int MODE> __device__ __forceinline__ void indexer_probe_w(unsigned char* lds_raw) { ArgsRef a = phase_args(); const Frame F = make_frame(lds_raw); indexer_phase<MODE>(F, a); }
__device__ __forceinline__ void attention_phase_w(unsigned char* lds_raw) { ArgsRef a = phase_args(); const Frame F = make_frame(lds_raw); attention_phase(F, a); }
__device__ __forceinline__ void out_phase(unsigned char* lds_raw) {
    ArgsRef a = phase_args(); const Frame F = make_frame(lds_raw);
    DenseOrder S; S.init(T, D, D, F.G, F.bid, 0, 0);
    EpiOut E{(const bf16_t*)(WS(a) + WS_XB), X2H ? (float*)(WS(a) + WS_X2H) : OUT(a), (bf16_t*)(WS(a) + WS_X2B)};
    pg8::gemm_phase<EpiOut, DenseOrder, false, false, D>(F.lds + LDS_STAGE, F.tid, (const bf16_t*)(WS(a) + WS_MIX), (const bf16_t*)(WS(a) + WS_WOUT), S, E);
}
__device__ __forceinline__ void convert_only_phase(unsigned char* lds_raw) { ArgsRef a = phase_args(); const Frame F = make_frame(lds_raw); moe_weight_convert(F, a); }
__device__ __forceinline__ void router_phase_w(unsigned char* lds_raw) { ArgsRef a = phase_args(); const Frame F = make_frame(lds_raw); moe_weight_convert(F, a); __syncthreads(); router_phase(F, a); }

#ifdef DIAG2
__device__ __forceinline__ void diag_ck(unsigned char* lds_raw, int k, const void* buf, size_t chunk_bytes) {
    grid_bar(lds_raw);
    ArgsRef a = phase_args(); unsigned* sums = (unsigned*)(WS(a) + WS_CTL + 256 * 1024) + k * 16384; unsigned* nbad = (unsigned*)(WS(a) + WS_CTL) + 16384 + 64 * k; const int gw = blockIdx.x * 8 + (threadIdx.x >> 6), lane = threadIdx.x & 63;
    for (int c = gw; c < 16384; c += gridDim.x * 8) { const unsigned* p = (const unsigned*)((const char*)buf + (size_t)c * chunk_bytes); unsigned sm = 0u; for (size_t i = lane; i < chunk_bytes / 4; i += 64) sm += p[i] * (unsigned)(2 * i + 1);
        for (int o = 1; o < 64; o <<= 1) sm += __shfl_xor(sm, o);
        if (lane == 0) { if (a.pass == 0) sums[c] = sm; else if (sums[c] != sm) atomicAdd(nbad, 1u); } }
    grid_bar(lds_raw);
}
__device__ __forceinline__ void diag_final(unsigned char* lds_raw) {
    grid_bar(lds_raw);
    ArgsRef a = phase_args(); const unsigned* nbad = (const unsigned*)(WS(a) + WS_CTL) + 16384; float c = 0.f;
    if (a.pass == 1) { for (int k = 0; k < 4; ++k) if (__hip_atomic_load(nbad + 64 * k, __ATOMIC_RELAXED, __HIP_MEMORY_SCOPE_AGENT) > 0u) c += (float)(1 << k); }
    grid_bar(lds_raw);
    for (size_t i = (size_t)blockIdx.x * 512 + threadIdx.x; i < (size_t)T * D; i += (size_t)gridDim.x * 512) OUT(a)[i] = c;
}
#endif
__global__ void __launch_bounds__(512, 2) fwd(Args a_unused) {
    extern __shared__ __attribute__((aligned(16))) unsigned char lds_raw[];
    { ArgsRef a = phase_args(); LAS unsigned* st = (LAS unsigned*)((LAS unsigned char*)lds_raw + LDS_MISC + LM_BAR);
      if (threadIdx.x < 4) st[threadIdx.x] = 0u;
      __syncthreads();
      (void)xcd_barrier_post((unsigned*)(WS(a) + WS_CTL) + CW_BAR, (volatile LAS unsigned*)st); }
#ifndef DUP
#define DUP 0u
#endif
#ifndef PHSEL
#define PHSEL 0xffffffffu
#endif
#define GRID_BAR() grid_bar(lds_raw)
#ifdef ZERO_OUT_FIRST
    { float* o_ = OUT(phase_args()); for (size_t i = (size_t)blockIdx.x * 512 + threadIdx.x; i < (size_t)T * D / 4; i += (size_t)gridDim.x * 512) ((f32x4*)o_)[i] = (f32x4){0.f, 0.f, 0.f, 0.f}; }
#endif
    if (PHSEL & (1u << 0)) prep_phase(lds_raw);
    if (DUP & (1u << 0)) { GRID_BAR(); prep2_phase(lds_raw); }
    GRID_BAR();
#if defined(DIAG2) && DIAG2 == 21
    { unsigned char* w_ = WS(phase_args()); diag_ck(lds_raw, 0, w_ + 1 * MiB, 256); diag_ck(lds_raw, 1, w_ + WS_MISC, 64); diag_ck(lds_raw, 2, w_ + WS_XB, 4096); diag_ck(lds_raw, 3, w_ + WS_WIN, 1024); diag_final(lds_raw); return; }
#endif
    if (PHSEL & (1u << 1)) inproj_a_phase(lds_raw);
    if (DUP & (1u << 1)) { GRID_BAR(); inproj_a_phase(lds_raw); }
    if (PHSEL & (1u << 2)) inproj_b_phase(lds_raw);
    if (DUP & (1u << 2)) { GRID_BAR(); inproj_b_phase(lds_raw); }
#if defined(DIAG2) && DIAG2 == 22
    { unsigned char* w_ = WS(phase_args()); diag_ck(lds_raw, 0, w_ + WS_QX, 4096); diag_ck(lds_raw, 1, w_ + WS_SMALL, 4096); diag_ck(lds_raw, 2, w_ + WS_KZT, 4096); diag_ck(lds_raw, 3, w_ + WS_VT, 8192); diag_final(lds_raw); return; }
#endif
#if defined(DIAG2) && DIAG2 == 10
    diag_ck(lds_raw, 0, WS(phase_args()) + WS_QX, 4096); diag_final(lds_raw); return;
#endif
    GRID_BAR();
    if (!ROWNORM_FUSED && (PHSEL & (1u << 16))) rownorm_phase_w(lds_raw);
    if (PHSEL & (1u << 3)) retention_phase_w(lds_raw);
    if (DUP & (1u << 3)) { GRID_BAR(); retention_phase_w(lds_raw); }
#if defined(DIAG2) && DIAG2 == 23
    diag_ck(lds_raw, 0, OUT(phase_args()), 8192);
#endif
#if defined(DIAG2) && DIAG2 == 11
    diag_ck(lds_raw, 1, OUT(phase_args()), 8192); diag_final(lds_raw); return;
#endif
    GRID_BAR();
    if (PHSEL & (1u << 4)) retnorm_phase_w(lds_raw);
    if (PHSEL & (1u << 17)) qproj_phase(lds_raw);
    if (DUP & (1u << 17)) { GRID_BAR(); qproj_phase(lds_raw); }
    GRID_BAR();
#if defined(DIAG2) && DIAG2 == 23
    diag_ck(lds_raw, 1, WS(phase_args()) + WS_QLAT, 4096);
#endif
    if (PHSEL & (1u << 18)) indexer_phase_w(lds_raw);
    __syncthreads();
    if (PHSEL & (1u << 5)) inproj_c_phase(lds_raw);
    if (DUP & (1u << 18)) { GRID_BAR(); indexer_phase_w(lds_raw); }
    if (DUP & (1u << 22)) { GRID_BAR(); indexer_probe_w<1>(lds_raw); }
    if (DUP & (1u << 23)) { GRID_BAR(); indexer_probe_w<2>(lds_raw); }
#if defined(DIAG2) && DIAG2 == 23
    diag_ck(lds_raw, 2, WS(phase_args()) + WS_MASK, 512);
#endif
#if defined(DIAG2) && DIAG2 == 12
    diag_ck(lds_raw, 2, WS(phase_args()) + WS_MASK, 512); diag_final(lds_raw); return;
#endif
    GRID_BAR();
    if (PHSEL & (1u << 19)) attention_phase_w(lds_raw);
    if (DUP & (1u << 19)) { GRID_BAR(); attention_phase_w(lds_raw); }
#if defined(DIAG2) && DIAG2 == 23
    diag_ck(lds_raw, 3, WS(phase_args()) + WS_OLAT, 4096); diag_final(lds_raw); return;
#endif
#if defined(DIAG2) && DIAG2 == 13
    diag_ck(lds_raw, 3, WS(phase_args()) + WS_QLAT, 4096); diag_final(lds_raw); return;
#endif
#if defined(DIAG2) && DIAG2 == 24
    diag_ck(lds_raw, 0, OUT(phase_args()), 8192);
#endif
    GRID_BAR();
    if (PHSEL & (1u << 20)) mix_a_phase(lds_raw);
    if (DUP & (1u << 20)) { GRID_BAR(); mix_a_phase(lds_raw); }
    if (PHSEL & (1u << 6)) mix_b_phase(lds_raw);
    if (DUP & (1u << 6)) { GRID_BAR(); mix_b_phase(lds_raw); }
#if defined(DIAG2) && DIAG2 == 24
    diag_ck(lds_raw, 1, WS(phase_args()) + WS_MIX, 4096);
#endif
#if defined(DIAG2) && DIAG2 == 28
    diag_ck(lds_raw, 3, WS(phase_args()) + WS_MIX, 4096);
#endif
    GRID_BAR();
    if (PHSEL & (1u << 7)) out_phase(lds_raw);
    if (DUP & (1u << 7)) { GRID_BAR(); out_phase(lds_raw); }
#if defined(DIAG2) && (DIAG2 == 38 || DIAG2 == 39)
    { asm volatile("s_waitcnt vmcnt(0)" ::: "memory"); __syncthreads(); if (threadIdx.x == 0) atomicAdd((unsigned*)(WS(phase_args()) + WS_CTL) + 16384 + 64 * 9, 1u); }
#endif
    GRID_BAR();
#if defined(DIAG2) && (DIAG2 == 38 || DIAG2 == 39)
    { if (threadIdx.x == 0) { unsigned* nb_ = (unsigned*)(WS(phase_args()) + WS_CTL) + 16384; const unsigned d_ = __hip_atomic_load(nb_ + 64 * 9, __ATOMIC_RELAXED, __HIP_MEMORY_SCOPE_AGENT); if (d_ != gridDim.x * (unsigned)(phase_args().pass + 1)) atomicAdd(nb_ + 64 * 10, 1u); } }
#endif
#if defined(DIAG2) && DIAG2 == 24
    diag_ck(lds_raw, 2, OUT(phase_args()), 8192); diag_ck(lds_raw, 3, WS(phase_args()) + WS_X2B, 2048); diag_final(lds_raw); return;
#endif
#if defined(DIAG2) && DIAG2 == 28
    diag_ck(lds_raw, 0, OUT(phase_args()), 8192); diag_ck(lds_raw, 1, WS(phase_args()) + WS_X2B, 2048);
#endif
    if (DUP & (1u << 21)) { convert_only_phase(lds_raw); GRID_BAR(); }
#if defined(DIAG2) && (DIAG2 == 29 || DIAG2 == 30 || DIAG2 == 31)
    diag_ck(lds_raw, 0, WS(phase_args()) + WS_MISC, 8);
#endif
    if (PHSEL & (1u << 8)) router_phase_w(lds_raw);
    GRID_BAR();
#if defined(DIAG2) && DIAG2 == 25
    diag_ck(lds_raw, 0, WS(phase_args()) + WS_WGU, 4096); diag_ck(lds_raw, 1, WS(phase_args()) + WS_WD, 2048);
#endif
#if defined(DIAG2) && DIAG2 == 26
    diag_ck(lds_raw, 0, WS(phase_args()) + WS_WGU, 4096); diag_ck(lds_raw, 1, WS(phase_args()) + WS_WD, 2048); diag_final(lds_raw); return;
#endif
#if defined(DIAG2) && DIAG2 == 29
    diag_final(lds_raw); return;
#endif
#if defined(DIAG2) && (DIAG2 >= 30 && DIAG2 <= 40)
    { grid_bar(lds_raw); ArgsRef a = phase_args(); const unsigned* nb = (const unsigned*)(WS(a) + WS_CTL) + 16384; float c = 0.f;
      if (a.pass == 1) { unsigned n = __hip_atomic_load(nb + 64 * 3, __ATOMIC_RELAXED, __HIP_MEMORY_SCOPE_AGENT);
#if DIAG2 == 31
        n = n >> 5;
#endif
#if DIAG2 == 38
        n = __hip_atomic_load(nb + 64 * 10, __ATOMIC_RELAXED, __HIP_MEMORY_SCOPE_AGENT);
#endif
#if DIAG2 == 40
        n = (__hip_atomic_load(nb + 64 * 11, __ATOMIC_RELAXED, __HIP_MEMORY_SCOPE_AGENT) ? 1u : 0u) + (__hip_atomic_load(nb + 64 * 12, __ATOMIC_RELAXED, __HIP_MEMORY_SCOPE_AGENT) ? 2u : 0u) + (__hip_atomic_load(nb + 64 * 13, __ATOMIC_RELAXED, __HIP_MEMORY_SCOPE_AGENT) ? 4u : 0u);
#endif
#if DIAG2 == 39
        n = (__hip_atomic_load(nb + 64 * 10, __ATOMIC_RELAXED, __HIP_MEMORY_SCOPE_AGENT) ? 1u : 0u) + (n ? 2u : 0u);
#endif
#if DIAG2 >= 34 && DIAG2 <= 37
        n = __builtin_popcount(__hip_atomic_load(nb + 64 * (DIAG2 - 30), __ATOMIC_RELAXED, __HIP_MEMORY_SCOPE_AGENT));
#endif
        c = (float)(n > 30u ? 30u : n); }
      grid_bar(lds_raw);
      for (size_t i = (size_t)blockIdx.x * 512 + threadIdx.x; i < (size_t)T * D; i += (size_t)gridDim.x * 512) OUT(a)[i] = c; return; }
#endif
#if defined(DIAG2) && (DIAG2 == 27 || DIAG2 == 28)
    { grid_bar(lds_raw); ArgsRef a = phase_args(); unsigned* sums = (unsigned*)(WS(a) + WS_CTL + 256 * 1024); unsigned* nbad = (unsigned*)(WS(a) + WS_CTL) + 16384;
      const unsigned* rec = (const unsigned*)(WS(a) + WS_REC); const unsigned* gc = (const unsigned*)(WS(a) + WS_CTL) + CW_CNT;
      for (int t = blockIdx.x * 512 + threadIdx.x; t < T; t += gridDim.x * 512) { unsigned sm = 0u; for (int k = 0; k < 4; ++k) { sm = sm * 31u + rec[(size_t)t * 16 + 4 * k]; sm = sm * 31u + rec[(size_t)t * 16 + 4 * k + 2]; sm = sm * 31u + rec[(size_t)t * 16 + 4 * k + 3]; }
          if (a.pass == 0) sums[2 * 16384 + t] = sm; else if (sums[2 * 16384 + t] != sm) atomicAdd(nbad + 64 * 2, 1u); }
      if (blockIdx.x == 0 && threadIdx.x < 64) { const unsigned v = gc[threadIdx.x]; if (a.pass == 0) sums[65536 + threadIdx.x] = v; else if (sums[65536 + threadIdx.x] != v) atomicAdd(nbad + 64 * 2, 1u); }
      grid_bar(lds_raw);
#if DIAG2 == 27
      diag_final(lds_raw); return;
#endif
    }
#endif
    if (PHSEL & (1u << 9)) moe_gateup_phase<0>(lds_raw);
    if (DUP & (1u << 9)) { GRID_BAR(); moe_gateup_phase<0>(lds_raw); }
    if (DUP & (1u << 24)) { GRID_BAR(); moe_gateup_probe<0>(lds_raw); }
    GRID_BAR();
    if (PHSEL & (1u << 10)) moe_down_phase<0>(lds_raw);
    if (DUP & (1u << 10)) { GRID_BAR(); moe_down_phase<0>(lds_raw); }
    if (DUP & (1u << 25)) { GRID_BAR(); moe_down_probe<0>(lds_raw); }
    GRID_BAR();
    if (PHSEL & (1u << 11)) moe_combine_phase<0>(lds_raw);
#if defined(DIAG2) && DIAG2 == 20
    diag_ck(lds_raw, 0, OUT(phase_args()), 8192); diag_final(lds_raw);
#endif
#if defined(DIAG2) && DIAG2 == 28
    diag_final(lds_raw);
#endif
}

extern "C" void kernel_launch(void* const* d_in, const int* in_sizes, int n_in, void* d_out, int out_size, void* d_ws, size_t ws_size, hipStream_t stream) {
    static int grid = 0;
    if (grid == 0) {
        if (n_in != 24 || out_size != T * D || ws_size < WS_END2) { fprintf(stderr, "kernel_launch: unexpected shapes n_in %d out %d ws %zu (need %zu)\n", n_in, out_size, ws_size, (size_t)WS_END2); grid = -1; return; }
        int dev = 0, cus = 0, per_cu = 0;
        if (hipGetDevice(&dev) != hipSuccess || hipDeviceGetAttribute(&cus, hipDeviceAttributeMultiprocessorCount, dev) != hipSuccess) { grid = -1; return; }
        if (hipFuncSetAttribute((const void*)fwd, hipFuncAttributeMaxDynamicSharedMemorySize, LDS_BYTES) != hipSuccess) { fprintf(stderr, "kernel_launch: hipFuncSetAttribute failed\n"); grid = -1; return; }
        if (hipOccupancyMaxActiveBlocksPerMultiprocessor(&per_cu, (const void*)fwd, 512, LDS_BYTES) != hipSuccess || per_cu < 1) fprintf(stderr, "kernel_launch: occupancy query reports %d\n", per_cu);
        (void)hipGetLastError();
        grid = cus;
    }
    if (grid < 0) return;
    if (hipMemsetAsync((char*)d_ws + WS_CTL, 0, CTL_BYTES, stream) != hipSuccess) return;
    Args a{};
    for (int i = 0; i < 24; ++i) a.in[i] = (const float*)d_in[i];
    a.out = (float*)d_out; a.ws = (unsigned char*)d_ws; a.pass = 0;
    hipLaunchKernelGGL(fwd, dim3(grid), dim3(512), LDS_BYTES, stream, a);
#ifdef DIAG2
    if (hipMemsetAsync((char*)d_ws + WS_CTL, 0, 49152, stream) != hipSuccess) return;
    a.pass = 1;
    hipLaunchKernelGGL(fwd, dim3(grid), dim3(512), LDS_BYTES, stream, a);
#endif
}
```

```cpp
#include <hip/hip_runtime.h>
#include <cstdio>
#include <cstdint>

#define LAS __attribute__((address_space(3)))
#define GAS __attribute__((address_space(1)))
typedef unsigned short bf16_t;
typedef short bf16x8 __attribute__((ext_vector_type(8)));
typedef short s16x4 __attribute__((ext_vector_type(4)));
typedef float f32x4 __attribute__((ext_vector_type(4)));
typedef float f32x2 __attribute__((ext_vector_type(2)));
typedef float f32x16 __attribute__((ext_vector_type(16)));
typedef unsigned u32x4 __attribute__((ext_vector_type(4)));
typedef unsigned u32x2 __attribute__((ext_vector_type(2)));
typedef int i32x4 __attribute__((ext_vector_type(4)));
typedef int i32x8 __attribute__((ext_vector_type(8)));

constexpr int NB = 16, SEQ = 2048, T = NB * SEQ, D = 1024;
constexpr int NE = 32, FF = 1024, TOPK_E = 4;
constexpr int HALF_T = T;
constexpr int LIST_CAP = HALF_T;
constexpr int PAD_ROWS = HALF_T * TOPK_E + NE * 256;
constexpr float RMS_EPS = 1e-6f;

constexpr size_t MiB = 1u << 20;
constexpr size_t WS_CTL = 0, CTL_BYTES = 1 * MiB;
constexpr size_t WS_MISC = 5 * MiB;
constexpr size_t MISC_RW_HI = 0, MISC_RW_LO = 65536, MISC_RSTD2 = 131072, MISC_RSTD1 = 262144;
constexpr bool MOE_FP8 = true;
constexpr float W8_SCALE = 32.f, W8_INV = 1.f / 32.f;
constexpr bool X2H = true;
constexpr bool ROWNORM_FUSED = true;
constexpr bool GA8 = true;
constexpr bool MIXA_FP8 = true;
constexpr bool Y_FP8 = true;
constexpr bool INB_FP8 = true;
constexpr bool INC_FP8 = true;
constexpr size_t WS_REC = 6 * MiB, WS_LTOK = 8 * MiB, WS_LRS = 12 * MiB, WS_WD = 48 * MiB, WS_X2B = 96 * MiB, WS_WGU = 144 * MiB, WS_ACT = 208 * MiB, WS_Y = 344 * MiB, WS_X2H = 480 * MiB, WS_END = 552 * MiB;
static_assert(MOE_FP8 && WS_ACT + (size_t)PAD_ROWS * FF <= WS_Y && WS_Y + (size_t)PAD_ROWS * D * (Y_FP8 ? 1 : 2) <= WS_END, "ws map (single-pass MoE needs the fp8 sizes)");
constexpr size_t WS_COSP = 1 * MiB, WS_SINP = 2 * MiB, WS_COST = 3 * MiB, WS_SINT = 4 * MiB;
constexpr size_t MISC_DQ = 393216, MISC_DK = 394240, MISC_DZ = 395264, MISC_RN = 524288;
constexpr size_t WS_WIN = 6 * MiB, WS_XB = 32 * MiB, WS_SMALL = 96 * MiB, WS_QX = 160 * MiB, WS_KP = 224 * MiB, WS_KZT = 288 * MiB, WS_VT = 352 * MiB;
constexpr size_t WS_CKV = 480 * MiB, WS_KIDX = 488 * MiB, WS_WIDX = 492 * MiB, WS_CQN = 493 * MiB, WS_QIDX = 509 * MiB, WS_MASK = 541 * MiB;
constexpr size_t WS_WQ = 552 * MiB, WS_WA = 553 * MiB, WS_WB = 555 * MiB, WS_WOUT = 559 * MiB, WS_END2 = 561 * MiB;
constexpr size_t WS_XB8 = 224 * MiB, WS_WIN8 = 256 * MiB;
constexpr size_t WS_GA = WS_QX, WS_GB = INC_FP8 ? WS_VT : WS_KP,        WS_MIXA = WS_KZT, WS_MIX = WS_VT, WS_QLAT = WS_SMALL, WS_OLAT = WS_VT + 64 * MiB;
constexpr int NIN = 8704;
constexpr int CW_BAR = 1024;
constexpr int CW_CNT = 8192;

__device__ __forceinline__ unsigned f2bf(float f) { unsigned u = __builtin_bit_cast(unsigned, f); return (u + 0x7fffu + ((u >> 16) & 1u)) >> 16; }
__device__ __forceinline__ unsigned pk2(float lo, float hi) { return f2bf(lo) | (f2bf(hi) << 16); }
__device__ __forceinline__ float bf2f(unsigned b) { return __builtin_bit_cast(float, b << 16); }
typedef __bf16 bf16v2_t __attribute__((ext_vector_type(2)));
__device__ __forceinline__ unsigned cvt_pk_bf16(float lo, float hi) { f32x2 v = {lo, hi}; bf16v2_t r = __builtin_convertvector(v, bf16v2_t); return __builtin_bit_cast(unsigned, r); }
__device__ __forceinline__ float wave_sum(float v) {
#pragma unroll
    for (int o = 1; o < 64; o <<= 1) v += __shfl_xor(v, o);
    return v;
}
__device__ __forceinline__ void ld4u(const void* p, unsigned (&w)[4]) { const f32x4 t = *(const f32x4*)p; const float t0 = t[0], t1 = t[1], t2 = t[2], t3 = t[3];
    w[0] = __builtin_bit_cast(unsigned, t0); w[1] = __builtin_bit_cast(unsigned, t1); w[2] = __builtin_bit_cast(unsigned, t2); w[3] = __builtin_bit_cast(unsigned, t3); }
__device__ __forceinline__ unsigned pk4_fp8(float a, float b, float c, float d) { unsigned w = 0u; w = __builtin_amdgcn_cvt_pk_fp8_f32(a, b, w, false); w = __builtin_amdgcn_cvt_pk_fp8_f32(c, d, w, true); return w; }
#define LDS_WAIT() asm volatile("s_waitcnt lgkmcnt(0)" ::: "memory")
#define VM_WAIT() asm volatile("s_waitcnt vmcnt(0)" ::: "memory")

#define XB_TMO      128
#define XB_XCNT(j)  (256  + 64 * (j))
#define XB_XSUB(j)  (1280 + 64 * (j))
#define XB_XGEN(j)  (2304 + 64 * (j))
#define XB_TOP      3328
#define XB_TOPGEN   3392
#define XCD_BAR_WORDS 3456
#define XB_SPIN_CAP (1u << 22)
__device__ __forceinline__ unsigned xb_ld(unsigned* p)              { return __hip_atomic_load(p, __ATOMIC_RELAXED, __HIP_MEMORY_SCOPE_AGENT); }
__device__ __forceinline__ unsigned xb_add(unsigned* p, unsigned v) { return __hip_atomic_fetch_add(p, v, __ATOMIC_RELAXED, __HIP_MEMORY_SCOPE_AGENT); }
__device__ __forceinline__ unsigned xb_xcc_id() { return (unsigned)__builtin_amdgcn_s_getreg((3 << 11) | 20) & 0xFu; }
#define XB_SPIN(cond, bar) do { unsigned _sp = 0; while (cond) { __builtin_amdgcn_s_sleep(1); \
    if ((++_sp & 255u) == 0u) { if (xb_ld(&(bar)[XB_TMO])) break; if (_sp > XB_SPIN_CAP) { atomicAdd(&(bar)[XB_TMO], 1u); break; } } } } while (0)
struct XcdBarrier { unsigned* bar; unsigned x; volatile LAS unsigned* st; };
__device__ __forceinline__ XcdBarrier xcd_barrier_post(unsigned* bar, volatile LAS unsigned* st) {
    XcdBarrier b; b.bar = bar; b.x = xb_xcc_id(); b.st = st;
    if (threadIdx.x == 0) (void)xb_add(&bar[XB_XCNT(b.x)], 1u);
    return b;
}
__device__ __forceinline__ void xcd_barrier_complete(unsigned* bar, unsigned x, unsigned& nloc, unsigned& nx) {
    const unsigned G = gridDim.x * gridDim.y * gridDim.z;
    unsigned sum, cnt, mine, sp = 0u;
    for (;;) {
        sum = 0u; cnt = 0u; mine = 0u;
#pragma unroll
        for (unsigned j = 0; j < 16; ++j) { const unsigned c = xb_ld(&bar[XB_XCNT(j)]); sum += c; cnt += (c > 0u) ? 1u : 0u; mine = (j == x) ? c : mine; }
        if (sum == G) break;
        __builtin_amdgcn_s_sleep(1);
        if ((++sp & 255u) == 0u) { if (xb_ld(&bar[XB_TMO])) break; if (sp > XB_SPIN_CAP) { atomicAdd(&bar[XB_TMO], 1u); break; } }
    }
    nloc = mine > 0u ? mine : 1u; nx = cnt > 0u ? cnt : 1u;
}
__device__ __forceinline__ void xcd_barrier(const XcdBarrier& b) {
    asm volatile("s_waitcnt vmcnt(0)" ::: "memory");
    __syncthreads();
    if (threadIdx.x == 0) {
        unsigned* bar = b.bar;
        __builtin_amdgcn_s_waitcnt(0);
        unsigned nloc = b.st[0], nx = b.st[1];
        if (nloc == 0u) { xcd_barrier_complete(bar, b.x, nloc, nx); b.st[0] = nloc; b.st[1] = nx; }
        const unsigned old = xb_add(&bar[XB_XSUB(b.x)], 1u);
        const unsigned gen = old / nloc;
        if (old + 1u == (gen + 1u) * nloc) {
            __builtin_amdgcn_fence(__ATOMIC_RELEASE, "agent");
            asm volatile("s_waitcnt vmcnt(0)" ::: "memory");
            const unsigned og = xb_add(&bar[XB_TOP], 1u);
            const unsigned tg = og / nx;
            if (og + 1u == (tg + 1u) * nx) xb_add(&bar[XB_TOPGEN], 1u);
            else XB_SPIN(xb_ld(&bar[XB_TOPGEN]) == tg, bar);
            __builtin_amdgcn_fence(__ATOMIC_ACQUIRE, "agent");
            xb_add(&bar[XB_XGEN(b.x)], 1u);
            asm volatile("s_waitcnt vmcnt(0)" ::: "memory");
        } else {
            XB_SPIN(xb_ld(&bar[XB_XGEN(b.x)]) == gen, bar);
            __builtin_amdgcn_fence(__ATOMIC_ACQUIRE, "agent");
            asm volatile("s_waitcnt vmcnt(0)" ::: "memory");
        }
    }
    __syncthreads();
#ifdef ALLWAVE_INV
    __builtin_amdgcn_fence(__ATOMIC_ACQUIRE, "agent"); asm volatile("s_waitcnt vmcnt(0)" ::: "memory");
#endif
}

namespace pg8 {
constexpr int BM = 256, BK = 64, HALF = 128, HTB = HALF * BK * 2, STAGE_BYTES = 8 * HTB;
__host__ __device__ __forceinline__ int lds_byte(int r, int c) { const int st = (r >> 4) * 2 + (c >> 5), rr = r & 15, cc = c & 31, ob = rr * 64 + cc * 2; return st * 1024 + (ob ^ (((ob >> 9) & 1) << 5)); }
__host__ __device__ __forceinline__ void stage_rc(int b, int& R, int& C) { const int st = b / 1024, sb = b % 1024, swz = sb ^ (((sb >> 9) & 1) << 5); R = (st >> 1) * 16 + swz / 64; C = (st & 1) * 32 + (swz % 64) / 2; }
__host__ __device__ __forceinline__ int perm32(int rho) { const int n = rho >> 4, i = rho & 15; return 8 * (i >> 2) + 4 * n + (i & 3); }

struct Unit { int pm, pn, e, j; };

#define PG8_SA(b, h) (((b) * 2 + (h)) * HTB)
#define PG8_SB(b, h) ((4 + (b) * 2 + (h)) * HTB)
#define PG8_STAGE(bufoff, rsrc, soff, voff) do { _Pragma("unroll") for (int _i = 0; _i < 2; ++_i) \
        __builtin_amdgcn_raw_ptr_buffer_load_lds(rsrc, (LAS void*)(lds + (bufoff) + ldsw + _i * 8192), 16, (int)(voff)[_i], (int)(soff), 0, 0); } while (0)
#define PG8_LDA(dst, b, h) do { _Pragma("unroll") for (int m = 0; m < 4; ++m) _Pragma("unroll") for (int k = 0; k < 2; ++k) dst[m][k] = *(const LAS bf16x8*)(lds + PG8_SA(b, h) + aoff + m * 2048 + k * 1024); } while (0)
#define PG8_LDB(dst, b, h) do { _Pragma("unroll") for (int n = 0; n < 2; ++n) _Pragma("unroll") for (int k = 0; k < 2; ++k) dst[n][k] = *(const LAS bf16x8*)(lds + PG8_SB(b, h) + boff + n * 2048 + k * 1024); } while (0)
#define PG8_CAT(x) __builtin_shufflevector(__builtin_bit_cast(i32x4, (x)[0]), __builtin_bit_cast(i32x4, (x)[1]), 0, 1, 2, 3, 4, 5, 6, 7)
#define PG8_MMA(ai, bj, At, Bt) do { __builtin_amdgcn_s_setprio(1); if constexpr (F8) { asm volatile("s_nop 1"); _Pragma("unroll") for (int m = 0; m < 4; ++m) _Pragma("unroll") for (int n = 0; n < 2; ++n) { \
        const i32x8 _b8 = PG8_CAT(Bt[n]), _a8 = PG8_CAT(At[m]); if constexpr (SWAP) asm volatile("v_mfma_f32_16x16x128_f8f6f4 %0, %1, %2, %0" : "+v"(acc[ai][bj][m][n]) : "v"(_a8), "v"(_b8)); \
        else asm volatile("v_mfma_f32_16x16x128_f8f6f4 %0, %1, %2, %0" : "+v"(acc[ai][bj][m][n]) : "v"(_b8), "v"(_a8)); } } else { \
        _Pragma("unroll") for (int m = 0; m < 4; ++m) _Pragma("unroll") for (int n = 0; n < 2; ++n) _Pragma("unroll") for (int k = 0; k < 2; ++k) \
        acc[ai][bj][m][n] = SWAP ? __builtin_amdgcn_mfma_f32_16x16x32_bf16(At[m][k], Bt[n][k], acc[ai][bj][m][n], 0, 0, 0) : __builtin_amdgcn_mfma_f32_16x16x32_bf16(Bt[n][k], At[m][k], acc[ai][bj][m][n], 0, 0, 0); } __builtin_amdgcn_s_setprio(0); } while (0)
#define PG8_ACC_SETTLE() do { _Pragma("unroll") for (int _a = 0; _a < 2; ++_a) _Pragma("unroll") for (int _b = 0; _b < 2; ++_b) \
        asm volatile("s_nop 15\n\ts_nop 7" : "+v"(acc[_a][_b][0][0]), "+v"(acc[_a][_b][0][1]), "+v"(acc[_a][_b][1][0]), "+v"(acc[_a][_b][1][1]), "+v"(acc[_a][_b][2][0]), "+v"(acc[_a][_b][2][1]), "+v"(acc[_a][_b][3][0]), "+v"(acc[_a][_b][3][1])); } while (0)
#define PG8_WAIT_V(n) asm volatile("s_waitcnt vmcnt(" #n ")" ::: "memory")
#define PG8_WAIT_L(n) asm volatile("s_waitcnt lgkmcnt(" #n ")" ::: "memory")
#define PG8_BAR __builtin_amdgcn_s_barrier()
#define PG8_SCHED __builtin_amdgcn_sched_barrier(0)
#define PG8_TRIP(a1, a2, a3, V1h1, V2h0, V2h1, b2, b3) do { \
            PG8_LDB(B0, 0, 0); PG8_SCHED; PG8_LDA(At, 0, 0); PG8_STAGE(PG8_SA(1, 1), rA, (a1) + ahstep, V1h1); \
            PG8_WAIT_L(8); PG8_BAR; PG8_WAIT_L(0); PG8_MMA(0, 0, At, B0); PG8_BAR; PG8_SCHED; \
            PG8_LDB(B1, 0, 1); PG8_STAGE(PG8_SB(0, 0), rB, b2, voffB); \
            PG8_BAR; PG8_WAIT_L(0); PG8_MMA(0, 1, At, B1); PG8_BAR; \
            PG8_LDA(At, 0, 1); PG8_STAGE(PG8_SA(0, 0), rA, a2, V2h0); \
            PG8_BAR; PG8_WAIT_L(0); PG8_MMA(1, 0, At, B0); PG8_BAR; PG8_SCHED; \
            PG8_STAGE(PG8_SB(0, 1), rB, (b2) + hstep, voffB); \
            PG8_WAIT_V(6); PG8_BAR; PG8_MMA(1, 1, At, B1); PG8_BAR; \
            PG8_LDB(B0, 1, 0); PG8_SCHED; PG8_LDA(At, 1, 0); PG8_STAGE(PG8_SA(0, 1), rA, (a2) + ahstep, V2h1); \
            PG8_WAIT_L(8); PG8_BAR; PG8_WAIT_L(0); PG8_MMA(0, 0, At, B0); PG8_BAR; PG8_SCHED; \
            PG8_LDB(B1, 1, 1); PG8_STAGE(PG8_SB(1, 0), rB, b3, voffB); \
            PG8_BAR; PG8_WAIT_L(0); PG8_MMA(0, 1, At, B1); PG8_BAR; \
            PG8_LDA(At, 1, 1); PG8_STAGE(PG8_SA(1, 0), rA, a3, V2h0); \
            PG8_BAR; PG8_WAIT_L(0); PG8_MMA(1, 0, At, B0); PG8_BAR; PG8_SCHED; \
            PG8_STAGE(PG8_SB(1, 1), rB, (b3) + hstep, voffB); \
            PG8_WAIT_V(6); PG8_BAR; PG8_MMA(1, 1, At, B1); PG8_BAR; } while (0)
template <class Epi, class Sched, bool SWAP, bool GATHER, int K, bool F8 = false>
__device__ __forceinline__ void gemm_phase(LAS unsigned char* lds, const int tid, const bf16_t* Abase, const bf16_t* Bbase, const Sched& S, const Epi& E, LAS u32x4* gslots = nullptr) {
    static_assert(!(SWAP && Epi::PERM), "SWAP needs natural B row order");
    const int wid = __builtin_amdgcn_readfirstlane(tid >> 6), lane = tid & 63, wr = wid >> 2, wc = wid & 3, fr = lane & 15, fq = lane >> 4;
    constexpr int nt = K / BK;
    const unsigned long long pa_ = (unsigned long long)Abase, pb_ = (unsigned long long)Bbase;
    const unsigned long long ua_ = ((unsigned long long)(unsigned)__builtin_amdgcn_readfirstlane((int)(pa_ >> 32)) << 32) | (unsigned)__builtin_amdgcn_readfirstlane((int)pa_);
    const unsigned long long ub_ = ((unsigned long long)(unsigned)__builtin_amdgcn_readfirstlane((int)(pb_ >> 32)) << 32) | (unsigned)__builtin_amdgcn_readfirstlane((int)pb_);
    const __amdgpu_buffer_rsrc_t rA = __builtin_amdgcn_make_buffer_rsrc((void*)ua_, 0, 0x7ffffffc, 0x00020000);
    const __amdgpu_buffer_rsrc_t rB = __builtin_amdgcn_make_buffer_rsrc((void*)ub_, 0, 0x7ffffffc, 0x00020000);
    unsigned voffB[2], vA0[2], vA1[2];
#pragma unroll
    for (int i = 0; i < 2; ++i) { int R, C; stage_rc(tid * 16 + i * 8192, R, C); const int Rb = Epi::PERM ? ((R & ~31) + perm32(R & 31)) : R;
        const int Ra = SWAP ? ((R & ~63) | (16 * ((R >> 2) & 3) + 4 * ((R >> 4) & 3) + (R & 3))) : R;
        voffB[i] = (unsigned)(Rb * K + C) * 2u; vA0[i] = (unsigned)(Ra * K + C) * 2u; vA1[i] = vA0[i]; }
    constexpr unsigned kstep = (unsigned)(BK * 2);
    constexpr unsigned hstep = (unsigned)HALF * K * 2;
    constexpr unsigned ahstep = GATHER ? 0u : hstep;
    const unsigned ldsw = (unsigned)wid * 1024u;
    const int aoff = lds_byte(wr * 64 + fr, fq * 8), boff = lds_byte(wc * 32 + fr, fq * 8);
#define PG8_ROWS(d0, d1, u) do { int _t = tid; asm volatile("" : "+v"(_t)); _Pragma("unroll") for (int _i = 0; _i < 2; ++_i) { int _R, _C; stage_rc(_t * 16 + _i * 8192, _R, _C); \
        const int _nr = S.nrows(u); int _x0 = _R < _nr ? _R : _nr - 1, _x1 = (_R + HALF) < _nr ? (_R + HALF) : _nr - 1; const int* _l = S.rows + S.lo(u); \
        d0[_i] = (unsigned)(_l[_x0] * K + _C) * 2u; d1[_i] = (unsigned)(_l[_x1] * K + _C) * 2u; } } while (0)
    Unit cur, nxt; int ui = 0;
    if (!S.next(0, cur)) return;
    f32x4 acc[2][2][4][2];
#pragma unroll
    for (int a = 0; a < 2; ++a)
#pragma unroll
        for (int b = 0; b < 2; ++b)
#pragma unroll
            for (int m = 0; m < 4; ++m)
#pragma unroll
                for (int n = 0; n < 2; ++n) acc[a][b][m][n] = (f32x4){0.f, 0.f, 0.f, 0.f};
    bf16x8 At[4][2], B0[2][2], B1[2][2];
    unsigned cA = S.aoff(cur), cB = S.boff(cur);
    if constexpr (GATHER) { PG8_ROWS(vA0, vA1, cur); gslots[tid] = (u32x4){vA0[0], vA0[1], vA1[0], vA1[1]}; }
    PG8_STAGE(PG8_SB(0, 0), rB, cB, voffB); PG8_STAGE(PG8_SA(0, 0), rA, cA, vA0); PG8_STAGE(PG8_SB(0, 1), rB, cB + hstep, voffB); PG8_STAGE(PG8_SA(0, 1), rA, cA + ahstep, vA1);
    if (wr == 1) PG8_BAR;
    PG8_WAIT_V(4); PG8_BAR;
    PG8_STAGE(PG8_SB(1, 0), rB, cB + kstep, voffB); PG8_STAGE(PG8_SA(1, 0), rA, cA + kstep, vA0); PG8_STAGE(PG8_SB(1, 1), rB, cB + hstep + kstep, voffB);
    PG8_WAIT_V(6); PG8_BAR;
    for (;;) {
        const bool has_next = S.next(ui + 1, nxt);
        const unsigned nA = has_next ? S.aoff(nxt) : cA, nB = has_next ? S.boff(nxt) : cB;
        int nrow0[2] = {0, 0}, nrow1[2] = {0, 0};
        if constexpr (GATHER) { if (has_next) { int _t = tid; asm volatile("" : "+v"(_t)); _Pragma("unroll") for (int _i = 0; _i < 2; ++_i) { int _R, _C; stage_rc(_t * 16 + _i * 8192, _R, _C);
            const int _nr = S.nrows(nxt); const int _x0 = _R < _nr ? _R : _nr - 1, _x1 = (_R + HALF) < _nr ? (_R + HALF) : _nr - 1; const int* _l = S.rows + S.lo(nxt); nrow0[_i] = _l[_x0]; nrow1[_i] = _l[_x1]; } } }
#pragma unroll 1
        for (int t = 0; t < nt; t += 2) {
            const bool last = (t == nt - 2);
            const unsigned a1 = cA + (unsigned)(t + 1) * kstep;
            const unsigned a2 = last ? nA : cA + (unsigned)(t + 2) * kstep, b2 = last ? nB : cB + (unsigned)(t + 2) * kstep;
            if constexpr (!GATHER) {
                PG8_TRIP(a1, a2, a2 + kstep, vA0, vA0, vA0, b2, b2 + kstep);
            } else {
                const int par = ui & 1;
                if (last && has_next) { unsigned n0[2], n1[2]; int _t = tid; asm volatile("" : "+v"(_t));
                    _Pragma("unroll") for (int _i = 0; _i < 2; ++_i) { int _R, _C; stage_rc(_t * 16 + _i * 8192, _R, _C); n0[_i] = (unsigned)(nrow0[_i] * K + _C) * 2u; n1[_i] = (unsigned)(nrow1[_i] * K + _C) * 2u; }
                    gslots[(par ^ 1) * 512 + tid] = (u32x4){n0[0], n0[1], n1[0], n1[1]}; }
                const u32x4 vc = gslots[par * 512 + tid], vn = gslots[((last && has_next) ? (par ^ 1) : par) * 512 + tid];
                const unsigned c1[2] = {vc.z, vc.w}, n0[2] = {vn.x, vn.y}, n1[2] = {vn.z, vn.w};
                PG8_TRIP(a1, a2, a2 + kstep, c1, n0, n1, b2, b2 + kstep);
            }
        }
        if constexpr (F8) PG8_ACC_SETTLE();
        E(acc, cur, wr, wc, fr, fq);
        if (!has_next) break;
#pragma unroll
        for (int a = 0; a < 2; ++a)
#pragma unroll
            for (int b = 0; b < 2; ++b)
#pragma unroll
                for (int m = 0; m < 4; ++m)
#pragma unroll
                    for (int n = 0; n < 2; ++n) acc[a][b][m][n] = (f32x4){0.f, 0.f, 0.f, 0.f};
        cur = nxt; cA = nA; cB = nB; ++ui;
    }
    PG8_WAIT_V(0);
    if (wr == 0) PG8_BAR;
    PG8_BAR;
#undef PG8_ROWS
}
}

struct Args { const float* in[24]; float* out; unsigned char* ws; long long pass; };
enum { I_X = 0, I_NORM_MIX_G, I_W_IN, I_CQ_G, I_CKV_G, I_KIDX_G, I_W_UQ, I_W_QIDX, I_W_UK, I_W_UV, I_T5, I_W_BA, I_W_BB, I_W_OUT, I_NORM_FFN_G, I_W_ROUTER, I_B_ROUTER,
       I_W_GATE, I_B_GATE, I_W_UP, I_B_UP, I_W_DOWN, I_B_DOWN, I_NORM_FINAL_G };

constexpr int LDS_STAGE = 0, LDS_MISC = 131072, LDS_BYTES = 163840;
constexpr int LM_BAR = 0;
constexpr int LM_TEND = 64;
constexpr int LM_CNT = 192;
constexpr int LM_PSTART = 320;
constexpr int LM_LCNT = 448;
constexpr int LM_GBASE = 576;
constexpr int LM_REC = 1024;
constexpr int LM_SCR = 9216;
constexpr int LM_SLOTS = 1024;
constexpr int LM_TILE = 27648;

struct Frame { LAS unsigned char* lds; LAS unsigned char* misc; int tid, lane, wave, G, bid; };
#define GAS __attribute__((address_space(1)))
typedef const __attribute__((address_space(4))) Args CArgs;
typedef CArgs& ArgsRef;
#define WS(a) ((unsigned char*)(GAS unsigned char*)(a).ws)
#define OUT(a) ((float*)(GAS float*)(a).out)
#define IN(a, i) ((const float*)(GAS const float*)(a).in[i])
__device__ __forceinline__ ArgsRef phase_args() { CArgs* ap = (CArgs*)__builtin_amdgcn_kernarg_segment_ptr(); asm volatile("" : "+s"(ap)); return *ap; }
__device__ __forceinline__ Frame make_frame(unsigned char* lds_raw) {
    Frame F; int tid = threadIdx.x; asm volatile("" : "+v"(tid)); int bid = blockIdx.x; asm volatile("" : "+s"(bid)); int G = gridDim.x; asm volatile("" : "+s"(G));
    F.lds = (LAS unsigned char*)lds_raw; F.misc = F.lds + LDS_MISC; F.tid = tid; F.lane = tid & 63; F.wave = __builtin_amdgcn_readfirstlane(tid >> 6); F.G = G; F.bid = bid; return F;
}

struct DenseOrder {
    int nM, nN, nwg, G, c, K; size_t a0, b0;
    __device__ __forceinline__ void init(int M, int N, int K_, int G_, int c_, size_t a0_ = 0, size_t b0_ = 0) { nM = M / 256; nN = N / 256; nwg = nM * nN; G = G_; c = c_; K = K_; a0 = a0_; b0 = b0_; }
    __device__ __forceinline__ bool next(int i, pg8::Unit& u) const {
        const long L = (long)i * G + c; if (L >= nwg) return false;
        int wgid = (int)L; { const int q = nwg / 8, r = nwg % 8, xcd = wgid % 8, off = wgid / 8; wgid = (xcd < r ? xcd * (q + 1) : r * (q + 1) + (xcd - r) * q) + off; }
        const int nig = 8 * nN, gid = wgid / nig, fm = gid * 8, gsz = (nM - fm) < 8 ? (nM - fm) : 8;
        u.pm = fm + ((wgid % nig) % gsz); u.pn = (wgid % nig) / gsz; u.e = 0; u.j = 0; return true;
    }
    __device__ __forceinline__ unsigned aoff(const pg8::Unit& u) const { return (unsigned)(a0 + (size_t)u.pm * 256 * K * 2); }
    __device__ __forceinline__ unsigned boff(const pg8::Unit& u) const { return (unsigned)(b0 + (size_t)u.pn * 256 * K * 2); }
};
template <int NPN, bool GATHER, int ROWB = 2048> struct MoeOrder {
    const LAS int* tile_e; const LAS int* cnt; const int* rows; int ntiles, G, c;
    __device__ __forceinline__ bool next(int i, pg8::Unit& u) const {
        int pm, pn;
        if (G == 256) {
            constexpr int PMG = 32 / NPN; const int xcd = c & 7, slot = c >> 3;
            pm = (i * 8 + xcd) * PMG + slot / NPN; pn = slot % NPN; if (pm >= ntiles) return false; }
        else { const int L = i * G + c; if (L >= ntiles * NPN) return false; pm = L / NPN; pn = L % NPN; }
        const int ej = __builtin_amdgcn_readfirstlane(tile_e[pm]);
        u.pm = pm; u.pn = pn; u.e = ej >> 16; u.j = ej & 0xffff; return true;
    }
    __device__ __forceinline__ int nrows(const pg8::Unit& u) const { int nr = __builtin_amdgcn_readfirstlane(cnt[u.e]) - 256 * u.j; return nr > 256 ? 256 : nr; }
    __device__ __forceinline__ int lo(const pg8::Unit& u) const { return u.e * LIST_CAP + 256 * u.j; }
    __device__ __forceinline__ unsigned aoff(const pg8::Unit& u) const { return GATHER ? 0u : (unsigned)u.pm * 256u * (unsigned)ROWB; }
    __device__ __forceinline__ unsigned boff(const pg8::Unit& u) const { return (unsigned)(u.e * NPN + u.pn) * 256u * (unsigned)ROWB; }
};

struct EpiGateUp { static constexpr bool PERM = true;
    bf16_t* act; const float* bgate; const float* bup; const float* lrs; const LAS int* cnt;
    __device__ __forceinline__ void operator()(const f32x4 (&acc)[2][2][4][2], const pg8::Unit& u, int wr, int wc, int fr, int fq) const {
        const int f0 = 128 * u.pn + 32 * wc + 8 * fq; const float* rsl = lrs + u.e * LIST_CAP + 256 * u.j; const int nrows = cnt[u.e] - 256 * u.j;
        f32x4 bg[2], bu[2]; float rsv[2][4];
#pragma unroll
        for (int n = 0; n < 2; ++n) { bg[n] = *(const f32x4*)(bgate + u.e * FF + f0 + 4 * n); bu[n] = *(const f32x4*)(bup + u.e * FF + f0 + 4 * n); }
#pragma unroll
        for (int ai = 0; ai < 2; ++ai)
#pragma unroll
            for (int m = 0; m < 4; ++m) rsv[ai][m] = rsl[128 * ai + 64 * wr + 16 * m + fr];
#pragma unroll
        for (int ai = 0; ai < 2; ++ai)
#pragma unroll
            for (int m = 0; m < 4; ++m) { const int r = 128 * ai + 64 * wr + 16 * m + fr; const float rs = r < nrows ? rsv[ai][m] * (MOE_FP8 ? W8_INV : 1.f) : 0.f;
                float a[8];
#pragma unroll
                for (int n = 0; n < 2; ++n)
#pragma unroll
                    for (int i = 0; i < 4; i += 2) {
                        const f32x2 ag = {acc[ai][0][m][n][i], acc[ai][0][m][n][i + 1]}, au = {acc[ai][1][m][n][i], acc[ai][1][m][n][i + 1]};
                        const f32x2 bg2 = {bg[n][i], bg[n][i + 1]}, bu2 = {bu[n][i], bu[n][i + 1]}, rs2 = {rs, rs};
                        f32x2 g = ag * rs2 + bg2, up = au * rs2 + bu2;
                        g[0] = fminf(g[0], 7.f); g[1] = fminf(g[1], 7.f); up[0] = fminf(fmaxf(up[0], -7.f), 7.f); up[1] = fminf(fmaxf(up[1], -7.f), 7.f);
                        const f32x2 ar = g * (f32x2){-1.702f * 1.4426950408889634f, -1.702f * 1.4426950408889634f};
                        f32x2 den = {__builtin_amdgcn_exp2f(ar[0]), __builtin_amdgcn_exp2f(ar[1])}; den = den + (f32x2){1.f, 1.f};
                        const f32x2 sg = {__builtin_amdgcn_rcpf(den[0]), __builtin_amdgcn_rcpf(den[1])};
                        const f32x2 res = (g * sg) * (up + (f32x2){1.f, 1.f});
                        a[4 * n + i] = res[0]; a[4 * n + i + 1] = res[1]; }
                if constexpr (MOE_FP8) { u32x2 w8; w8.x = pk4_fp8(a[0], a[1], a[2], a[3]); w8.y = pk4_fp8(a[4], a[5], a[6], a[7]); *(u32x2*)((unsigned char*)act + ((size_t)u.pm * 256 + r) * FF + f0) = w8; }
                else { u32x4 w; w.x = cvt_pk_bf16(a[0], a[1]); w.y = cvt_pk_bf16(a[2], a[3]); w.z = cvt_pk_bf16(a[4], a[5]); w.w = cvt_pk_bf16(a[6], a[7]);
                *(u32x4*)(act + ((size_t)u.pm * 256 + r) * FF + f0) = w; } }
    }
};
struct EpiDown { static constexpr bool PERM = true;
    bf16_t* y; const float* bdown;
    __device__ __forceinline__ void operator()(const f32x4 (&acc)[2][2][4][2], const pg8::Unit& u, int wr, int wc, int fr, int fq) const {
        const int c0 = 256 * u.pn + 32 * wc + 8 * fq;
        f32x4 bv[2][2];
#pragma unroll
        for (int bj = 0; bj < 2; ++bj)
#pragma unroll
            for (int n = 0; n < 2; ++n) bv[bj][n] = *(const f32x4*)(bdown + u.e * D + c0 + 128 * bj + 4 * n);
#pragma unroll
        for (int ai = 0; ai < 2; ++ai)
#pragma unroll
            for (int m = 0; m < 4; ++m) { const int r = 128 * ai + 64 * wr + 16 * m + fr;
#pragma unroll
                for (int bj = 0; bj < 2; ++bj) { const f32x4 v0 = acc[ai][bj][m][0] * (MOE_FP8 ? W8_INV : 1.f) + bv[bj][0], v1 = acc[ai][bj][m][1] * (MOE_FP8 ? W8_INV : 1.f) + bv[bj][1];
                    if constexpr (Y_FP8) { u32x2 w8; w8.x = pk4_fp8(v0[0], v0[1], v0[2], v0[3]); w8.y = pk4_fp8(v1[0], v1[1], v1[2], v1[3]); *(u32x2*)((unsigned char*)y + ((size_t)u.pm * 256 + r) * D + c0 + 128 * bj) = w8; }
                    else { u32x4 w; w.x = cvt_pk_bf16(v0[0], v0[1]); w.y = cvt_pk_bf16(v0[2], v0[3]); w.z = cvt_pk_bf16(v1[0], v1[1]); w.w = cvt_pk_bf16(v1[2], v1[3]);
                    *(u32x4*)(y + ((size_t)u.pm * 256 + r) * D + c0 + 128 * bj) = w; } } }
    }
};

struct EpiProbe { static constexpr bool PERM = true;
    float* sink;
    __device__ __forceinline__ void operator()(const f32x4 (&acc)[2][2][4][2], const pg8::Unit& u, int wr, int wc, int fr, int fq) const {
        float s = 0.f;
#pragma unroll
        for (int ai = 0; ai < 2; ++ai)
#pragma unroll
            for (int bj = 0; bj < 2; ++bj)
#pragma unroll
                for (int m = 0; m < 4; ++m)
#pragma unroll
                    for (int n = 0; n < 2; ++n) s += acc[ai][bj][m][n][0];
        if (s != s) sink[u.pm] = s;
    }
};
template <bool F8 = false> __device__ __forceinline__ void transpose_item64(const float* W, int ldw, int Kd, bf16_t* WT, long dst_row0, const float* g, LAS float* scr, int k0, int srccol, int lane) {
    float v[64];
#pragma unroll
    for (int kk = 0; kk < 64; ++kk) v[kk] = srccol >= 0 ? W[(size_t)(k0 + kk) * ldw + srccol] : 0.f;
    if (g) {
#pragma unroll
        for (int kk = 0; kk < 64; kk += 4) { const f32x4 gg = *(const f32x4*)(g + k0 + kk); v[kk] *= gg[0]; v[kk + 1] *= gg[1]; v[kk + 2] *= gg[2]; v[kk + 3] *= gg[3]; } }
#pragma unroll
    for (int kk = 0; kk < 64; ++kk) scr[lane * 65 + kk] = v[kk];
    LDS_WAIT(); asm volatile("" ::: "memory");
    const int c = lane & 7;
#pragma unroll
    for (int j = 0; j < 8; ++j) { const int n = (lane >> 3) + 8 * j; const LAS float* sp = scr + n * 65 + 8 * c;
        if constexpr (F8) { u32x2 o8; o8.x = pk4_fp8(sp[0] * W8_SCALE, sp[1] * W8_SCALE, sp[2] * W8_SCALE, sp[3] * W8_SCALE); o8.y = pk4_fp8(sp[4] * W8_SCALE, sp[5] * W8_SCALE, sp[6] * W8_SCALE, sp[7] * W8_SCALE);
            *(u32x2*)((unsigned char*)WT + (size_t)(dst_row0 + n) * Kd + k0 + 8 * c) = o8; }
        else { u32x4 o; o.x = pk2(sp[0], sp[1]); o.y = pk2(sp[2], sp[3]); o.z = pk2(sp[4], sp[5]); o.w = pk2(sp[6], sp[7]);
        *(u32x4*)(WT + (size_t)(dst_row0 + n) * Kd + k0 + 8 * c) = o; } }
    LDS_WAIT(); asm volatile("" ::: "memory");
}

__device__ __forceinline__ void moe_weight_convert(const Frame& F, ArgsRef a) {
    LAS float* scr = (LAS float*)(F.wave < 7 ? F.lds + LDS_STAGE + F.wave * 16640 : F.misc + 4096);
    const int gw = F.bid * 8 + F.wave, NGW = F.G * 8;
    const float* gffn = IN(a, I_NORM_FFN_G);
    bf16_t* wgu = (bf16_t*)(WS(a) + WS_WGU); bf16_t* wd = (bf16_t*)(WS(a) + WS_WD);
    constexpr int KB = MOE_FP8 ? 2 : 1, PER = (16 / KB) * 16;
    for (int it = gw; it < 3 * NE * PER; it += NGW) {
        const int mat = it / (NE * PER), r = it % (NE * PER), e = r / PER, q = r % PER, kb0 = (q / 16) * KB, nb = q % 16;
#pragma unroll 1
        for (int kk = 0; kk < KB; ++kk) { const int kb = kb0 + kk;
            if (mat < 2) { const float* W = IN(a, mat == 0 ? I_W_GATE : I_W_UP) + (size_t)e * D * FF;
                const long row = (long)e * 2048 + (nb / 2) * 256 + (mat ? 128 : 0) + (nb % 2) * 64;
                transpose_item64<MOE_FP8>(W, FF, D, wgu, row, gffn, scr, 64 * kb, 64 * nb + F.lane, F.lane);
            } else { const float* W = IN(a, I_W_DOWN) + (size_t)e * FF * D;
                transpose_item64<MOE_FP8>(W, D, FF, wd, (long)e * 1024 + 64 * nb, nullptr, scr, 64 * kb, 64 * nb + F.lane, F.lane); } }
    }
}
__device__ __forceinline__ void router_weight_prep(const Frame& F, ArgsRef a) {
    bf16_t* whi = (bf16_t*)(WS(a) + WS_MISC + MISC_RW_HI); bf16_t* wlo = (bf16_t*)(WS(a) + WS_MISC + MISC_RW_LO);
    const float* wr = IN(a, I_W_ROUTER); const float* g = IN(a, I_NORM_FFN_G);
    for (int i = F.bid * 512 + F.tid; i < NE * D; i += F.G * 512) { const int e = i / D, k = i % D; const float v = g[k] * wr[k * NE + e];
        const unsigned h = f2bf(v); const float r = v - bf2f(h); whi[i] = (bf16_t)h; wlo[i] = (bf16_t)f2bf(r); }
}
__device__ __forceinline__ void copy_x_phase(const Frame& F, ArgsRef a) {
    const int gw = F.bid * 8 + F.wave, NGW = F.G * 8; bf16_t* x2b = (bf16_t*)(WS(a) + WS_X2B);
    for (int t = gw; t < T; t += NGW) { const f32x4* xr = (const f32x4*)(IN(a, I_X) + (size_t)t * D) + F.lane; f32x4* o = (f32x4*)(OUT(a) + (size_t)t * D) + F.lane; u32x2* ob = (u32x2*)(x2b + (size_t)t * D) + F.lane;
#pragma unroll
        for (int j = 0; j < 4; ++j) { const f32x4 v = xr[64 * j]; o[64 * j] = v; u32x2 w; w.x = pk2(v[0], v[1]); w.y = pk2(v[2], v[3]); ob[64 * j] = w; } }
}
__device__ __forceinline__ void router_phase(const Frame& F, ArgsRef a) {
    LAS int* lcnt = (LAS int*)(F.misc + LM_LCNT); LAS int* gbase = (LAS int*)(F.misc + LM_GBASE);
    LAS int* rec_e = (LAS int*)(F.misc + LM_REC); LAS int* rec_p = rec_e + 512; LAS float* rec_w = (LAS float*)(rec_p + 512); LAS float* rec_rs = rec_w + 512; LAS float* scr = (LAS float*)(F.misc + LM_SCR + F.wave * 2304);
    const bf16_t* whi = (const bf16_t*)(WS(a) + WS_MISC + MISC_RW_HI); const bf16_t* wlo = (const bf16_t*)(WS(a) + WS_MISC + MISC_RW_LO);
    unsigned* gcnt = (unsigned*)(WS(a) + WS_CTL) + CW_CNT;
    const float* x2 = X2H ? (const float*)(WS(a) + WS_X2H) : OUT(a); const float* brt = IN(a, I_B_ROUTER);
    const unsigned long long px_ = (unsigned long long)x2; const unsigned long long ux_ = ((unsigned long long)(unsigned)__builtin_amdgcn_readfirstlane((int)(px_ >> 32)) << 32) | (unsigned)__builtin_amdgcn_readfirstlane((int)px_);
    const __amdgpu_buffer_rsrc_t x2rsrc = __builtin_amdgcn_make_buffer_rsrc((void*)ux_, 0, 0x7ffffffc, 0x00020000);
    u32x4* grec = (u32x4*)(WS(a) + WS_REC); int* ltok = (int*)(WS(a) + WS_LTOK); float* lrs = (float*)(WS(a) + WS_LRS);
    const int fr = F.lane & 15, fq = F.lane >> 4;
    LAS unsigned char* wl_lds = F.lds + LDS_STAGE;
    __syncthreads();
    for (int i = F.tid; i < 8192; i += 512) { const int arr = i >> 12, row = (i >> 7) & 31, ch = i & 127; const f32x4 v = *(const f32x4*)((arr ? wlo : whi) + (size_t)row * D + ch * 8);
        *(LAS f32x4*)(wl_lds + arr * 65536 + row * 2048 + ((ch ^ (row & 7)) << 4)) = v; }
    __syncthreads();
#if defined(DIAG2) && (DIAG2 == 29 || DIAG2 == 30 || DIAG2 == 31)
    { unsigned* dbgA = (unsigned*)(WS(a) + WS_CTL + 640 * 1024); unsigned* nb = (unsigned*)(WS(a) + WS_CTL) + 16384; unsigned sm = 0u;
      for (int i = F.lane; i < 4096; i += 64) sm += ((const LAS unsigned*)(wl_lds + F.wave * 16384))[i] * (unsigned)(2 * i + 1);
      for (int o = 1; o < 64; o <<= 1) sm += __shfl_xor(sm, o);
      if (F.lane == 0) { if (a.pass == 0) dbgA[F.bid * 8 + F.wave] = sm; else if (dbgA[F.bid * 8 + F.wave] != sm) atomicAdd(nb + 64 * 1, 1u); } }
#endif
    for (int grp = F.bid; grp < T / 128; grp += F.G) {
        if (F.tid < 32) lcnt[F.tid] = 0;
        __syncthreads();
        const int t0 = grp * 128 + F.wave * 16;
        f32x4 acc0 = {0.f, 0.f, 0.f, 0.f}, acc1 = {0.f, 0.f, 0.f, 0.f}; float ssq = 0.f;
        const float* xr = x2 + (size_t)(t0 + fr) * D + 8 * fq;
#pragma unroll 1
        for (int k8 = 0; k8 < 4; ++k8) {
            f32x4 xa[8], xb[8]; u32x4 xh[8];
#pragma unroll
            for (int u = 0; u < 8; ++u) {
                if constexpr (X2H) { const unsigned vo = (unsigned)(t0 + fr) * 2048u + 16u * fq + 64u * (8 * k8 + u); xh[u] = __builtin_amdgcn_raw_buffer_load_b128(x2rsrc, vo, 0, 16); }
                else { const unsigned vo = (unsigned)(t0 + fr) * 4096u + 32u * fq + 128u * (8 * k8 + u);
                xa[u] = __builtin_bit_cast(f32x4, __builtin_amdgcn_raw_buffer_load_b128(x2rsrc, vo, 0, 16)); xb[u] = __builtin_bit_cast(f32x4, __builtin_amdgcn_raw_buffer_load_b128(x2rsrc, vo + 16u, 0, 16)); } }

#pragma unroll
            for (int u = 0; u < 8; ++u) { const int ks = 8 * k8 + u; bf16x8 ah, al;
                if constexpr (X2H) { const u32x4 hw = xh[u]; const unsigned h0 = hw.x, h1 = hw.y, h2 = hw.z, h3 = hw.w; ah = __builtin_bit_cast(bf16x8, hw);
                    const float e0 = bf2f(h0 & 0xffffu), e1 = bf2f(h0 >> 16), e2 = bf2f(h1 & 0xffffu), e3 = bf2f(h1 >> 16), e4 = bf2f(h2 & 0xffffu), e5 = bf2f(h2 >> 16), e6 = bf2f(h3 & 0xffffu), e7 = bf2f(h3 >> 16);
                    ssq += (e0 * e0 + e1 * e1) + (e2 * e2 + e3 * e3) + (e4 * e4 + e5 * e5) + (e6 * e6 + e7 * e7); al = ah; }
                else { const f32x4 v0 = xa[u], v1 = xb[u];
                ssq += (v0[0] * v0[0] + v0[1] * v0[1]) + (v0[2] * v0[2] + v0[3] * v0[3]) + (v1[0] * v1[0] + v1[1] * v1[1]) + (v1[2] * v1[2] + v1[3] * v1[3]);
                float xv[8] = {v0[0], v0[1], v0[2], v0[3], v1[0], v1[1], v1[2], v1[3]};
#pragma unroll
                for (int j = 0; j < 8; ++j) { const unsigned h = f2bf(xv[j]); ah[j] = (short)h; al[j] = (short)f2bf(xv[j] - bf2f(h)); } }
                const int ch = 4 * ks + fq;
                const LAS unsigned char* w0 = wl_lds + fr * 2048 + ((ch ^ (fr & 7)) << 4); const LAS unsigned char* w1 = wl_lds + (16 + fr) * 2048 + ((ch ^ (fr & 7)) << 4);
                const bf16x8 bh0 = *(const LAS bf16x8*)w0, bh1 = *(const LAS bf16x8*)w1, bl0 = *(const LAS bf16x8*)(w0 + 65536), bl1 = *(const LAS bf16x8*)(w1 + 65536);
                acc0 = __builtin_amdgcn_mfma_f32_16x16x32_bf16(ah, bh0, acc0, 0, 0, 0); if constexpr (!X2H) acc0 = __builtin_amdgcn_mfma_f32_16x16x32_bf16(al, bh0, acc0, 0, 0, 0); acc0 = __builtin_amdgcn_mfma_f32_16x16x32_bf16(ah, bl0, acc0, 0, 0, 0);
                acc1 = __builtin_amdgcn_mfma_f32_16x16x32_bf16(ah, bh1, acc1, 0, 0, 0); if constexpr (!X2H) acc1 = __builtin_amdgcn_mfma_f32_16x16x32_bf16(al, bh1, acc1, 0, 0, 0); acc1 = __builtin_amdgcn_mfma_f32_16x16x32_bf16(ah, bl1, acc1, 0, 0, 0); } }
        ssq += __shfl_xor(ssq, 16); ssq += __shfl_xor(ssq, 32);
#if defined(DIAG2) && (DIAG2 >= 32 && DIAG2 <= 40)
        { float s2 = 0.f; for (int ks = 0; ks < 32; ++ks) for (int j = 0; j < 8; ++j) { const unsigned w = __hip_atomic_load((const unsigned*)(xr + 32 * ks + j), __ATOMIC_RELAXED, DIAG2 == 32 ? __HIP_MEMORY_SCOPE_SYSTEM : __HIP_MEMORY_SCOPE_AGENT); const float f = __uint_as_float(w); s2 += f * f; }
          s2 += __shfl_xor(s2, 16); s2 += __shfl_xor(s2, 32);
          const float rel = fabsf(s2 - ssq) / (fabsf(ssq) + 1e-20f);
          if (F.lane < 16 && !(rel < 1e-3f)) { unsigned* nb_ = (unsigned*)(WS(a) + WS_CTL) + 16384; atomicAdd(nb_ + 64 * 3, 1u); const int t_ = t0 + F.lane;
              if (a.pass == 1) { if (ssq == 0.f) atomicAdd(nb_ + 64 * 11, 1u); else if (s2 == 0.f) atomicAdd(nb_ + 64 * 12, 1u); else atomicAdd(nb_ + 64 * 13, 1u); }
              atomicOr(nb_ + 64 * 4, 1u << (t_ & 15)); atomicOr(nb_ + 64 * 5, 1u << ((t_ >> 4) & 7)); atomicOr(nb_ + 64 * 6, 1u << ((t_ >> 7) & 31)); atomicOr(nb_ + 64 * 7, 1u << ((t_ >> 12) & 7)); } }
#endif
        const float rstd = 1.0f / sqrtf(ssq * (1.0f / D) + RMS_EPS);
#pragma unroll
        for (int r = 0; r < 4; ++r) { scr[(4 * fq + r) * 36 + fr] = acc0[r]; scr[(4 * fq + r) * 36 + 16 + fr] = acc1[r]; }
        LDS_WAIT(); asm volatile("" ::: "memory");
        if (F.lane < 16) {
            float v[32];
#pragma unroll
            for (int e = 0; e < 32; ++e) v[e] = scr[F.lane * 36 + e] * rstd + brt[e];
#if defined(DIAG2) && (DIAG2 == 29 || DIAG2 == 30 || DIAG2 == 31)
            { unsigned* dbgB = (unsigned*)(WS(a) + WS_CTL + 704 * 1024); unsigned* nb = (unsigned*)(WS(a) + WS_CTL) + 16384; unsigned sm = 0u;
              for (int e = 0; e < 32; ++e) sm = sm * 31u + __float_as_uint(v[e]);
              const int t_ = t0 + F.lane; if (a.pass == 0) dbgB[t_] = sm; else if (dbgB[t_] != sm) atomicAdd(nb + 64 * 2, 1u);
              unsigned s2 = __float_as_uint(rstd); unsigned* dbgC = dbgB + 32768; if (a.pass == 0) dbgC[t_] = s2; else if (dbgC[t_] != s2) atomicAdd(nb + 64 * 3, 1u); }
#endif
            float tv[4]; int ti[4];
#pragma unroll
            for (int k = 0; k < 4; ++k) { float best = v[0]; int bi = 0;
#pragma unroll
                for (int e = 1; e < 32; ++e) if (v[e] > best) { best = v[e]; bi = e; }
                tv[k] = best; ti[k] = bi;
#pragma unroll
                for (int e = 0; e < 32; ++e) v[e] = (e == bi) ? -3.0e38f : v[e]; }
            float ex[4], sum = 0.f;
#pragma unroll
            for (int k = 0; k < 4; ++k) { ex[k] = __expf(tv[k] - tv[0]); sum += ex[k]; }
            const float inv = 1.0f / sum;
#pragma unroll
            for (int k = 0; k < 4; ++k) { const int lp = atomicAdd((int*)(lcnt + ti[k]), 1); const int ri = (F.wave * 16 + F.lane) * 4 + k;
                rec_e[ri] = ti[k]; rec_p[ri] = lp; rec_w[ri] = ex[k] * inv; }
            rec_rs[F.wave * 16 + F.lane] = rstd;
        }
        __syncthreads();
        const int half = (grp * 128) / HALF_T;
        if (F.tid < 32) gbase[F.tid] = (int)atomicAdd(gcnt + half * 32 + F.tid, (unsigned)lcnt[F.tid]);
        __syncthreads();
        { const int e = rec_e[F.tid], pos = gbase[e] + rec_p[F.tid], t = grp * 128 + (F.tid >> 2); const float w = rec_w[F.tid], rs = rec_rs[F.tid >> 2];
            float* gr = (float*)(grec + (size_t)t * 4 + (F.tid & 3)); ((int*)gr)[0] = e; ((int*)gr)[1] = pos; gr[2] = w; gr[3] = 0.f;
            const size_t li = ((size_t)half * NE + e) * LIST_CAP + pos; ltok[li] = t; lrs[li] = rs; }
        __syncthreads();
    }
}
__device__ __forceinline__ int moe_tables(const Frame& F, ArgsRef a, int half) {
    LAS int* tend = (LAS int*)(F.misc + LM_TEND); LAS int* cnt = (LAS int*)(F.misc + LM_CNT); LAS int* pstart = (LAS int*)(F.misc + LM_PSTART);
    const unsigned* gcnt = (const unsigned*)(WS(a) + WS_CTL) + CW_CNT + half * 32;
    __syncthreads();
    if (F.tid < 32) cnt[F.tid] = (int)__hip_atomic_load(gcnt + F.tid, __ATOMIC_RELAXED, __HIP_MEMORY_SCOPE_AGENT);
    __syncthreads();
    if (F.tid == 0) { int acc = 0; for (int e = 0; e < NE; ++e) { pstart[e] = acc * 256; acc += (cnt[e] + 255) >> 8; tend[e] = acc; } }
    __syncthreads();
    { LAS int* tile_e = (LAS int*)(F.misc + LM_TILE); for (int ti = F.tid; ti < 576; ti += 512) { int e = 0; while (e < NE - 1 && ti >= tend[e]) ++e; const int t0 = e ? tend[e - 1] : 0; tile_e[ti] = (e << 16) | (ti - t0); } }
    __syncthreads();
    return __builtin_amdgcn_readfirstlane(tend[NE - 1]);
}
__device__ __forceinline__ void combine_phase(const Frame& F, ArgsRef a, int half) {
    const LAS int* pstart = (const LAS int*)(F.misc + LM_PSTART);
    const u32x4* grec = (const u32x4*)(WS(a) + WS_REC); const bf16_t* y = (const bf16_t*)(WS(a) + WS_Y); const float* gfin = IN(a, I_NORM_FINAL_G);
    const int gw = F.bid * 8 + F.wave, NGW = F.G * 8;
    for (int tb2 = half * HALF_T + gw * 2; tb2 < (half + 1) * HALF_T; tb2 += NGW * 2) {
        int slot[2][4]; float rw[2][4];
#pragma unroll
        for (int u = 0; u < 2; ++u)
#pragma unroll
            for (int k = 0; k < 4; ++k) { const int* ri = (const int*)(grec + (size_t)(tb2 + u) * 4 + k); const int re = ri[0], rp = ri[1]; rw[u][k] = ((const float*)ri)[2]; slot[u][k] = pstart[re] + rp; }
        f32x4 v[2][4]; u32x2 yv[2][4][4];
#pragma unroll
        for (int u = 0; u < 2; ++u) {
            if constexpr (X2H) { const u32x2* xh = (const u32x2*)((const bf16_t*)(WS(a) + WS_X2H) + (size_t)(tb2 + u) * D) + F.lane;
#pragma unroll
                for (int j = 0; j < 4; ++j) { const u32x2 hw = xh[64 * j]; const unsigned h0 = hw.x, h1 = hw.y; v[u][j] = (f32x4){bf2f(h0 & 0xffffu), bf2f(h0 >> 16), bf2f(h1 & 0xffffu), bf2f(h1 >> 16)}; } }
            else { const f32x4* xr = (const f32x4*)(OUT(a) + (size_t)(tb2 + u) * D) + F.lane;
#pragma unroll
            for (int j = 0; j < 4; ++j) v[u][j] = xr[64 * j]; }
#pragma unroll
            for (int k = 0; k < 4; ++k) {
                if constexpr (Y_FP8) { const unsigned* yr = (const unsigned*)((const unsigned char*)y + (size_t)slot[u][k] * D) + F.lane;
#pragma unroll
                    for (int j = 0; j < 4; ++j) { yv[u][k][j].x = yr[64 * j]; yv[u][k][j].y = 0u; } }
                else { const u32x2* yr = (const u32x2*)(y + (size_t)slot[u][k] * D) + F.lane;
#pragma unroll
                    for (int j = 0; j < 4; ++j) yv[u][k][j] = yr[64 * j]; } } }
#pragma unroll
        for (int u = 0; u < 2; ++u) {
#pragma unroll
            for (int k = 0; k < 4; ++k) { const float w = rw[u][k];
#pragma unroll
                for (int j = 0; j < 4; ++j) { const u32x2 p = yv[u][k][j];
                    if constexpr (Y_FP8) { const unsigned pw = p.x; const f32x2 lo = __builtin_amdgcn_cvt_pk_f32_fp8(pw, false), hi = __builtin_amdgcn_cvt_pk_f32_fp8(pw, true);
                        v[u][j][0] += w * lo[0]; v[u][j][1] += w * lo[1]; v[u][j][2] += w * hi[0]; v[u][j][3] += w * hi[1]; }
                    else { v[u][j][0] += w * bf2f(p.x & 0xffffu); v[u][j][1] += w * bf2f(p.x >> 16); v[u][j][2] += w * bf2f(p.y & 0xffffu); v[u][j][3] += w * bf2f(p.y >> 16); } } }
            float ss = 0.f;
#pragma unroll
            for (int j = 0; j < 4; ++j) ss += (v[u][j][0] * v[u][j][0] + v[u][j][1] * v[u][j][1]) + (v[u][j][2] * v[u][j][2] + v[u][j][3] * v[u][j][3]);
            const float rstd = 1.0f / sqrtf(wave_sum(ss) * (1.0f / D) + RMS_EPS); f32x4* xo = (f32x4*)(OUT(a) + (size_t)(tb2 + u) * D) + F.lane;
#pragma unroll
            for (int j = 0; j < 4; ++j) { const f32x4 g = ((const f32x4*)gfin)[F.lane + 64 * j]; xo[64 * j] = v[u][j] * rstd * g; } }
    }
}

#ifndef V1TEST
#define V1TEST 0
#endif
#ifndef RT_VAR
#define RT_VAR 0
#endif
constexpr int D_IN = 8648;
__device__ __forceinline__ int win_src_col(int n) {
    if (n < 1024) return 456 + n;
    if (n < 1280) return n - 1024;
    if (n < 1480) return 256 + (n - 1280);
    if (n < 1536) return -1;
    if (n < 2560) return 1480 + (n - 1536);
    if (n < 4608) return 2504 + (n - 2560);
    return 4552 + (n - 4608);
}
template <int PM = 63> __device__ __forceinline__ void mixer_prep_phase(const Frame& F, ArgsRef a) {
    const int gw = F.bid * 8 + F.wave, NGW = F.G * 8, gt = F.bid * 512 + F.tid, NGT = F.G * 512;
    unsigned char* ws = WS(a);
    if (PM & 1) { bf16_t* xb = (bf16_t*)(ws + WS_XB); float* rstd1 = (float*)(ws + WS_MISC + MISC_RSTD1);
      for (int t4 = gw * 4; t4 < T; t4 += NGW * 4) { f32x4 v[4][4];
#pragma unroll
          for (int u = 0; u < 4; ++u) { const f32x4* xr = (const f32x4*)(IN(a, I_X) + (size_t)(t4 + u) * D) + F.lane;
#pragma unroll
              for (int j = 0; j < 4; ++j) v[u][j] = xr[64 * j]; }
#pragma unroll
          for (int u = 0; u < 4; ++u) { u32x2* ob = (u32x2*)(xb + (size_t)(t4 + u) * D) + F.lane; unsigned* o8 = (unsigned*)(ws + WS_XB8 + (size_t)(t4 + u) * D) + F.lane; float ss = 0.f;
#pragma unroll
              for (int j = 0; j < 4; ++j) { const f32x4 x = v[u][j]; ss += (x[0] * x[0] + x[1] * x[1]) + (x[2] * x[2] + x[3] * x[3]); u32x2 w; w.x = pk2(x[0], x[1]); w.y = pk2(x[2], x[3]); ob[64 * j] = w;
                  if constexpr (INC_FP8) o8[64 * j] = pk4_fp8(x[0], x[1], x[2], x[3]); }
              ss = wave_sum(ss); if (F.lane == 0) rstd1[t4 + u] = 1.0f / sqrtf(ss * (1.0f / D) + RMS_EPS); } } }
    if (PM & 2) { LAS float* scr = (LAS float*)(F.wave < 7 ? F.lds + LDS_STAGE + F.wave * 16640 : F.misc + 4096); const float* g = IN(a, I_NORM_MIX_G);
      constexpr int I_WIN = 16 * (NIN / 64), I_WB = 32 * 16, I_WO = 16 * 16;
      for (int it = gw; it < I_WIN + I_WB + I_WO; it += NGW) {
          if (it < I_WIN) { const int kb = it / (NIN / 64), nb = it % (NIN / 64);
              if (INC_FP8 && nb >= 72) transpose_item64<true>(IN(a, I_W_IN), D_IN, D, (bf16_t*)(ws + WS_WIN8), 64 * (nb - 72), g, scr, 64 * kb, win_src_col(64 * nb + F.lane), F.lane);
              else if (INB_FP8 && nb >= 40) transpose_item64<true>(IN(a, I_W_IN), D_IN, D, (bf16_t*)(ws + WS_WIN8 + 4 * MiB), 64 * (nb - 40), g, scr, 64 * kb, win_src_col(64 * nb + F.lane), F.lane);
              else transpose_item64(IN(a, I_W_IN), D_IN, D, (bf16_t*)(ws + WS_WIN), 64 * nb, g, scr, 64 * kb, win_src_col(64 * nb + F.lane), F.lane); }
          else if (it < I_WIN + I_WB) { const int r = it - I_WIN, kb = r / 16, nb = r % 16; transpose_item64(IN(a, I_W_BB), D, 2048, (bf16_t*)(ws + WS_WB), 64 * nb, nullptr, scr, 64 * kb, 64 * nb + F.lane, F.lane); }
          else { const int r = it - I_WIN - I_WB, kb = r / 16, nb = r % 16; transpose_item64(IN(a, I_W_OUT), D, D, (bf16_t*)(ws + WS_WOUT), 64 * nb, nullptr, scr, 64 * kb, 64 * nb + F.lane, F.lane); } } }
    if (PM & 4) { bf16_t* wq = (bf16_t*)(ws + WS_WQ); const float* wuq = IN(a, I_W_UQ); const float* wuk = IN(a, I_W_UK); const float* wqi = IN(a, I_W_QIDX); const float* cg = IN(a, I_CQ_G);
      for (int i = gt; i < 1536 * 32; i += NGT) { const int kk = i / 1536, n = i - kk * 1536;
          float v[8];
          if (n < 1024) { const int h = n >> 7; const float* q = wuk + (size_t)n * 128; const float* p = wuq + (size_t)(8 * kk) * 1024 + h * 128;
#pragma unroll
              for (int jj = 0; jj < 8; ++jj) v[jj] = 0.f;
#pragma unroll 2
              for (int d = 0; d < 128; d += 4) { const f32x4 y = *(const f32x4*)(q + d);
#pragma unroll
                  for (int jj = 0; jj < 8; ++jj) { const f32x4 x = *(const f32x4*)(p + jj * 1024 + d); v[jj] += (x[0] * y[0] + x[1] * y[1]) + (x[2] * y[2] + x[3] * y[3]); } } }
          else {
#pragma unroll
              for (int jj = 0; jj < 8; ++jj) v[jj] = wqi[(size_t)(8 * kk + jj) * 512 + (n - 1024)] * 0.125f; }
          const f32x4 g0 = *(const f32x4*)(cg + 8 * kk), g1 = *(const f32x4*)(cg + 8 * kk + 4);
          u32x4 w; w.x = pk2(v[0] * g0[0], v[1] * g0[1]); w.y = pk2(v[2] * g0[2], v[3] * g0[3]); w.z = pk2(v[4] * g1[0], v[5] * g1[1]); w.w = pk2(v[6] * g1[2], v[7] * g1[3]);
          *(u32x4*)(wq + (size_t)n * 256 + 8 * kk) = w; } }
    if (PM & 8) { bf16_t* wa = (bf16_t*)(ws + WS_WA); const float* wuv = IN(a, I_W_UV); const float* wba = IN(a, I_W_BA);
      for (int i = gt; i < 1024 * 128; i += NGT) { const int kk = i >> 10, n = i & 1023, h = kk >> 4, rr = kk & 15; const float* q = wba + (size_t)(h * 128) * 1024 + n;
          const float* p[8];
#pragma unroll
          for (int jj = 0; jj < 8; ++jj) p[jj] = wuv + (size_t)(MIXA_FP8 ? h * 128 + 32 * (jj & 3) + 2 * rr + (jj >> 2) : 8 * kk + jj) * 128;
          float v[8];
#pragma unroll
          for (int jj = 0; jj < 8; ++jj) v[jj] = 0.f;
#pragma unroll 2
          for (int d = 0; d < 128; d += 4) { const float y0 = q[(size_t)d * 1024], y1 = q[(size_t)(d + 1) * 1024], y2 = q[(size_t)(d + 2) * 1024], y3 = q[(size_t)(d + 3) * 1024];
#pragma unroll
              for (int jj = 0; jj < 8; ++jj) { const f32x4 x = *(const f32x4*)(p[jj] + d); v[jj] += (x[0] * y0 + x[1] * y1) + (x[2] * y2 + x[3] * y3); } }
          if constexpr (MIXA_FP8) { u32x2 w8; w8.x = pk4_fp8(v[0] * W8_SCALE, v[1] * W8_SCALE, v[2] * W8_SCALE, v[3] * W8_SCALE); w8.y = pk4_fp8(v[4] * W8_SCALE, v[5] * W8_SCALE, v[6] * W8_SCALE, v[7] * W8_SCALE);
              *(u32x2*)((unsigned char*)wa + (size_t)n * 1024 + h * 128 + 8 * rr) = w8; }
          else { u32x4 w; w.x = pk2(v[0], v[1]); w.y = pk2(v[2], v[3]); w.z = pk2(v[4], v[5]); w.w = pk2(v[6], v[7]);
          *(u32x4*)(wa + (size_t)n * 1024 + 8 * kk) = w; } } }
    if (PM & 16) { float* cosP = (float*)(ws + WS_COSP); float* sinP = (float*)(ws + WS_SINP); float* cosT = (float*)(ws + WS_COST); float* sinT = (float*)(ws + WS_SINT);
      LAS double* invr = (LAS double*)(F.misc + LM_SCR);
      __syncthreads();
      if (F.tid < 128) invr[F.tid] = exp(-9.210340371976184 * (double)F.tid / 128.0) * 0.15915494309189535;
      __syncthreads();
      for (int i = gt; i < SEQ * 128; i += NGT) { const int pos = i >> 7, j = i & 127; const double rev = (double)pos * invr[j]; const float fr_ = (float)(rev - floor(rev));
          const float c = __builtin_amdgcn_cosf(fr_), sn = __builtin_amdgcn_sinf(fr_); cosP[i] = c; sinP[i] = sn; cosT[j * SEQ + pos] = c; sinT[j * SEQ + pos] = sn; }
      __syncthreads();
      if (gt < 256) { const int h = gt >> 6, i = gt & 63; const double lg = log(1.0 - exp2(-5.0 - (double)h));
          ((float*)(ws + WS_MISC + MISC_DQ))[gt] = (float)exp(lg * (i + 1)); ((float*)(ws + WS_MISC + MISC_DK))[gt] = (float)(exp(-lg * (i + 1)) * 0.0625); ((float*)(ws + WS_MISC + MISC_DZ))[gt] = (float)(exp(lg * (63 - i)) * 0.0625); } }
    if (PM & 32) router_weight_prep(F, a);
}

struct EpiInA { static constexpr bool PERM = true;
    bf16_t* qx; float* small; const float* rstd1; const float* cosP; const float* sinP; const float* dq;
    bf16_t* cqn; bf16_t* ckv; bf16_t* kidx; float* widx; const float* gkv; const float* gki; LAS float* xch;
    __device__ __forceinline__ void small_fused(const f32x4 (&acc)[2][2][4][2], const pg8::Unit& u, int wr, int wc, int fr, int fq) const {
        const int d0 = 32 * wc + 8 * fq;
#pragma unroll
        for (int ai = 0; ai < 2; ++ai) {
#pragma unroll
            for (int m = 0; m < 4; ++m) { int rl_ = 128 * ai + 64 * wr + 16 * m + fr; asm volatile("" : "+v"(rl_)); float p0 = 0.f, p1 = 0.f; const float rsv_ = rstd1[u.pm * 256 + rl_];
#pragma unroll
                for (int n = 0; n < 2; ++n)
#pragma unroll
                    for (int i = 0; i < 4; ++i) { const float x0 = acc[ai][0][m][n][i] * rsv_, x1 = acc[ai][1][m][n][i] * rsv_; p0 += x0 * x0; p1 += x1 * x1; }
                p0 += __shfl_xor(p0, 16); p0 += __shfl_xor(p0, 32); p1 += __shfl_xor(p1, 16); p1 += __shfl_xor(p1, 32);
                if (fq == 0) { xch[rl_ * 8 + wc] = p0; xch[rl_ * 8 + 4 + wc] = p1; } } }
        asm volatile("s_waitcnt lgkmcnt(0)" ::: "memory"); __builtin_amdgcn_s_barrier(); asm volatile("" ::: "memory");
#pragma unroll
        for (int ai = 0; ai < 2; ++ai)
#pragma unroll
            for (int m = 0; m < 4; ++m) { int rl = 128 * ai + 64 * wr + 16 * m + fr; asm volatile("" : "+v"(rl));        const size_t row = (size_t)u.pm * 256 + rl;
                const f32x4 q0 = *(const LAS f32x4*)(xch + rl * 8), q1 = *(const LAS f32x4*)(xch + rl * 8 + 4); const float rsm = rstd1[row];
                if (u.pn == 4) { const float r = rsm * (1.0f / sqrtf(((q0[0] + q0[1]) + (q0[2] + q0[3]) + (q1[0] + q1[1]) + (q1[2] + q1[3])) * (1.f / 256.f) + RMS_EPS));
#pragma unroll
                    for (int bj = 0; bj < 2; ++bj) { const f32x4 v0 = acc[ai][bj][m][0] * r, v1 = acc[ai][bj][m][1] * r; u32x4 w; w.x = cvt_pk_bf16(v0[0], v0[1]); w.y = cvt_pk_bf16(v0[2], v0[3]); w.z = cvt_pk_bf16(v1[0], v1[1]); w.w = cvt_pk_bf16(v1[2], v1[3]);
                        *(u32x4*)(cqn + row * 256 + 128 * bj + d0) = w; } }
                else { const float* gkv_ = gkv; const float* gki_ = gki; asm volatile("" : "+s"(gkv_), "+s"(gki_));
                    { const float r = rsm * (1.0f / sqrtf(((q0[0] + q0[1]) + (q0[2] + q0[3])) * (1.f / 128.f) + RMS_EPS)); const f32x4 g0 = *(const f32x4*)(gkv_ + d0), g1 = *(const f32x4*)(gkv_ + d0 + 4);
                        const f32x4 v0 = acc[ai][0][m][0] * r * g0, v1 = acc[ai][0][m][1] * r * g1; u32x4 w; w.x = cvt_pk_bf16(v0[0], v0[1]); w.y = cvt_pk_bf16(v0[2], v0[3]); w.z = cvt_pk_bf16(v1[0], v1[1]); w.w = cvt_pk_bf16(v1[2], v1[3]);
                        *(u32x4*)(ckv + row * 128 + d0) = w; }
                    if (wc < 2) { const float r = rsm * (1.0f / sqrtf((q1[0] + q1[1]) * (1.f / 64.f) + RMS_EPS)); const f32x4 g0 = *(const f32x4*)(gki_ + d0), g1 = *(const f32x4*)(gki_ + d0 + 4);
                        const f32x4 v0 = acc[ai][1][m][0] * r * g0, v1 = acc[ai][1][m][1] * r * g1; u32x4 w; w.x = cvt_pk_bf16(v0[0], v0[1]); w.y = cvt_pk_bf16(v0[2], v0[3]); w.z = cvt_pk_bf16(v1[0], v1[1]); w.w = cvt_pk_bf16(v1[2], v1[3]);
                        *(u32x4*)(kidx + row * 64 + d0) = w; }
                    else if (wc == 2 && fq == 0) { const float sc = 0.35355339059327373f * rsm; *(f32x4*)(widx + row * 8) = acc[ai][1][m][0] * sc; *(f32x4*)(widx + row * 8 + 4) = acc[ai][1][m][1] * sc; } } }
    }
    __device__ __forceinline__ void operator()(const f32x4 (&acc)[2][2][4][2], const pg8::Unit& u, int wr, int wc, int fr, int fq) const {
        const int d0 = 32 * wc + 8 * fq;
        if (ROWNORM_FUSED && u.pn >= 4) { small_fused(acc, u, wr, wc, fr, fq); return; }
#pragma unroll
        for (int ai = 0; ai < 2; ++ai) { const int row0 = u.pm * 256 + 128 * ai + 64 * wr + fr;
            float rs[4];
#pragma unroll
            for (int m = 0; m < 4; ++m) rs[m] = rstd1[row0 + 16 * m];
            if (u.pn < 4) { f32x4 c4[4][2], s4[4][2]; float sc[4];
#pragma unroll
                for (int m = 0; m < 4; ++m) { const int pos = (row0 + 16 * m) & (SEQ - 1); sc[m] = dq[u.pn * 64 + (pos & 63)];
#pragma unroll
                    for (int n = 0; n < 2; ++n) { c4[m][n] = *(const f32x4*)(cosP + pos * 128 + d0 + 4 * n); s4[m][n] = *(const f32x4*)(sinP + pos * 128 + d0 + 4 * n); } }
#pragma unroll
                for (int m = 0; m < 4; ++m) { const float scm = sc[m] * rs[m]; float o1[8], o2[8];
#pragma unroll
                    for (int n = 0; n < 2; ++n)
#pragma unroll
                        for (int i = 0; i < 4; ++i) { const float v1 = acc[ai][0][m][n][i], v2 = acc[ai][1][m][n][i]; o1[4 * n + i] = (v1 * c4[m][n][i] - v2 * s4[m][n][i]) * scm; o2[4 * n + i] = (v2 * c4[m][n][i] + v1 * s4[m][n][i]) * scm; }
                    u32x4 w1, w2; w1.x = cvt_pk_bf16(o1[0], o1[1]); w1.y = cvt_pk_bf16(o1[2], o1[3]); w1.z = cvt_pk_bf16(o1[4], o1[5]); w1.w = cvt_pk_bf16(o1[6], o1[7]);
                    w2.x = cvt_pk_bf16(o2[0], o2[1]); w2.y = cvt_pk_bf16(o2[2], o2[3]); w2.z = cvt_pk_bf16(o2[4], o2[5]); w2.w = cvt_pk_bf16(o2[6], o2[7]);
                    bf16_t* p = qx + (size_t)(row0 + 16 * m) * 1024 + u.pn * 256 + d0; *(u32x4*)p = w1; *(u32x4*)(p + 128) = w2; }
            } else {
#pragma unroll
                for (int m = 0; m < 4; ++m) { float* p = small + (size_t)(row0 + 16 * m) * 512 + (u.pn - 4) * 256 + d0;
#pragma unroll
                    for (int bj = 0; bj < 2; ++bj)
#pragma unroll
                        for (int n = 0; n < 2; ++n) *(f32x4*)(p + 128 * bj + 4 * n) = acc[ai][bj][m][n] * rs[m]; } } }
    }
};
template <int PN0 = 0, bool F8 = false> struct EpiInB { static constexpr bool PERM = false;
    bf16_t* kzt; bf16_t* vt; const float* rstd1; const float* cosT; const float* sinT; const float* dz;
    __device__ __forceinline__ void operator()(const f32x4 (&acc)[2][2][4][2], const pg8::Unit& u, int wr, int wc, int fr, int fq) const {
#pragma unroll
        for (int ai = 0; ai < 2; ++ai) { const int tokb = u.pm * 256 + 128 * ai + 64 * wr + 16 * fq, b = tokb >> 11, posb = tokb & (SEQ - 1);
            f32x4 rs4[4];
#pragma unroll
            for (int m = 0; m < 4; ++m) rs4[m] = *(const f32x4*)(rstd1 + tokb + 4 * m);
            const int pn = u.pn + PN0;
            if (pn < 4) { const int h = pn;
#pragma unroll
              for (int mg = 0; mg < 2; ++mg) { f32x4 kz4[2], c4[2][2], s4[2][2];
#pragma unroll
                for (int mm = 0; mm < 2; ++mm) { const int m = 2 * mg + mm; kz4[mm] = *(const f32x4*)(dz + h * 64 + ((posb + 4 * m) & 63));
#pragma unroll
                    for (int n = 0; n < 2; ++n) { const int d = 32 * wc + 16 * n + fr; c4[mm][n] = *(const f32x4*)(cosT + d * SEQ + posb + 4 * m); s4[mm][n] = *(const f32x4*)(sinT + d * SEQ + posb + 4 * m); } }
#pragma unroll
                for (int n = 0; n < 2; ++n) { const int d = 32 * wc + 16 * n + fr; float o1[8], o2[8];
#pragma unroll
                    for (int mm = 0; mm < 2; ++mm) { const int m = 2 * mg + mm;
#pragma unroll
                        for (int i = 0; i < 4; ++i) { const float v1 = acc[ai][0][m][n][i] * rs4[m][i], v2 = acc[ai][1][m][n][i] * rs4[m][i]; o1[4 * mm + i] = (v1 * c4[mm][n][i] - v2 * s4[mm][n][i]) * kz4[mm][i]; o2[4 * mm + i] = (v2 * c4[mm][n][i] + v1 * s4[mm][n][i]) * kz4[mm][i]; } }
                    u32x4 z1, z2; z1.x = cvt_pk_bf16(o1[0], o1[1]); z1.y = cvt_pk_bf16(o1[2], o1[3]); z1.z = cvt_pk_bf16(o1[4], o1[5]); z1.w = cvt_pk_bf16(o1[6], o1[7]);
                    z2.x = cvt_pk_bf16(o2[0], o2[1]); z2.y = cvt_pk_bf16(o2[2], o2[3]); z2.z = cvt_pk_bf16(o2[4], o2[5]); z2.w = cvt_pk_bf16(o2[6], o2[7]);
                    bf16_t* q = kzt + ((size_t)((b * 4 + h) * 256 + d)) * SEQ + posb + 8 * mg; *(u32x4*)q = z1; *(u32x4*)(q + (size_t)128 * SEQ) = z2; } }
            } else { const int j = pn - 4, hd = j >> 1;
#pragma unroll
                for (int bj = 0; bj < 2; ++bj)
#pragma unroll
                    for (int n = 0; n < 2; ++n) { const int v = (j & 1) * 256 + 128 * bj + 32 * wc + 16 * n + fr; bf16_t* q = vt + ((size_t)((b * 4 + hd) * 512 + v)) * SEQ + posb;
#pragma unroll
                        for (int mg = 0; mg < 2; ++mg) { const f32x4 x0 = acc[ai][bj][2 * mg][n] * rs4[2 * mg] * (F8 ? W8_INV : 1.f), x1 = acc[ai][bj][2 * mg + 1][n] * rs4[2 * mg + 1] * (F8 ? W8_INV : 1.f);
                            u32x4 z; z.x = cvt_pk_bf16(x0[0], x0[1]); z.y = cvt_pk_bf16(x0[2], x0[3]); z.z = cvt_pk_bf16(x1[0], x1[1]); z.w = cvt_pk_bf16(x1[2], x1[3]); *(u32x4*)(q + 8 * mg) = z; } } } }
    }
};
struct EpiInC { static constexpr bool PERM = true;
    bf16_t* oret; bf16_t* ga; bf16_t* gb; const float* rstd1; const float* rn;
    __device__ __forceinline__ void operator()(const f32x4 (&acc)[2][2][4][2], const pg8::Unit& u, int wr, int wc, int fr, int fq) const {
        const int c0 = 32 * wc + 8 * fq;
#pragma unroll
        for (int ai = 0; ai < 2; ++ai) { const int row0 = u.pm * 256 + 128 * ai + 64 * wr + fr;
            float rs[4], rr[4]; unsigned ow[4][2][4];
#pragma unroll
            for (int m = 0; m < 4; ++m) { rs[m] = rstd1[row0 + 16 * m] * (INC_FP8 ? W8_INV : 1.f); rr[m] = 1.f; }
            if (u.pn < 8) {
#pragma unroll
                for (int m = 0; m < 4; ++m) { rr[m] = rn[(row0 + 16 * m) * 4 + (u.pn >> 1)];
#pragma unroll
                    for (int bj = 0; bj < 2; ++bj) ld4u(oret + (size_t)(row0 + 16 * m) * 2048 + u.pn * 256 + 128 * bj + c0, ow[m][bj]); } }
#pragma unroll
            for (int m = 0; m < 4; ++m)
#pragma unroll
                for (int bj = 0; bj < 2; ++bj) { float v[8];
#pragma unroll
                    for (int n = 0; n < 2; ++n)
#pragma unroll
                        for (int i = 0; i < 4; ++i) { const float x = acc[ai][bj][m][n][i] * rs[m]; v[4 * n + i] = __builtin_amdgcn_rcpf(1.f + __builtin_amdgcn_exp2f(-1.4426950408889634f * x)) * (u.pn < 8 ? x : 1.f); }
                    bf16_t* p;
                    if (u.pn < 8) { p = oret + (size_t)(row0 + 16 * m) * 2048 + u.pn * 256 + 128 * bj + c0;
#pragma unroll
                        for (int q = 0; q < 4; ++q) { v[2 * q] *= bf2f(ow[m][bj][q] & 0xffffu) * rr[m]; v[2 * q + 1] *= bf2f(ow[m][bj][q] >> 16) * rr[m]; } }
                    else if (u.pn < 12) { p = ga + (size_t)(row0 + 16 * m) * 1024 + (u.pn - 8) * 256 + 128 * bj + c0;
                        if constexpr (GA8) { u32x2 w8; w8.x = pk4_fp8(v[0], v[1], v[2], v[3]); w8.y = pk4_fp8(v[4], v[5], v[6], v[7]); *(u32x2*)((unsigned char*)ga + (size_t)(row0 + 16 * m) * 1024 + (u.pn - 8) * 256 + 128 * bj + c0) = w8; continue; } }
                    else p = gb + (size_t)(row0 + 16 * m) * 1024 + (u.pn - 12) * 256 + 128 * bj + c0;
                    u32x4 w; w.x = cvt_pk_bf16(v[0], v[1]); w.y = cvt_pk_bf16(v[2], v[3]); w.z = cvt_pk_bf16(v[4], v[5]); w.w = cvt_pk_bf16(v[6], v[7]); *(u32x4*)p = w; } }
    }
};
template <int MODE, bool F8S = false> struct EpiMix { static constexpr bool PERM = true;
    const bf16_t* gate; bf16_t* mixa; bf16_t* mix;
    static constexpr bool G8 = GA8 && MODE == 0, M8 = GA8;
    __device__ static __forceinline__ void ld8(const void* base, size_t eoff, bool f8, unsigned (&w)[4]) { if (f8) { const u32x2 t = *(const u32x2*)((const unsigned char*)base + eoff); w[0] = t.x; w[1] = t.y; w[2] = 0u; w[3] = 0u; } else ld4u((const bf16_t*)base + eoff, w); }
    __device__ static __forceinline__ void un8(const unsigned (&w)[4], bool f8, float (&f)[8]) {
        if (f8) { const f32x2 a0 = __builtin_amdgcn_cvt_pk_f32_fp8(w[0], false), a1 = __builtin_amdgcn_cvt_pk_f32_fp8(w[0], true), a2 = __builtin_amdgcn_cvt_pk_f32_fp8(w[1], false), a3 = __builtin_amdgcn_cvt_pk_f32_fp8(w[1], true);
            f[0] = a0[0]; f[1] = a0[1]; f[2] = a1[0]; f[3] = a1[1]; f[4] = a2[0]; f[5] = a2[1]; f[6] = a3[0]; f[7] = a3[1]; }
        else {
#pragma unroll
            for (int q = 0; q < 4; ++q) { f[2 * q] = bf2f(w[q] & 0xffffu); f[2 * q + 1] = bf2f(w[q] >> 16); } } }
    __device__ __forceinline__ void operator()(const f32x4 (&acc)[2][2][4][2], const pg8::Unit& u, int wr, int wc, int fr, int fq) const {
#pragma unroll
        for (int ai = 0; ai < 2; ++ai) { const size_t off0 = (size_t)(u.pm * 256 + 128 * ai + 64 * wr + fr) * 1024 + u.pn * 256 + 32 * wc + 8 * fq;
            unsigned gw[4][2][4], mw[4][2][4];
#pragma unroll
            for (int m = 0; m < 4; ++m)
#pragma unroll
                for (int bj = 0; bj < 2; ++bj) { ld8(gate, off0 + (size_t)m * 16 * 1024 + 128 * bj, G8, gw[m][bj]); if (MODE == 1) ld8(mixa, off0 + (size_t)m * 16 * 1024 + 128 * bj, M8, mw[m][bj]); }
#pragma unroll
            for (int m = 0; m < 4; ++m)
#pragma unroll
                for (int bj = 0; bj < 2; ++bj) { float v[8], g[8]; un8(gw[m][bj], G8, g);
#pragma unroll
                    for (int q = 0; q < 8; ++q) v[q] = g[q] * acc[ai][bj][m][q >> 2][q & 3] * (F8S ? W8_INV * 0.25f : 1.f);
                    if (MODE == 1) { float mm[8]; un8(mw[m][bj], M8, mm);
#pragma unroll
                        for (int q = 0; q < 8; ++q) v[q] += mm[q]; }
                    const size_t off = off0 + (size_t)m * 16 * 1024 + 128 * bj;
                    if (MODE == 0 && M8) { u32x2 w8; w8.x = pk4_fp8(v[0], v[1], v[2], v[3]); w8.y = pk4_fp8(v[4], v[5], v[6], v[7]); *(u32x2*)((unsigned char*)mixa + off) = w8; }
                    else { u32x4 w; w.x = cvt_pk_bf16(v[0], v[1]); w.y = cvt_pk_bf16(v[2], v[3]); w.z = cvt_pk_bf16(v[4], v[5]); w.w = cvt_pk_bf16(v[6], v[7]);
                        *(u32x4*)((MODE == 0 ? mixa : mix) + off) = w; } } }
    }
};
struct EpiOut { static constexpr bool PERM = true;
    const bf16_t* x; float* out; bf16_t* x2b;
    __device__ __forceinline__ void operator()(const f32x4 (&acc)[2][2][4][2], const pg8::Unit& u, int wr, int wc, int fr, int fq) const {
#pragma unroll
        for (int ai = 0; ai < 2; ++ai) { const size_t off0 = (size_t)(u.pm * 256 + 128 * ai + 64 * wr + fr) * 1024 + u.pn * 256 + 32 * wc + 8 * fq;
            f32x4 xv[4][2][2];
#pragma unroll
            for (int m = 0; m < 4; ++m)
#pragma unroll
                for (int bj = 0; bj < 2; ++bj) { unsigned xw[4]; ld4u(x + off0 + (size_t)m * 16 * 1024 + 128 * bj, xw);
                    xv[m][bj][0] = (f32x4){bf2f(xw[0] & 0xffffu), bf2f(xw[0] >> 16), bf2f(xw[1] & 0xffffu), bf2f(xw[1] >> 16)}; xv[m][bj][1] = (f32x4){bf2f(xw[2] & 0xffffu), bf2f(xw[2] >> 16), bf2f(xw[3] & 0xffffu), bf2f(xw[3] >> 16)}; }
#pragma unroll
            for (int m = 0; m < 4; ++m)
#pragma unroll
                for (int bj = 0; bj < 2; ++bj) { const size_t off = off0 + (size_t)m * 16 * 1024 + 128 * bj; const f32x4 r0 = xv[m][bj][0] + acc[ai][bj][m][0], r1 = xv[m][bj][1] + acc[ai][bj][m][1];
                    if constexpr (X2H) { u32x4 wh; wh.x = cvt_pk_bf16(r0[0], r0[1]); wh.y = cvt_pk_bf16(r0[2], r0[3]); wh.z = cvt_pk_bf16(r1[0], r1[1]); wh.w = cvt_pk_bf16(r1[2], r1[3]); *(u32x4*)((bf16_t*)out + off) = wh; }
                    else { *(f32x4*)(out + off) = r0; *(f32x4*)(out + off + 4) = r1; }
                    if constexpr (MOE_FP8) { u32x2 w8; w8.x = pk4_fp8(r0[0], r0[1], r0[2], r0[3]); w8.y = pk4_fp8(r1[0], r1[1], r1[2], r1[3]); *(u32x2*)((unsigned char*)x2b + off) = w8; }
                    else { u32x4 w; w.x = cvt_pk_bf16(r0[0], r0[1]); w.y = cvt_pk_bf16(r0[2], r0[3]); w.z = cvt_pk_bf16(r1[0], r1[1]); w.w = cvt_pk_bf16(r1[2], r1[3]); *(u32x4*)(x2b + off) = w; } } }
    }
};

constexpr int RT_QX = 0, RT_KP = 33280, RT_KZT = 66560, RT_VT = 103424, RT_S = 121856, RT_PART = RT_KP, RT_QS = 520, RT_TS = 144;
__device__ __forceinline__ int crow32(int reg, int hh) { return (reg & 3) + 8 * (reg >> 2) + 4 * hh; }
__device__ __forceinline__ bf16x8 lds_frag2x8(const LAS unsigned char* p) { const s16x4 lo = *(const LAS s16x4*)p, hi = *(const LAS s16x4*)(p + 16); return __builtin_shufflevector(lo, hi, 0, 1, 2, 3, 4, 5, 6, 7); }
__device__ __forceinline__ bf16x8 lds_frag8x2(const LAS unsigned char* p) { const s16x4 lo = *(const LAS s16x4*)p, hi = *(const LAS s16x4*)(p + 8); return __builtin_shufflevector(lo, hi, 0, 1, 2, 3, 4, 5, 6, 7); }
template <int OFF> __device__ __forceinline__ s16x4 lds_tr_read(int vb) { s16x4 r; asm volatile("ds_read_b64_tr_b16 %0, %1 offset:%2" : "=&v"(r) : "v"(vb), "i"(OFF) : "memory"); return r; }
__device__ __forceinline__ bf16x8 lds_frag16(const LAS unsigned char* p) { return *(const LAS bf16x8*)p; }
__device__ __forceinline__ bf16x8 pack8(const f32x16& x, int s8) { u32x4 p; p.x = cvt_pk_bf16(x[s8 + 0], x[s8 + 1]); p.y = cvt_pk_bf16(x[s8 + 2], x[s8 + 3]); p.z = cvt_pk_bf16(x[s8 + 4], x[s8 + 5]); p.w = cvt_pk_bf16(x[s8 + 6], x[s8 + 7]); return __builtin_bit_cast(bf16x8, p); }
#define MFMA32(a, b, c) __builtin_amdgcn_mfma_f32_32x32x16_bf16((a), (b), (c), 0, 0, 0)
__device__ __forceinline__ void retention_phase(const Frame& F, ArgsRef a) {
    const bf16_t* QX = (const bf16_t*)(WS(a) + WS_QX); const bf16_t* KZT = (const bf16_t*)(WS(a) + WS_KZT); const bf16_t* VT = (const bf16_t*)(WS(a) + WS_VT);
    bf16_t* ORET = (bf16_t*)OUT(a);
    LAS unsigned char* L = F.lds + LDS_STAGE;
    const int tid = F.tid, lane = F.lane, w = F.wave, wd = w >> 2, wv = w & 3, r = lane & 31, hh = lane >> 5;
    for (int item = F.bid; item < 256; item += F.G) {
        const int xcd = item & 7, index = item >> 3, q = (index >> 2) * 8 + xcd, vs = index & 3, b = q >> 2, h = q & 3, tb = b * SEQ;
        const float g64 = (float)exp(64.0 * log(1.0 - exp2(-5.0 - (double)h))), g64inv = (float)exp(-64.0 * log(1.0 - exp2(-5.0 - (double)h)));
        f32x16 Racc[4];
#pragma unroll
        for (int i = 0; i < 4; ++i) { for (int j = 0; j < 16; ++j) Racc[i][j] = 0.f; }
        f32x4 pq[4], pz[4], pv[2];
        unsigned gq = (unsigned)(((tb + (tid >> 5)) * 1024 + h * 256 + (tid & 31) * 8) * 2), gz = (unsigned)((((b * 4 + h) * 256 + (tid >> 3)) * SEQ + (tid & 7) * 8) * 2), gv = (unsigned)((((b * 4 + h) * 512 + vs * 128 + (tid >> 3)) * SEQ + (tid & 7) * 8) * 2);
        unsigned lq = (unsigned)(uintptr_t)(L + RT_QX + (tid >> 5) * RT_QS + (tid & 31) * 16), lz = (unsigned)(uintptr_t)(L + RT_KZT + (tid >> 3) * RT_TS + (tid & 7) * 16), lv = (unsigned)(uintptr_t)(L + RT_VT + (tid >> 3) * RT_TS + (tid & 7) * 16);
#define RT_LOADG(c) do { unsigned _q = gq + (unsigned)(c) * (64u * 1024u * 2u), _z = gz + (unsigned)(c) * 128u, _v = gv + (unsigned)(c) * 128u; asm volatile("" : "+v"(_q), "+v"(_z), "+v"(_v)); \
        _Pragma("unroll") for (int i = 0; i < 4; ++i) { pq[i] = *(const f32x4*)((const char*)QX + _q + i * (16 * 1024 * 2)); pz[i] = *(const f32x4*)((const char*)KZT + _z + i * (64 * SEQ * 2)); } \
        _Pragma("unroll") for (int i = 0; i < 2; ++i) pv[i] = *(const f32x4*)((const char*)VT + _v + i * (64 * SEQ * 2)); } while (0)
#define RT_STOREL() do { unsigned _q = lq, _z = lz, _v = lv; asm volatile("" : "+v"(_q), "+v"(_z), "+v"(_v)); \
        _Pragma("unroll") for (int i = 0; i < 4; ++i) { LAS unsigned char* dq_ = (LAS unsigned char*)(uintptr_t)_q + i * (16 * RT_QS); \
            *(LAS f32x2*)(dq_) = (f32x2){pq[i][0], pq[i][1]}; *(LAS f32x2*)(dq_ + 8) = (f32x2){pq[i][2], pq[i][3]}; \
            *(LAS f32x4*)((LAS unsigned char*)(uintptr_t)_z + i * (64 * RT_TS)) = pz[i]; } \
        _Pragma("unroll") for (int i = 0; i < 2; ++i) *(LAS f32x4*)((LAS unsigned char*)(uintptr_t)_v + i * (64 * RT_TS)) = pv[i]; } while (0)
        __syncthreads();
        RT_LOADG(0); RT_STOREL(); __syncthreads();
        const int ti = wv >> 1, tj = wv & 1;
        unsigned bQa = (unsigned)(uintptr_t)(L + RT_QX + (32 * ti + r) * RT_QS + 16 * hh), bKb = (unsigned)(uintptr_t)(L + RT_KZT + (8 * hh + ((lane & 15) >> 2)) * RT_TS + (32 * tj + 16 * ((lane >> 4) & 1) + 4 * (lane & 3)) * 2);
        unsigned bSw = (unsigned)(uintptr_t)(L + RT_S + (32 * ti + 4 * hh) * RT_TS + (32 * tj + r) * 2), bQr = (unsigned)(uintptr_t)(L + RT_QX + r * RT_QS + (128 * wd + 4 * hh) * 2);
        unsigned bV = (unsigned)(uintptr_t)(L + RT_VT + (32 * wv + r) * RT_TS + 16 * hh), bSr = (unsigned)(uintptr_t)(L + RT_S + r * RT_TS + 16 * hh);
        unsigned bP = (unsigned)(uintptr_t)(L + RT_PART + wv * 8192 + 4 * hh * 128 + r * 4), bZ = (unsigned)(uintptr_t)(L + RT_KZT + (128 * wd + r) * RT_TS + 16 * hh);
        asm volatile("" : "+v"(bQa), "+v"(bKb), "+v"(bSw), "+v"(bQr)); asm volatile("" : "+v"(bV), "+v"(bSr), "+v"(bP), "+v"(bZ));
#define LP(x) ((const LAS unsigned char*)(uintptr_t)(x))
#define LPW(x) ((LAS unsigned char*)(uintptr_t)(x))
        for (int c = 0; c < 32; ++c) {
            if (c + 1 < 32) RT_LOADG(c + 1);
            f32x16 o[2];
#pragma unroll
            for (int j = 0; j < 16; ++j) { o[0][j] = 0.f; o[1][j] = 0.f; }
            if (wd == 1 && wv != 1) { f32x16 sacc;
#pragma unroll
                for (int j = 0; j < 16; ++j) sacc[j] = 0.f;
#define RT_KQ(KQ) { s16x4 tl0 = lds_tr_read<(4 * (KQ) + 0) * 16 * RT_TS>((int)bKb), th0 = lds_tr_read<(4 * (KQ) + 0) * 16 * RT_TS + 4 * RT_TS>((int)bKb), tl1 = lds_tr_read<(4 * (KQ) + 1) * 16 * RT_TS>((int)bKb), th1 = lds_tr_read<(4 * (KQ) + 1) * 16 * RT_TS + 4 * RT_TS>((int)bKb); \
                    s16x4 tl2 = lds_tr_read<(4 * (KQ) + 2) * 16 * RT_TS>((int)bKb), th2 = lds_tr_read<(4 * (KQ) + 2) * 16 * RT_TS + 4 * RT_TS>((int)bKb), tl3 = lds_tr_read<(4 * (KQ) + 3) * 16 * RT_TS>((int)bKb), th3 = lds_tr_read<(4 * (KQ) + 3) * 16 * RT_TS + 4 * RT_TS>((int)bKb); \
                    asm volatile("s_waitcnt lgkmcnt(0)" ::: "memory"); __builtin_amdgcn_sched_barrier(0); \
                    sacc = MFMA32(lds_frag8x2(LP(bQa) + 32 * (4 * (KQ) + 0)), ((bf16x8){tl0[0], tl0[1], tl0[2], tl0[3], th0[0], th0[1], th0[2], th0[3]}), sacc); \
                    sacc = MFMA32(lds_frag8x2(LP(bQa) + 32 * (4 * (KQ) + 1)), ((bf16x8){tl1[0], tl1[1], tl1[2], tl1[3], th1[0], th1[1], th1[2], th1[3]}), sacc); \
                    sacc = MFMA32(lds_frag8x2(LP(bQa) + 32 * (4 * (KQ) + 2)), ((bf16x8){tl2[0], tl2[1], tl2[2], tl2[3], th2[0], th2[1], th2[2], th2[3]}), sacc); \
                    sacc = MFMA32(lds_frag8x2(LP(bQa) + 32 * (4 * (KQ) + 3)), ((bf16x8){tl3[0], tl3[1], tl3[2], tl3[3], th3[0], th3[1], th3[2], th3[3]}), sacc); }
                RT_KQ(0) RT_KQ(1) RT_KQ(2) RT_KQ(3)
#undef RT_KQ
#pragma unroll
                for (int j = 0; j < 16; ++j) sacc[j] *= g64inv;
#pragma unroll
                for (int j = 0; j < 16; ++j) { const int cl = (j & 3) + 8 * (j >> 2); float v = (ti != tj || cl + 4 * hh >= r) ? sacc[j] : 0.f; if (RT_VAR == 6) v = (ti == tj && cl + 4 * hh == r) ? 1.f : 0.f; *(LAS bf16_t*)(LPW(bSw) + cl * RT_TS) = (bf16_t)f2bf(v); } }
            if (RT_VAR != 5 && RT_VAR != 6 && RT_VAR != 9 && RT_VAR != 10)
#pragma unroll
            for (int s = 0; s < 8; ++s) { const bf16x8 rb = pack8(Racc[s >> 1], 8 * (s & 1));
#pragma unroll
                for (int m = 0; m < 2; ++m) { const bf16x8 af = lds_frag2x8(LP(bQr) + 32 * m * RT_QS + (32 * (s >> 1) + 16 * (s & 1)) * 2); o[m] = MFMA32(af, rb, o[m]); } }
            __syncthreads();
            bf16x8 Bv[4];
#pragma unroll
            for (int ks = 0; ks < 4; ++ks) Bv[ks] = lds_frag16(LP(bV) + 32 * ks);
            if (wd == 0) {
#pragma unroll
                for (int ks = 0; ks < 4; ++ks) { if (RT_VAR == 4) continue; if (ks < 2) { const bf16x8 a0 = lds_frag16(LP(bSr) + 32 * ks); o[0] = MFMA32(a0, Bv[ks], o[0]); }
                    const bf16x8 a1 = lds_frag16(LP(bSr) + 32 * RT_TS + 32 * ks); o[1] = MFMA32(a1, Bv[ks], o[1]); }
            } else {
#pragma unroll
                for (int m = 0; m < 2; ++m)
#pragma unroll
                    for (int j = 0; j < 16; ++j) *(LAS float*)(LPW(bP) + (32 * m + (j & 3) + 8 * (j >> 2)) * 128) = o[m][j];
            }
            __syncthreads();
            if (wd == 0) { bf16_t* op = ORET + (size_t)(tb + c * 64 + 4 * hh) * 2048 + h * 512 + vs * 128 + 32 * wv + r;
#pragma unroll
                for (int m = 0; m < 2; ++m)
#pragma unroll
                    for (int j = 0; j < 16; ++j) { const int cl = 32 * m + (j & 3) + 8 * (j >> 2); const float v = o[m][j] + *(const LAS float*)(LP(bP) + cl * 128); op[(size_t)cl * 2048] = (bf16_t)f2bf(v); }
            }
#pragma unroll
            for (int t4 = 0; t4 < 4; ++t4) {
#pragma unroll
                for (int j = 0; j < 16; ++j) Racc[t4][j] *= g64;
#pragma unroll
                for (int ks = 0; ks < 4; ++ks) { const bf16x8 af = lds_frag16(LP(bZ) + 32 * t4 * RT_TS + 32 * ks); Racc[t4] = MFMA32(af, Bv[ks], Racc[t4]); }
            }
            __syncthreads();
            if (c + 1 < 32) RT_STOREL();
            __syncthreads();
        }
    }
#undef RT_LOADG
#undef RT_STOREL
#undef LP
#undef LPW
}
__device__ __forceinline__ void retnorm_phase(const Frame& F, ArgsRef a) {
    const bf16_t* oret = (const bf16_t*)OUT(a); float* rn = (float*)(WS(a) + WS_MISC + MISC_RN);
    const int gw = F.bid * 8 + F.wave, NGW = F.G * 8;
    for (int i0 = gw * 8; i0 < T * 4; i0 += NGW * 8) {
        unsigned w4[8][4];
#pragma unroll
        for (int u = 0; u < 8; ++u) ld4u(oret + (size_t)(i0 + u) * 512 + F.lane * 8, w4[u]);
#pragma unroll
        for (int u = 0; u < 8; ++u) { float s = 0.f;
#pragma unroll
            for (int qq = 0; qq < 4; ++qq) { const float lo = bf2f(w4[u][qq] & 0xffffu), hi = bf2f(w4[u][qq] >> 16); s += lo * lo + hi * hi; }
            s = wave_sum(s); if (F.lane == 0) rn[i0 + u] = 1.0f / sqrtf(s * (1.0f / 512.f) + RMS_EPS); } }
}

__device__ __forceinline__ void rownorm_phase(const Frame& F, ArgsRef a) {
    const float* small = (const float*)(WS(a) + WS_SMALL); bf16_t* cqn = (bf16_t*)(WS(a) + WS_CQN); bf16_t* ckv = (bf16_t*)(WS(a) + WS_CKV); bf16_t* kidx = (bf16_t*)(WS(a) + WS_KIDX); float* widx = (float*)(WS(a) + WS_WIDX);
    const float* gkv = IN(a, I_CKV_G); const float* gki = IN(a, I_KIDX_G);
    const int gw = F.bid * 8 + F.wave, NGW = F.G * 8, l = F.lane;
    for (int tb4 = gw * 4; tb4 < T; tb4 += NGW * 4) { f32x4 va[4], vb[4];
#pragma unroll
      for (int u = 0; u < 4; ++u) { va[u] = *(const f32x4*)(small + (size_t)(tb4 + u) * 512 + 8 * l); vb[u] = *(const f32x4*)(small + (size_t)(tb4 + u) * 512 + 8 * l + 4); }
#pragma unroll
      for (int u = 0; u < 4; ++u) { const int t = tb4 + u; const f32x4 v0 = va[u], v1 = vb[u];
        const float ss = (v0[0] * v0[0] + v0[1] * v0[1]) + (v0[2] * v0[2] + v0[3] * v0[3]) + (v1[0] * v1[0] + v1[1] * v1[1]) + (v1[2] * v1[2] + v1[3] * v1[3]);
        const float sq = wave_sum(l < 32 ? ss : 0.f), skv = wave_sum((l >= 32 && l < 48) ? ss : 0.f), ski = wave_sum((l >= 48 && l < 56) ? ss : 0.f);
        float x[8] = {v0[0], v0[1], v0[2], v0[3], v1[0], v1[1], v1[2], v1[3]};
        if (l < 32) { const float r = 1.0f / sqrtf(sq * (1.f / 256.f) + RMS_EPS); u32x4 w; w.x = cvt_pk_bf16(x[0] * r, x[1] * r); w.y = cvt_pk_bf16(x[2] * r, x[3] * r); w.z = cvt_pk_bf16(x[4] * r, x[5] * r); w.w = cvt_pk_bf16(x[6] * r, x[7] * r); *(u32x4*)(cqn + (size_t)t * 256 + 8 * l) = w; }
        else if (l < 48) { const float r = 1.0f / sqrtf(skv * (1.f / 128.f) + RMS_EPS); const int c = 8 * (l - 32); const f32x4 g0 = *(const f32x4*)(gkv + c), g1 = *(const f32x4*)(gkv + c + 4);
            u32x4 w; w.x = cvt_pk_bf16(x[0] * r * g0[0], x[1] * r * g0[1]); w.y = cvt_pk_bf16(x[2] * r * g0[2], x[3] * r * g0[3]); w.z = cvt_pk_bf16(x[4] * r * g1[0], x[5] * r * g1[1]); w.w = cvt_pk_bf16(x[6] * r * g1[2], x[7] * r * g1[3]); *(u32x4*)(ckv + (size_t)t * 128 + c) = w; }
        else if (l < 56) { const float r = 1.0f / sqrtf(ski * (1.f / 64.f) + RMS_EPS); const int c = 8 * (l - 48); const f32x4 g0 = *(const f32x4*)(gki + c), g1 = *(const f32x4*)(gki + c + 4);
            u32x4 w; w.x = cvt_pk_bf16(x[0] * r * g0[0], x[1] * r * g0[1]); w.y = cvt_pk_bf16(x[2] * r * g0[2], x[3] * r * g0[3]); w.z = cvt_pk_bf16(x[4] * r * g1[0], x[5] * r * g1[1]); w.w = cvt_pk_bf16(x[6] * r * g1[2], x[7] * r * g1[3]); *(u32x4*)(kidx + (size_t)t * 64 + c) = w; }
        else if (l == 56) { const float sc = 0.35355339059327373f; *(f32x4*)(widx + (size_t)t * 8) = v0 * sc; *(f32x4*)(widx + (size_t)t * 8 + 4) = v1 * sc; }
      } }
}
struct EpiQ { static constexpr bool PERM = true;
    bf16_t* qlat; bf16_t* qidx;
    __device__ __forceinline__ void operator()(const f32x4 (&acc)[2][2][4][2], const pg8::Unit& u, int wr, int wc, int fr, int fq) const {
#pragma unroll
        for (int ai = 0; ai < 2; ++ai)
#pragma unroll
            for (int m = 0; m < 4; ++m) { const int row = u.pm * 256 + 128 * ai + 64 * wr + 16 * m + fr;
#pragma unroll
                for (int bj = 0; bj < 2; ++bj) { const int c = 128 * bj + 32 * wc + 8 * fq; bf16_t* p = u.pn < 4 ? qlat + (size_t)row * 1024 + u.pn * 256 + c : qidx + (size_t)row * 512 + (u.pn - 4) * 256 + c;
                    const f32x4 v0 = acc[ai][bj][m][0], v1 = acc[ai][bj][m][1]; u32x4 w; w.x = cvt_pk_bf16(v0[0], v0[1]); w.y = cvt_pk_bf16(v0[2], v0[3]); w.z = cvt_pk_bf16(v1[0], v1[1]); w.w = cvt_pk_bf16(v1[2], v1[3]); *(u32x4*)p = w; } }
    }
};
#define DPP_STEP_(op, ctrl, rmask) { const unsigned t_ = (unsigned)__builtin_amdgcn_update_dpp((int)v, (int)v, ctrl, rmask, 0xf, false); v = op(v, t_); }
__device__ __forceinline__ unsigned umax_(unsigned a, unsigned b) { return a > b ? a : b; }
__device__ __forceinline__ unsigned umin_(unsigned a, unsigned b) { return a < b ? a : b; }
__device__ __forceinline__ unsigned wave_umax(unsigned v) { DPP_STEP_(umax_, 0x111, 0xf) DPP_STEP_(umax_, 0x112, 0xf) DPP_STEP_(umax_, 0x114, 0xf) DPP_STEP_(umax_, 0x118, 0xf) DPP_STEP_(umax_, 0x142, 0xa) DPP_STEP_(umax_, 0x143, 0xc) return (unsigned)__builtin_amdgcn_readlane((int)v, 63); }
__device__ __forceinline__ unsigned wave_umin(unsigned v) { DPP_STEP_(umin_, 0x111, 0xf) DPP_STEP_(umin_, 0x112, 0xf) DPP_STEP_(umin_, 0x114, 0xf) DPP_STEP_(umin_, 0x118, 0xf) DPP_STEP_(umin_, 0x142, 0xa) DPP_STEP_(umin_, 0x143, 0xc) return (unsigned)__builtin_amdgcn_readlane((int)v, 63); }
template <int MODE> __device__ __forceinline__ void indexer_phase(const Frame& F, ArgsRef a) {
    const bf16_t* qidx = (const bf16_t*)(WS(a) + WS_QIDX); const bf16_t* kidx = (const bf16_t*)(WS(a) + WS_KIDX); const float* widx = (const float*)(WS(a) + WS_WIDX);
    unsigned long long* mask = (unsigned long long*)(WS(a) + WS_MASK);
    LAS float* sc = (LAS float*)(F.lds + LDS_STAGE); LAS float* wl = (LAS float*)(F.misc + LM_REC);
    const int lane = F.lane, w = F.wave, r = lane & 31, hh = lane >> 5;
    const int rq = 2 * (r >> 4) + ((r >> 2) & 1), rh = 4 * ((r >> 3) & 1) + (r & 3);
    for (int k8 = 0; k8 < 8; ++k8) {
        const int u = F.bid + F.G * k8; if (u >= NB * 128) break;
        const int b = u & 15, j = u >> 4, kk = j >> 4, cc = j & 15, blk = (kk & 1) ? 127 - 16 * (kk >> 1) - cc : 16 * (kk >> 1) + cc, qc = blk >> 2,     NK = 64 * (qc + 1), t0 = b * SEQ + 16 * blk;
        if (qc <= 3) {
            if (MODE == 0) for (int i = F.tid; i < 16 * 32; i += 512) { const int q = i >> 5, wi = i & 31; mask[(size_t)(t0 + q) * 32 + wi] = wi <= qc ? ~0ull : 0ull; }
            continue; }
        __syncthreads();
        if (F.tid < 128) wl[F.tid] = widx[(size_t)t0 * 8 + F.tid];
        bf16x8 A[4][4];
#pragma unroll
        for (int rt = 0; rt < 4; ++rt)
#pragma unroll
            for (int ks = 0; ks < 4; ++ks) A[rt][ks] = *(const bf16x8*)(qidx + (size_t)(t0 + 4 * rt + rq) * 512 + rh * 64 + 16 * ks + 8 * hh);
        __syncthreads();
        bf16x8 Bn[4];
#pragma unroll
        for (int ks = 0; ks < 4; ++ks) Bn[ks] = *(const bf16x8*)(kidx + (size_t)(b * SEQ + 32 * w + r) * 64 + 16 * ks + 8 * hh);
        if (MODE != 2) for (int kt = w; kt < NK / 32; kt += 8) {
            bf16x8 B[4];
#pragma unroll
            for (int ks = 0; ks < 4; ++ks) B[ks] = Bn[ks];
            if (kt + 8 < NK / 32) {
#pragma unroll
                for (int ks = 0; ks < 4; ++ks) Bn[ks] = *(const bf16x8*)(kidx + (size_t)(b * SEQ + 32 * (kt + 8) + r) * 64 + 16 * ks + 8 * hh); }
#pragma unroll
            for (int rt = 0; rt < 4; ++rt) { f32x16 c;
#pragma unroll
                for (int i = 0; i < 16; ++i) c[i] = 0.f;
#pragma unroll
                for (int ks = 0; ks < 4; ++ks) c = MFMA32(A[rt][ks], B[ks], c);
#pragma unroll
                for (int aa = 0; aa < 2; ++aa) { const int q = 4 * rt + 2 * aa + hh; const f32x4 w0 = *(const LAS f32x4*)(wl + q * 8), w1 = *(const LAS f32x4*)(wl + q * 8 + 4);
                    float s = 0.f;
#pragma unroll
                    for (int d = 0; d < 4; ++d) { s += fmaxf(c[8 * aa + d], 0.f) * w0[d]; s += fmaxf(c[8 * aa + 4 + d], 0.f) * w1[d]; }
                    sc[q * 2048 + 32 * kt + r] = s; } }
        }
        __syncthreads();
        if (MODE != 1)
#pragma unroll 1
        for (int qq = 0; qq < 2; ++qq) { const int q = 2 * w + qq; unsigned uu[32]; int nk = NK; asm volatile("" : "+s"(nk));
#pragma unroll
            for (int i = 0; i < 32; ++i) { const float f = sc[q * 2048 + 64 * i + lane]; const unsigned bits = __builtin_bit_cast(unsigned, f); const unsigned vm = (unsigned)((64 * i + lane - nk) >> 31); uu[i] = (bits ^ ((bits >> 31) ? 0xffffffffu : 0x80000000u)) & vm; }
            unsigned lo = 0xffffffffu, hi = 0u;
#pragma unroll
            for (int i = 0; i < 32; ++i) { const unsigned v = uu[i]; hi = v > hi ? v : hi; const unsigned vv = v ? v : 0xffffffffu; lo = vv < lo ? vv : lo; }
            lo = wave_umin(lo); hi = wave_umax(hi);
            unsigned theta = lo; bool exact = false; int chi = 0;
#pragma unroll 1
            while (lo < hi) { const unsigned mid = lo + ((hi - lo) >> 1) + 1u;
                int cnt = 0;
#pragma unroll
                for (int i8 = 0; i8 < 32; i8 += 8) { if (i8 * 64 >= nk) continue;
                    unsigned long long mk[8];
#pragma unroll
                    for (int i = 0; i < 8; ++i) mk[i] = __ballot(uu[i8 + i] >= mid);
                    __builtin_amdgcn_sched_barrier(0);
#pragma unroll
                    for (int i = 0; i < 8; ++i) cnt += __builtin_popcountll(mk[i]);
                    __builtin_amdgcn_sched_barrier(0); }
                if (cnt == 256) { theta = mid; exact = true; break; }
                if (cnt > 256) lo = mid; else { hi = mid - 1u; chi = cnt; }
                theta = lo; }
            unsigned wlo_ = 0u, whi_ = 0u;
            if (exact) {
#pragma unroll
                for (int i = 0; i < 32; ++i) { const unsigned long long word = __ballot(uu[i] >= theta); wlo_ = lane == i ? (unsigned)word : wlo_; whi_ = lane == i ? (unsigned)(word >> 32) : whi_; }
            } else { const int need = 256 - chi; int run = 0;
#pragma unroll
                for (int i = 0; i < 32; ++i) { const unsigned long long m = __ballot(uu[i] == theta); const int pre = run + __builtin_popcountll(m & ((1ull << lane) - 1ull));
                    const bool sel = (uu[i] > theta) || (uu[i] == theta && pre < need); run += __builtin_popcountll(m);
                    const unsigned long long word = __ballot(sel); wlo_ = lane == i ? (unsigned)word : wlo_; whi_ = lane == i ? (unsigned)(word >> 32) : whi_; } }
            if (MODE == 0 && lane < 32) { u32x2 w2; w2.x = wlo_; w2.y = whi_; *(u32x2*)(mask + (size_t)(t0 + q) * 32 + lane) = w2; }
            if (MODE == 2) asm volatile("" :: "v"(wlo_), "v"(whi_));
        }
    }
}

namespace att {
constexpr int SHM_V = 64 * 128 * 2, SHM_K = 64 * 128 * 2, LDS_MSK = 3 * SHM_V + 3 * SHM_K, LDS_BT = LDS_MSK + 8192, LDS_WS = LDS_BT + 8 * 320 * 4, LDS_END = LDS_WS + 8 * 64 * 4;
#define KSWZ(row, colB) ((row) * 256 + ((colB) ^ (((row) & 7) << 4)))
#define SBAR() __builtin_amdgcn_sched_barrier(0)
__device__ __forceinline__ int crow(int r, int hi) { return (r & 3) + 8 * (r >> 2) + 4 * hi; }
__device__ __forceinline__ int v_st(int k, int c) { const int kk = (k & ~0xC) | ((k & 4) << 1) | ((k & 8) >> 1); return ((kk >> 3) * 4 + (c >> 5)) * 512 + ((kk & 7) * 32 + (c & 31)) * 2; }
__device__ __forceinline__ int v_rd_base(int lane) { return ((lane & 3) << 3) | (((lane >> 2) & 3) << 6) | (((lane >> 4) & 1) << 5) | (((lane >> 5) & 1) << 8); }
constexpr int v_rd_off(int d0, int ks, int half) { return d0 * 512 + ks * 4096 + half * 2048; }
template <int OFF> __device__ __forceinline__ s16x4 tr_read(int vb) { s16x4 r; asm volatile("ds_read_b64_tr_b16 %0, %1 offset:%2" : "=&v"(r) : "v"(vb), "i"(OFF) : "memory"); return r; }
template <int D0> __device__ __forceinline__ void pv_one(f32x16& od, int vb, bf16x8 pa0, bf16x8 pa1, bf16x8 pa2, bf16x8 pa3) {
    const s16x4 l0 = tr_read<v_rd_off(D0, 0, 0)>(vb), h0 = tr_read<v_rd_off(D0, 0, 1)>(vb), l1 = tr_read<v_rd_off(D0, 1, 0)>(vb), h1 = tr_read<v_rd_off(D0, 1, 1)>(vb);
    const s16x4 l2 = tr_read<v_rd_off(D0, 2, 0)>(vb), h2 = tr_read<v_rd_off(D0, 2, 1)>(vb), l3 = tr_read<v_rd_off(D0, 3, 0)>(vb), h3 = tr_read<v_rd_off(D0, 3, 1)>(vb);
    asm volatile("s_waitcnt lgkmcnt(0)" ::: "memory"); SBAR();
#define PK(L, H) (bf16x8){L[0], L[1], L[2], L[3], H[0], H[1], H[2], H[3]}
    od = MFMA32(pa0, PK(l0, h0), od); od = MFMA32(pa1, PK(l1, h1), od); od = MFMA32(pa2, PK(l2, h2), od); od = MFMA32(pa3, PK(l3, h3), od);
#undef PK
}
__device__ __forceinline__ void pv_d0(f32x16* o, int vb, bf16x8 pa0, bf16x8 pa1, bf16x8 pa2, bf16x8 pa3) {
    pv_one<0>(o[0], vb, pa0, pa1, pa2, pa3); pv_one<1>(o[1], vb, pa0, pa1, pa2, pa3); pv_one<2>(o[2], vb, pa0, pa1, pa2, pa3); pv_one<3>(o[3], vb, pa0, pa1, pa2, pa3);
}
__device__ __forceinline__ void qkt(f32x16& p0, f32x16& p1, const LAS unsigned char* Ks, const bf16x8* qr, int r32, int hi) {
#pragma unroll
    for (int i = 0; i < 16; ++i) { p0[i] = 0.f; p1[i] = 0.f; }
#pragma unroll
    for (int d0 = 0; d0 < 8; ++d0) { const int cb = (d0 * 16 + hi * 8) * 2;
        const bf16x8 b0 = *(const LAS bf16x8*)(Ks + KSWZ(r32, cb)), b1 = *(const LAS bf16x8*)(Ks + KSWZ(32 + r32, cb));
        p0 = MFMA32(b0, qr[d0], p0); p1 = MFMA32(b1, qr[d0], p1); }
}
template <bool NEAR> __device__ __forceinline__ void bias_mask(f32x16& p0, f32x16& p1, unsigned wlo, unsigned whi, float bfar, const LAS float* bt, int relbase) {
    constexpr float C = 0.088388347648318440f * 1.4426950408889634f;
    asm volatile("" : "+v"(wlo), "+v"(whi));
#pragma unroll
    for (int r = 0; r < 16; ++r) { const int cr = (r & 3) + 8 * (r >> 2);
        const float b0 = NEAR ? bt[relbase + cr] : bfar, b1 = NEAR ? bt[relbase + 32 + cr] : bfar;
        const float s0 = fmaf(p0[r], C, b0), s1 = fmaf(p1[r], C, b1);
        p0[r] = (wlo & (1u << cr)) ? s0 : -INFINITY; p1[r] = (whi & (1u << cr)) ? s1 : -INFINITY; }
}
__device__ __forceinline__ void partialSM(f32x16& p0, f32x16& p1, float& m_reg, float& mn, float& alpha) {
    float pmax = p0[0];
#pragma unroll
    for (int r = 1; r < 16; ++r) pmax = fmaxf(pmax, p0[r]);
#pragma unroll
    for (int r = 0; r < 16; ++r) pmax = fmaxf(pmax, p1[r]);
    { auto rr = __builtin_amdgcn_permlane32_swap(__float_as_uint(pmax), __float_as_uint(pmax), false, false); pmax = fmaxf(__uint_as_float(rr[0]), __uint_as_float(rr[1])); }
    if (__all(pmax - m_reg <= 8.f)) { mn = m_reg; alpha = 1.f; }
    else { mn = fmaxf(m_reg, pmax); alpha = __builtin_amdgcn_exp2f(m_reg - mn); m_reg = mn; }
#pragma unroll
    for (int r = 0; r < 16; ++r) p0[r] = __builtin_amdgcn_exp2f(p0[r] - mn);
}
__device__ __forceinline__ void finishSM(f32x16& p0, f32x16& p1, float mn, float alpha, float& l_reg, bf16x8& pa0, bf16x8& pa1, bf16x8& pa2, bf16x8& pa3) {
#pragma unroll
    for (int r = 0; r < 16; ++r) p1[r] = __builtin_amdgcn_exp2f(p1[r] - mn);
    float ps = 0;
#pragma unroll
    for (int r = 0; r < 16; ++r) ps += p0[r];
#pragma unroll
    for (int r = 0; r < 16; ++r) ps += p1[r];
    { auto rr = __builtin_amdgcn_permlane32_swap(__float_as_uint(ps), __float_as_uint(ps), false, false); ps = __uint_as_float(rr[0]) + __uint_as_float(rr[1]); }
    l_reg = l_reg * alpha + ps;
#define PK4(P, BASE, OUT) do { unsigned a0 = cvt_pk_bf16(P[BASE + 0], P[BASE + 1]), a1 = cvt_pk_bf16(P[BASE + 2], P[BASE + 3]); \
    unsigned b0 = cvt_pk_bf16(P[BASE + 4], P[BASE + 5]), b1 = cvt_pk_bf16(P[BASE + 6], P[BASE + 7]); \
    auto r0 = __builtin_amdgcn_permlane32_swap(a0, b0, false, false); auto r1 = __builtin_amdgcn_permlane32_swap(a1, b1, false, false); \
    u32x4 w = {r0[0], r1[0], r0[1], r1[1]}; OUT = __builtin_bit_cast(bf16x8, w); } while (0)
    PK4(p0, 0, pa0); PK4(p0, 8, pa1); PK4(p1, 0, pa2); PK4(p1, 8, pa3);
#undef PK4
}
}
__device__ __forceinline__ int t5_bucket_abs(int n) { return n < 8 ? n : n < 12 ? 8 : n < 16 ? 9 : n < 23 ? 10 : n < 32 ? 11 : n < 46 ? 12 : n < 64 ? 13 : n < 91 ? 14 : 15; }
__device__ __forceinline__ void attention_phase(const Frame& F, ArgsRef a) {
    using namespace att;
    const bf16_t* qlat = (const bf16_t*)(WS(a) + WS_QLAT); const bf16_t* ckv = (const bf16_t*)(WS(a) + WS_CKV); const unsigned* mask = (const unsigned*)(WS(a) + WS_MASK); bf16_t* olat = (bf16_t*)(WS(a) + WS_OLAT);
    LAS unsigned char* L = F.lds + LDS_STAGE; LAS unsigned char* V_lds = L; LAS unsigned char* K_lds = L + 3 * SHM_V;
    LAS unsigned* msk = (LAS unsigned*)(L + LDS_MSK); LAS float* bt = (LAS float*)(L + LDS_BT);
    const int tid = F.tid, wid = F.wave, lane = F.lane, r32 = lane & 31, hi = lane >> 5, hd = r32 & 7;
    LAS float* wsx = (LAS float*)(L + LDS_WS) + wid * 64; LAS float* li_l = wsx; LAS float* al_l = wsx + 32;
    __syncthreads();
    for (int i = tid; i < 8 * 320; i += 512) { const int h = i / 320, rel = (i % 320) - 255; const int n = rel < 0 ? -rel : rel; bt[i] = IN(a, I_T5)[h * 32 + (rel > 0 ? 16 : 0) + t5_bucket_abs(n)] * 1.4426950408889634f; }
    const float bfar = IN(a, I_T5)[hd * 32 + 15] * 1.4426950408889634f;
    for (int k4 = 0; k4 < 4; ++k4) {
        const int u = F.bid + F.G * k4; if (u >= NB * 64) break;
        const int b = u & 15, j = u >> 4, kk = j >> 4, cc = j & 15, blk = (kk & 1) ? 63 - 16 * (kk >> 1) - cc : 16 * (kk >> 1) + cc, qc = blk >> 1,     t0 = b * SEQ + 32 * blk, NT = qc + 1;
        __syncthreads();
        for (int i = tid; i < 32 * 64; i += 512) msk[i] = mask[(size_t)t0 * 64 + i];
        const bf16_t* Kh = ckv + (size_t)b * SEQ * 128;
        const int qi = 4 * wid + (r32 >> 3), qpos = 32 * blk + qi;
        float m_reg = -1e30f, l_reg = 0.f; f32x16 o[4]; bf16x8 qr[8];
#pragma unroll
        for (int d = 0; d < 4; ++d)
#pragma unroll
            for (int i = 0; i < 16; ++i) o[d][i] = 0.f;
        const bf16_t* Qw = qlat + (size_t)(t0 * 8 + wid * 32 + r32) * 128 + hi * 8;
#pragma unroll
        for (int d0 = 0; d0 < 8; ++d0) qr[d0] = *(const bf16x8*)(Qw + d0 * 16);
        const int sr = tid >> 4, scol = (tid & 15) * 8, vst0 = v_st(sr, scol), vst1 = v_st(32 + sr, scol);
        const int vb0 = (int)(uintptr_t)V_lds + v_rd_base(lane);
        bf16x8 st0[1], st1[1];
#define SLOAD(i, k0) do { st0[i] = *(const bf16x8*)(Kh + (size_t)((k0) + sr) * 128 + scol); st1[i] = *(const bf16x8*)(Kh + (size_t)((k0) + 32 + sr) * 128 + scol); } while (0)
#define SWRITE(bb, i) do { *(LAS bf16x8*)(V_lds + (bb) * SHM_V + vst0) = st0[i]; *(LAS bf16x8*)(V_lds + (bb) * SHM_V + vst1) = st1[i]; const int kc = scol * 2; \
        *(LAS bf16x8*)(K_lds + (bb) * SHM_K + KSWZ(sr, kc)) = st0[i]; *(LAS bf16x8*)(K_lds + (bb) * SHM_K + KSWZ(32 + sr, kc)) = st1[i]; } while (0)
#define SWAIT() asm volatile("s_waitcnt vmcnt(2)" ::: "memory")
#define RESC(al) do { if (__any((al) < 1.f)) { if (hi == 0) al_l[r32] = (al); asm volatile("s_waitcnt lgkmcnt(0)" ::: "memory"); \
        _Pragma("unroll") for (int d = 0; d < 4; ++d) _Pragma("unroll") for (int r = 0; r < 16; ++r) o[d][r] *= al_l[crow(r, hi)]; } } while (0)
#define BIASMASK(P0, P1, jt) do { const unsigned wl_ = msk[qi * 64 + 2 * (jt)] >> (4 * hi), wh_ = msk[qi * 64 + 2 * (jt) + 1] >> (4 * hi); \
        if (64 * (jt) + 63 - 32 * blk > -128) bias_mask<true>(P0, P1, wl_, wh_, bfar, bt + hd * 320, 64 * (jt) + 4 * hi - qpos + 255); else bias_mask<false>(P0, P1, wl_, wh_, bfar, bt, 0); } while (0)
        f32x16 p0, p1; float mn, al; bf16x8 pa0, pa1, pa2, pa3;
        SLOAD(0, 0); asm volatile("s_waitcnt vmcnt(0)" ::: "memory"); SWRITE(0, 0); __syncthreads();
        for (int jt = 0, bb = 0; jt < NT; ++jt) { const int nb = bb == 2 ? 0 : bb + 1;
            if (jt + 1 < NT) SLOAD(0, (jt + 1) * 64);
            qkt(p0, p1, K_lds + bb * SHM_K, qr, r32, hi); BIASMASK(p0, p1, jt);
            partialSM(p0, p1, m_reg, mn, al); finishSM(p0, p1, mn, al, l_reg, pa0, pa1, pa2, pa3); SBAR();
            RESC(al);
            pv_d0(o, vb0 + bb * SHM_V, pa0, pa1, pa2, pa3);
            if (jt + 1 < NT) SWRITE(nb, 0);
            __syncthreads();
            bb = nb;
        }
        if (hi == 0) li_l[r32] = l_reg; asm volatile("s_waitcnt lgkmcnt(0)" ::: "memory");
        float rli[16];
#pragma unroll
        for (int r = 0; r < 16; ++r) rli[r] = __builtin_amdgcn_rcpf(li_l[crow(r, hi)]);
        if constexpr (MIXA_FP8) { unsigned char* O8 = (unsigned char*)olat + (size_t)(t0 * 8 + wid * 32) * 128 + 4 * r32;
#pragma unroll
            for (int r = 0; r < 16; ++r) { const float sc_ = rli[r] * 4.f; *(unsigned*)(O8 + (size_t)crow(r, hi) * 128) = pk4_fp8(o[0][r] * sc_, o[1][r] * sc_, o[2][r] * sc_, o[3][r] * sc_); } }
        else { bf16_t* Ow = olat + (size_t)(t0 * 8 + wid * 32) * 128;
#pragma unroll
        for (int r = 0; r < 16; ++r) { const int orow = crow(r, hi);
#pragma unroll
            for (int d0 = 0; d0 < 4; ++d0) Ow[(size_t)orow * 128 + d0 * 32 + r32] = (bf16_t)f2bf(o[d0][r] * rli[r]); } }
#undef SLOAD
#undef SWRITE
#undef SWAIT
#undef RESC
#undef BIASMASK
    }
}
#undef KSWZ
#undef SBAR

__device__ __forceinline__ void grid_bar(unsigned char* lds_raw) {
    ArgsRef a = phase_args(); XcdBarrier b; b.bar = (unsigned*)(WS(a) + WS_CTL) + CW_BAR; b.x = xb_xcc_id(); b.st = (volatile LAS unsigned*)((LAS unsigned char*)lds_raw + LDS_MISC + LM_BAR);
    xcd_barrier(b);
}
template <int HALFI> __device__ __forceinline__ void moe_gateup_phase(unsigned char* lds_raw) {
    ArgsRef a = phase_args(); const Frame F = make_frame(lds_raw);
    const int ntiles = moe_tables(F, a, HALFI);
    const int* lists = (const int*)(WS(a) + WS_LTOK) + (size_t)HALFI * NE * LIST_CAP; const float* lrs = (const float*)(WS(a) + WS_LRS) + (size_t)HALFI * NE * LIST_CAP;
    typedef MoeOrder<8, true, MOE_FP8 ? 1024 : 2048> Ord;
    Ord S{(const LAS int*)(F.misc + LM_TILE), (const LAS int*)(F.misc + LM_CNT), lists, ntiles, F.G, F.bid};
    EpiGateUp E{(bf16_t*)(WS(a) + WS_ACT), IN(a, I_B_GATE), IN(a, I_B_UP), lrs, (const LAS int*)(F.misc + LM_CNT)};
    pg8::gemm_phase<EpiGateUp, Ord, false, true, MOE_FP8 ? D / 2 : D, MOE_FP8>(F.lds + LDS_STAGE, F.tid, (const bf16_t*)(WS(a) + WS_X2B), (const bf16_t*)(WS(a) + WS_WGU), S, E, (LAS u32x4*)(F.misc + LM_SLOTS));
}
template <int HALFI> __device__ __forceinline__ void moe_down_phase(unsigned char* lds_raw) {
    ArgsRef a = phase_args(); const Frame F = make_frame(lds_raw);
    const int ntiles = moe_tables(F, a, HALFI);
    typedef MoeOrder<4, false, MOE_FP8 ? 1024 : 2048> Ord;
    Ord S{(const LAS int*)(F.misc + LM_TILE), (const LAS int*)(F.misc + LM_CNT), nullptr, ntiles, F.G, F.bid};
    EpiDown E{(bf16_t*)(WS(a) + WS_Y), IN(a, I_B_DOWN)};
    pg8::gemm_phase<EpiDown, Ord, false, false, MOE_FP8 ? FF / 2 : FF, MOE_FP8>(F.lds + LDS_STAGE, F.tid, (const bf16_t*)(WS(a) + WS_ACT), (const bf16_t*)(WS(a) + WS_WD), S, E);
}
template <int HALFI> __device__ __forceinline__ void moe_gateup_probe(unsigned char* lds_raw) {
    ArgsRef a = phase_args(); const Frame F = make_frame(lds_raw);
    const int ntiles = moe_tables(F, a, HALFI);
    const int* lists = (const int*)(WS(a) + WS_LTOK) + (size_t)HALFI * NE * LIST_CAP;
    typedef MoeOrder<8, true, MOE_FP8 ? 1024 : 2048> Ord;
    Ord S{(const LAS int*)(F.misc + LM_TILE), (const LAS int*)(F.misc + LM_CNT), lists, ntiles, F.G, F.bid};
    EpiProbe E{(float*)(WS(a) + WS_Y)};
    pg8::gemm_phase<EpiProbe, Ord, false, true, MOE_FP8 ? D / 2 : D, MOE_FP8>(F.lds + LDS_STAGE, F.tid, (const bf16_t*)(WS(a) + WS_X2B), (const bf16_t*)(WS(a) + WS_WGU), S, E, (LAS u32x4*)(F.misc + LM_SLOTS));
}
template <int HALFI> __device__ __forceinline__ void moe_down_probe(unsigned char* lds_raw) {
    ArgsRef a = phase_args(); const Frame F = make_frame(lds_raw);
    const int ntiles = moe_tables(F, a, HALFI);
    typedef MoeOrder<4, false, MOE_FP8 ? 1024 : 2048> Ord;
    Ord S{(const LAS int*)(F.misc + LM_TILE), (const LAS int*)(F.misc + LM_CNT), nullptr, ntiles, F.G, F.bid};
    EpiProbe E{(float*)(WS(a) + WS_X2B)};
    pg8::gemm_phase<EpiProbe, Ord, false, false, MOE_FP8 ? FF / 2 : FF, MOE_FP8>(F.lds + LDS_STAGE, F.tid, (const bf16_t*)(WS(a) + WS_ACT), (const bf16_t*)(WS(a) + WS_WD), S, E);
}
template <int HALFI> __device__ __forceinline__ void moe_combine_phase(unsigned char* lds_raw) {
    ArgsRef a = phase_args(); const Frame F = make_frame(lds_raw);
    (void)moe_tables(F, a, HALFI);
    combine_phase(F, a, HALFI);
}
__device__ __forceinline__ void prep_phase(unsigned char* lds_raw) { ArgsRef a = phase_args(); const Frame F = make_frame(lds_raw); mixer_prep_phase(F, a); }
#ifndef PREP2MASK
#define PREP2MASK 63
#endif
__device__ __forceinline__ void prep2_phase(unsigned char* lds_raw) { ArgsRef a = phase_args(); const Frame F = make_frame(lds_raw); mixer_prep_phase<PREP2MASK>(F, a); }
__device__ __forceinline__ void inproj_a_phase(unsigned char* lds_raw) {
    ArgsRef a = phase_args(); const Frame F = make_frame(lds_raw); const float* misc = (const float*)(WS(a) + WS_MISC);
    { DenseOrder S; S.init(T, 6 * 256, D, F.G, F.bid, 0, 0);
      EpiInA E{(bf16_t*)(WS(a) + WS_QX), (float*)(WS(a) + WS_SMALL), misc + MISC_RSTD1 / 4, (const float*)(WS(a) + WS_COSP), (const float*)(WS(a) + WS_SINP), misc + MISC_DQ / 4,
               (bf16_t*)(WS(a) + WS_CQN), (bf16_t*)(WS(a) + WS_CKV), (bf16_t*)(WS(a) + WS_KIDX), (float*)(WS(a) + WS_WIDX), IN(a, I_CKV_G), IN(a, I_KIDX_G), (LAS float*)(F.misc + 17408)};
      pg8::gemm_phase<EpiInA, DenseOrder, false, false, D>(F.lds + LDS_STAGE, F.tid, (const bf16_t*)(WS(a) + WS_XB), (const bf16_t*)(WS(a) + WS_WIN), S, E); }
}
__device__ __forceinline__ void inproj_b_phase(unsigned char* lds_raw) {
    ArgsRef a = phase_args(); const Frame F = make_frame(lds_raw); const float* misc = (const float*)(WS(a) + WS_MISC);
    if constexpr (INB_FP8) {
      { DenseOrder S; S.init(T, 4 * 256, D, F.G, F.bid, 0, (size_t)6 * 256 * D * 2);
        EpiInB<0, false> E{(bf16_t*)(WS(a) + WS_KZT), (bf16_t*)(WS(a) + WS_VT), misc + MISC_RSTD1 / 4, (const float*)(WS(a) + WS_COST), (const float*)(WS(a) + WS_SINT), misc + MISC_DZ / 4};
        pg8::gemm_phase<EpiInB<0, false>, DenseOrder, true, false, D>(F.lds + LDS_STAGE, F.tid, (const bf16_t*)(WS(a) + WS_XB), (const bf16_t*)(WS(a) + WS_WIN), S, E); }
      { DenseOrder S; S.init(T, 8 * 256, D / 2, F.G, F.bid, 0, 0);
        EpiInB<4, true> E{(bf16_t*)(WS(a) + WS_KZT), (bf16_t*)(WS(a) + WS_VT), misc + MISC_RSTD1 / 4, (const float*)(WS(a) + WS_COST), (const float*)(WS(a) + WS_SINT), misc + MISC_DZ / 4};
        pg8::gemm_phase<EpiInB<4, true>, DenseOrder, true, false, D / 2, true>(F.lds + LDS_STAGE, F.tid, (const bf16_t*)(WS(a) + WS_XB8), (const bf16_t*)(WS(a) + WS_WIN8 + 4 * MiB), S, E); }
    } else {
      DenseOrder S; S.init(T, 12 * 256, D, F.G, F.bid, 0, (size_t)6 * 256 * D * 2);
      EpiInB<0, false> E{(bf16_t*)(WS(a) + WS_KZT), (bf16_t*)(WS(a) + WS_VT), misc + MISC_RSTD1 / 4, (const float*)(WS(a) + WS_COST), (const float*)(WS(a) + WS_SINT), misc + MISC_DZ / 4};
      pg8::gemm_phase<EpiInB<0, false>, DenseOrder, true, false, D>(F.lds + LDS_STAGE, F.tid, (const bf16_t*)(WS(a) + WS_XB), (const bf16_t*)(WS(a) + WS_WIN), S, E); }
}
__device__ __forceinline__ void inproj_c_phase(unsigned char* lds_raw) {
    ArgsRef a = phase_args(); const Frame F = make_frame(lds_raw); const float* misc = (const float*)(WS(a) + WS_MISC);
    DenseOrder S; S.init(T, 16 * 256, INC_FP8 ? D / 2 : D, F.G, F.bid, 0, INC_FP8 ? (size_t)0 : (size_t)18 * 256 * D * 2);
    EpiInC E{(bf16_t*)OUT(a), (bf16_t*)(WS(a) + WS_GA), (bf16_t*)(WS(a) + WS_GB), misc + MISC_RSTD1 / 4, misc + MISC_RN / 4};
    pg8::gemm_phase<EpiInC, DenseOrder, false, false, INC_FP8 ? D / 2 : D, INC_FP8>(F.lds + LDS_STAGE, F.tid, (const bf16_t*)(WS(a) + (INC_FP8 ? WS_XB8 : WS_XB)), (const bf16_t*)(WS(a) + (INC_FP8 ? WS_WIN8 : WS_WIN)), S, E);
}
__device__ __forceinline__ void retention_phase_w(unsigned char* lds_raw) { ArgsRef a = phase_args(); const Frame F = make_frame(lds_raw); retention_phase(F, a); }
__device__ __forceinline__ void retnorm_phase_w(unsigned char* lds_raw) { ArgsRef a = phase_args(); const Frame F = make_frame(lds_raw); retnorm_phase(F, a); }
__device__ __forceinline__ void mix_a_phase(unsigned char* lds_raw) {
    ArgsRef a = phase_args(); const Frame F = make_frame(lds_raw);
    DenseOrder S; S.init(T, D, MIXA_FP8 ? D / 2 : D, F.G, F.bid, 0, 0);
    EpiMix<0, MIXA_FP8> E{(const bf16_t*)(WS(a) + WS_GA), (bf16_t*)(WS(a) + WS_MIXA), (bf16_t*)(WS(a) + WS_MIX)};
    pg8::gemm_phase<EpiMix<0, MIXA_FP8>, DenseOrder, false, false, MIXA_FP8 ? D / 2 : D, MIXA_FP8>(F.lds + LDS_STAGE, F.tid, (const bf16_t*)(WS(a) + WS_OLAT), (const bf16_t*)(WS(a) + WS_WA), S, E);
}
__device__ __forceinline__ void mix_b_phase(unsigned char* lds_raw) {
    ArgsRef a = phase_args(); const Frame F = make_frame(lds_raw);
    DenseOrder S; S.init(T, D, 2048, F.G, F.bid, 0, 0);
    EpiMix<1> E{(const bf16_t*)(WS(a) + WS_GB), (bf16_t*)(WS(a) + WS_MIXA), (bf16_t*)(WS(a) + WS_MIX)};
    pg8::gemm_phase<EpiMix<1>, DenseOrder, false, false, 2048>(F.lds + LDS_STAGE, F.tid, (const bf16_t*)OUT(a), (const bf16_t*)(WS(a) + WS_WB), S, E);
}
__device__ __forceinline__ void rownorm_phase_w(unsigned char* lds_raw) { ArgsRef a = phase_args(); const Frame F = make_frame(lds_raw); rownorm_phase(F, a); }
__device__ __forceinline__ void qproj_phase(unsigned char* lds_raw) {
    ArgsRef a = phase_args(); const Frame F = make_frame(lds_raw);
    DenseOrder S; S.init(T, 1536, 256, F.G, F.bid, 0, 0);
    EpiQ E{(bf16_t*)(WS(a) + WS_QLAT), (bf16_t*)(WS(a) + WS_QIDX)};
    pg8::gemm_phase<EpiQ, DenseOrder, false, false, 256>(F.lds + LDS_STAGE, F.tid, (const bf16_t*)(WS(a) + WS_CQN), (const bf16_t*)(WS(a) + WS_WQ), S, E);
}
__device__ __forceinline__ void indexer_phase_w(unsigned char* lds_raw) { ArgsRef a = phase_args(); const Frame F = make_frame(lds_raw); indexer_phase<0>(F, a); }
template <int MODE> __device__ __forceinline__ void indexer_probe_w(unsigned char* lds_raw) { ArgsRef a = phase_args(); const Frame F = make_frame(lds_raw); indexer_phase<MODE>(F, a); }
__device__ __forceinline__ void attention_phase_w(unsigned char* lds_raw) { ArgsRef a = phase_args(); const Frame F = make_frame(lds_raw); attention_phase(F, a); }
__device__ __forceinline__ void out_phase(unsigned char* lds_raw) {
    ArgsRef a = phase_args(); const Frame F = make_frame(lds_raw);
    DenseOrder S; S.init(T, D, D, F.G, F.bid, 0, 0);
    EpiOut E{(const bf16_t*)(WS(a) + WS_XB), X2H ? (float*)(WS(a) + WS_X2H) : OUT(a), (bf16_t*)(WS(a) + WS_X2B)};
    pg8::gemm_phase<EpiOut, DenseOrder, false, false, D>(F.lds + LDS_STAGE, F.tid, (const bf16_t*)(WS(a) + WS_MIX), (const bf16_t*)(WS(a) + WS_WOUT), S, E);
}
__device__ __forceinline__ void convert_only_phase(unsigned char* lds_raw) { ArgsRef a = phase_args(); const Frame F = make_frame(lds_raw); moe_weight_convert(F, a); }
__device__ __forceinline__ void router_phase_w(unsigned char* lds_raw) { ArgsRef a = phase_args(); const Frame F = make_frame(lds_raw); moe_weight_convert(F, a); __syncthreads(); router_phase(F, a); }

#ifdef DIAG2
__device__ __forceinline__ void diag_ck(unsigned char* lds_raw, int k, const void* buf, size_t chunk_bytes) {
    grid_bar(lds_raw);
    ArgsRef a = phase_args(); unsigned* sums = (unsigned*)(WS(a) + WS_CTL + 256 * 1024) + k * 16384; unsigned* nbad = (unsigned*)(WS(a) + WS_CTL) + 16384 + 64 * k; const int gw = blockIdx.x * 8 + (threadIdx.x >> 6), lane = threadIdx.x & 63;
    for (int c = gw; c < 16384; c += gridDim.x * 8) { const unsigned* p = (const unsigned*)((const char*)buf + (size_t)c * chunk_bytes); unsigned sm = 0u; for (size_t i = lane; i < chunk_bytes / 4; i += 64) sm += p[i] * (unsigned)(2 * i + 1);
        for (int o = 1; o < 64; o <<= 1) sm += __shfl_xor(sm, o);
        if (lane == 0) { if (a.pass == 0) sums[c] = sm; else if (sums[c] != sm) atomicAdd(nbad, 1u); } }
    grid_bar(lds_raw);
}
__device__ __forceinline__ void diag_final(unsigned char* lds_raw) {
    grid_bar(lds_raw);
    ArgsRef a = phase_args(); const unsigned* nbad = (const unsigned*)(WS(a) + WS_CTL) + 16384; float c = 0.f;
    if (a.pass == 1) { for (int k = 0; k < 4; ++k) if (__hip_atomic_load(nbad + 64 * k, __ATOMIC_RELAXED, __HIP_MEMORY_SCOPE_AGENT) > 0u) c += (float)(1 << k); }
    grid_bar(lds_raw);
    for (size_t i = (size_t)blockIdx.x * 512 + threadIdx.x; i < (size_t)T * D; i += (size_t)gridDim.x * 512) OUT(a)[i] = c;
}
#endif
__global__ void __launch_bounds__(512, 2) fwd(Args a_unused) {
    extern __shared__ __attribute__((aligned(16))) unsigned char lds_raw[];
    { ArgsRef a = phase_args(); LAS unsigned* st = (LAS unsigned*)((LAS unsigned char*)lds_raw + LDS_MISC + LM_BAR);
      if (threadIdx.x < 4) st[threadIdx.x] = 0u;
      __syncthreads();
      (void)xcd_barrier_post((unsigned*)(WS(a) + WS_CTL) + CW_BAR, (volatile LAS unsigned*)st); }
#ifndef DUP
#define DUP 0u
#endif
#ifndef PHSEL
#define PHSEL 0xffffffffu
#endif
#define GRID_BAR() grid_bar(lds_raw)
#ifdef ZERO_OUT_FIRST
    { float* o_ = OUT(phase_args()); for (size_t i = (size_t)blockIdx.x * 512 + threadIdx.x; i < (size_t)T * D / 4; i += (size_t)gridDim.x * 512) ((f32x4*)o_)[i] = (f32x4){0.f, 0.f, 0.f, 0.f}; }
#endif
    if (PHSEL & (1u << 0)) prep_phase(lds_raw);
    if (DUP & (1u << 0)) { GRID_BAR(); prep2_phase(lds_raw); }
    GRID_BAR();
#if defined(DIAG2) && DIAG2 == 21
    { unsigned char* w_ = WS(phase_args()); diag_ck(lds_raw, 0, w_ + 1 * MiB, 256); diag_ck(lds_raw, 1, w_ + WS_MISC, 64); diag_ck(lds_raw, 2, w_ + WS_XB, 4096); diag_ck(lds_raw, 3, w_ + WS_WIN, 1024); diag_final(lds_raw); return; }
#endif
    if (PHSEL & (1u << 1)) inproj_a_phase(lds_raw);
    if (DUP & (1u << 1)) { GRID_BAR(); inproj_a_phase(lds_raw); }
    if (PHSEL & (1u << 2)) inproj_b_phase(lds_raw);
    if (DUP & (1u << 2)) { GRID_BAR(); inproj_b_phase(lds_raw); }
#if defined(DIAG2) && DIAG2 == 22
    { unsigned char* w_ = WS(phase_args()); diag_ck(lds_raw, 0, w_ + WS_QX, 4096); diag_ck(lds_raw, 1, w_ + WS_SMALL, 4096); diag_ck(lds_raw, 2, w_ + WS_KZT, 4096); diag_ck(lds_raw, 3, w_ + WS_VT, 8192); diag_final(lds_raw); return; }
#endif
#if defined(DIAG2) && DIAG2 == 10
    diag_ck(lds_raw, 0, WS(phase_args()) + WS_QX, 4096); diag_final(lds_raw); return;
#endif
    GRID_BAR();
    if (!ROWNORM_FUSED && (PHSEL & (1u << 16))) rownorm_phase_w(lds_raw);
    if (PHSEL & (1u << 3)) retention_phase_w(lds_raw);
    if (DUP & (1u << 3)) { GRID_BAR(); retention_phase_w(lds_raw); }
#if defined(DIAG2) && DIAG2 == 23
    diag_ck(lds_raw, 0, OUT(phase_args()), 8192);
#endif
#if defined(DIAG2) && DIAG2 == 11
    diag_ck(lds_raw, 1, OUT(phase_args()), 8192); diag_final(lds_raw); return;
#endif
    GRID_BAR();
    if (PHSEL & (1u << 4)) retnorm_phase_w(lds_raw);
    if (PHSEL & (1u << 17)) qproj_phase(lds_raw);
    if (DUP & (1u << 17)) { GRID_BAR(); qproj_phase(lds_raw); }
    GRID_BAR();
#if defined(DIAG2) && DIAG2 == 23
    diag_ck(lds_raw, 1, WS(phase_args()) + WS_QLAT, 4096);
#endif
    if (PHSEL & (1u << 18)) indexer_phase_w(lds_raw);
    __syncthreads();
    if (PHSEL & (1u << 5)) inproj_c_phase(lds_raw);
    if (DUP & (1u << 18)) { GRID_BAR(); indexer_phase_w(lds_raw); }
    if (DUP & (1u << 22)) { GRID_BAR(); indexer_probe_w<1>(lds_raw); }
    if (DUP & (1u << 23)) { GRID_BAR(); indexer_probe_w<2>(lds_raw); }
#if defined(DIAG2) && DIAG2 == 23
    diag_ck(lds_raw, 2, WS(phase_args()) + WS_MASK, 512);
#endif
#if defined(DIAG2) && DIAG2 == 12
    diag_ck(lds_raw, 2, WS(phase_args()) + WS_MASK, 512); diag_final(lds_raw); return;
#endif
    GRID_BAR();
    if (PHSEL & (1u << 19)) attention_phase_w(lds_raw);
    if (DUP & (1u << 19)) { GRID_BAR(); attention_phase_w(lds_raw); }
#if defined(DIAG2) && DIAG2 == 23
    diag_ck(lds_raw, 3, WS(phase_args()) + WS_OLAT, 4096); diag_final(lds_raw); return;
#endif
#if defined(DIAG2) && DIAG2 == 13
    diag_ck(lds_raw, 3, WS(phase_args()) + WS_QLAT, 4096); diag_final(lds_raw); return;
#endif
#if defined(DIAG2) && DIAG2 == 24
    diag_ck(lds_raw, 0, OUT(phase_args()), 8192);
#endif
    GRID_BAR();
    if (PHSEL & (1u << 20)) mix_a_phase(lds_raw);
    if (DUP & (1u << 20)) { GRID_BAR(); mix_a_phase(lds_raw); }
    if (PHSEL & (1u << 6)) mix_b_phase(lds_raw);
    if (DUP & (1u << 6)) { GRID_BAR(); mix_b_phase(lds_raw); }
#if defined(DIAG2) && DIAG2 == 24
    diag_ck(lds_raw, 1, WS(phase_args()) + WS_MIX, 4096);
#endif
#if defined(DIAG2) && DIAG2 == 28
    diag_ck(lds_raw, 3, WS(phase_args()) + WS_MIX, 4096);
#endif
    GRID_BAR();
    if (PHSEL & (1u << 7)) out_phase(lds_raw);
    if (DUP & (1u << 7)) { GRID_BAR(); out_phase(lds_raw); }
#if defined(DIAG2) && (DIAG2 == 38 || DIAG2 == 39)
    { asm volatile("s_waitcnt vmcnt(0)" ::: "memory"); __syncthreads(); if (threadIdx.x == 0) atomicAdd((unsigned*)(WS(phase_args()) + WS_CTL) + 16384 + 64 * 9, 1u); }
#endif
    GRID_BAR();
#if defined(DIAG2) && (DIAG2 == 38 || DIAG2 == 39)
    { if (threadIdx.x == 0) { unsigned* nb_ = (unsigned*)(WS(phase_args()) + WS_CTL) + 16384; const unsigned d_ = __hip_atomic_load(nb_ + 64 * 9, __ATOMIC_RELAXED, __HIP_MEMORY_SCOPE_AGENT); if (d_ != gridDim.x * (unsigned)(phase_args().pass + 1)) atomicAdd(nb_ + 64 * 10, 1u); } }
#endif
#if defined(DIAG2) && DIAG2 == 24
    diag_ck(lds_raw, 2, OUT(phase_args()), 8192); diag_ck(lds_raw, 3, WS(phase_args()) + WS_X2B, 2048); diag_final(lds_raw); return;
#endif
#if defined(DIAG2) && DIAG2 == 28
    diag_ck(lds_raw, 0, OUT(phase_args()), 8192); diag_ck(lds_raw, 1, WS(phase_args()) + WS_X2B, 2048);
#endif
    if (DUP & (1u << 21)) { convert_only_phase(lds_raw); GRID_BAR(); }
#if defined(DIAG2) && (DIAG2 == 29 || DIAG2 == 30 || DIAG2 == 31)
    diag_ck(lds_raw, 0, WS(phase_args()) + WS_MISC, 8);
#endif
    if (PHSEL & (1u << 8)) router_phase_w(lds_raw);
    GRID_BAR();
#if defined(DIAG2) && DIAG2 == 25
    diag_ck(lds_raw, 0, WS(phase_args()) + WS_WGU, 4096); diag_ck(lds_raw, 1, WS(phase_args()) + WS_WD, 2048);
#endif
#if defined(DIAG2) && DIAG2 == 26
    diag_ck(lds_raw, 0, WS(phase_args()) + WS_WGU, 4096); diag_ck(lds_raw, 1, WS(phase_args()) + WS_WD, 2048); diag_final(lds_raw); return;
#endif
#if defined(DIAG2) && DIAG2 == 29
    diag_final(lds_raw); return;
#endif
#if defined(DIAG2) && (DIAG2 >= 30 && DIAG2 <= 40)
    { grid_bar(lds_raw); ArgsRef a = phase_args(); const unsigned* nb = (const unsigned*)(WS(a) + WS_CTL) + 16384; float c = 0.f;
      if (a.pass == 1) { unsigned n = __hip_atomic_load(nb + 64 * 3, __ATOMIC_RELAXED, __HIP_MEMORY_SCOPE_AGENT);
#if DIAG2 == 31
        n = n >> 5;
#endif
#if DIAG2 == 38
        n = __hip_atomic_load(nb + 64 * 10, __ATOMIC_RELAXED, __HIP_MEMORY_SCOPE_AGENT);
#endif
#if DIAG2 == 40
        n = (__hip_atomic_load(nb + 64 * 11, __ATOMIC_RELAXED, __HIP_MEMORY_SCOPE_AGENT) ? 1u : 0u) + (__hip_atomic_load(nb + 64 * 12, __ATOMIC_RELAXED, __HIP_MEMORY_SCOPE_AGENT) ? 2u : 0u) + (__hip_atomic_load(nb + 64 * 13, __ATOMIC_RELAXED, __HIP_MEMORY_SCOPE_AGENT) ? 4u : 0u);
#endif
#if DIAG2 == 39
        n = (__hip_atomic_load(nb + 64 * 10, __ATOMIC_RELAXED, __HIP_MEMORY_SCOPE_AGENT) ? 1u : 0u) + (n ? 2u : 0u);
#endif
#if DIAG2 >= 34 && DIAG2 <= 37
        n = __builtin_popcount(__hip_atomic_load(nb + 64 * (DIAG2 - 30), __ATOMIC_RELAXED, __HIP_MEMORY_SCOPE_AGENT));
#endif
        c = (float)(n > 30u ? 30u : n); }
      grid_bar(lds_raw);
      for (size_t i = (size_t)blockIdx.x * 512 + threadIdx.x; i < (size_t)T * D; i += (size_t)gridDim.x * 512) OUT(a)[i] = c; return; }
#endif
#if defined(DIAG2) && (DIAG2 == 27 || DIAG2 == 28)
    { grid_bar(lds_raw); ArgsRef a = phase_args(); unsigned* sums = (unsigned*)(WS(a) + WS_CTL + 256 * 1024); unsigned* nbad = (unsigned*)(WS(a) + WS_CTL) + 16384;
      const unsigned* rec = (const unsigned*)(WS(a) + WS_REC); const unsigned* gc = (const unsigned*)(WS(a) + WS_CTL) + CW_CNT;
      for (int t = blockIdx.x * 512 + threadIdx.x; t < T; t += gridDim.x * 512) { unsigned sm = 0u; for (int k = 0; k < 4; ++k) { sm = sm * 31u + rec[(size_t)t * 16 + 4 * k]; sm = sm * 31u + rec[(size_t)t * 16 + 4 * k + 2]; sm = sm * 31u + rec[(size_t)t * 16 + 4 * k + 3]; }
          if (a.pass == 0) sums[2 * 16384 + t] = sm; else if (sums[2 * 16384 + t] != sm) atomicAdd(nbad + 64 * 2, 1u); }
      if (blockIdx.x == 0 && threadIdx.x < 64) { const unsigned v = gc[threadIdx.x]; if (a.pass == 0) sums[65536 + threadIdx.x] = v; else if (sums[65536 + threadIdx.x] != v) atomicAdd(nbad + 64 * 2, 1u); }
      grid_bar(lds_raw);
#if DIAG2 == 27
      diag_final(lds_raw); return;
#endif
    }
#endif
    if (PHSEL & (1u << 9)) moe_gateup_phase<0>(lds_raw);
    if (DUP & (1u << 9)) { GRID_BAR(); moe_gateup_phase<0>(lds_raw); }
    if (DUP & (1u << 24)) { GRID_BAR(); moe_gateup_probe<0>(lds_raw); }
    GRID_BAR();
    if (PHSEL & (1u << 10)) moe_down_phase<0>(lds_raw);
    if (DUP & (1u << 10)) { GRID_BAR(); moe_down_phase<0>(lds_raw); }
    if (DUP & (1u << 25)) { GRID_BAR(); moe_down_probe<0>(lds_raw); }
    GRID_BAR();
    if (PHSEL & (1u << 11)) moe_combine_phase<0>(lds_raw);
#if defined(DIAG2) && DIAG2 == 20
    diag_ck(lds_raw, 0, OUT(phase_args()), 8192); diag_final(lds_raw);
#endif
#if defined(DIAG2) && DIAG2 == 28
    diag_final(lds_raw);
#endif
}

extern "C" void kernel_launch(void* const* d_in, const int* in_sizes, int n_in, void* d_out, int out_size, void* d_ws, size_t ws_size, hipStream_t stream) {
    static int grid = 0;
    if (grid == 0) {
        if (n_in != 24 || out_size != T * D || ws_size < WS_END2) { fprintf(stderr, "kernel_launch: unexpected shapes n_in %d out %d ws %zu (need %zu)\n", n_in, out_size, ws_size, (size_t)WS_END2); grid = -1; return; }
        int dev = 0, cus = 0, per_cu = 0;
        if (hipGetDevice(&dev) != hipSuccess || hipDeviceGetAttribute(&cus, hipDeviceAttributeMultiprocessorCount, dev) != hipSuccess) { grid = -1; return; }
        if (hipFuncSetAttribute((const void*)fwd, hipFuncAttributeMaxDynamicSharedMemorySize, LDS_BYTES) != hipSuccess) { fprintf(stderr, "kernel_launch: hipFuncSetAttribute failed\n"); grid = -1; return; }
        if (hipOccupancyMaxActiveBlocksPerMultiprocessor(&per_cu, (const void*)fwd, 512, LDS_BYTES) != hipSuccess || per_cu < 1) fprintf(stderr, "kernel_launch: occupancy query reports %d\n", per_cu);
        (void)hipGetLastError();
        grid = cus;
    }
    if (grid < 0) return;
    if (hipMemsetAsync((char*)d_ws + WS_CTL, 0, CTL_BYTES, stream) != hipSuccess) return;
    Args a{};
    for (int i = 0; i < 24; ++i) a.in[i] = (const float*)d_in[i];
    a.out = (float*)d_out; a.ws = (unsigned char*)d_ws; a.pass = 0;
    hipLaunchKernelGGL(fwd, dim3(grid), dim3(512), LDS_BYTES, stream, a);
#ifdef DIAG2
    if (hipMemsetAsync((char*)d_ws + WS_CTL, 0, 49152, stream) != hipSuccess) return;
    a.pass = 1;
    hipLaunchKernelGGL(fwd, dim3(grid), dim3(512), LDS_BYTES, stream, a);
#endif
}
```

```cpp
#include <hip/hip_runtime.h>
#include <cstdio>
#include <cstdint>

#define LAS __attribute__((address_space(3)))
#define GAS __attribute__((address_space(1)))
typedef unsigned short bf16_t;
typedef short bf16x8 __attribute__((ext_vector_type(8)));
typedef short s16x4 __attribute__((ext_vector_type(4)));
typedef float f32x4 __attribute__((ext_vector_type(4)));
typedef float f32x2 __attribute__((ext_vector_type(2)));
typedef float f32x16 __attribute__((ext_vector_type(16)));
typedef unsigned u32x4 __attribute__((ext_vector_type(4)));
typedef unsigned u32x2 __attribute__((ext_vector_type(2)));
typedef int i32x4 __attribute__((ext_vector_type(4)));
typedef int i32x8 __attribute__((ext_vector_type(8)));

constexpr int NB = 16, SEQ = 2048, T = NB * SEQ, D = 1024;
constexpr int NE = 32, FF = 1024, TOPK_E = 4;
constexpr int HALF_T = T;
constexpr int LIST_CAP = HALF_T;
constexpr int PAD_ROWS = HALF_T * TOPK_E + NE * 256;
constexpr float RMS_EPS = 1e-6f;

constexpr size_t MiB = 1u << 20;
constexpr size_t WS_CTL = 0, CTL_BYTES = 1 * MiB;
constexpr size_t WS_MISC = 5 * MiB;
constexpr size_t MISC_RW_HI = 0, MISC_RW_LO = 65536, MISC_RSTD2 = 131072, MISC_RSTD1 = 262144;
constexpr bool MOE_FP8 = true;
constexpr float W8_SCALE = 32.f, W8_INV = 1.f / 32.f;
constexpr bool X2H = true;
constexpr bool ROWNORM_FUSED = true;
constexpr bool GA8 = true;
constexpr bool MIXA_FP8 = true;
constexpr bool Y_FP8 = true;
constexpr bool INB_FP8 = true;
constexpr bool INC_FP8 = true;
constexpr size_t WS_REC = 6 * MiB, WS_LTOK = 8 * MiB, WS_LRS = 12 * MiB, WS_X2H = 32 * MiB  , WS_X2B = 96 * MiB, WS_WD = 128 * MiB, WS_WGU = 192 * MiB, WS_ACT = 256 * MiB, WS_Y = 392 * MiB, WS_END = 552 * MiB;
static_assert(MOE_FP8 && WS_ACT + (size_t)PAD_ROWS * FF <= WS_Y && WS_Y + (size_t)PAD_ROWS * D * (Y_FP8 ? 1 : 2) <= WS_END, "ws map (single-pass MoE needs the fp8 sizes)");
constexpr size_t WS_COSP = 1 * MiB, WS_SINP = 2 * MiB, WS_COST = 3 * MiB, WS_SINT = 4 * MiB;
constexpr size_t MISC_DQ = 393216, MISC_DK = 394240, MISC_DZ = 395264, MISC_RN = 524288;
constexpr size_t WS_WIN = 6 * MiB, WS_XB = 32 * MiB, WS_SMALL = 96 * MiB, WS_QX = 160 * MiB, WS_KP = 224 * MiB, WS_KZT = 288 * MiB, WS_VT = 352 * MiB;
constexpr size_t WS_CKV = 480 * MiB, WS_KIDX = 488 * MiB, WS_WIDX = 492 * MiB, WS_CQN = 493 * MiB, WS_QIDX = 509 * MiB, WS_MASK = 541 * MiB;
constexpr size_t WS_WQ = 552 * MiB, WS_WA = 553 * MiB, WS_WB = 555 * MiB, WS_WOUT = 559 * MiB, WS_END2 = 561 * MiB;
constexpr size_t WS_XB8 = 224 * MiB, WS_WIN8 = 256 * MiB;
constexpr size_t WS_GA = WS_QX, WS_GB = INC_FP8 ? WS_VT : WS_KP,        WS_MIXA = WS_KZT, WS_MIX = WS_VT, WS_QLAT = WS_SMALL, WS_OLAT = WS_VT + 64 * MiB;
constexpr int NIN = 8704;
constexpr int CW_BAR = 1024;
constexpr int CW_CNT = 8192;

__device__ __forceinline__ unsigned f2bf(float f) { unsigned u = __builtin_bit_cast(unsigned, f); return (u + 0x7fffu + ((u >> 16) & 1u)) >> 16; }
__device__ __forceinline__ unsigned pk2(float lo, float hi) { return f2bf(lo) | (f2bf(hi) << 16); }
__device__ __forceinline__ float bf2f(unsigned b) { return __builtin_bit_cast(float, b << 16); }
typedef __bf16 bf16v2_t __attribute__((ext_vector_type(2)));
__device__ __forceinline__ unsigned cvt_pk_bf16(float lo, float hi) { f32x2 v = {lo, hi}; bf16v2_t r = __builtin_convertvector(v, bf16v2_t); return __builtin_bit_cast(unsigned, r); }
__device__ __forceinline__ float wave_sum(float v) {
#pragma unroll
    for (int o = 1; o < 64; o <<= 1) v += __shfl_xor(v, o);
    return v;
}
__device__ __forceinline__ void ld4u(const void* p, unsigned (&w)[4]) { const f32x4 t = *(const f32x4*)p; const float t0 = t[0], t1 = t[1], t2 = t[2], t3 = t[3];
    w[0] = __builtin_bit_cast(unsigned, t0); w[1] = __builtin_bit_cast(unsigned, t1); w[2] = __builtin_bit_cast(unsigned, t2); w[3] = __builtin_bit_cast(unsigned, t3); }
__device__ __forceinline__ unsigned pk4_fp8(float a, float b, float c, float d) { unsigned w = 0u; w = __builtin_amdgcn_cvt_pk_fp8_f32(a, b, w, false); w = __builtin_amdgcn_cvt_pk_fp8_f32(c, d, w, true); return w; }
#define LDS_WAIT() asm volatile("s_waitcnt lgkmcnt(0)" ::: "memory")
#define VM_WAIT() asm volatile("s_waitcnt vmcnt(0)" ::: "memory")

#define XB_TMO      128
#define XB_XCNT(j)  (256  + 64 * (j))
#define XB_XSUB(j)  (1280 + 64 * (j))
#define XB_XGEN(j)  (2304 + 64 * (j))
#define XB_TOP      3328
#define XB_TOPGEN   3392
#define XCD_BAR_WORDS 3456
#define XB_SPIN_CAP (1u << 22)
__device__ __forceinline__ unsigned xb_ld(unsigned* p)              { return __hip_atomic_load(p, __ATOMIC_RELAXED, __HIP_MEMORY_SCOPE_AGENT); }
__device__ __forceinline__ unsigned xb_add(unsigned* p, unsigned v) { return __hip_atomic_fetch_add(p, v, __ATOMIC_RELAXED, __HIP_MEMORY_SCOPE_AGENT); }
__device__ __forceinline__ unsigned xb_xcc_id() { return (unsigned)__builtin_amdgcn_s_getreg((3 << 11) | 20) & 0xFu; }
#define XB_SPIN(cond, bar) do { unsigned _sp = 0; while (cond) { __builtin_amdgcn_s_sleep(1); \
    if ((++_sp & 255u) == 0u) { if (xb_ld(&(bar)[XB_TMO])) break; if (_sp > XB_SPIN_CAP) { atomicAdd(&(bar)[XB_TMO], 1u); break; } } } } while (0)
struct XcdBarrier { unsigned* bar; unsigned x; volatile LAS unsigned* st; };
__device__ __forceinline__ XcdBarrier xcd_barrier_post(unsigned* bar, volatile LAS unsigned* st) {
    XcdBarrier b; b.bar = bar; b.x = xb_xcc_id(); b.st = st;
    if (threadIdx.x == 0) (void)xb_add(&bar[XB_XCNT(b.x)], 1u);
    return b;
}
__device__ __forceinline__ void xcd_barrier_complete(unsigned* bar, unsigned x, unsigned& nloc, unsigned& nx) {
    const unsigned G = gridDim.x * gridDim.y * gridDim.z;
    unsigned sum, cnt, mine, sp = 0u;
    for (;;) {
        sum = 0u; cnt = 0u; mine = 0u;
#pragma unroll
        for (unsigned j = 0; j < 16; ++j) { const unsigned c = xb_ld(&bar[XB_XCNT(j)]); sum += c; cnt += (c > 0u) ? 1u : 0u; mine = (j == x) ? c : mine; }
        if (sum == G) break;
        __builtin_amdgcn_s_sleep(1);
        if ((++sp & 255u) == 0u) { if (xb_ld(&bar[XB_TMO])) break; if (sp > XB_SPIN_CAP) { atomicAdd(&bar[XB_TMO], 1u); break; } }
    }
    nloc = mine > 0u ? mine : 1u; nx = cnt > 0u ? cnt : 1u;
}
__device__ __forceinline__ void xcd_barrier(const XcdBarrier& b) {
    asm volatile("s_waitcnt vmcnt(0)" ::: "memory");
    __syncthreads();
    if (threadIdx.x == 0) {
        unsigned* bar = b.bar;
        __builtin_amdgcn_s_waitcnt(0);
        unsigned nloc = b.st[0], nx = b.st[1];
        if (nloc == 0u) { xcd_barrier_complete(bar, b.x, nloc, nx); b.st[0] = nloc; b.st[1] = nx; }
        const unsigned old = xb_add(&bar[XB_XSUB(b.x)], 1u);
        const unsigned gen = old / nloc;
        if (old + 1u == (gen + 1u) * nloc) {
            __builtin_amdgcn_fence(__ATOMIC_RELEASE, "agent");
            asm volatile("s_waitcnt vmcnt(0)" ::: "memory");
            const unsigned og = xb_add(&bar[XB_TOP], 1u);
            const unsigned tg = og / nx;
            if (og + 1u == (tg + 1u) * nx) xb_add(&bar[XB_TOPGEN], 1u);
            else XB_SPIN(xb_ld(&bar[XB_TOPGEN]) == tg, bar);
            __builtin_amdgcn_fence(__ATOMIC_ACQUIRE, "agent");
            xb_add(&bar[XB_XGEN(b.x)], 1u);
            asm volatile("s_waitcnt vmcnt(0)" ::: "memory");
        } else {
            XB_SPIN(xb_ld(&bar[XB_XGEN(b.x)]) == gen, bar);
            __builtin_amdgcn_fence(__ATOMIC_ACQUIRE, "agent");
            asm volatile("s_waitcnt vmcnt(0)" ::: "memory");
        }
    }
    __syncthreads();
#ifdef ALLWAVE_INV
    __builtin_amdgcn_fence(__ATOMIC_ACQUIRE, "agent"); asm volatile("s_waitcnt vmcnt(0)" ::: "memory");
#endif
}

namespace pg8 {
constexpr int BM = 256, BK = 64, HALF = 128, HTB = HALF * BK * 2, STAGE_BYTES = 8 * HTB;
__host__ __device__ __forceinline__ int lds_byte(int r, int c) { const int st = (r >> 4) * 2 + (c >> 5), rr = r & 15, cc = c & 31, ob = rr * 64 + cc * 2; return st * 1024 + (ob ^ (((ob >> 9) & 1) << 5)); }
__host__ __device__ __forceinline__ void stage_rc(int b, int& R, int& C) { const int st = b / 1024, sb = b % 1024, swz = sb ^ (((sb >> 9) & 1) << 5); R = (st >> 1) * 16 + swz / 64; C = (st & 1) * 32 + (swz % 64) / 2; }
__host__ __device__ __forceinline__ int perm32(int rho) { const int n = rho >> 4, i = rho & 15; return 8 * (i >> 2) + 4 * n + (i & 3); }

struct Unit { int pm, pn, e, j; };

#define PG8_SA(b, h) (((b) * 2 + (h)) * HTB)
#define PG8_SB(b, h) ((4 + (b) * 2 + (h)) * HTB)
#define PG8_STAGE(bufoff, rsrc, soff, voff) do { _Pragma("unroll") for (int _i = 0; _i < 2; ++_i) \
        __builtin_amdgcn_raw_ptr_buffer_load_lds(rsrc, (LAS void*)(lds + (bufoff) + ldsw + _i * 8192), 16, (int)(voff)[_i], (int)(soff), 0, 0); } while (0)
#define PG8_LDA(dst, b, h) do { _Pragma("unroll") for (int m = 0; m < 4; ++m) _Pragma("unroll") for (int k = 0; k < 2; ++k) dst[m][k] = *(const LAS bf16x8*)(lds + PG8_SA(b, h) + aoff + m * 2048 + k * 1024); } while (0)
#define PG8_LDB(dst, b, h) do { _Pragma("unroll") for (int n = 0; n < 2; ++n) _Pragma("unroll") for (int k = 0; k < 2; ++k) dst[n][k] = *(const LAS bf16x8*)(lds + PG8_SB(b, h) + boff + n * 2048 + k * 1024); } while (0)
#define PG8_CAT(x) __builtin_shufflevector(__builtin_bit_cast(i32x4, (x)[0]), __builtin_bit_cast(i32x4, (x)[1]), 0, 1, 2, 3, 4, 5, 6, 7)
#define PG8_MMA(ai, bj, At, Bt) do { __builtin_amdgcn_s_setprio(1); if constexpr (F8) { asm volatile("s_nop 1"); _Pragma("unroll") for (int m = 0; m < 4; ++m) _Pragma("unroll") for (int n = 0; n < 2; ++n) { \
        const i32x8 _b8 = PG8_CAT(Bt[n]), _a8 = PG8_CAT(At[m]); if constexpr (SWAP) asm volatile("v_mfma_f32_16x16x128_f8f6f4 %0, %1, %2, %0" : "+v"(acc[ai][bj][m][n]) : "v"(_a8), "v"(_b8)); \
        else asm volatile("v_mfma_f32_16x16x128_f8f6f4 %0, %1, %2, %0" : "+v"(acc[ai][bj][m][n]) : "v"(_b8), "v"(_a8)); } } else { \
        _Pragma("unroll") for (int m = 0; m < 4; ++m) _Pragma("unroll") for (int n = 0; n < 2; ++n) _Pragma("unroll") for (int k = 0; k < 2; ++k) \
        acc[ai][bj][m][n] = SWAP ? __builtin_amdgcn_mfma_f32_16x16x32_bf16(At[m][k], Bt[n][k], acc[ai][bj][m][n], 0, 0, 0) : __builtin_amdgcn_mfma_f32_16x16x32_bf16(Bt[n][k], At[m][k], acc[ai][bj][m][n], 0, 0, 0); } __builtin_amdgcn_s_setprio(0); } while (0)
#define PG8_ACC_SETTLE() do { _Pragma("unroll") for (int _a = 0; _a < 2; ++_a) _Pragma("unroll") for (int _b = 0; _b < 2; ++_b) \
        asm volatile("s_nop 15\n\ts_nop 7" : "+v"(acc[_a][_b][0][0]), "+v"(acc[_a][_b][0][1]), "+v"(acc[_a][_b][1][0]), "+v"(acc[_a][_b][1][1]), "+v"(acc[_a][_b][2][0]), "+v"(acc[_a][_b][2][1]), "+v"(acc[_a][_b][3][0]), "+v"(acc[_a][_b][3][1])); } while (0)
#define PG8_WAIT_V(n) asm volatile("s_waitcnt vmcnt(" #n ")" ::: "memory")
#define PG8_WAIT_L(n) asm volatile("s_waitcnt lgkmcnt(" #n ")" ::: "memory")
#define PG8_BAR __builtin_amdgcn_s_barrier()
#define PG8_SCHED __builtin_amdgcn_sched_barrier(0)
#define PG8_TRIP(a1, a2, a3, V1h1, V2h0, V2h1, b2, b3) do { \
            PG8_LDB(B0, 0, 0); PG8_SCHED; PG8_LDA(At, 0, 0); PG8_STAGE(PG8_SA(1, 1), rA, (a1) + ahstep, V1h1); \
            PG8_WAIT_L(8); PG8_BAR; PG8_WAIT_L(0); PG8_MMA(0, 0, At, B0); PG8_BAR; PG8_SCHED; \
            PG8_LDB(B1, 0, 1); PG8_STAGE(PG8_SB(0, 0), rB, b2, voffB); \
            PG8_BAR; PG8_WAIT_L(0); PG8_MMA(0, 1, At, B1); PG8_BAR; \
            PG8_LDA(At, 0, 1); PG8_STAGE(PG8_SA(0, 0), rA, a2, V2h0); \
            PG8_BAR; PG8_WAIT_L(0); PG8_MMA(1, 0, At, B0); PG8_BAR; PG8_SCHED; \
            PG8_STAGE(PG8_SB(0, 1), rB, (b2) + hstep, voffB); \
            PG8_WAIT_V(6); PG8_BAR; PG8_MMA(1, 1, At, B1); PG8_BAR; \
            PG8_LDB(B0, 1, 0); PG8_SCHED; PG8_LDA(At, 1, 0); PG8_STAGE(PG8_SA(0, 1), rA, (a2) + ahstep, V2h1); \
            PG8_WAIT_L(8); PG8_BAR; PG8_WAIT_L(0); PG8_MMA(0, 0, At, B0); PG8_BAR; PG8_SCHED; \
            PG8_LDB(B1, 1, 1); PG8_STAGE(PG8_SB(1, 0), rB, b3, voffB); \
            PG8_BAR; PG8_WAIT_L(0); PG8_MMA(0, 1, At, B1); PG8_BAR; \
            PG8_LDA(At, 1, 1); PG8_STAGE(PG8_SA(1, 0), rA, a3, V2h0); \
            PG8_BAR; PG8_WAIT_L(0); PG8_MMA(1, 0, At, B0); PG8_BAR; PG8_SCHED; \
            PG8_STAGE(PG8_SB(1, 1), rB, (b3) + hstep, voffB); \
            PG8_WAIT_V(6); PG8_BAR; PG8_MMA(1, 1, At, B1); PG8_BAR; } while (0)
template <class Epi, class Sched, bool SWAP, bool GATHER, int K, bool F8 = false>
__device__ __forceinline__ void gemm_phase(LAS unsigned char* lds, const int tid, const bf16_t* Abase, const bf16_t* Bbase, const Sched& S, const Epi& E, LAS u32x4* gslots = nullptr) {
    static_assert(!(SWAP && Epi::PERM), "SWAP needs natural B row order");
    const int wid = __builtin_amdgcn_readfirstlane(tid >> 6), lane = tid & 63, wr = wid >> 2, wc = wid & 3, fr = lane & 15, fq = lane >> 4;
    constexpr int nt = K / BK;
    const unsigned long long pa_ = (unsigned long long)Abase, pb_ = (unsigned long long)Bbase;
    const unsigned long long ua_ = ((unsigned long long)(unsigned)__builtin_amdgcn_readfirstlane((int)(pa_ >> 32)) << 32) | (unsigned)__builtin_amdgcn_readfirstlane((int)pa_);
    const unsigned long long ub_ = ((unsigned long long)(unsigned)__builtin_amdgcn_readfirstlane((int)(pb_ >> 32)) << 32) | (unsigned)__builtin_amdgcn_readfirstlane((int)pb_);
    const __amdgpu_buffer_rsrc_t rA = __builtin_amdgcn_make_buffer_rsrc((void*)ua_, 0, 0x7ffffffc, 0x00020000);
    const __amdgpu_buffer_rsrc_t rB = __builtin_amdgcn_make_buffer_rsrc((void*)ub_, 0, 0x7ffffffc, 0x00020000);
    unsigned voffB[2], vA0[2], vA1[2];
#pragma unroll
    for (int i = 0; i < 2; ++i) { int R, C; stage_rc(tid * 16 + i * 8192, R, C); const int Rb = Epi::PERM ? ((R & ~31) + perm32(R & 31)) : R;
        const int Ra = SWAP ? ((R & ~63) | (16 * ((R >> 2) & 3) + 4 * ((R >> 4) & 3) + (R & 3))) : R;
        voffB[i] = (unsigned)(Rb * K + C) * 2u; vA0[i] = (unsigned)(Ra * K + C) * 2u; vA1[i] = vA0[i]; }
    constexpr unsigned kstep = (unsigned)(BK * 2);
    constexpr unsigned hstep = (unsigned)HALF * K * 2;
    constexpr unsigned ahstep = GATHER ? 0u : hstep;
    const unsigned ldsw = (unsigned)wid * 1024u;
    const int aoff = lds_byte(wr * 64 + fr, fq * 8), boff = lds_byte(wc * 32 + fr, fq * 8);
#define PG8_ROWS(d0, d1, u) do { int _t = tid; asm volatile("" : "+v"(_t)); _Pragma("unroll") for (int _i = 0; _i < 2; ++_i) { int _R, _C; stage_rc(_t * 16 + _i * 8192, _R, _C); \
        const int _nr = S.nrows(u); int _x0 = _R < _nr ? _R : _nr - 1, _x1 = (_R + HALF) < _nr ? (_R + HALF) : _nr - 1; const int* _l = S.rows + S.lo(u); \
        d0[_i] = (unsigned)(_l[_x0] * K + _C) * 2u; d1[_i] = (unsigned)(_l[_x1] * K + _C) * 2u; } } while (0)
    Unit cur, nxt; int ui = 0;
    if (!S.next(0, cur)) return;
    f32x4 acc[2][2][4][2];
#pragma unroll
    for (int a = 0; a < 2; ++a)
#pragma unroll
        for (int b = 0; b < 2; ++b)
#pragma unroll
            for (int m = 0; m < 4; ++m)
#pragma unroll
                for (int n = 0; n < 2; ++n) acc[a][b][m][n] = (f32x4){0.f, 0.f, 0.f, 0.f};
    bf16x8 At[4][2], B0[2][2], B1[2][2];
    unsigned cA = S.aoff(cur), cB = S.boff(cur);
    if constexpr (GATHER) { PG8_ROWS(vA0, vA1, cur); gslots[tid] = (u32x4){vA0[0], vA0[1], vA1[0], vA1[1]}; }
    PG8_STAGE(PG8_SB(0, 0), rB, cB, voffB); PG8_STAGE(PG8_SA(0, 0), rA, cA, vA0); PG8_STAGE(PG8_SB(0, 1), rB, cB + hstep, voffB); PG8_STAGE(PG8_SA(0, 1), rA, cA + ahstep, vA1);
    if (wr == 1) PG8_BAR;
    PG8_WAIT_V(4); PG8_BAR;
    PG8_STAGE(PG8_SB(1, 0), rB, cB + kstep, voffB); PG8_STAGE(PG8_SA(1, 0), rA, cA + kstep, vA0); PG8_STAGE(PG8_SB(1, 1), rB, cB + hstep + kstep, voffB);
    PG8_WAIT_V(6); PG8_BAR;
    for (;;) {
        const bool has_next = S.next(ui + 1, nxt);
        const unsigned nA = has_next ? S.aoff(nxt) : cA, nB = has_next ? S.boff(nxt) : cB;
        int nrow0[2] = {0, 0}, nrow1[2] = {0, 0};
        if constexpr (GATHER) { if (has_next) { int _t = tid; asm volatile("" : "+v"(_t)); _Pragma("unroll") for (int _i = 0; _i < 2; ++_i) { int _R, _C; stage_rc(_t * 16 + _i * 8192, _R, _C);
            const int _nr = S.nrows(nxt); const int _x0 = _R < _nr ? _R : _nr - 1, _x1 = (_R + HALF) < _nr ? (_R + HALF) : _nr - 1; const int* _l = S.rows + S.lo(nxt); nrow0[_i] = _l[_x0]; nrow1[_i] = _l[_x1]; } } }
#pragma unroll 1
        for (int t = 0; t < nt; t += 2) {
            const bool last = (t == nt - 2);
            const unsigned a1 = cA + (unsigned)(t + 1) * kstep;
            const unsigned a2 = last ? nA : cA + (unsigned)(t + 2) * kstep, b2 = last ? nB : cB + (unsigned)(t + 2) * kstep;
            if constexpr (!GATHER) {
                PG8_TRIP(a1, a2, a2 + kstep, vA0, vA0, vA0, b2, b2 + kstep);
            } else {
                const int par = ui & 1;
                if (last && has_next) { unsigned n0[2], n1[2]; int _t = tid; asm volatile("" : "+v"(_t));
                    _Pragma("unroll") for (int _i = 0; _i < 2; ++_i) { int _R, _C; stage_rc(_t * 16 + _i * 8192, _R, _C); n0[_i] = (unsigned)(nrow0[_i] * K + _C) * 2u; n1[_i] = (unsigned)(nrow1[_i] * K + _C) * 2u; }
                    gslots[(par ^ 1) * 512 + tid] = (u32x4){n0[0], n0[1], n1[0], n1[1]}; }
                const u32x4 vc = gslots[par * 512 + tid], vn = gslots[((last && has_next) ? (par ^ 1) : par) * 512 + tid];
                const unsigned c1[2] = {vc.z, vc.w}, n0[2] = {vn.x, vn.y}, n1[2] = {vn.z, vn.w};
                PG8_TRIP(a1, a2, a2 + kstep, c1, n0, n1, b2, b2 + kstep);
            }
        }
        if constexpr (F8) PG8_ACC_SETTLE();
        E(acc, cur, wr, wc, fr, fq);
        if (!has_next) break;
#pragma unroll
        for (int a = 0; a < 2; ++a)
#pragma unroll
            for (int b = 0; b < 2; ++b)
#pragma unroll
                for (int m = 0; m < 4; ++m)
#pragma unroll
                    for (int n = 0; n < 2; ++n) acc[a][b][m][n] = (f32x4){0.f, 0.f, 0.f, 0.f};
        cur = nxt; cA = nA; cB = nB; ++ui;
    }
    PG8_WAIT_V(0);
    if (wr == 0) PG8_BAR;
    PG8_BAR;
#undef PG8_ROWS
}
}

struct Args { const float* in[24]; float* out; unsigned char* ws; long long pass; };
enum { I_X = 0, I_NORM_MIX_G, I_W_IN, I_CQ_G, I_CKV_G, I_KIDX_G, I_W_UQ, I_W_QIDX, I_W_UK, I_W_UV, I_T5, I_W_BA, I_W_BB, I_W_OUT, I_NORM_FFN_G, I_W_ROUTER, I_B_ROUTER,
       I_W_GATE, I_B_GATE, I_W_UP, I_B_UP, I_W_DOWN, I_B_DOWN, I_NORM_FINAL_G };

constexpr int LDS_STAGE = 0, LDS_MISC = 131072, LDS_BYTES = 163840;
constexpr int LM_BAR = 0;
constexpr int LM_TEND = 64;
constexpr int LM_CNT = 192;
constexpr int LM_PSTART = 320;
constexpr int LM_LCNT = 448;
constexpr int LM_GBASE = 576;
constexpr int LM_REC = 1024;
constexpr int LM_SCR = 9216;
constexpr int LM_SLOTS = 1024;
constexpr int LM_TILE = 27648;

struct Frame { LAS unsigned char* lds; LAS unsigned char* misc; int tid, lane, wave, G, bid; };
#define GAS __attribute__((address_space(1)))
typedef const __attribute__((address_space(4))) Args CArgs;
typedef CArgs& ArgsRef;
#define WS(a) ((unsigned char*)(GAS unsigned char*)(a).ws)
#define OUT(a) ((float*)(GAS float*)(a).out)
#define IN(a, i) ((const float*)(GAS const float*)(a).in[i])
__device__ __forceinline__ ArgsRef phase_args() { CArgs* ap = (CArgs*)__builtin_amdgcn_kernarg_segment_ptr(); asm volatile("" : "+s"(ap)); return *ap; }
__device__ __forceinline__ Frame make_frame(unsigned char* lds_raw) {
    Frame F; int tid = threadIdx.x; asm volatile("" : "+v"(tid)); int bid = blockIdx.x; asm volatile("" : "+s"(bid)); int G = gridDim.x; asm volatile("" : "+s"(G));
    F.lds = (LAS unsigned char*)lds_raw; F.misc = F.lds + LDS_MISC; F.tid = tid; F.lane = tid & 63; F.wave = __builtin_amdgcn_readfirstlane(tid >> 6); F.G = G; F.bid = bid; return F;
}

struct DenseOrder {
    int nM, nN, nwg, G, c, K; size_t a0, b0;
    __device__ __forceinline__ void init(int M, int N, int K_, int G_, int c_, size_t a0_ = 0, size_t b0_ = 0) { nM = M / 256; nN = N / 256; nwg = nM * nN; G = G_; c = c_; K = K_; a0 = a0_; b0 = b0_; }
    __device__ __forceinline__ bool next(int i, pg8::Unit& u) const {
        const long L = (long)i * G + c; if (L >= nwg) return false;
        int wgid = (int)L; { const int q = nwg / 8, r = nwg % 8, xcd = wgid % 8, off = wgid / 8; wgid = (xcd < r ? xcd * (q + 1) : r * (q + 1) + (xcd - r) * q) + off; }
        const int nig = 8 * nN, gid = wgid / nig, fm = gid * 8, gsz = (nM - fm) < 8 ? (nM - fm) : 8;
        u.pm = fm + ((wgid % nig) % gsz); u.pn = (wgid % nig) / gsz; u.e = 0; u.j = 0; return true;
    }
    __device__ __forceinline__ unsigned aoff(const pg8::Unit& u) const { return (unsigned)(a0 + (size_t)u.pm * 256 * K * 2); }
    __device__ __forceinline__ unsigned boff(const pg8::Unit& u) const { return (unsigned)(b0 + (size_t)u.pn * 256 * K * 2); }
};
template <int NPN, bool GATHER, int ROWB = 2048> struct MoeOrder {
    const LAS int* tile_e; const LAS int* cnt; const int* rows; int ntiles, G, c;
    __device__ __forceinline__ bool next(int i, pg8::Unit& u) const {
        int pm, pn;
        if (G == 256) {
            constexpr int PMG = 32 / NPN; const int xcd = c & 7, slot = c >> 3;
            pm = (i * 8 + xcd) * PMG + slot / NPN; pn = slot % NPN; if (pm >= ntiles) return false; }
        else { const int L = i * G + c; if (L >= ntiles * NPN) return false; pm = L / NPN; pn = L % NPN; }
        const int ej = __builtin_amdgcn_readfirstlane(tile_e[pm]);
        u.pm = pm; u.pn = pn; u.e = ej >> 16; u.j = ej & 0xffff; return true;
    }
    __device__ __forceinline__ int nrows(const pg8::Unit& u) const { int nr = __builtin_amdgcn_readfirstlane(cnt[u.e]) - 256 * u.j; return nr > 256 ? 256 : nr; }
    __device__ __forceinline__ int lo(const pg8::Unit& u) const { return u.e * LIST_CAP + 256 * u.j; }
    __device__ __forceinline__ unsigned aoff(const pg8::Unit& u) const { return GATHER ? 0u : (unsigned)u.pm * 256u * (unsigned)ROWB; }
    __device__ __forceinline__ unsigned boff(const pg8::Unit& u) const { return (unsigned)(u.e * NPN + u.pn) * 256u * (unsigned)ROWB; }
};

struct EpiGateUp { static constexpr bool PERM = true;
    bf16_t* act; const float* bgate; const float* bup; const float* lrs; const LAS int* cnt;
    __device__ __forceinline__ void operator()(const f32x4 (&acc)[2][2][4][2], const pg8::Unit& u, int wr, int wc, int fr, int fq) const {
        const int f0 = 128 * u.pn + 32 * wc + 8 * fq; const float* rsl = lrs + u.e * LIST_CAP + 256 * u.j; const int nrows = cnt[u.e] - 256 * u.j;
        f32x4 bg[2], bu[2]; float rsv[2][4];
#pragma unroll
        for (int n = 0; n < 2; ++n) { bg[n] = *(const f32x4*)(bgate + u.e * FF + f0 + 4 * n); bu[n] = *(const f32x4*)(bup + u.e * FF + f0 + 4 * n); }
#pragma unroll
        for (int ai = 0; ai < 2; ++ai)
#pragma unroll
            for (int m = 0; m < 4; ++m) rsv[ai][m] = rsl[128 * ai + 64 * wr + 16 * m + fr];
#pragma unroll
        for (int ai = 0; ai < 2; ++ai)
#pragma unroll
            for (int m = 0; m < 4; ++m) { const int r = 128 * ai + 64 * wr + 16 * m + fr; const float rs = r < nrows ? rsv[ai][m] * (MOE_FP8 ? W8_INV : 1.f) : 0.f;
                float a[8];
#pragma unroll
                for (int n = 0; n < 2; ++n)
#pragma unroll
                    for (int i = 0; i < 4; i += 2) {
                        const f32x2 ag = {acc[ai][0][m][n][i], acc[ai][0][m][n][i + 1]}, au = {acc[ai][1][m][n][i], acc[ai][1][m][n][i + 1]};
                        const f32x2 bg2 = {bg[n][i], bg[n][i + 1]}, bu2 = {bu[n][i], bu[n][i + 1]}, rs2 = {rs, rs};
                        f32x2 g = ag * rs2 + bg2, up = au * rs2 + bu2;
                        g[0] = fminf(g[0], 7.f); g[1] = fminf(g[1], 7.f); up[0] = fminf(fmaxf(up[0], -7.f), 7.f); up[1] = fminf(fmaxf(up[1], -7.f), 7.f);
                        const f32x2 ar = g * (f32x2){-1.702f * 1.4426950408889634f, -1.702f * 1.4426950408889634f};
                        f32x2 den = {__builtin_amdgcn_exp2f(ar[0]), __builtin_amdgcn_exp2f(ar[1])}; den = den + (f32x2){1.f, 1.f};
                        const f32x2 sg = {__builtin_amdgcn_rcpf(den[0]), __builtin_amdgcn_rcpf(den[1])};
                        const f32x2 res = (g * sg) * (up + (f32x2){1.f, 1.f});
                        a[4 * n + i] = res[0]; a[4 * n + i + 1] = res[1]; }
                if constexpr (MOE_FP8) { u32x2 w8; w8.x = pk4_fp8(a[0], a[1], a[2], a[3]); w8.y = pk4_fp8(a[4], a[5], a[6], a[7]); *(u32x2*)((unsigned char*)act + ((size_t)u.pm * 256 + r) * FF + f0) = w8; }
                else { u32x4 w; w.x = cvt_pk_bf16(a[0], a[1]); w.y = cvt_pk_bf16(a[2], a[3]); w.z = cvt_pk_bf16(a[4], a[5]); w.w = cvt_pk_bf16(a[6], a[7]);
                *(u32x4*)(act + ((size_t)u.pm * 256 + r) * FF + f0) = w; } }
    }
};
struct EpiDown { static constexpr bool PERM = true;
    bf16_t* y; const float* bdown;
    __device__ __forceinline__ void operator()(const f32x4 (&acc)[2][2][4][2], const pg8::Unit& u, int wr, int wc, int fr, int fq) const {
        const int c0 = 256 * u.pn + 32 * wc + 8 * fq;
        f32x4 bv[2][2];
#pragma unroll
        for (int bj = 0; bj < 2; ++bj)
#pragma unroll
            for (int n = 0; n < 2; ++n) bv[bj][n] = *(const f32x4*)(bdown + u.e * D + c0 + 128 * bj + 4 * n);
#pragma unroll
        for (int ai = 0; ai < 2; ++ai)
#pragma unroll
            for (int m = 0; m < 4; ++m) { const int r = 128 * ai + 64 * wr + 16 * m + fr;
#pragma unroll
                for (int bj = 0; bj < 2; ++bj) { const f32x4 v0 = acc[ai][bj][m][0] * (MOE_FP8 ? W8_INV : 1.f) + bv[bj][0], v1 = acc[ai][bj][m][1] * (MOE_FP8 ? W8_INV : 1.f) + bv[bj][1];
                    if constexpr (Y_FP8) { u32x2 w8; w8.x = pk4_fp8(v0[0], v0[1], v0[2], v0[3]); w8.y = pk4_fp8(v1[0], v1[1], v1[2], v1[3]); *(u32x2*)((unsigned char*)y + ((size_t)u.pm * 256 + r) * D + c0 + 128 * bj) = w8; }
                    else { u32x4 w; w.x = cvt_pk_bf16(v0[0], v0[1]); w.y = cvt_pk_bf16(v0[2], v0[3]); w.z = cvt_pk_bf16(v1[0], v1[1]); w.w = cvt_pk_bf16(v1[2], v1[3]);
                    *(u32x4*)(y + ((size_t)u.pm * 256 + r) * D + c0 + 128 * bj) = w; } } }
    }
};

struct EpiProbe { static constexpr bool PERM = true;
    float* sink;
    __device__ __forceinline__ void operator()(const f32x4 (&acc)[2][2][4][2], const pg8::Unit& u, int wr, int wc, int fr, int fq) const {
        float s = 0.f;
#pragma unroll
        for (int ai = 0; ai < 2; ++ai)
#pragma unroll
            for (int bj = 0; bj < 2; ++bj)
#pragma unroll
                for (int m = 0; m < 4; ++m)
#pragma unroll
                    for (int n = 0; n < 2; ++n) s += acc[ai][bj][m][n][0];
        if (s != s) sink[u.pm] = s;
    }
};
template <bool F8 = false> __device__ __forceinline__ void transpose_item64(const float* W, int ldw, int Kd, bf16_t* WT, long dst_row0, const float* g, LAS float* scr, int k0, int srccol, int lane) {
    float v[64];
#pragma unroll
    for (int kk = 0; kk < 64; ++kk) v[kk] = srccol >= 0 ? W[(size_t)(k0 + kk) * ldw + srccol] : 0.f;
    if (g) {
#pragma unroll
        for (int kk = 0; kk < 64; kk += 4) { const f32x4 gg = *(const f32x4*)(g + k0 + kk); v[kk] *= gg[0]; v[kk + 1] *= gg[1]; v[kk + 2] *= gg[2]; v[kk + 3] *= gg[3]; } }
#pragma unroll
    for (int kk = 0; kk < 64; ++kk) scr[lane * 65 + kk] = v[kk];
    LDS_WAIT(); asm volatile("" ::: "memory");
    const int c = lane & 7;
#pragma unroll
    for (int j = 0; j < 8; ++j) { const int n = (lane >> 3) + 8 * j; const LAS float* sp = scr + n * 65 + 8 * c;
        if constexpr (F8) { u32x2 o8; o8.x = pk4_fp8(sp[0] * W8_SCALE, sp[1] * W8_SCALE, sp[2] * W8_SCALE, sp[3] * W8_SCALE); o8.y = pk4_fp8(sp[4] * W8_SCALE, sp[5] * W8_SCALE, sp[6] * W8_SCALE, sp[7] * W8_SCALE);
            *(u32x2*)((unsigned char*)WT + (size_t)(dst_row0 + n) * Kd + k0 + 8 * c) = o8; }
        else { u32x4 o; o.x = pk2(sp[0], sp[1]); o.y = pk2(sp[2], sp[3]); o.z = pk2(sp[4], sp[5]); o.w = pk2(sp[6], sp[7]);
        *(u32x4*)(WT + (size_t)(dst_row0 + n) * Kd + k0 + 8 * c) = o; } }
    LDS_WAIT(); asm volatile("" ::: "memory");
}

__device__ __forceinline__ void moe_weight_convert(const Frame& F, ArgsRef a) {
    LAS float* scr = (LAS float*)(F.wave < 7 ? F.lds + LDS_STAGE + F.wave * 16640 : F.misc + 4096);
    const int gw = F.bid * 8 + F.wave, NGW = F.G * 8;
    const float* gffn = IN(a, I_NORM_FFN_G);
    bf16_t* wgu = (bf16_t*)(WS(a) + WS_WGU); bf16_t* wd = (bf16_t*)(WS(a) + WS_WD);
    constexpr int KB = MOE_FP8 ? 2 : 1, PER = (16 / KB) * 16;
    for (int it = gw; it < 3 * NE * PER; it += NGW) {
        const int mat = it / (NE * PER), r = it % (NE * PER), e = r / PER, q = r % PER, kb0 = (q / 16) * KB, nb = q % 16;
#pragma unroll 1
        for (int kk = 0; kk < KB; ++kk) { const int kb = kb0 + kk;
            if (mat < 2) { const float* W = IN(a, mat == 0 ? I_W_GATE : I_W_UP) + (size_t)e * D * FF;
                const long row = (long)e * 2048 + (nb / 2) * 256 + (mat ? 128 : 0) + (nb % 2) * 64;
                transpose_item64<MOE_FP8>(W, FF, D, wgu, row, gffn, scr, 64 * kb, 64 * nb + F.lane, F.lane);
            } else { const float* W = IN(a, I_W_DOWN) + (size_t)e * FF * D;
                transpose_item64<MOE_FP8>(W, D, FF, wd, (long)e * 1024 + 64 * nb, nullptr, scr, 64 * kb, 64 * nb + F.lane, F.lane); } }
    }
}
__device__ __forceinline__ bool cv_decode(int j, int gw, int NGW, int lane, ArgsRef a, unsigned char* wgu, unsigned char* wd, const float* gffn, const float*& src, unsigned char*& dst, const float*& g) {
    constexpr int PER = 8 * 16; const int it = gw + (j >> 1) * NGW; if (it >= 3 * NE * PER) return false;
    const int mat = it / (NE * PER), r = it % (NE * PER), e = r / PER, q = r % PER, kb = (q / 16) * 2 + (j & 1), nb = q % 16, k0 = 64 * kb;
    if (mat < 2) { src = IN(a, mat == 0 ? I_W_GATE : I_W_UP) + (size_t)e * D * FF + (size_t)k0 * 1024 + 64 * nb + lane;
        dst = wgu + ((size_t)e * 2048 + (nb / 2) * 256 + (mat ? 128 : 0) + (nb % 2) * 64) * 1024 + k0; g = gffn + k0; }
    else { src = IN(a, I_W_DOWN) + (size_t)e * FF * D + (size_t)k0 * 1024 + 64 * nb + lane; dst = wd + ((size_t)e * 1024 + 64 * nb) * 1024 + k0; g = nullptr; }
    return true;
}
#define CV_LOAD(v, src) do { _Pragma("unroll") for (int kk = 0; kk < 64; ++kk) v[kk] = (src)[(size_t)kk * 1024]; } while (0)
#define CV_FIN(v, dst, g) do { if (g) { _Pragma("unroll") for (int kk = 0; kk < 64; kk += 4) { const f32x4 gg = *(const f32x4*)((g) + kk); v[kk] *= gg[0]; v[kk + 1] *= gg[1]; v[kk + 2] *= gg[2]; v[kk + 3] *= gg[3]; } } \
        _Pragma("unroll") for (int kk = 0; kk < 64; ++kk) scr[lane * 65 + kk] = v[kk]; \
        LDS_WAIT(); asm volatile("" ::: "memory"); \
        _Pragma("unroll") for (int j8 = 0; j8 < 8; ++j8) { const int n = (lane >> 3) + 8 * j8; const LAS float* sp = scr + n * 65 + 8 * (lane & 7); u32x2 o8; \
            o8.x = pk4_fp8(sp[0] * W8_SCALE, sp[1] * W8_SCALE, sp[2] * W8_SCALE, sp[3] * W8_SCALE); o8.y = pk4_fp8(sp[4] * W8_SCALE, sp[5] * W8_SCALE, sp[6] * W8_SCALE, sp[7] * W8_SCALE); \
            *(u32x2*)((dst) + (size_t)n * 1024 + 8 * (lane & 7)) = o8; } \
        LDS_WAIT(); asm volatile("" ::: "memory"); } while (0)
__device__ __forceinline__ void moe_weight_convert_pipe(const Frame& F, ArgsRef a) {
    LAS float* scr = (LAS float*)(F.wave < 7 ? F.lds + LDS_STAGE + F.wave * 16640 : F.misc + 4096);
    const int gw = F.bid * 8 + F.wave, NGW = F.G * 8, lane = F.lane; const float* gffn = IN(a, I_NORM_FFN_G);
    unsigned char* wgu = WS(a) + WS_WGU; unsigned char* wd = WS(a) + WS_WD;
    float va[64], vb[64]; const float* sA; const float* sB; unsigned char* dA; unsigned char* dB; const float* gA; const float* gB;
    if (!cv_decode(0, gw, NGW, lane, a, wgu, wd, gffn, sA, dA, gA)) return;
    CV_LOAD(va, sA);
#pragma unroll 1
    for (int j = 0;; j += 2) {
        const bool hB = cv_decode(j + 1, gw, NGW, lane, a, wgu, wd, gffn, sB, dB, gB); if (hB) CV_LOAD(vb, sB);
        CV_FIN(va, dA, gA);
        if (!hB) break;
        const bool hA = cv_decode(j + 2, gw, NGW, lane, a, wgu, wd, gffn, sA, dA, gA); if (hA) CV_LOAD(va, sA);
        CV_FIN(vb, dB, gB);
        if (!hA) break;
    }
}
#undef CV_LOAD
#undef CV_FIN
__device__ __forceinline__ void router_weight_prep(const Frame& F, ArgsRef a) {
    bf16_t* whi = (bf16_t*)(WS(a) + WS_MISC + MISC_RW_HI); bf16_t* wlo = (bf16_t*)(WS(a) + WS_MISC + MISC_RW_LO);
    const float* wr = IN(a, I_W_ROUTER); const float* g = IN(a, I_NORM_FFN_G);
    for (int i = F.bid * 512 + F.tid; i < NE * D; i += F.G * 512) { const int e = i / D, k = i % D; const float v = g[k] * wr[k * NE + e];
        const unsigned h = f2bf(v); const float r = v - bf2f(h); whi[i] = (bf16_t)h; wlo[i] = (bf16_t)f2bf(r); }
}
__device__ __forceinline__ void copy_x_phase(const Frame& F, ArgsRef a) {
    const int gw = F.bid * 8 + F.wave, NGW = F.G * 8; bf16_t* x2b = (bf16_t*)(WS(a) + WS_X2B);
    for (int t = gw; t < T; t += NGW) { const f32x4* xr = (const f32x4*)(IN(a, I_X) + (size_t)t * D) + F.lane; f32x4* o = (f32x4*)(OUT(a) + (size_t)t * D) + F.lane; u32x2* ob = (u32x2*)(x2b + (size_t)t * D) + F.lane;
#pragma unroll
        for (int j = 0; j < 4; ++j) { const f32x4 v = xr[64 * j]; o[64 * j] = v; u32x2 w; w.x = pk2(v[0], v[1]); w.y = pk2(v[2], v[3]); ob[64 * j] = w; } }
}
__device__ __forceinline__ void router_phase(const Frame& F, ArgsRef a) {
    LAS int* lcnt = (LAS int*)(F.misc + LM_LCNT); LAS int* gbase = (LAS int*)(F.misc + LM_GBASE);
    LAS int* rec_e = (LAS int*)(F.misc + LM_REC); LAS int* rec_p = rec_e + 512; LAS float* rec_w = (LAS float*)(rec_p + 512); LAS float* rec_rs = rec_w + 512; LAS float* scr = (LAS float*)(F.misc + LM_SCR + F.wave * 2304);
    const bf16_t* whi = (const bf16_t*)(WS(a) + WS_MISC + MISC_RW_HI); const bf16_t* wlo = (const bf16_t*)(WS(a) + WS_MISC + MISC_RW_LO);
    unsigned* gcnt = (unsigned*)(WS(a) + WS_CTL) + CW_CNT;
    const float* x2 = X2H ? (const float*)(WS(a) + WS_X2H) : OUT(a); const float* brt = IN(a, I_B_ROUTER);
    const unsigned long long px_ = (unsigned long long)x2; const unsigned long long ux_ = ((unsigned long long)(unsigned)__builtin_amdgcn_readfirstlane((int)(px_ >> 32)) << 32) | (unsigned)__builtin_amdgcn_readfirstlane((int)px_);
    const __amdgpu_buffer_rsrc_t x2rsrc = __builtin_amdgcn_make_buffer_rsrc((void*)ux_, 0, 0x7ffffffc, 0x00020000);
    u32x4* grec = (u32x4*)(WS(a) + WS_REC); int* ltok = (int*)(WS(a) + WS_LTOK); float* lrs = (float*)(WS(a) + WS_LRS);
    const int fr = F.lane & 15, fq = F.lane >> 4;
    LAS unsigned char* wl_lds = F.lds + LDS_STAGE;
    __syncthreads();
    for (int i = F.tid; i < 8192; i += 512) { const int arr = i >> 12, row = (i >> 7) & 31, ch = i & 127; const f32x4 v = *(const f32x4*)((arr ? wlo : whi) + (size_t)row * D + ch * 8);
        *(LAS f32x4*)(wl_lds + arr * 65536 + row * 2048 + ((ch ^ (row & 7)) << 4)) = v; }
    __syncthreads();
#if defined(DIAG2) && (DIAG2 == 29 || DIAG2 == 30 || DIAG2 == 31)
    { unsigned* dbgA = (unsigned*)(WS(a) + WS_CTL + 640 * 1024); unsigned* nb = (unsigned*)(WS(a) + WS_CTL) + 16384; unsigned sm = 0u;
      for (int i = F.lane; i < 4096; i += 64) sm += ((const LAS unsigned*)(wl_lds + F.wave * 16384))[i] * (unsigned)(2 * i + 1);
      for (int o = 1; o < 64; o <<= 1) sm += __shfl_xor(sm, o);
      if (F.lane == 0) { if (a.pass == 0) dbgA[F.bid * 8 + F.wave] = sm; else if (dbgA[F.bid * 8 + F.wave] != sm) atomicAdd(nb + 64 * 1, 1u); } }
#endif
    for (int grp = F.bid; grp < T / 128; grp += F.G) {
        if (F.tid < 32) lcnt[F.tid] = 0;
        __syncthreads();
        const int t0 = grp * 128 + F.wave * 16;
        f32x4 acc0 = {0.f, 0.f, 0.f, 0.f}, acc1 = {0.f, 0.f, 0.f, 0.f}; float ssq = 0.f;
        const float* xr = x2 + (size_t)(t0 + fr) * D + 8 * fq;
#pragma unroll 1
        for (int k8 = 0; k8 < 4; ++k8) {
            f32x4 xa[8], xb[8]; u32x4 xh[8];
#pragma unroll
            for (int u = 0; u < 8; ++u) {
                if constexpr (X2H) { const unsigned vo = (unsigned)(t0 + fr) * 2048u + 16u * fq + 64u * (8 * k8 + u); xh[u] = __builtin_amdgcn_raw_buffer_load_b128(x2rsrc, vo, 0, 16); }
                else { const unsigned vo = (unsigned)(t0 + fr) * 4096u + 32u * fq + 128u * (8 * k8 + u);
                xa[u] = __builtin_bit_cast(f32x4, __builtin_amdgcn_raw_buffer_load_b128(x2rsrc, vo, 0, 16)); xb[u] = __builtin_bit_cast(f32x4, __builtin_amdgcn_raw_buffer_load_b128(x2rsrc, vo + 16u, 0, 16)); } }

#pragma unroll
            for (int u = 0; u < 8; ++u) { const int ks = 8 * k8 + u; bf16x8 ah, al;
                if constexpr (X2H) { const u32x4 hw = xh[u]; const unsigned h0 = hw.x, h1 = hw.y, h2 = hw.z, h3 = hw.w; ah = __builtin_bit_cast(bf16x8, hw);
                    const float e0 = bf2f(h0 & 0xffffu), e1 = bf2f(h0 >> 16), e2 = bf2f(h1 & 0xffffu), e3 = bf2f(h1 >> 16), e4 = bf2f(h2 & 0xffffu), e5 = bf2f(h2 >> 16), e6 = bf2f(h3 & 0xffffu), e7 = bf2f(h3 >> 16);
                    ssq += (e0 * e0 + e1 * e1) + (e2 * e2 + e3 * e3) + (e4 * e4 + e5 * e5) + (e6 * e6 + e7 * e7); al = ah; }
                else { const f32x4 v0 = xa[u], v1 = xb[u];
                ssq += (v0[0] * v0[0] + v0[1] * v0[1]) + (v0[2] * v0[2] + v0[3] * v0[3]) + (v1[0] * v1[0] + v1[1] * v1[1]) + (v1[2] * v1[2] + v1[3] * v1[3]);
                float xv[8] = {v0[0], v0[1], v0[2], v0[3], v1[0], v1[1], v1[2], v1[3]};
#pragma unroll
                for (int j = 0; j < 8; ++j) { const unsigned h = f2bf(xv[j]); ah[j] = (short)h; al[j] = (short)f2bf(xv[j] - bf2f(h)); } }
                const int ch = 4 * ks + fq;
                const LAS unsigned char* w0 = wl_lds + fr * 2048 + ((ch ^ (fr & 7)) << 4); const LAS unsigned char* w1 = wl_lds + (16 + fr) * 2048 + ((ch ^ (fr & 7)) << 4);
                const bf16x8 bh0 = *(const LAS bf16x8*)w0, bh1 = *(const LAS bf16x8*)w1, bl0 = *(const LAS bf16x8*)(w0 + 65536), bl1 = *(const LAS bf16x8*)(w1 + 65536);
                acc0 = __builtin_amdgcn_mfma_f32_16x16x32_bf16(ah, bh0, acc0, 0, 0, 0); if constexpr (!X2H) acc0 = __builtin_amdgcn_mfma_f32_16x16x32_bf16(al, bh0, acc0, 0, 0, 0); acc0 = __builtin_amdgcn_mfma_f32_16x16x32_bf16(ah, bl0, acc0, 0, 0, 0);
                acc1 = __builtin_amdgcn_mfma_f32_16x16x32_bf16(ah, bh1, acc1, 0, 0, 0); if constexpr (!X2H) acc1 = __builtin_amdgcn_mfma_f32_16x16x32_bf16(al, bh1, acc1, 0, 0, 0); acc1 = __builtin_amdgcn_mfma_f32_16x16x32_bf16(ah, bl1, acc1, 0, 0, 0); } }
        ssq += __shfl_xor(ssq, 16); ssq += __shfl_xor(ssq, 32);
#if defined(DIAG2) && (DIAG2 >= 32 && DIAG2 <= 40)
        { float s2 = 0.f; for (int ks = 0; ks < 32; ++ks) for (int j = 0; j < 8; ++j) { const unsigned w = __hip_atomic_load((const unsigned*)(xr + 32 * ks + j), __ATOMIC_RELAXED, DIAG2 == 32 ? __HIP_MEMORY_SCOPE_SYSTEM : __HIP_MEMORY_SCOPE_AGENT); const float f = __uint_as_float(w); s2 += f * f; }
          s2 += __shfl_xor(s2, 16); s2 += __shfl_xor(s2, 32);
          const float rel = fabsf(s2 - ssq) / (fabsf(ssq) + 1e-20f);
          if (F.lane < 16 && !(rel < 1e-3f)) { unsigned* nb_ = (unsigned*)(WS(a) + WS_CTL) + 16384; atomicAdd(nb_ + 64 * 3, 1u); const int t_ = t0 + F.lane;
              if (a.pass == 1) { if (ssq == 0.f) atomicAdd(nb_ + 64 * 11, 1u); else if (s2 == 0.f) atomicAdd(nb_ + 64 * 12, 1u); else atomicAdd(nb_ + 64 * 13, 1u); }
              atomicOr(nb_ + 64 * 4, 1u << (t_ & 15)); atomicOr(nb_ + 64 * 5, 1u << ((t_ >> 4) & 7)); atomicOr(nb_ + 64 * 6, 1u << ((t_ >> 7) & 31)); atomicOr(nb_ + 64 * 7, 1u << ((t_ >> 12) & 7)); } }
#endif
        const float rstd = 1.0f / sqrtf(ssq * (1.0f / D) + RMS_EPS);
#pragma unroll
        for (int r = 0; r < 4; ++r) { scr[(4 * fq + r) * 36 + fr] = acc0[r]; scr[(4 * fq + r) * 36 + 16 + fr] = acc1[r]; }
        LDS_WAIT(); asm volatile("" ::: "memory");
        if (F.lane < 16) {
            float v[32];
#pragma unroll
            for (int e = 0; e < 32; ++e) v[e] = scr[F.lane * 36 + e] * rstd + brt[e];
#if defined(DIAG2) && (DIAG2 == 29 || DIAG2 == 30 || DIAG2 == 31)
            { unsigned* dbgB = (unsigned*)(WS(a) + WS_CTL + 704 * 1024); unsigned* nb = (unsigned*)(WS(a) + WS_CTL) + 16384; unsigned sm = 0u;
              for (int e = 0; e < 32; ++e) sm = sm * 31u + __float_as_uint(v[e]);
              const int t_ = t0 + F.lane; if (a.pass == 0) dbgB[t_] = sm; else if (dbgB[t_] != sm) atomicAdd(nb + 64 * 2, 1u);
              unsigned s2 = __float_as_uint(rstd); unsigned* dbgC = dbgB + 32768; if (a.pass == 0) dbgC[t_] = s2; else if (dbgC[t_] != s2) atomicAdd(nb + 64 * 3, 1u); }
#endif
            float tv[4]; int ti[4];
#pragma unroll
            for (int k = 0; k < 4; ++k) { float best = v[0]; int bi = 0;
#pragma unroll
                for (int e = 1; e < 32; ++e) if (v[e] > best) { best = v[e]; bi = e; }
                tv[k] = best; ti[k] = bi;
#pragma unroll
                for (int e = 0; e < 32; ++e) v[e] = (e == bi) ? -3.0e38f : v[e]; }
            float ex[4], sum = 0.f;
#pragma unroll
            for (int k = 0; k < 4; ++k) { ex[k] = __expf(tv[k] - tv[0]); sum += ex[k]; }
            const float inv = 1.0f / sum;
#pragma unroll
            for (int k = 0; k < 4; ++k) { const int lp = atomicAdd((int*)(lcnt + ti[k]), 1); const int ri = (F.wave * 16 + F.lane) * 4 + k;
                rec_e[ri] = ti[k]; rec_p[ri] = lp; rec_w[ri] = ex[k] * inv; }
            rec_rs[F.wave * 16 + F.lane] = rstd;
        }
        __syncthreads();
        const int half = (grp * 128) / HALF_T;
        if (F.tid < 32) gbase[F.tid] = (int)atomicAdd(gcnt + half * 32 + F.tid, (unsigned)lcnt[F.tid]);
        __syncthreads();
        { const int e = rec_e[F.tid], pos = gbase[e] + rec_p[F.tid], t = grp * 128 + (F.tid >> 2); const float w = rec_w[F.tid], rs = rec_rs[F.tid >> 2];
            float* gr = (float*)(grec + (size_t)t * 4 + (F.tid & 3)); ((int*)gr)[0] = e; ((int*)gr)[1] = pos; gr[2] = w; gr[3] = 0.f;
            const size_t li = ((size_t)half * NE + e) * LIST_CAP + pos; ltok[li] = t; lrs[li] = rs; }
        __syncthreads();
    }
}
__device__ __forceinline__ int moe_tables(const Frame& F, ArgsRef a, int half) {
    LAS int* tend = (LAS int*)(F.misc + LM_TEND); LAS int* cnt = (LAS int*)(F.misc + LM_CNT); LAS int* pstart = (LAS int*)(F.misc + LM_PSTART);
    const unsigned* gcnt = (const unsigned*)(WS(a) + WS_CTL) + CW_CNT + half * 32;
    __syncthreads();
    if (F.tid < 32) cnt[F.tid] = (int)__hip_atomic_load(gcnt + F.tid, __ATOMIC_RELAXED, __HIP_MEMORY_SCOPE_AGENT);
    __syncthreads();
    if (F.tid == 0) { int acc = 0; for (int e = 0; e < NE; ++e) { pstart[e] = acc * 256; acc += (cnt[e] + 255) >> 8; tend[e] = acc; } }
    __syncthreads();
    { LAS int* tile_e = (LAS int*)(F.misc + LM_TILE); for (int ti = F.tid; ti < 576; ti += 512) { int e = 0; while (e < NE - 1 && ti >= tend[e]) ++e; const int t0 = e ? tend[e - 1] : 0; tile_e[ti] = (e << 16) | (ti - t0); } }
    __syncthreads();
    return __builtin_amdgcn_readfirstlane(tend[NE - 1]);
}
__device__ __forceinline__ void combine_phase(const Frame& F, ArgsRef a, int half) {
    const LAS int* pstart = (const LAS int*)(F.misc + LM_PSTART);
    const u32x4* grec = (const u32x4*)(WS(a) + WS_REC); const bf16_t* y = (const bf16_t*)(WS(a) + WS_Y); const float* gfin = IN(a, I_NORM_FINAL_G);
    const int gw = F.bid * 8 + F.wave, NGW = F.G * 8;
    for (int tb2 = half * HALF_T + gw * 2; tb2 < (half + 1) * HALF_T; tb2 += NGW * 2) {
        int slot[2][4]; float rw[2][4];
#pragma unroll
        for (int u = 0; u < 2; ++u)
#pragma unroll
            for (int k = 0; k < 4; ++k) { const int* ri = (const int*)(grec + (size_t)(tb2 + u) * 4 + k); const int re = ri[0], rp = ri[1]; rw[u][k] = ((const float*)ri)[2]; slot[u][k] = pstart[re] + rp; }
        f32x4 v[2][4]; u32x2 yv[2][4][4];
#pragma unroll
        for (int u = 0; u < 2; ++u) {
            if constexpr (X2H) { const u32x2* xh = (const u32x2*)((const bf16_t*)(WS(a) + WS_X2H) + (size_t)(tb2 + u) * D) + F.lane;
#pragma unroll
                for (int j = 0; j < 4; ++j) { const u32x2 hw = xh[64 * j]; const unsigned h0 = hw.x, h1 = hw.y; v[u][j] = (f32x4){bf2f(h0 & 0xffffu), bf2f(h0 >> 16), bf2f(h1 & 0xffffu), bf2f(h1 >> 16)}; } }
            else { const f32x4* xr = (const f32x4*)(OUT(a) + (size_t)(tb2 + u) * D) + F.lane;
#pragma unroll
            for (int j = 0; j < 4; ++j) v[u][j] = xr[64 * j]; }
#pragma unroll
            for (int k = 0; k < 4; ++k) {
                if constexpr (Y_FP8) { const unsigned* yr = (const unsigned*)((const unsigned char*)y + (size_t)slot[u][k] * D) + F.lane;
#pragma unroll
                    for (int j = 0; j < 4; ++j) { yv[u][k][j].x = yr[64 * j]; yv[u][k][j].y = 0u; } }
                else { const u32x2* yr = (const u32x2*)(y + (size_t)slot[u][k] * D) + F.lane;
#pragma unroll
                    for (int j = 0; j < 4; ++j) yv[u][k][j] = yr[64 * j]; } } }
#pragma unroll
        for (int u = 0; u < 2; ++u) {
#pragma unroll
            for (int k = 0; k < 4; ++k) { const float w = rw[u][k];
#pragma unroll
                for (int j = 0; j < 4; ++j) { const u32x2 p = yv[u][k][j];
                    if constexpr (Y_FP8) { const unsigned pw = p.x; const f32x2 lo = __builtin_amdgcn_cvt_pk_f32_fp8(pw, false), hi = __builtin_amdgcn_cvt_pk_f32_fp8(pw, true);
                        v[u][j][0] += w * lo[0]; v[u][j][1] += w * lo[1]; v[u][j][2] += w * hi[0]; v[u][j][3] += w * hi[1]; }
                    else { v[u][j][0] += w * bf2f(p.x & 0xffffu); v[u][j][1] += w * bf2f(p.x >> 16); v[u][j][2] += w * bf2f(p.y & 0xffffu); v[u][j][3] += w * bf2f(p.y >> 16); } } }
            float ss = 0.f;
#pragma unroll
            for (int j = 0; j < 4; ++j) ss += (v[u][j][0] * v[u][j][0] + v[u][j][1] * v[u][j][1]) + (v[u][j][2] * v[u][j][2] + v[u][j][3] * v[u][j][3]);
            const float rstd = 1.0f / sqrtf(wave_sum(ss) * (1.0f / D) + RMS_EPS); f32x4* xo = (f32x4*)(OUT(a) + (size_t)(tb2 + u) * D) + F.lane;
#pragma unroll
            for (int j = 0; j < 4; ++j) { const f32x4 g = ((const f32x4*)gfin)[F.lane + 64 * j]; xo[64 * j] = v[u][j] * rstd * g; } }
    }
}

#ifndef V1TEST
#define V1TEST 0
#endif
#ifndef RT_VAR
#define RT_VAR 0
#endif
constexpr int D_IN = 8648;
__device__ __forceinline__ int win_src_col(int n) {
    if (n < 1024) return 456 + n;
    if (n < 1280) return n - 1024;
    if (n < 1480) return 256 + (n - 1280);
    if (n < 1536) return -1;
    if (n < 2560) return 1480 + (n - 1536);
    if (n < 4608) return 2504 + (n - 2560);
    return 4552 + (n - 4608);
}
template <int PM = 63> __device__ __forceinline__ void mixer_prep_phase(const Frame& F, ArgsRef a) {
    const int gw = F.bid * 8 + F.wave, NGW = F.G * 8, gt = F.bid * 512 + F.tid, NGT = F.G * 512;
    unsigned char* ws = WS(a);
    const bool a_first = (F.bid & 1) == 0;
#pragma unroll 1
    for (int pass = 0; pass < 2; ++pass) { int pl = pass; asm volatile("" : "+s"(pl)); const bool doA = (pl == 0) == a_first;
    if ((PM & 1) && doA) { bf16_t* xb = (bf16_t*)(ws + WS_XB); float* rstd1 = (float*)(ws + WS_MISC + MISC_RSTD1);
      for (int t4 = gw * 4; t4 < T; t4 += NGW * 4) { f32x4 v[4][4];
#pragma unroll
          for (int u = 0; u < 4; ++u) { const f32x4* xr = (const f32x4*)(IN(a, I_X) + (size_t)(t4 + u) * D) + F.lane;
#pragma unroll
              for (int j = 0; j < 4; ++j) v[u][j] = xr[64 * j]; }
#pragma unroll
          for (int u = 0; u < 4; ++u) { u32x2* ob = (u32x2*)(xb + (size_t)(t4 + u) * D) + F.lane; unsigned* o8 = (unsigned*)(ws + WS_XB8 + (size_t)(t4 + u) * D) + F.lane; float ss = 0.f;
#pragma unroll
              for (int j = 0; j < 4; ++j) { const f32x4 x = v[u][j]; ss += (x[0] * x[0] + x[1] * x[1]) + (x[2] * x[2] + x[3] * x[3]); u32x2 w; w.x = pk2(x[0], x[1]); w.y = pk2(x[2], x[3]); ob[64 * j] = w;
                  if constexpr (INC_FP8) o8[64 * j] = pk4_fp8(x[0], x[1], x[2], x[3]); }
              ss = wave_sum(ss); if (F.lane == 0) rstd1[t4 + u] = 1.0f / sqrtf(ss * (1.0f / D) + RMS_EPS); } } }
    if ((PM & 2) && !doA) { LAS float* scr = (LAS float*)(F.wave < 7 ? F.lds + LDS_STAGE + F.wave * 16640 : F.misc + 4096); const float* g = IN(a, I_NORM_MIX_G);
      constexpr int I_WIN = 16 * (NIN / 64), I_WB = 32 * 16, I_WO = 16 * 16;
      for (int it = gw; it < I_WIN + I_WB + I_WO; it += NGW) {
          if (it < I_WIN) { const int kb = it / (NIN / 64), nb = it % (NIN / 64);
              if (INC_FP8 && nb >= 72) transpose_item64<true>(IN(a, I_W_IN), D_IN, D, (bf16_t*)(ws + WS_WIN8), 64 * (nb - 72), g, scr, 64 * kb, win_src_col(64 * nb + F.lane), F.lane);
              else if (INB_FP8 && nb >= 40) transpose_item64<true>(IN(a, I_W_IN), D_IN, D, (bf16_t*)(ws + WS_WIN8 + 4 * MiB), 64 * (nb - 40), g, scr, 64 * kb, win_src_col(64 * nb + F.lane), F.lane);
              else transpose_item64(IN(a, I_W_IN), D_IN, D, (bf16_t*)(ws + WS_WIN), 64 * nb, g, scr, 64 * kb, win_src_col(64 * nb + F.lane), F.lane); }
          else if (it < I_WIN + I_WB) { const int r = it - I_WIN, kb = r / 16, nb = r % 16; transpose_item64(IN(a, I_W_BB), D, 2048, (bf16_t*)(ws + WS_WB), 64 * nb, nullptr, scr, 64 * kb, 64 * nb + F.lane, F.lane); }
          else { const int r = it - I_WIN - I_WB, kb = r / 16, nb = r % 16; transpose_item64(IN(a, I_W_OUT), D, D, (bf16_t*)(ws + WS_WOUT), 64 * nb, nullptr, scr, 64 * kb, 64 * nb + F.lane, F.lane); } } }
    if ((PM & 4) && !doA) { bf16_t* wq = (bf16_t*)(ws + WS_WQ); const float* wuq = IN(a, I_W_UQ); const float* wuk = IN(a, I_W_UK); const float* wqi = IN(a, I_W_QIDX); const float* cg = IN(a, I_CQ_G);
      for (int i = gt; i < 1536 * 32; i += NGT) { const int kk = i / 1536, n = i - kk * 1536;
          float v[8];
          if (n < 1024) { const int h = n >> 7; const float* q = wuk + (size_t)n * 128; const float* p = wuq + (size_t)(8 * kk) * 1024 + h * 128;
#pragma unroll
              for (int jj = 0; jj < 8; ++jj) v[jj] = 0.f;
#pragma unroll 2
              for (int d = 0; d < 128; d += 4) { const f32x4 y = *(const f32x4*)(q + d);
#pragma unroll
                  for (int jj = 0; jj < 8; ++jj) { const f32x4 x = *(const f32x4*)(p + jj * 1024 + d); v[jj] += (x[0] * y[0] + x[1] * y[1]) + (x[2] * y[2] + x[3] * y[3]); } } }
          else {
#pragma unroll
              for (int jj = 0; jj < 8; ++jj) v[jj] = wqi[(size_t)(8 * kk + jj) * 512 + (n - 1024)] * 0.125f; }
          const f32x4 g0 = *(const f32x4*)(cg + 8 * kk), g1 = *(const f32x4*)(cg + 8 * kk + 4);
          u32x4 w; w.x = pk2(v[0] * g0[0], v[1] * g0[1]); w.y = pk2(v[2] * g0[2], v[3] * g0[3]); w.z = pk2(v[4] * g1[0], v[5] * g1[1]); w.w = pk2(v[6] * g1[2], v[7] * g1[3]);
          *(u32x4*)(wq + (size_t)n * 256 + 8 * kk) = w; } }
    if ((PM & 8) && !doA) { bf16_t* wa = (bf16_t*)(ws + WS_WA); const float* wuv = IN(a, I_W_UV); const float* wba = IN(a, I_W_BA);
      for (int i = gt; i < 1024 * 128; i += NGT) { const int kk = i >> 10, n = i & 1023, h = kk >> 4, rr = kk & 15; const float* q = wba + (size_t)(h * 128) * 1024 + n;
          const float* p[8];
#pragma unroll
          for (int jj = 0; jj < 8; ++jj) p[jj] = wuv + (size_t)(MIXA_FP8 ? h * 128 + 32 * (jj & 3) + 2 * rr + (jj >> 2) : 8 * kk + jj) * 128;
          float v[8];
#pragma unroll
          for (int jj = 0; jj < 8; ++jj) v[jj] = 0.f;
#pragma unroll 2
          for (int d = 0; d < 128; d += 4) { const float y0 = q[(size_t)d * 1024], y1 = q[(size_t)(d + 1) * 1024], y2 = q[(size_t)(d + 2) * 1024], y3 = q[(size_t)(d + 3) * 1024];
#pragma unroll
              for (int jj = 0; jj < 8; ++jj) { const f32x4 x = *(const f32x4*)(p[jj] + d); v[jj] += (x[0] * y0 + x[1] * y1) + (x[2] * y2 + x[3] * y3); } }
          if constexpr (MIXA_FP8) { u32x2 w8; w8.x = pk4_fp8(v[0] * W8_SCALE, v[1] * W8_SCALE, v[2] * W8_SCALE, v[3] * W8_SCALE); w8.y = pk4_fp8(v[4] * W8_SCALE, v[5] * W8_SCALE, v[6] * W8_SCALE, v[7] * W8_SCALE);
              *(u32x2*)((unsigned char*)wa + (size_t)n * 1024 + h * 128 + 8 * rr) = w8; }
          else { u32x4 w; w.x = pk2(v[0], v[1]); w.y = pk2(v[2], v[3]); w.z = pk2(v[4], v[5]); w.w = pk2(v[6], v[7]);
          *(u32x4*)(wa + (size_t)n * 1024 + 8 * kk) = w; } } }
    }
    if (PM & 16) { float* cosP = (float*)(ws + WS_COSP); float* sinP = (float*)(ws + WS_SINP); float* cosT = (float*)(ws + WS_COST); float* sinT = (float*)(ws + WS_SINT);
      LAS double* invr = (LAS double*)(F.misc + LM_SCR);
      __syncthreads();
      if (F.tid < 128) invr[F.tid] = exp(-9.210340371976184 * (double)F.tid / 128.0) * 0.15915494309189535;
      __syncthreads();
      for (int i = gt; i < SEQ * 128; i += NGT) { const int pos = i >> 7, j = i & 127; const double rev = (double)pos * invr[j]; const float fr_ = (float)(rev - floor(rev));
          const float c = __builtin_amdgcn_cosf(fr_), sn = __builtin_amdgcn_sinf(fr_); cosP[i] = c; sinP[i] = sn; cosT[j * SEQ + pos] = c; sinT[j * SEQ + pos] = sn; }
      __syncthreads();
      if (gt < 256) { const int h = gt >> 6, i = gt & 63; const double lg = log(1.0 - exp2(-5.0 - (double)h));
          ((float*)(ws + WS_MISC + MISC_DQ))[gt] = (float)exp(lg * (i + 1)); ((float*)(ws + WS_MISC + MISC_DK))[gt] = (float)(exp(-lg * (i + 1)) * 0.0625); ((float*)(ws + WS_MISC + MISC_DZ))[gt] = (float)(exp(lg * (63 - i)) * 0.0625); } }
    if (PM & 32) router_weight_prep(F, a);
}

struct EpiInA { static constexpr bool PERM = true;
    bf16_t* qx; float* small; const float* rstd1; const float* cosP; const float* sinP; const float* dq;
    bf16_t* cqn; bf16_t* ckv; bf16_t* kidx; float* widx; const float* gkv; const float* gki; LAS float* xch;
    __device__ __forceinline__ void small_fused(const f32x4 (&acc)[2][2][4][2], const pg8::Unit& u, int wr, int wc, int fr, int fq) const {
        const int d0 = 32 * wc + 8 * fq;
#pragma unroll
        for (int ai = 0; ai < 2; ++ai) {
#pragma unroll
            for (int m = 0; m < 4; ++m) { int rl_ = 128 * ai + 64 * wr + 16 * m + fr; asm volatile("" : "+v"(rl_)); float p0 = 0.f, p1 = 0.f; const float rsv_ = rstd1[u.pm * 256 + rl_];
#pragma unroll
                for (int n = 0; n < 2; ++n)
#pragma unroll
                    for (int i = 0; i < 4; ++i) { const float x0 = acc[ai][0][m][n][i] * rsv_, x1 = acc[ai][1][m][n][i] * rsv_; p0 += x0 * x0; p1 += x1 * x1; }
                p0 += __shfl_xor(p0, 16); p0 += __shfl_xor(p0, 32); p1 += __shfl_xor(p1, 16); p1 += __shfl_xor(p1, 32);
                if (fq == 0) { xch[rl_ * 8 + wc] = p0; xch[rl_ * 8 + 4 + wc] = p1; } } }
        asm volatile("s_waitcnt lgkmcnt(0)" ::: "memory"); __builtin_amdgcn_s_barrier(); asm volatile("" ::: "memory");
#pragma unroll
        for (int ai = 0; ai < 2; ++ai)
#pragma unroll
            for (int m = 0; m < 4; ++m) { int rl = 128 * ai + 64 * wr + 16 * m + fr; asm volatile("" : "+v"(rl));        const size_t row = (size_t)u.pm * 256 + rl;
                const f32x4 q0 = *(const LAS f32x4*)(xch + rl * 8), q1 = *(const LAS f32x4*)(xch + rl * 8 + 4); const float rsm = rstd1[row];
                if (u.pn == 4) { const float r = rsm * (1.0f / sqrtf(((q0[0] + q0[1]) + (q0[2] + q0[3]) + (q1[0] + q1[1]) + (q1[2] + q1[3])) * (1.f / 256.f) + RMS_EPS));
#pragma unroll
                    for (int bj = 0; bj < 2; ++bj) { const f32x4 v0 = acc[ai][bj][m][0] * r, v1 = acc[ai][bj][m][1] * r; u32x4 w; w.x = cvt_pk_bf16(v0[0], v0[1]); w.y = cvt_pk_bf16(v0[2], v0[3]); w.z = cvt_pk_bf16(v1[0], v1[1]); w.w = cvt_pk_bf16(v1[2], v1[3]);
                        *(u32x4*)(cqn + row * 256 + 128 * bj + d0) = w; } }
                else { const float* gkv_ = gkv; const float* gki_ = gki; asm volatile("" : "+s"(gkv_), "+s"(gki_));
                    { const float r = rsm * (1.0f / sqrtf(((q0[0] + q0[1]) + (q0[2] + q0[3])) * (1.f / 128.f) + RMS_EPS)); const f32x4 g0 = *(const f32x4*)(gkv_ + d0), g1 = *(const f32x4*)(gkv_ + d0 + 4);
                        const f32x4 v0 = acc[ai][0][m][0] * r * g0, v1 = acc[ai][0][m][1] * r * g1; u32x4 w; w.x = cvt_pk_bf16(v0[0], v0[1]); w.y = cvt_pk_bf16(v0[2], v0[3]); w.z = cvt_pk_bf16(v1[0], v1[1]); w.w = cvt_pk_bf16(v1[2], v1[3]);
                        *(u32x4*)(ckv + row * 128 + d0) = w; }
                    if (wc < 2) { const float r = rsm * (1.0f / sqrtf((q1[0] + q1[1]) * (1.f / 64.f) + RMS_EPS)); const f32x4 g0 = *(const f32x4*)(gki_ + d0), g1 = *(const f32x4*)(gki_ + d0 + 4);
                        const f32x4 v0 = acc[ai][1][m][0] * r * g0, v1 = acc[ai][1][m][1] * r * g1; u32x4 w; w.x = cvt_pk_bf16(v0[0], v0[1]); w.y = cvt_pk_bf16(v0[2], v0[3]); w.z = cvt_pk_bf16(v1[0], v1[1]); w.w = cvt_pk_bf16(v1[2], v1[3]);
                        *(u32x4*)(kidx + row * 64 + d0) = w; }
                    else if (wc == 2 && fq == 0) { const float sc = 0.35355339059327373f * rsm; *(f32x4*)(widx + row * 8) = acc[ai][1][m][0] * sc; *(f32x4*)(widx + row * 8 + 4) = acc[ai][1][m][1] * sc; } } }
    }
    __device__ __forceinline__ void operator()(const f32x4 (&acc)[2][2][4][2], const pg8::Unit& u, int wr, int wc, int fr, int fq) const {
        const int d0 = 32 * wc + 8 * fq;
        if (ROWNORM_FUSED && u.pn >= 4) { small_fused(acc, u, wr, wc, fr, fq); return; }
#pragma unroll
        for (int ai = 0; ai < 2; ++ai) { const int row0 = u.pm * 256 + 128 * ai + 64 * wr + fr;
            float rs[4];
#pragma unroll
            for (int m = 0; m < 4; ++m) rs[m] = rstd1[row0 + 16 * m];
            if (u.pn < 4) { f32x4 c4[4][2], s4[4][2]; float sc[4];
#pragma unroll
                for (int m = 0; m < 4; ++m) { const int pos = (row0 + 16 * m) & (SEQ - 1); sc[m] = dq[u.pn * 64 + (pos & 63)];
#pragma unroll
                    for (int n = 0; n < 2; ++n) { c4[m][n] = *(const f32x4*)(cosP + pos * 128 + d0 + 4 * n); s4[m][n] = *(const f32x4*)(sinP + pos * 128 + d0 + 4 * n); } }
#pragma unroll
                for (int m = 0; m < 4; ++m) { const float scm = sc[m] * rs[m]; float o1[8], o2[8];
#pragma unroll
                    for (int n = 0; n < 2; ++n)
#pragma unroll
                        for (int i = 0; i < 4; ++i) { const float v1 = acc[ai][0][m][n][i], v2 = acc[ai][1][m][n][i]; o1[4 * n + i] = (v1 * c4[m][n][i] - v2 * s4[m][n][i]) * scm; o2[4 * n + i] = (v2 * c4[m][n][i] + v1 * s4[m][n][i]) * scm; }
                    u32x4 w1, w2; w1.x = cvt_pk_bf16(o1[0], o1[1]); w1.y = cvt_pk_bf16(o1[2], o1[3]); w1.z = cvt_pk_bf16(o1[4], o1[5]); w1.w = cvt_pk_bf16(o1[6], o1[7]);
                    w2.x = cvt_pk_bf16(o2[0], o2[1]); w2.y = cvt_pk_bf16(o2[2], o2[3]); w2.z = cvt_pk_bf16(o2[4], o2[5]); w2.w = cvt_pk_bf16(o2[6], o2[7]);
                    bf16_t* p = qx + (size_t)(row0 + 16 * m) * 1024 + u.pn * 256 + d0; *(u32x4*)p = w1; *(u32x4*)(p + 128) = w2; }
            } else {
#pragma unroll
                for (int m = 0; m < 4; ++m) { float* p = small + (size_t)(row0 + 16 * m) * 512 + (u.pn - 4) * 256 + d0;
#pragma unroll
                    for (int bj = 0; bj < 2; ++bj)
#pragma unroll
                        for (int n = 0; n < 2; ++n) *(f32x4*)(p + 128 * bj + 4 * n) = acc[ai][bj][m][n] * rs[m]; } } }
    }
};
template <int PN0 = 0, bool F8 = false> struct EpiInB { static constexpr bool PERM = false;
    bf16_t* kzt; bf16_t* vt; const float* rstd1; const float* cosT; const float* sinT; const float* dz;
    __device__ __forceinline__ void operator()(const f32x4 (&acc)[2][2][4][2], const pg8::Unit& u, int wr, int wc, int fr, int fq) const {
#pragma unroll
        for (int ai = 0; ai < 2; ++ai) { const int tokb = u.pm * 256 + 128 * ai + 64 * wr + 16 * fq, b = tokb >> 11, posb = tokb & (SEQ - 1);
            f32x4 rs4[4];
#pragma unroll
            for (int m = 0; m < 4; ++m) rs4[m] = *(const f32x4*)(rstd1 + tokb + 4 * m);
            const int pn = u.pn + PN0;
            if (pn < 4) { const int h = pn;
#pragma unroll
              for (int mg = 0; mg < 2; ++mg) { f32x4 kz4[2], c4[2][2], s4[2][2];
#pragma unroll
                for (int mm = 0; mm < 2; ++mm) { const int m = 2 * mg + mm; kz4[mm] = *(const f32x4*)(dz + h * 64 + ((posb + 4 * m) & 63));
#pragma unroll
                    for (int n = 0; n < 2; ++n) { const int d = 32 * wc + 16 * n + fr; c4[mm][n] = *(const f32x4*)(cosT + d * SEQ + posb + 4 * m); s4[mm][n] = *(const f32x4*)(sinT + d * SEQ + posb + 4 * m); } }
#pragma unroll
                for (int n = 0; n < 2; ++n) { const int d = 32 * wc + 16 * n + fr; float o1[8], o2[8];
#pragma unroll
                    for (int mm = 0; mm < 2; ++mm) { const int m = 2 * mg + mm;
#pragma unroll
                        for (int i = 0; i < 4; ++i) { const float v1 = acc[ai][0][m][n][i] * rs4[m][i], v2 = acc[ai][1][m][n][i] * rs4[m][i]; o1[4 * mm + i] = (v1 * c4[mm][n][i] - v2 * s4[mm][n][i]) * kz4[mm][i]; o2[4 * mm + i] = (v2 * c4[mm][n][i] + v1 * s4[mm][n][i]) * kz4[mm][i]; } }
                    u32x4 z1, z2; z1.x = cvt_pk_bf16(o1[0], o1[1]); z1.y = cvt_pk_bf16(o1[2], o1[3]); z1.z = cvt_pk_bf16(o1[4], o1[5]); z1.w = cvt_pk_bf16(o1[6], o1[7]);
                    z2.x = cvt_pk_bf16(o2[0], o2[1]); z2.y = cvt_pk_bf16(o2[2], o2[3]); z2.z = cvt_pk_bf16(o2[4], o2[5]); z2.w = cvt_pk_bf16(o2[6], o2[7]);
                    bf16_t* q = kzt + ((size_t)((b * 4 + h) * 256 + d)) * SEQ + posb + 8 * mg; *(u32x4*)q = z1; *(u32x4*)(q + (size_t)128 * SEQ) = z2; } }
            } else { const int j = pn - 4, hd = j >> 1;
#pragma unroll
                for (int bj = 0; bj < 2; ++bj)
#pragma unroll
                    for (int n = 0; n < 2; ++n) { const int v = (j & 1) * 256 + 128 * bj + 32 * wc + 16 * n + fr; bf16_t* q = vt + ((size_t)((b * 4 + hd) * 512 + v)) * SEQ + posb;
#pragma unroll
                        for (int mg = 0; mg < 2; ++mg) { const f32x4 x0 = acc[ai][bj][2 * mg][n] * rs4[2 * mg] * (F8 ? W8_INV : 1.f), x1 = acc[ai][bj][2 * mg + 1][n] * rs4[2 * mg + 1] * (F8 ? W8_INV : 1.f);
                            u32x4 z; z.x = cvt_pk_bf16(x0[0], x0[1]); z.y = cvt_pk_bf16(x0[2], x0[3]); z.z = cvt_pk_bf16(x1[0], x1[1]); z.w = cvt_pk_bf16(x1[2], x1[3]); *(u32x4*)(q + 8 * mg) = z; } } } }
    }
};
struct EpiInC { static constexpr bool PERM = true;
    bf16_t* oret; bf16_t* ga; bf16_t* gb; const float* rstd1; const float* rn;
    __device__ __forceinline__ void operator()(const f32x4 (&acc)[2][2][4][2], const pg8::Unit& u, int wr, int wc, int fr, int fq) const {
        const int c0 = 32 * wc + 8 * fq;
#pragma unroll
        for (int ai = 0; ai < 2; ++ai) { const int row0 = u.pm * 256 + 128 * ai + 64 * wr + fr;
            float rs[4], rr[4]; unsigned ow[4][2][4];
#pragma unroll
            for (int m = 0; m < 4; ++m) { rs[m] = rstd1[row0 + 16 * m] * (INC_FP8 ? W8_INV : 1.f); rr[m] = 1.f; }
            if (u.pn < 8) {
#pragma unroll
                for (int m = 0; m < 4; ++m) { rr[m] = rn[(row0 + 16 * m) * 4 + (u.pn >> 1)];
#pragma unroll
                    for (int bj = 0; bj < 2; ++bj) ld4u(oret + (size_t)(row0 + 16 * m) * 2048 + u.pn * 256 + 128 * bj + c0, ow[m][bj]); } }
#pragma unroll
            for (int m = 0; m < 4; ++m)
#pragma unroll
                for (int bj = 0; bj < 2; ++bj) { float v[8];
#pragma unroll
                    for (int n = 0; n < 2; ++n)
#pragma unroll
                        for (int i = 0; i < 4; ++i) { const float x = acc[ai][bj][m][n][i] * rs[m]; v[4 * n + i] = __builtin_amdgcn_rcpf(1.f + __builtin_amdgcn_exp2f(-1.4426950408889634f * x)) * (u.pn < 8 ? x : 1.f); }
                    bf16_t* p;
                    if (u.pn < 8) { p = oret + (size_t)(row0 + 16 * m) * 2048 + u.pn * 256 + 128 * bj + c0;
#pragma unroll
                        for (int q = 0; q < 4; ++q) { v[2 * q] *= bf2f(ow[m][bj][q] & 0xffffu) * rr[m]; v[2 * q + 1] *= bf2f(ow[m][bj][q] >> 16) * rr[m]; } }
                    else if (u.pn < 12) { p = ga + (size_t)(row0 + 16 * m) * 1024 + (u.pn - 8) * 256 + 128 * bj + c0;
                        if constexpr (GA8) { u32x2 w8; w8.x = pk4_fp8(v[0], v[1], v[2], v[3]); w8.y = pk4_fp8(v[4], v[5], v[6], v[7]); *(u32x2*)((unsigned char*)ga + (size_t)(row0 + 16 * m) * 1024 + (u.pn - 8) * 256 + 128 * bj + c0) = w8; continue; } }
                    else p = gb + (size_t)(row0 + 16 * m) * 1024 + (u.pn - 12) * 256 + 128 * bj + c0;
                    u32x4 w; w.x = cvt_pk_bf16(v[0], v[1]); w.y = cvt_pk_bf16(v[2], v[3]); w.z = cvt_pk_bf16(v[4], v[5]); w.w = cvt_pk_bf16(v[6], v[7]); *(u32x4*)p = w; } }
    }
};
template <int MODE, bool F8S = false> struct EpiMix { static constexpr bool PERM = true;
    const bf16_t* gate; bf16_t* mixa; bf16_t* mix;
    static constexpr bool G8 = GA8 && MODE == 0, M8 = GA8;
    __device__ static __forceinline__ void ld8(const void* base, size_t eoff, bool f8, unsigned (&w)[4]) { if (f8) { const u32x2 t = *(const u32x2*)((const unsigned char*)base + eoff); w[0] = t.x; w[1] = t.y; w[2] = 0u; w[3] = 0u; } else ld4u((const bf16_t*)base + eoff, w); }
    __device__ static __forceinline__ void un8(const unsigned (&w)[4], bool f8, float (&f)[8]) {
        if (f8) { const f32x2 a0 = __builtin_amdgcn_cvt_pk_f32_fp8(w[0], false), a1 = __builtin_amdgcn_cvt_pk_f32_fp8(w[0], true), a2 = __builtin_amdgcn_cvt_pk_f32_fp8(w[1], false), a3 = __builtin_amdgcn_cvt_pk_f32_fp8(w[1], true);
            f[0] = a0[0]; f[1] = a0[1]; f[2] = a1[0]; f[3] = a1[1]; f[4] = a2[0]; f[5] = a2[1]; f[6] = a3[0]; f[7] = a3[1]; }
        else {
#pragma unroll
            for (int q = 0; q < 4; ++q) { f[2 * q] = bf2f(w[q] & 0xffffu); f[2 * q + 1] = bf2f(w[q] >> 16); } } }
    __device__ __forceinline__ void operator()(const f32x4 (&acc)[2][2][4][2], const pg8::Unit& u, int wr, int wc, int fr, int fq) const {
#pragma unroll
        for (int ai = 0; ai < 2; ++ai) { const size_t off0 = (size_t)(u.pm * 256 + 128 * ai + 64 * wr + fr) * 1024 + u.pn * 256 + 32 * wc + 8 * fq;
            unsigned gw[4][2][4], mw[4][2][4];
#pragma unroll
            for (int m = 0; m < 4; ++m)
#pragma unroll
                for (int bj = 0; bj < 2; ++bj) { ld8(gate, off0 + (size_t)m * 16 * 1024 + 128 * bj, G8, gw[m][bj]); if (MODE == 1) ld8(mixa, off0 + (size_t)m * 16 * 1024 + 128 * bj, M8, mw[m][bj]); }
#pragma unroll
            for (int m = 0; m < 4; ++m)
#pragma unroll
                for (int bj = 0; bj < 2; ++bj) { float v[8], g[8]; un8(gw[m][bj], G8, g);
#pragma unroll
                    for (int q = 0; q < 8; ++q) v[q] = g[q] * acc[ai][bj][m][q >> 2][q & 3] * (F8S ? W8_INV * 0.25f : 1.f);
                    if (MODE == 1) { float mm[8]; un8(mw[m][bj], M8, mm);
#pragma unroll
                        for (int q = 0; q < 8; ++q) v[q] += mm[q]; }
                    const size_t off = off0 + (size_t)m * 16 * 1024 + 128 * bj;
                    if (MODE == 0 && M8) { u32x2 w8; w8.x = pk4_fp8(v[0], v[1], v[2], v[3]); w8.y = pk4_fp8(v[4], v[5], v[6], v[7]); *(u32x2*)((unsigned char*)mixa + off) = w8; }
                    else { u32x4 w; w.x = cvt_pk_bf16(v[0], v[1]); w.y = cvt_pk_bf16(v[2], v[3]); w.z = cvt_pk_bf16(v[4], v[5]); w.w = cvt_pk_bf16(v[6], v[7]);
                        *(u32x4*)((MODE == 0 ? mixa : mix) + off) = w; } } }
    }
};
struct EpiOut { static constexpr bool PERM = true;
    const bf16_t* x; float* out; bf16_t* x2b;
    __device__ __forceinline__ void operator()(const f32x4 (&acc)[2][2][4][2], const pg8::Unit& u, int wr, int wc, int fr, int fq) const {
#pragma unroll
        for (int ai = 0; ai < 2; ++ai) { const size_t off0 = (size_t)(u.pm * 256 + 128 * ai + 64 * wr + fr) * 1024 + u.pn * 256 + 32 * wc + 8 * fq;
            f32x4 xv[4][2][2];
#pragma unroll
            for (int m = 0; m < 4; ++m)
#pragma unroll
                for (int bj = 0; bj < 2; ++bj) { unsigned xw[4]; ld4u(x + off0 + (size_t)m * 16 * 1024 + 128 * bj, xw);
                    xv[m][bj][0] = (f32x4){bf2f(xw[0] & 0xffffu), bf2f(xw[0] >> 16), bf2f(xw[1] & 0xffffu), bf2f(xw[1] >> 16)}; xv[m][bj][1] = (f32x4){bf2f(xw[2] & 0xffffu), bf2f(xw[2] >> 16), bf2f(xw[3] & 0xffffu), bf2f(xw[3] >> 16)}; }
#pragma unroll
            for (int m = 0; m < 4; ++m)
#pragma unroll
                for (int bj = 0; bj < 2; ++bj) { const size_t off = off0 + (size_t)m * 16 * 1024 + 128 * bj; const f32x4 r0 = xv[m][bj][0] + acc[ai][bj][m][0], r1 = xv[m][bj][1] + acc[ai][bj][m][1];
                    if constexpr (X2H) { u32x4 wh; wh.x = cvt_pk_bf16(r0[0], r0[1]); wh.y = cvt_pk_bf16(r0[2], r0[3]); wh.z = cvt_pk_bf16(r1[0], r1[1]); wh.w = cvt_pk_bf16(r1[2], r1[3]); *(u32x4*)((bf16_t*)out + off) = wh; }
                    else { *(f32x4*)(out + off) = r0; *(f32x4*)(out + off + 4) = r1; }
                    if constexpr (MOE_FP8) { u32x2 w8; w8.x = pk4_fp8(r0[0], r0[1], r0[2], r0[3]); w8.y = pk4_fp8(r1[0], r1[1], r1[2], r1[3]); *(u32x2*)((unsigned char*)x2b + off) = w8; }
                    else { u32x4 w; w.x = cvt_pk_bf16(r0[0], r0[1]); w.y = cvt_pk_bf16(r0[2], r0[3]); w.z = cvt_pk_bf16(r1[0], r1[1]); w.w = cvt_pk_bf16(r1[2], r1[3]); *(u32x4*)(x2b + off) = w; } } }
    }
};

constexpr int RT_QX = 0, RT_KP = 33280, RT_KZT = 66560, RT_VT = 103424, RT_S = 121856, RT_PART = RT_KP, RT_QS = 520, RT_TS = 144;
__device__ __forceinline__ int crow32(int reg, int hh) { return (reg & 3) + 8 * (reg >> 2) + 4 * hh; }
__device__ __forceinline__ bf16x8 lds_frag2x8(const LAS unsigned char* p) { const s16x4 lo = *(const LAS s16x4*)p, hi = *(const LAS s16x4*)(p + 16); return __builtin_shufflevector(lo, hi, 0, 1, 2, 3, 4, 5, 6, 7); }
__device__ __forceinline__ bf16x8 lds_frag8x2(const LAS unsigned char* p) { const s16x4 lo = *(const LAS s16x4*)p, hi = *(const LAS s16x4*)(p + 8); return __builtin_shufflevector(lo, hi, 0, 1, 2, 3, 4, 5, 6, 7); }
template <int OFF> __device__ __forceinline__ s16x4 lds_tr_read(int vb) { s16x4 r; asm volatile("ds_read_b64_tr_b16 %0, %1 offset:%2" : "=&v"(r) : "v"(vb), "i"(OFF) : "memory"); return r; }
__device__ __forceinline__ bf16x8 lds_frag16(const LAS unsigned char* p) { return *(const LAS bf16x8*)p; }
__device__ __forceinline__ bf16x8 pack8(const f32x16& x, int s8) { u32x4 p; p.x = cvt_pk_bf16(x[s8 + 0], x[s8 + 1]); p.y = cvt_pk_bf16(x[s8 + 2], x[s8 + 3]); p.z = cvt_pk_bf16(x[s8 + 4], x[s8 + 5]); p.w = cvt_pk_bf16(x[s8 + 6], x[s8 + 7]); return __builtin_bit_cast(bf16x8, p); }
#define MFMA32(a, b, c) __builtin_amdgcn_mfma_f32_32x32x16_bf16((a), (b), (c), 0, 0, 0)
__device__ __forceinline__ void retention_phase(const Frame& F, ArgsRef a) {
    const bf16_t* QX = (const bf16_t*)(WS(a) + WS_QX); const bf16_t* KZT = (const bf16_t*)(WS(a) + WS_KZT); const bf16_t* VT = (const bf16_t*)(WS(a) + WS_VT);
    bf16_t* ORET = (bf16_t*)OUT(a);
    LAS unsigned char* L = F.lds + LDS_STAGE;
    const int tid = F.tid, lane = F.lane, w = F.wave, wd = w >> 2, wv = w & 3, r = lane & 31, hh = lane >> 5;
    for (int item = F.bid; item < 256; item += F.G) {
        const int xcd = item & 7, index = item >> 3, q = (index >> 2) * 8 + xcd, vs = index & 3, b = q >> 2, h = q & 3, tb = b * SEQ;
        const float g64 = (float)exp(64.0 * log(1.0 - exp2(-5.0 - (double)h))), g64inv = (float)exp(-64.0 * log(1.0 - exp2(-5.0 - (double)h)));
        f32x16 Racc[4];
#pragma unroll
        for (int i = 0; i < 4; ++i) { for (int j = 0; j < 16; ++j) Racc[i][j] = 0.f; }
        f32x4 pq[4], pz[4], pv[2];
        unsigned gq = (unsigned)(((tb + (tid >> 5)) * 1024 + h * 256 + (tid & 31) * 8) * 2), gz = (unsigned)((((b * 4 + h) * 256 + (tid >> 3)) * SEQ + (tid & 7) * 8) * 2), gv = (unsigned)((((b * 4 + h) * 512 + vs * 128 + (tid >> 3)) * SEQ + (tid & 7) * 8) * 2);
        unsigned lq = (unsigned)(uintptr_t)(L + RT_QX + (tid >> 5) * RT_QS + (tid & 31) * 16), lz = (unsigned)(uintptr_t)(L + RT_KZT + (tid >> 3) * RT_TS + (tid & 7) * 16), lv = (unsigned)(uintptr_t)(L + RT_VT + (tid >> 3) * RT_TS + (tid & 7) * 16);
#define RT_LOADG(c) do { unsigned _q = gq + (unsigned)(c) * (64u * 1024u * 2u), _z = gz + (unsigned)(c) * 128u, _v = gv + (unsigned)(c) * 128u; asm volatile("" : "+v"(_q), "+v"(_z), "+v"(_v)); \
        _Pragma("unroll") for (int i = 0; i < 4; ++i) { pq[i] = *(const f32x4*)((const char*)QX + _q + i * (16 * 1024 * 2)); pz[i] = *(const f32x4*)((const char*)KZT + _z + i * (64 * SEQ * 2)); } \
        _Pragma("unroll") for (int i = 0; i < 2; ++i) pv[i] = *(const f32x4*)((const char*)VT + _v + i * (64 * SEQ * 2)); } while (0)
#define RT_STOREL() do { unsigned _q = lq, _z = lz, _v = lv; asm volatile("" : "+v"(_q), "+v"(_z), "+v"(_v)); \
        _Pragma("unroll") for (int i = 0; i < 4; ++i) { LAS unsigned char* dq_ = (LAS unsigned char*)(uintptr_t)_q + i * (16 * RT_QS); \
            *(LAS f32x2*)(dq_) = (f32x2){pq[i][0], pq[i][1]}; *(LAS f32x2*)(dq_ + 8) = (f32x2){pq[i][2], pq[i][3]}; \
            *(LAS f32x4*)((LAS unsigned char*)(uintptr_t)_z + i * (64 * RT_TS)) = pz[i]; } \
        _Pragma("unroll") for (int i = 0; i < 2; ++i) *(LAS f32x4*)((LAS unsigned char*)(uintptr_t)_v + i * (64 * RT_TS)) = pv[i]; } while (0)
        __syncthreads();
        RT_LOADG(0); RT_STOREL(); __syncthreads();
        const int ti = wv >> 1, tj = wv & 1;
        unsigned bQa = (unsigned)(uintptr_t)(L + RT_QX + (32 * ti + r) * RT_QS + 16 * hh), bKb = (unsigned)(uintptr_t)(L + RT_KZT + (8 * hh + ((lane & 15) >> 2)) * RT_TS + (32 * tj + 16 * ((lane >> 4) & 1) + 4 * (lane & 3)) * 2);
        unsigned bSw = (unsigned)(uintptr_t)(L + RT_S + (32 * ti + 4 * hh) * RT_TS + (32 * tj + r) * 2), bQr = (unsigned)(uintptr_t)(L + RT_QX + r * RT_QS + (128 * wd + 4 * hh) * 2);
        unsigned bV = (unsigned)(uintptr_t)(L + RT_VT + (32 * wv + r) * RT_TS + 16 * hh), bSr = (unsigned)(uintptr_t)(L + RT_S + r * RT_TS + 16 * hh);
        unsigned bP = (unsigned)(uintptr_t)(L + RT_PART + wv * 8192 + 4 * hh * 128 + r * 4), bZ = (unsigned)(uintptr_t)(L + RT_KZT + (128 * wd + r) * RT_TS + 16 * hh);
        asm volatile("" : "+v"(bQa), "+v"(bKb), "+v"(bSw), "+v"(bQr)); asm volatile("" : "+v"(bV), "+v"(bSr), "+v"(bP), "+v"(bZ));
#define LP(x) ((const LAS unsigned char*)(uintptr_t)(x))
#define LPW(x) ((LAS unsigned char*)(uintptr_t)(x))
        for (int c = 0; c < 32; ++c) {
            if (c + 1 < 32) RT_LOADG(c + 1);
            f32x16 o[2];
#pragma unroll
            for (int j = 0; j < 16; ++j) { o[0][j] = 0.f; o[1][j] = 0.f; }
            if (wd == 1 && wv != 1) { f32x16 sacc;
#pragma unroll
                for (int j = 0; j < 16; ++j) sacc[j] = 0.f;
#define RT_KQ(KQ) { s16x4 tl0 = lds_tr_read<(4 * (KQ) + 0) * 16 * RT_TS>((int)bKb), th0 = lds_tr_read<(4 * (KQ) + 0) * 16 * RT_TS + 4 * RT_TS>((int)bKb), tl1 = lds_tr_read<(4 * (KQ) + 1) * 16 * RT_TS>((int)bKb), th1 = lds_tr_read<(4 * (KQ) + 1) * 16 * RT_TS + 4 * RT_TS>((int)bKb); \
                    s16x4 tl2 = lds_tr_read<(4 * (KQ) + 2) * 16 * RT_TS>((int)bKb), th2 = lds_tr_read<(4 * (KQ) + 2) * 16 * RT_TS + 4 * RT_TS>((int)bKb), tl3 = lds_tr_read<(4 * (KQ) + 3) * 16 * RT_TS>((int)bKb), th3 = lds_tr_read<(4 * (KQ) + 3) * 16 * RT_TS + 4 * RT_TS>((int)bKb); \
                    asm volatile("s_waitcnt lgkmcnt(0)" ::: "memory"); __builtin_amdgcn_sched_barrier(0); \
                    sacc = MFMA32(lds_frag8x2(LP(bQa) + 32 * (4 * (KQ) + 0)), ((bf16x8){tl0[0], tl0[1], tl0[2], tl0[3], th0[0], th0[1], th0[2], th0[3]}), sacc); \
                    sacc = MFMA32(lds_frag8x2(LP(bQa) + 32 * (4 * (KQ) + 1)), ((bf16x8){tl1[0], tl1[1], tl1[2], tl1[3], th1[0], th1[1], th1[2], th1[3]}), sacc); \
                    sacc = MFMA32(lds_frag8x2(LP(bQa) + 32 * (4 * (KQ) + 2)), ((bf16x8){tl2[0], tl2[1], tl2[2], tl2[3], th2[0], th2[1], th2[2], th2[3]}), sacc); \
                    sacc = MFMA32(lds_frag8x2(LP(bQa) + 32 * (4 * (KQ) + 3)), ((bf16x8){tl3[0], tl3[1], tl3[2], tl3[3], th3[0], th3[1], th3[2], th3[3]}), sacc); }
                RT_KQ(0) RT_KQ(1) RT_KQ(2) RT_KQ(3)
#undef RT_KQ
#pragma unroll
                for (int j = 0; j < 16; ++j) sacc[j] *= g64inv;
#pragma unroll
                for (int j = 0; j < 16; ++j) { const int cl = (j & 3) + 8 * (j >> 2); float v = (ti != tj || cl + 4 * hh >= r) ? sacc[j] : 0.f; if (RT_VAR == 6) v = (ti == tj && cl + 4 * hh == r) ? 1.f : 0.f; *(LAS bf16_t*)(LPW(bSw) + cl * RT_TS) = (bf16_t)f2bf(v); } }
            if (RT_VAR != 5 && RT_VAR != 6 && RT_VAR != 9 && RT_VAR != 10)
#pragma unroll
            for (int s = 0; s < 8; ++s) { const bf16x8 rb = pack8(Racc[s >> 1], 8 * (s & 1));
#pragma unroll
                for (int m = 0; m < 2; ++m) { const bf16x8 af = lds_frag2x8(LP(bQr) + 32 * m * RT_QS + (32 * (s >> 1) + 16 * (s & 1)) * 2); o[m] = MFMA32(af, rb, o[m]); } }
            __syncthreads();
            bf16x8 Bv[4];
#pragma unroll
            for (int ks = 0; ks < 4; ++ks) Bv[ks] = lds_frag16(LP(bV) + 32 * ks);
            if (wd == 0) {
#pragma unroll
                for (int ks = 0; ks < 4; ++ks) { if (RT_VAR == 4) continue; if (ks < 2) { const bf16x8 a0 = lds_frag16(LP(bSr) + 32 * ks); o[0] = MFMA32(a0, Bv[ks], o[0]); }
                    const bf16x8 a1 = lds_frag16(LP(bSr) + 32 * RT_TS + 32 * ks); o[1] = MFMA32(a1, Bv[ks], o[1]); }
            } else {
#pragma unroll
                for (int m = 0; m < 2; ++m)
#pragma unroll
                    for (int j = 0; j < 16; ++j) *(LAS float*)(LPW(bP) + (32 * m + (j & 3) + 8 * (j >> 2)) * 128) = o[m][j];
            }
            __syncthreads();
            if (wd == 0) { bf16_t* op = ORET + (size_t)(tb + c * 64 + 4 * hh) * 2048 + h * 512 + vs * 128 + 32 * wv + r;
#pragma unroll
                for (int m = 0; m < 2; ++m)
#pragma unroll
                    for (int j = 0; j < 16; ++j) { const int cl = 32 * m + (j & 3) + 8 * (j >> 2); const float v = o[m][j] + *(const LAS float*)(LP(bP) + cl * 128); op[(size_t)cl * 2048] = (bf16_t)f2bf(v); }
            }
#pragma unroll
            for (int t4 = 0; t4 < 4; ++t4) {
#pragma unroll
                for (int j = 0; j < 16; ++j) Racc[t4][j] *= g64;
#pragma unroll
                for (int ks = 0; ks < 4; ++ks) { const bf16x8 af = lds_frag16(LP(bZ) + 32 * t4 * RT_TS + 32 * ks); Racc[t4] = MFMA32(af, Bv[ks], Racc[t4]); }
            }
            __syncthreads();
            if (c + 1 < 32) RT_STOREL();
            __syncthreads();
        }
    }
#undef RT_LOADG
#undef RT_STOREL
#undef LP
#undef LPW
}
__device__ __forceinline__ void retnorm_phase(const Frame& F, ArgsRef a) {
    const bf16_t* oret = (const bf16_t*)OUT(a); float* rn = (float*)(WS(a) + WS_MISC + MISC_RN);
    const int gw = F.bid * 8 + F.wave, NGW = F.G * 8;
    for (int i0 = gw * 8; i0 < T * 4; i0 += NGW * 8) {
        unsigned w4[8][4];
#pragma unroll
        for (int u = 0; u < 8; ++u) ld4u(oret + (size_t)(i0 + u) * 512 + F.lane * 8, w4[u]);
#pragma unroll
        for (int u = 0; u < 8; ++u) { float s = 0.f;
#pragma unroll
            for (int qq = 0; qq < 4; ++qq) { const float lo = bf2f(w4[u][qq] & 0xffffu), hi = bf2f(w4[u][qq] >> 16); s += lo * lo + hi * hi; }
            s = wave_sum(s); if (F.lane == 0) rn[i0 + u] = 1.0f / sqrtf(s * (1.0f / 512.f) + RMS_EPS); } }
}

__device__ __forceinline__ void rownorm_phase(const Frame& F, ArgsRef a) {
    const float* small = (const float*)(WS(a) + WS_SMALL); bf16_t* cqn = (bf16_t*)(WS(a) + WS_CQN); bf16_t* ckv = (bf16_t*)(WS(a) + WS_CKV); bf16_t* kidx = (bf16_t*)(WS(a) + WS_KIDX); float* widx = (float*)(WS(a) + WS_WIDX);
    const float* gkv = IN(a, I_CKV_G); const float* gki = IN(a, I_KIDX_G);
    const int gw = F.bid * 8 + F.wave, NGW = F.G * 8, l = F.lane;
    for (int tb4 = gw * 4; tb4 < T; tb4 += NGW * 4) { f32x4 va[4], vb[4];
#pragma unroll
      for (int u = 0; u < 4; ++u) { va[u] = *(const f32x4*)(small + (size_t)(tb4 + u) * 512 + 8 * l); vb[u] = *(const f32x4*)(small + (size_t)(tb4 + u) * 512 + 8 * l + 4); }
#pragma unroll
      for (int u = 0; u < 4; ++u) { const int t = tb4 + u; const f32x4 v0 = va[u], v1 = vb[u];
        const float ss = (v0[0] * v0[0] + v0[1] * v0[1]) + (v0[2] * v0[2] + v0[3] * v0[3]) + (v1[0] * v1[0] + v1[1] * v1[1]) + (v1[2] * v1[2] + v1[3] * v1[3]);
        const float sq = wave_sum(l < 32 ? ss : 0.f), skv = wave_sum((l >= 32 && l < 48) ? ss : 0.f), ski = wave_sum((l >= 48 && l < 56) ? ss : 0.f);
        float x[8] = {v0[0], v0[1], v0[2], v0[3], v1[0], v1[1], v1[2], v1[3]};
        if (l < 32) { const float r = 1.0f / sqrtf(sq * (1.f / 256.f) + RMS_EPS); u32x4 w; w.x = cvt_pk_bf16(x[0] * r, x[1] * r); w.y = cvt_pk_bf16(x[2] * r, x[3] * r); w.z = cvt_pk_bf16(x[4] * r, x[5] * r); w.w = cvt_pk_bf16(x[6] * r, x[7] * r); *(u32x4*)(cqn + (size_t)t * 256 + 8 * l) = w; }
        else if (l < 48) { const float r = 1.0f / sqrtf(skv * (1.f / 128.f) + RMS_EPS); const int c = 8 * (l - 32); const f32x4 g0 = *(const f32x4*)(gkv + c), g1 = *(const f32x4*)(gkv + c + 4);
            u32x4 w; w.x = cvt_pk_bf16(x[0] * r * g0[0], x[1] * r * g0[1]); w.y = cvt_pk_bf16(x[2] * r * g0[2], x[3] * r * g0[3]); w.z = cvt_pk_bf16(x[4] * r * g1[0], x[5] * r * g1[1]); w.w = cvt_pk_bf16(x[6] * r * g1[2], x[7] * r * g1[3]); *(u32x4*)(ckv + (size_t)t * 128 + c) = w; }
        else if (l < 56) { const float r = 1.0f / sqrtf(ski * (1.f / 64.f) + RMS_EPS); const int c = 8 * (l - 48); const f32x4 g0 = *(const f32x4*)(gki + c), g1 = *(const f32x4*)(gki + c + 4);
            u32x4 w; w.x = cvt_pk_bf16(x[0] * r * g0[0], x[1] * r * g0[1]); w.y = cvt_pk_bf16(x[2] * r * g0[2], x[3] * r * g0[3]); w.z = cvt_pk_bf16(x[4] * r * g1[0], x[5] * r * g1[1]); w.w = cvt_pk_bf16(x[6] * r * g1[2], x[7] * r * g1[3]); *(u32x4*)(kidx + (size_t)t * 64 + c) = w; }
        else if (l == 56) { const float sc = 0.35355339059327373f; *(f32x4*)(widx + (size_t)t * 8) = v0 * sc; *(f32x4*)(widx + (size_t)t * 8 + 4) = v1 * sc; }
      } }
}
struct EpiQ { static constexpr bool PERM = true;
    bf16_t* qlat; bf16_t* qidx;
    __device__ __forceinline__ void operator()(const f32x4 (&acc)[2][2][4][2], const pg8::Unit& u, int wr, int wc, int fr, int fq) const {
#pragma unroll
        for (int ai = 0; ai < 2; ++ai)
#pragma unroll
            for (int m = 0; m < 4; ++m) { const int row = u.pm * 256 + 128 * ai + 64 * wr + 16 * m + fr;
#pragma unroll
                for (int bj = 0; bj < 2; ++bj) { const int c = 128 * bj + 32 * wc + 8 * fq; bf16_t* p = u.pn < 4 ? qlat + (size_t)row * 1024 + u.pn * 256 + c : qidx + (size_t)row * 512 + (u.pn - 4) * 256 + c;
                    const f32x4 v0 = acc[ai][bj][m][0], v1 = acc[ai][bj][m][1]; u32x4 w; w.x = cvt_pk_bf16(v0[0], v0[1]); w.y = cvt_pk_bf16(v0[2], v0[3]); w.z = cvt_pk_bf16(v1[0], v1[1]); w.w = cvt_pk_bf16(v1[2], v1[3]); *(u32x4*)p = w; } }
    }
};
#define DPP_STEP_(op, ctrl, rmask) { const unsigned t_ = (unsigned)__builtin_amdgcn_update_dpp((int)v, (int)v, ctrl, rmask, 0xf, false); v = op(v, t_); }
__device__ __forceinline__ unsigned umax_(unsigned a, unsigned b) { return a > b ? a : b; }
__device__ __forceinline__ unsigned umin_(unsigned a, unsigned b) { return a < b ? a : b; }
__device__ __forceinline__ unsigned wave_umax(unsigned v) { DPP_STEP_(umax_, 0x111, 0xf) DPP_STEP_(umax_, 0x112, 0xf) DPP_STEP_(umax_, 0x114, 0xf) DPP_STEP_(umax_, 0x118, 0xf) DPP_STEP_(umax_, 0x142, 0xa) DPP_STEP_(umax_, 0x143, 0xc) return (unsigned)__builtin_amdgcn_readlane((int)v, 63); }
__device__ __forceinline__ unsigned wave_umin(unsigned v) { DPP_STEP_(umin_, 0x111, 0xf) DPP_STEP_(umin_, 0x112, 0xf) DPP_STEP_(umin_, 0x114, 0xf) DPP_STEP_(umin_, 0x118, 0xf) DPP_STEP_(umin_, 0x142, 0xa) DPP_STEP_(umin_, 0x143, 0xc) return (unsigned)__builtin_amdgcn_readlane((int)v, 63); }
template <int MODE> __device__ __forceinline__ void indexer_phase(const Frame& F, ArgsRef a) {
    const bf16_t* qidx = (const bf16_t*)(WS(a) + WS_QIDX); const bf16_t* kidx = (const bf16_t*)(WS(a) + WS_KIDX); const float* widx = (const float*)(WS(a) + WS_WIDX);
    unsigned long long* mask = (unsigned long long*)(WS(a) + WS_MASK);
    LAS float* sc = (LAS float*)(F.lds + LDS_STAGE); LAS float* wl = (LAS float*)(F.misc + LM_REC);
    const int lane = F.lane, w = F.wave, r = lane & 31, hh = lane >> 5;
    const int rq = 2 * (r >> 4) + ((r >> 2) & 1), rh = 4 * ((r >> 3) & 1) + (r & 3);
    for (int k8 = 0; k8 < 8; ++k8) {
        const int u = F.bid + F.G * k8; if (u >= NB * 128) break;
        const int b = u & 15, j = u >> 4, kk = j >> 4, cc = j & 15, blk = (kk & 1) ? 127 - 16 * (kk >> 1) - cc : 16 * (kk >> 1) + cc, qc = blk >> 2,     NK = 64 * (qc + 1), t0 = b * SEQ + 16 * blk;
        if (qc <= 3) {
            if (MODE == 0) for (int i = F.tid; i < 16 * 32; i += 512) { const int q = i >> 5, wi = i & 31; mask[(size_t)(t0 + q) * 32 + wi] = wi <= qc ? ~0ull : 0ull; }
            continue; }
        __syncthreads();
        if (F.tid < 128) wl[F.tid] = widx[(size_t)t0 * 8 + F.tid];
        bf16x8 A[4][4];
#pragma unroll
        for (int rt = 0; rt < 4; ++rt)
#pragma unroll
            for (int ks = 0; ks < 4; ++ks) A[rt][ks] = *(const bf16x8*)(qidx + (size_t)(t0 + 4 * rt + rq) * 512 + rh * 64 + 16 * ks + 8 * hh);
        __syncthreads();
        bf16x8 Bn[4];
#pragma unroll
        for (int ks = 0; ks < 4; ++ks) Bn[ks] = *(const bf16x8*)(kidx + (size_t)(b * SEQ + 32 * w + r) * 64 + 16 * ks + 8 * hh);
        if (MODE != 2) for (int kt = w; kt < NK / 32; kt += 8) {
            bf16x8 B[4];
#pragma unroll
            for (int ks = 0; ks < 4; ++ks) B[ks] = Bn[ks];
            if (kt + 8 < NK / 32) {
#pragma unroll
                for (int ks = 0; ks < 4; ++ks) Bn[ks] = *(const bf16x8*)(kidx + (size_t)(b * SEQ + 32 * (kt + 8) + r) * 64 + 16 * ks + 8 * hh); }
#pragma unroll
            for (int rt = 0; rt < 4; ++rt) { f32x16 c;
#pragma unroll
                for (int i = 0; i < 16; ++i) c[i] = 0.f;
#pragma unroll
                for (int ks = 0; ks < 4; ++ks) c = MFMA32(A[rt][ks], B[ks], c);
#pragma unroll
                for (int aa = 0; aa < 2; ++aa) { const int q = 4 * rt + 2 * aa + hh; const f32x4 w0 = *(const LAS f32x4*)(wl + q * 8), w1 = *(const LAS f32x4*)(wl + q * 8 + 4);
                    float s = 0.f;
#pragma unroll
                    for (int d = 0; d < 4; ++d) { s += fmaxf(c[8 * aa + d], 0.f) * w0[d]; s += fmaxf(c[8 * aa + 4 + d], 0.f) * w1[d]; }
                    sc[q * 2048 + 32 * kt + r] = s; } }
        }
        __syncthreads();
        if (MODE != 1)
#pragma unroll 1
        for (int qq = 0; qq < 2; ++qq) { const int q = 2 * w + qq; unsigned uu[32]; int nk = NK; asm volatile("" : "+s"(nk));
#pragma unroll
            for (int i = 0; i < 32; ++i) { const float f = sc[q * 2048 + 64 * i + lane]; const unsigned bits = __builtin_bit_cast(unsigned, f); const unsigned vm = (unsigned)((64 * i + lane - nk) >> 31); uu[i] = (bits ^ ((bits >> 31) ? 0xffffffffu : 0x80000000u)) & vm; }
            unsigned lo = 0xffffffffu, hi = 0u;
#pragma unroll
            for (int i = 0; i < 32; ++i) { const unsigned v = uu[i]; hi = v > hi ? v : hi; const unsigned vv = v ? v : 0xffffffffu; lo = vv < lo ? vv : lo; }
            lo = wave_umin(lo); hi = wave_umax(hi);
            unsigned theta = lo; bool exact = false; int chi = 0;
#pragma unroll 1
            while (lo < hi) { const unsigned mid = lo + ((hi - lo) >> 1) + 1u;
                int cnt = 0;
#pragma unroll
                for (int i8 = 0; i8 < 32; i8 += 8) { if (i8 * 64 >= nk) continue;
                    unsigned long long mk[8];
#pragma unroll
                    for (int i = 0; i < 8; ++i) mk[i] = __ballot(uu[i8 + i] >= mid);
                    __builtin_amdgcn_sched_barrier(0);
#pragma unroll
                    for (int i = 0; i < 8; ++i) cnt += __builtin_popcountll(mk[i]);
                    __builtin_amdgcn_sched_barrier(0); }
                if (cnt == 256) { theta = mid; exact = true; break; }
                if (cnt > 256) lo = mid; else { hi = mid - 1u; chi = cnt; }
                theta = lo; }
            unsigned wlo_ = 0u, whi_ = 0u;
            if (exact) {
#pragma unroll
                for (int i = 0; i < 32; ++i) { const unsigned long long word = __ballot(uu[i] >= theta); wlo_ = lane == i ? (unsigned)word : wlo_; whi_ = lane == i ? (unsigned)(word >> 32) : whi_; }
            } else { const int need = 256 - chi; int run = 0;
#pragma unroll
                for (int i = 0; i < 32; ++i) { const unsigned long long m = __ballot(uu[i] == theta); const int pre = run + __builtin_popcountll(m & ((1ull << lane) - 1ull));
                    const bool sel = (uu[i] > theta) || (uu[i] == theta && pre < need); run += __builtin_popcountll(m);
                    const unsigned long long word = __ballot(sel); wlo_ = lane == i ? (unsigned)word : wlo_; whi_ = lane == i ? (unsigned)(word >> 32) : whi_; } }
            if (MODE == 0 && lane < 32) { u32x2 w2; w2.x = wlo_; w2.y = whi_; *(u32x2*)(mask + (size_t)(t0 + q) * 32 + lane) = w2; }
            if (MODE == 2) asm volatile("" :: "v"(wlo_), "v"(whi_));
        }
    }
}

namespace att {
constexpr int SHM_V = 64 * 128 * 2, SHM_K = 64 * 128 * 2, LDS_MSK = 3 * SHM_V + 3 * SHM_K, LDS_BT = LDS_MSK + 8192, LDS_WS = LDS_BT + 8 * 320 * 4, LDS_END = LDS_WS + 8 * 64 * 4;
#define KSWZ(row, colB) ((row) * 256 + ((colB) ^ (((row) & 7) << 4)))
#define SBAR() __builtin_amdgcn_sched_barrier(0)
__device__ __forceinline__ int crow(int r, int hi) { return (r & 3) + 8 * (r >> 2) + 4 * hi; }
__device__ __forceinline__ int v_st(int k, int c) { const int kk = (k & ~0xC) | ((k & 4) << 1) | ((k & 8) >> 1); return ((kk >> 3) * 4 + (c >> 5)) * 512 + ((kk & 7) * 32 + (c & 31)) * 2; }
__device__ __forceinline__ int v_rd_base(int lane) { return ((lane & 3) << 3) | (((lane >> 2) & 3) << 6) | (((lane >> 4) & 1) << 5) | (((lane >> 5) & 1) << 8); }
constexpr int v_rd_off(int d0, int ks, int half) { return d0 * 512 + ks * 4096 + half * 2048; }
template <int OFF> __device__ __forceinline__ s16x4 tr_read(int vb) { s16x4 r; asm volatile("ds_read_b64_tr_b16 %0, %1 offset:%2" : "=&v"(r) : "v"(vb), "i"(OFF) : "memory"); return r; }
template <int D0> __device__ __forceinline__ void pv_one(f32x16& od, int vb, bf16x8 pa0, bf16x8 pa1, bf16x8 pa2, bf16x8 pa3) {
    const s16x4 l0 = tr_read<v_rd_off(D0, 0, 0)>(vb), h0 = tr_read<v_rd_off(D0, 0, 1)>(vb), l1 = tr_read<v_rd_off(D0, 1, 0)>(vb), h1 = tr_read<v_rd_off(D0, 1, 1)>(vb);
    const s16x4 l2 = tr_read<v_rd_off(D0, 2, 0)>(vb), h2 = tr_read<v_rd_off(D0, 2, 1)>(vb), l3 = tr_read<v_rd_off(D0, 3, 0)>(vb), h3 = tr_read<v_rd_off(D0, 3, 1)>(vb);
    asm volatile("s_waitcnt lgkmcnt(0)" ::: "memory"); SBAR();
#define PK(L, H) (bf16x8){L[0], L[1], L[2], L[3], H[0], H[1], H[2], H[3]}
    od = MFMA32(pa0, PK(l0, h0), od); od = MFMA32(pa1, PK(l1, h1), od); od = MFMA32(pa2, PK(l2, h2), od); od = MFMA32(pa3, PK(l3, h3), od);
#undef PK
}
__device__ __forceinline__ void pv_d0(f32x16* o, int vb, bf16x8 pa0, bf16x8 pa1, bf16x8 pa2, bf16x8 pa3) {
    pv_one<0>(o[0], vb, pa0, pa1, pa2, pa3); pv_one<1>(o[1], vb, pa0, pa1, pa2, pa3); pv_one<2>(o[2], vb, pa0, pa1, pa2, pa3); pv_one<3>(o[3], vb, pa0, pa1, pa2, pa3);
}
__device__ __forceinline__ void qkt(f32x16& p0, f32x16& p1, const LAS unsigned char* Ks, const bf16x8* qr, int r32, int hi) {
#pragma unroll
    for (int i = 0; i < 16; ++i) { p0[i] = 0.f; p1[i] = 0.f; }
#pragma unroll
    for (int d0 = 0; d0 < 8; ++d0) { const int cb = (d0 * 16 + hi * 8) * 2;
        const bf16x8 b0 = *(const LAS bf16x8*)(Ks + KSWZ(r32, cb)), b1 = *(const LAS bf16x8*)(Ks + KSWZ(32 + r32, cb));
        p0 = MFMA32(b0, qr[d0], p0); p1 = MFMA32(b1, qr[d0], p1); }
}
template <bool NEAR> __device__ __forceinline__ void bias_mask(f32x16& p0, f32x16& p1, unsigned wlo, unsigned whi, float bfar, const LAS float* bt, int relbase) {
    constexpr float C = 0.088388347648318440f * 1.4426950408889634f;
    asm volatile("" : "+v"(wlo), "+v"(whi));
#pragma unroll
    for (int r = 0; r < 16; ++r) { const int cr = (r & 3) + 8 * (r >> 2);
        const float b0 = NEAR ? bt[relbase + cr] : bfar, b1 = NEAR ? bt[relbase + 32 + cr] : bfar;
        const float s0 = fmaf(p0[r], C, b0), s1 = fmaf(p1[r], C, b1);
        p0[r] = (wlo & (1u << cr)) ? s0 : -INFINITY; p1[r] = (whi & (1u << cr)) ? s1 : -INFINITY; }
}
__device__ __forceinline__ void partialSM(f32x16& p0, f32x16& p1, float& m_reg, float& mn, float& alpha) {
    float pmax = p0[0];
#pragma unroll
    for (int r = 1; r < 16; ++r) pmax = fmaxf(pmax, p0[r]);
#pragma unroll
    for (int r = 0; r < 16; ++r) pmax = fmaxf(pmax, p1[r]);
    { auto rr = __builtin_amdgcn_permlane32_swap(__float_as_uint(pmax), __float_as_uint(pmax), false, false); pmax = fmaxf(__uint_as_float(rr[0]), __uint_as_float(rr[1])); }
    if (__all(pmax - m_reg <= 8.f)) { mn = m_reg; alpha = 1.f; }
    else { mn = fmaxf(m_reg, pmax); alpha = __builtin_amdgcn_exp2f(m_reg - mn); m_reg = mn; }
#pragma unroll
    for (int r = 0; r < 16; ++r) p0[r] = __builtin_amdgcn_exp2f(p0[r] - mn);
}
__device__ __forceinline__ void finishSM(f32x16& p0, f32x16& p1, float mn, float alpha, float& l_reg, bf16x8& pa0, bf16x8& pa1, bf16x8& pa2, bf16x8& pa3) {
#pragma unroll
    for (int r = 0; r < 16; ++r) p1[r] = __builtin_amdgcn_exp2f(p1[r] - mn);
    float ps = 0;
#pragma unroll
    for (int r = 0; r < 16; ++r) ps += p0[r];
#pragma unroll
    for (int r = 0; r < 16; ++r) ps += p1[r];
    { auto rr = __builtin_amdgcn_permlane32_swap(__float_as_uint(ps), __float_as_uint(ps), false, false); ps = __uint_as_float(rr[0]) + __uint_as_float(rr[1]); }
    l_reg = l_reg * alpha + ps;
#define PK4(P, BASE, OUT) do { unsigned a0 = cvt_pk_bf16(P[BASE + 0], P[BASE + 1]), a1 = cvt_pk_bf16(P[BASE + 2], P[BASE + 3]); \
    unsigned b0 = cvt_pk_bf16(P[BASE + 4], P[BASE + 5]), b1 = cvt_pk_bf16(P[BASE + 6], P[BASE + 7]); \
    auto r0 = __builtin_amdgcn_permlane32_swap(a0, b0, false, false); auto r1 = __builtin_amdgcn_permlane32_swap(a1, b1, false, false); \
    u32x4 w = {r0[0], r1[0], r0[1], r1[1]}; OUT = __builtin_bit_cast(bf16x8, w); } while (0)
    PK4(p0, 0, pa0); PK4(p0, 8, pa1); PK4(p1, 0, pa2); PK4(p1, 8, pa3);
#undef PK4
}
}
__device__ __forceinline__ int t5_bucket_abs(int n) { return n < 8 ? n : n < 12 ? 8 : n < 16 ? 9 : n < 23 ? 10 : n < 32 ? 11 : n < 46 ? 12 : n < 64 ? 13 : n < 91 ? 14 : 15; }
__device__ __forceinline__ void attention_phase(const Frame& F, ArgsRef a) {
    using namespace att;
    const bf16_t* qlat = (const bf16_t*)(WS(a) + WS_QLAT); const bf16_t* ckv = (const bf16_t*)(WS(a) + WS_CKV); const unsigned* mask = (const unsigned*)(WS(a) + WS_MASK); bf16_t* olat = (bf16_t*)(WS(a) + WS_OLAT);
    LAS unsigned char* L = F.lds + LDS_STAGE; LAS unsigned char* V_lds = L; LAS unsigned char* K_lds = L + 3 * SHM_V;
    LAS unsigned* msk = (LAS unsigned*)(L + LDS_MSK); LAS float* bt = (LAS float*)(L + LDS_BT);
    const int tid = F.tid, wid = F.wave, lane = F.lane, r32 = lane & 31, hi = lane >> 5, hd = r32 & 7;
    LAS float* wsx = (LAS float*)(L + LDS_WS) + wid * 64; LAS float* li_l = wsx; LAS float* al_l = wsx + 32;
    __syncthreads();
    for (int i = tid; i < 8 * 320; i += 512) { const int h = i / 320, rel = (i % 320) - 255; const int n = rel < 0 ? -rel : rel; bt[i] = IN(a, I_T5)[h * 32 + (rel > 0 ? 16 : 0) + t5_bucket_abs(n)] * 1.4426950408889634f; }
    const float bfar = IN(a, I_T5)[hd * 32 + 15] * 1.4426950408889634f;
    for (int k4 = 0; k4 < 4; ++k4) {
        const int u = F.bid + F.G * k4; if (u >= NB * 64) break;
        const int b = u & 15, j = u >> 4, kk = j >> 4, cc = j & 15, blk = (kk & 1) ? 63 - 16 * (kk >> 1) - cc : 16 * (kk >> 1) + cc, qc = blk >> 1,     t0 = b * SEQ + 32 * blk, NT = qc + 1;
        __syncthreads();
        for (int i = tid; i < 32 * 64; i += 512) msk[i] = mask[(size_t)t0 * 64 + i];
        const bf16_t* Kh = ckv + (size_t)b * SEQ * 128;
        const int qi = 4 * wid + (r32 >> 3), qpos = 32 * blk + qi;
        float m_reg = -1e30f, l_reg = 0.f; f32x16 o[4]; bf16x8 qr[8];
#pragma unroll
        for (int d = 0; d < 4; ++d)
#pragma unroll
            for (int i = 0; i < 16; ++i) o[d][i] = 0.f;
        const bf16_t* Qw = qlat + (size_t)(t0 * 8 + wid * 32 + r32) * 128 + hi * 8;
#pragma unroll
        for (int d0 = 0; d0 < 8; ++d0) qr[d0] = *(const bf16x8*)(Qw + d0 * 16);
        const int sr = tid >> 4, scol = (tid & 15) * 8, vst0 = v_st(sr, scol), vst1 = v_st(32 + sr, scol);
        const int vb0 = (int)(uintptr_t)V_lds + v_rd_base(lane);
        bf16x8 st0[1], st1[1];
#define SLOAD(i, k0) do { st0[i] = *(const bf16x8*)(Kh + (size_t)((k0) + sr) * 128 + scol); st1[i] = *(const bf16x8*)(Kh + (size_t)((k0) + 32 + sr) * 128 + scol); } while (0)
#define SWRITE(bb, i) do { *(LAS bf16x8*)(V_lds + (bb) * SHM_V + vst0) = st0[i]; *(LAS bf16x8*)(V_lds + (bb) * SHM_V + vst1) = st1[i]; const int kc = scol * 2; \
        *(LAS bf16x8*)(K_lds + (bb) * SHM_K + KSWZ(sr, kc)) = st0[i]; *(LAS bf16x8*)(K_lds + (bb) * SHM_K + KSWZ(32 + sr, kc)) = st1[i]; } while (0)
#define SWAIT() asm volatile("s_waitcnt vmcnt(2)" ::: "memory")
#define RESC(al) do { if (__any((al) < 1.f)) { if (hi == 0) al_l[r32] = (al); asm volatile("s_waitcnt lgkmcnt(0)" ::: "memory"); \
        _Pragma("unroll") for (int d = 0; d < 4; ++d) _Pragma("unroll") for (int r = 0; r < 16; ++r) o[d][r] *= al_l[crow(r, hi)]; } } while (0)
#define BIASMASK(P0, P1, jt) do { const unsigned wl_ = msk[qi * 64 + 2 * (jt)] >> (4 * hi), wh_ = msk[qi * 64 + 2 * (jt) + 1] >> (4 * hi); \
        if (64 * (jt) + 63 - 32 * blk > -128) bias_mask<true>(P0, P1, wl_, wh_, bfar, bt + hd * 320, 64 * (jt) + 4 * hi - qpos + 255); else bias_mask<false>(P0, P1, wl_, wh_, bfar, bt, 0); } while (0)
        f32x16 p0, p1; float mn, al; bf16x8 pa0, pa1, pa2, pa3;
        SLOAD(0, 0); asm volatile("s_waitcnt vmcnt(0)" ::: "memory"); SWRITE(0, 0); __syncthreads();
        for (int jt = 0, bb = 0; jt < NT; ++jt) { const int nb = bb == 2 ? 0 : bb + 1;
            if (jt + 1 < NT) SLOAD(0, (jt + 1) * 64);
            qkt(p0, p1, K_lds + bb * SHM_K, qr, r32, hi); BIASMASK(p0, p1, jt);
            partialSM(p0, p1, m_reg, mn, al); finishSM(p0, p1, mn, al, l_reg, pa0, pa1, pa2, pa3); SBAR();
            RESC(al);
            pv_d0(o, vb0 + bb * SHM_V, pa0, pa1, pa2, pa3);
            if (jt + 1 < NT) SWRITE(nb, 0);
            __syncthreads();
            bb = nb;
        }
        if (hi == 0) li_l[r32] = l_reg; asm volatile("s_waitcnt lgkmcnt(0)" ::: "memory");
        float rli[16];
#pragma unroll
        for (int r = 0; r < 16; ++r) rli[r] = __builtin_amdgcn_rcpf(li_l[crow(r, hi)]);
        if constexpr (MIXA_FP8) { unsigned char* O8 = (unsigned char*)olat + (size_t)(t0 * 8 + wid * 32) * 128 + 4 * r32;
#pragma unroll
            for (int r = 0; r < 16; ++r) { const float sc_ = rli[r] * 4.f; *(unsigned*)(O8 + (size_t)crow(r, hi) * 128) = pk4_fp8(o[0][r] * sc_, o[1][r] * sc_, o[2][r] * sc_, o[3][r] * sc_); } }
        else { bf16_t* Ow = olat + (size_t)(t0 * 8 + wid * 32) * 128;
#pragma unroll
        for (int r = 0; r < 16; ++r) { const int orow = crow(r, hi);
#pragma unroll
            for (int d0 = 0; d0 < 4; ++d0) Ow[(size_t)orow * 128 + d0 * 32 + r32] = (bf16_t)f2bf(o[d0][r] * rli[r]); } }
#undef SLOAD
#undef SWRITE
#undef SWAIT
#undef RESC
#undef BIASMASK
    }
}
#undef KSWZ
#undef SBAR

__device__ __forceinline__ void grid_bar(unsigned char* lds_raw) {
    ArgsRef a = phase_args(); XcdBarrier b; b.bar = (unsigned*)(WS(a) + WS_CTL) + CW_BAR; b.x = xb_xcc_id(); b.st = (volatile LAS unsigned*)((LAS unsigned char*)lds_raw + LDS_MISC + LM_BAR);
    xcd_barrier(b);
}
template <int HALFI> __device__ __forceinline__ void moe_gateup_phase(unsigned char* lds_raw) {
    ArgsRef a = phase_args(); const Frame F = make_frame(lds_raw);
    const int ntiles = moe_tables(F, a, HALFI);
    const int* lists = (const int*)(WS(a) + WS_LTOK) + (size_t)HALFI * NE * LIST_CAP; const float* lrs = (const float*)(WS(a) + WS_LRS) + (size_t)HALFI * NE * LIST_CAP;
    typedef MoeOrder<8, true, MOE_FP8 ? 1024 : 2048> Ord;
    Ord S{(const LAS int*)(F.misc + LM_TILE), (const LAS int*)(F.misc + LM_CNT), lists, ntiles, F.G, F.bid};
    EpiGateUp E{(bf16_t*)(WS(a) + WS_ACT), IN(a, I_B_GATE), IN(a, I_B_UP), lrs, (const LAS int*)(F.misc + LM_CNT)};
    pg8::gemm_phase<EpiGateUp, Ord, false, true, MOE_FP8 ? D / 2 : D, MOE_FP8>(F.lds + LDS_STAGE, F.tid, (const bf16_t*)(WS(a) + WS_X2B), (const bf16_t*)(WS(a) + WS_WGU), S, E, (LAS u32x4*)(F.misc + LM_SLOTS));
}
template <int HALFI> __device__ __forceinline__ void moe_down_phase(unsigned char* lds_raw) {
    ArgsRef a = phase_args(); const Frame F = make_frame(lds_raw);
    const int ntiles = moe_tables(F, a, HALFI);
    typedef MoeOrder<4, false, MOE_FP8 ? 1024 : 2048> Ord;
    Ord S{(const LAS int*)(F.misc + LM_TILE), (const LAS int*)(F.misc + LM_CNT), nullptr, ntiles, F.G, F.bid};
    EpiDown E{(bf16_t*)(WS(a) + WS_Y), IN(a, I_B_DOWN)};
    pg8::gemm_phase<EpiDown, Ord, false, false, MOE_FP8 ? FF / 2 : FF, MOE_FP8>(F.lds + LDS_STAGE, F.tid, (const bf16_t*)(WS(a) + WS_ACT), (const bf16_t*)(WS(a) + WS_WD), S, E);
}
template <int HALFI> __device__ __forceinline__ void moe_gateup_probe(unsigned char* lds_raw) {
    ArgsRef a = phase_args(); const Frame F = make_frame(lds_raw);
    const int ntiles = moe_tables(F, a, HALFI);
    const int* lists = (const int*)(WS(a) + WS_LTOK) + (size_t)HALFI * NE * LIST_CAP;
    typedef MoeOrder<8, true, MOE_FP8 ? 1024 : 2048> Ord;
    Ord S{(const LAS int*)(F.misc + LM_TILE), (const LAS int*)(F.misc + LM_CNT), lists, ntiles, F.G, F.bid};
    EpiProbe E{(float*)(WS(a) + WS_Y)};
    pg8::gemm_phase<EpiProbe, Ord, false, true, MOE_FP8 ? D / 2 : D, MOE_FP8>(F.lds + LDS_STAGE, F.tid, (const bf16_t*)(WS(a) + WS_X2B), (const bf16_t*)(WS(a) + WS_WGU), S, E, (LAS u32x4*)(F.misc + LM_SLOTS));
}
template <int HALFI> __device__ __forceinline__ void moe_down_probe(unsigned char* lds_raw) {
    ArgsRef a = phase_args(); const Frame F = make_frame(lds_raw);
    const int ntiles = moe_tables(F, a, HALFI);
    typedef MoeOrder<4, false, MOE_FP8 ? 1024 : 2048> Ord;
    Ord S{(const LAS int*)(F.misc + LM_TILE), (const LAS int*)(F.misc + LM_CNT), nullptr, ntiles, F.G, F.bid};
    EpiProbe E{(float*)(WS(a) + WS_X2B)};
    pg8::gemm_phase<EpiProbe, Ord, false, false, MOE_FP8 ? FF / 2 : FF, MOE_FP8>(F.lds + LDS_STAGE, F.tid, (const bf16_t*)(WS(a) + WS_ACT), (const bf16_t*)(WS(a) + WS_WD), S, E);
}
template <int HALFI> __device__ __forceinline__ void moe_combine_phase(unsigned char* lds_raw) {
    ArgsRef a = phase_args(); const Frame F = make_frame(lds_raw);
    (void)moe_tables(F, a, HALFI);
    combine_phase(F, a, HALFI);
}
__device__ __forceinline__ void prep_phase(unsigned char* lds_raw) { ArgsRef a = phase_args(); const Frame F = make_frame(lds_raw); mixer_prep_phase(F, a); }
#ifndef PREP2MASK
#define PREP2MASK 63
#endif
__device__ __forceinline__ void prep2_phase(unsigned char* lds_raw) { ArgsRef a = phase_args(); const Frame F = make_frame(lds_raw); mixer_prep_phase<PREP2MASK>(F, a); }
__device__ __forceinline__ void inproj_a_phase(unsigned char* lds_raw) {
    ArgsRef a = phase_args(); const Frame F = make_frame(lds_raw); const float* misc = (const float*)(WS(a) + WS_MISC);
    { DenseOrder S; S.init(T, 6 * 256, D, F.G, F.bid, 0, 0);
      EpiInA E{(bf16_t*)(WS(a) + WS_QX), (float*)(WS(a) + WS_SMALL), misc + MISC_RSTD1 / 4, (const float*)(WS(a) + WS_COSP), (const float*)(WS(a) + WS_SINP), misc + MISC_DQ / 4,
               (bf16_t*)(WS(a) + WS_CQN), (bf16_t*)(WS(a) + WS_CKV), (bf16_t*)(WS(a) + WS_KIDX), (float*)(WS(a) + WS_WIDX), IN(a, I_CKV_G), IN(a, I_KIDX_G), (LAS float*)(F.misc + 17408)};
      pg8::gemm_phase<EpiInA, DenseOrder, false, false, D>(F.lds + LDS_STAGE, F.tid, (const bf16_t*)(WS(a) + WS_XB), (const bf16_t*)(WS(a) + WS_WIN), S, E); }
}
__device__ __forceinline__ void inproj_b_phase(unsigned char* lds_raw) {
    ArgsRef a = phase_args(); const Frame F = make_frame(lds_raw); const float* misc = (const float*)(WS(a) + WS_MISC);
    if constexpr (INB_FP8) {
      { DenseOrder S; S.init(T, 4 * 256, D, F.G, F.bid, 0, (size_t)6 * 256 * D * 2);
        EpiInB<0, false> E{(bf16_t*)(WS(a) + WS_KZT), (bf16_t*)(WS(a) + WS_VT), misc + MISC_RSTD1 / 4, (const float*)(WS(a) + WS_COST), (const float*)(WS(a) + WS_SINT), misc + MISC_DZ / 4};
        pg8::gemm_phase<EpiInB<0, false>, DenseOrder, true, false, D>(F.lds + LDS_STAGE, F.tid, (const bf16_t*)(WS(a) + WS_XB), (const bf16_t*)(WS(a) + WS_WIN), S, E); }
      { DenseOrder S; S.init(T, 8 * 256, D / 2, F.G, F.bid, 0, 0);
        EpiInB<4, true> E{(bf16_t*)(WS(a) + WS_KZT), (bf16_t*)(WS(a) + WS_VT), misc + MISC_RSTD1 / 4, (const float*)(WS(a) + WS_COST), (const float*)(WS(a) + WS_SINT), misc + MISC_DZ / 4};
        pg8::gemm_phase<EpiInB<4, true>, DenseOrder, true, false, D / 2, true>(F.lds + LDS_STAGE, F.tid, (const bf16_t*)(WS(a) + WS_XB8), (const bf16_t*)(WS(a) + WS_WIN8 + 4 * MiB), S, E); }
    } else {
      DenseOrder S; S.init(T, 12 * 256, D, F.G, F.bid, 0, (size_t)6 * 256 * D * 2);
      EpiInB<0, false> E{(bf16_t*)(WS(a) + WS_KZT), (bf16_t*)(WS(a) + WS_VT), misc + MISC_RSTD1 / 4, (const float*)(WS(a) + WS_COST), (const float*)(WS(a) + WS_SINT), misc + MISC_DZ / 4};
      pg8::gemm_phase<EpiInB<0, false>, DenseOrder, true, false, D>(F.lds + LDS_STAGE, F.tid, (const bf16_t*)(WS(a) + WS_XB), (const bf16_t*)(WS(a) + WS_WIN), S, E); }
}
__device__ __forceinline__ void inproj_c_phase(unsigned char* lds_raw) {
    ArgsRef a = phase_args(); const Frame F = make_frame(lds_raw); const float* misc = (const float*)(WS(a) + WS_MISC);
    DenseOrder S; S.init(T, 16 * 256, INC_FP8 ? D / 2 : D, F.G, F.bid, 0, INC_FP8 ? (size_t)0 : (size_t)18 * 256 * D * 2);
    EpiInC E{(bf16_t*)OUT(a), (bf16_t*)(WS(a) + WS_GA), (bf16_t*)(WS(a) + WS_GB), misc + MISC_RSTD1 / 4, misc + MISC_RN / 4};
    pg8::gemm_phase<EpiInC, DenseOrder, false, false, INC_FP8 ? D / 2 : D, INC_FP8>(F.lds + LDS_STAGE, F.tid, (const bf16_t*)(WS(a) + (INC_FP8 ? WS_XB8 : WS_XB)), (const bf16_t*)(WS(a) + (INC_FP8 ? WS_WIN8 : WS_WIN)), S, E);
}
__device__ __forceinline__ void retention_phase_w(unsigned char* lds_raw) { ArgsRef a = phase_args(); const Frame F = make_frame(lds_raw); retention_phase(F, a); }
__device__ __forceinline__ void retnorm_phase_w(unsigned char* lds_raw) { ArgsRef a = phase_args(); const Frame F = make_frame(lds_raw); retnorm_phase(F, a); }
__device__ __forceinline__ void mix_a_phase(unsigned char* lds_raw) {
    ArgsRef a = phase_args(); const Frame F = make_frame(lds_raw);
    DenseOrder S; S.init(T, D, MIXA_FP8 ? D / 2 : D, F.G, F.bid, 0, 0);
    EpiMix<0, MIXA_FP8> E{(const bf16_t*)(WS(a) + WS_GA), (bf16_t*)(WS(a) + WS_MIXA), (bf16_t*)(WS(a) + WS_MIX)};
    pg8::gemm_phase<EpiMix<0, MIXA_FP8>, DenseOrder, false, false, MIXA_FP8 ? D / 2 : D, MIXA_FP8>(F.lds + LDS_STAGE, F.tid, (const bf16_t*)(WS(a) + WS_OLAT), (const bf16_t*)(WS(a) + WS_WA), S, E);
}
__device__ __forceinline__ void mix_b_phase(unsigned char* lds_raw) {
    ArgsRef a = phase_args(); const Frame F = make_frame(lds_raw);
    DenseOrder S; S.init(T, D, 2048, F.G, F.bid, 0, 0);
    EpiMix<1> E{(const bf16_t*)(WS(a) + WS_GB), (bf16_t*)(WS(a) + WS_MIXA), (bf16_t*)(WS(a) + WS_MIX)};
    pg8::gemm_phase<EpiMix<1>, DenseOrder, false, false, 2048>(F.lds + LDS_STAGE, F.tid, (const bf16_t*)OUT(a), (const bf16_t*)(WS(a) + WS_WB), S, E);
}
__device__ __forceinline__ void rownorm_phase_w(unsigned char* lds_raw) { ArgsRef a = phase_args(); const Frame F = make_frame(lds_raw); rownorm_phase(F, a); }
__device__ __forceinline__ void qproj_phase(unsigned char* lds_raw) {
    ArgsRef a = phase_args(); const Frame F = make_frame(lds_raw);
    DenseOrder S; S.init(T, 1536, 256, F.G, F.bid, 0, 0);
    EpiQ E{(bf16_t*)(WS(a) + WS_QLAT), (bf16_t*)(WS(a) + WS_QIDX)};
    pg8::gemm_phase<EpiQ, DenseOrder, false, false, 256>(F.lds + LDS_STAGE, F.tid, (const bf16_t*)(WS(a) + WS_CQN), (const bf16_t*)(WS(a) + WS_WQ), S, E);
}
__device__ __forceinline__ void indexer_phase_w(unsigned char* lds_raw) { ArgsRef a = phase_args(); const Frame F = make_frame(lds_raw); indexer_phase<0>(F, a); }
template <int MODE> __device__ __forceinline__ void indexer_probe_w(unsigned char* lds_raw) { ArgsRef a = phase_args(); const Frame F = make_frame(lds_raw); indexer_phase<MODE>(F, a); }
__device__ __forceinline__ void attention_phase_w(unsigned char* lds_raw) { ArgsRef a = phase_args(); const Frame F = make_frame(lds_raw); attention_phase(F, a); }
__device__ __forceinline__ void out_phase(unsigned char* lds_raw) {
    ArgsRef a = phase_args(); const Frame F = make_frame(lds_raw);
    DenseOrder S; S.init(T, D, D, F.G, F.bid, 0, 0);
    EpiOut E{(const bf16_t*)(WS(a) + WS_XB), X2H ? (float*)(WS(a) + WS_X2H) : OUT(a), (bf16_t*)(WS(a) + WS_X2B)};
    pg8::gemm_phase<EpiOut, DenseOrder, false, false, D>(F.lds + LDS_STAGE, F.tid, (const bf16_t*)(WS(a) + WS_MIX), (const bf16_t*)(WS(a) + WS_WOUT), S, E);
}
__device__ __forceinline__ void convert_only_phase(unsigned char* lds_raw) { ArgsRef a = phase_args(); const Frame F = make_frame(lds_raw); if constexpr (MOE_FP8) moe_weight_convert_pipe(F, a); else moe_weight_convert(F, a); }
__device__ __forceinline__ void router_phase_w(unsigned char* lds_raw) { ArgsRef a = phase_args(); const Frame F = make_frame(lds_raw); router_phase(F, a); }

#ifdef DIAG2
__device__ __forceinline__ void diag_ck(unsigned char* lds_raw, int k, const void* buf, size_t chunk_bytes) {
    grid_bar(lds_raw);
    ArgsRef a = phase_args(); unsigned* sums = (unsigned*)(WS(a) + WS_CTL + 256 * 1024) + k * 16384; unsigned* nbad = (unsigned*)(WS(a) + WS_CTL) + 16384 + 64 * k; const int gw = blockIdx.x * 8 + (threadIdx.x >> 6), lane = threadIdx.x & 63;
    for (int c = gw; c < 16384; c += gridDim.x * 8) { const unsigned* p = (const unsigned*)((const char*)buf + (size_t)c * chunk_bytes); unsigned sm = 0u; for (size_t i = lane; i < chunk_bytes / 4; i += 64) sm += p[i] * (unsigned)(2 * i + 1);
        for (int o = 1; o < 64; o <<= 1) sm += __shfl_xor(sm, o);
        if (lane == 0) { if (a.pass == 0) sums[c] = sm; else if (sums[c] != sm) atomicAdd(nbad, 1u); } }
    grid_bar(lds_raw);
}
__device__ __forceinline__ void diag_final(unsigned char* lds_raw) {
    grid_bar(lds_raw);
    ArgsRef a = phase_args(); const unsigned* nbad = (const unsigned*)(WS(a) + WS_CTL) + 16384; float c = 0.f;
    if (a.pass == 1) { for (int k = 0; k < 4; ++k) if (__hip_atomic_load(nbad + 64 * k, __ATOMIC_RELAXED, __HIP_MEMORY_SCOPE_AGENT) > 0u) c += (float)(1 << k); }
    grid_bar(lds_raw);
    for (size_t i = (size_t)blockIdx.x * 512 + threadIdx.x; i < (size_t)T * D; i += (size_t)gridDim.x * 512) OUT(a)[i] = c;
}
#endif
__global__ void __launch_bounds__(512, 2) fwd(Args a_unused) {
    extern __shared__ __attribute__((aligned(16))) unsigned char lds_raw[];
    { ArgsRef a = phase_args(); LAS unsigned* st = (LAS unsigned*)((LAS unsigned char*)lds_raw + LDS_MISC + LM_BAR);
      if (threadIdx.x < 4) st[threadIdx.x] = 0u;
      __syncthreads();
      (void)xcd_barrier_post((unsigned*)(WS(a) + WS_CTL) + CW_BAR, (volatile LAS unsigned*)st); }
#ifndef DUP
#define DUP 0u
#endif
#ifndef PHSEL
#define PHSEL 0xffffffffu
#endif
#define GRID_BAR() grid_bar(lds_raw)
#ifdef ZERO_OUT_FIRST
    { float* o_ = OUT(phase_args()); for (size_t i = (size_t)blockIdx.x * 512 + threadIdx.x; i < (size_t)T * D / 4; i += (size_t)gridDim.x * 512) ((f32x4*)o_)[i] = (f32x4){0.f, 0.f, 0.f, 0.f}; }
#endif
    if (PHSEL & (1u << 0)) prep_phase(lds_raw);
    if (DUP & (1u << 0)) { GRID_BAR(); prep2_phase(lds_raw); }
    GRID_BAR();
#if defined(DIAG2) && DIAG2 == 21
    { unsigned char* w_ = WS(phase_args()); diag_ck(lds_raw, 0, w_ + 1 * MiB, 256); diag_ck(lds_raw, 1, w_ + WS_MISC, 64); diag_ck(lds_raw, 2, w_ + WS_XB, 4096); diag_ck(lds_raw, 3, w_ + WS_WIN, 1024); diag_final(lds_raw); return; }
#endif
    if (PHSEL & (1u << 1)) inproj_a_phase(lds_raw);
    if (DUP & (1u << 1)) { GRID_BAR(); inproj_a_phase(lds_raw); }
    if (PHSEL & (1u << 2)) inproj_b_phase(lds_raw);
    if (DUP & (1u << 2)) { GRID_BAR(); inproj_b_phase(lds_raw); }
#if defined(DIAG2) && DIAG2 == 22
    { unsigned char* w_ = WS(phase_args()); diag_ck(lds_raw, 0, w_ + WS_QX, 4096); diag_ck(lds_raw, 1, w_ + WS_SMALL, 4096); diag_ck(lds_raw, 2, w_ + WS_KZT, 4096); diag_ck(lds_raw, 3, w_ + WS_VT, 8192); diag_final(lds_raw); return; }
#endif
#if defined(DIAG2) && DIAG2 == 10
    diag_ck(lds_raw, 0, WS(phase_args()) + WS_QX, 4096); diag_final(lds_raw); return;
#endif
    GRID_BAR();
    if (!ROWNORM_FUSED && (PHSEL & (1u << 16))) rownorm_phase_w(lds_raw);
    if ((blockIdx.x & 1) == 0) { if (PHSEL & (1u << 3)) retention_phase_w(lds_raw); __syncthreads(); if (PHSEL & (1u << 17)) qproj_phase(lds_raw); }
    else { if (PHSEL & (1u << 17)) qproj_phase(lds_raw); __syncthreads(); if (PHSEL & (1u << 3)) retention_phase_w(lds_raw); }
    if (DUP & (1u << 3)) { GRID_BAR(); retention_phase_w(lds_raw); }
#if defined(DIAG2) && DIAG2 == 23
    diag_ck(lds_raw, 0, OUT(phase_args()), 8192);
#endif
#if defined(DIAG2) && DIAG2 == 11
    diag_ck(lds_raw, 1, OUT(phase_args()), 8192); diag_final(lds_raw); return;
#endif
    GRID_BAR();
    if (PHSEL & (1u << 4)) retnorm_phase_w(lds_raw);
#if defined(DIAG2) && DIAG2 == 23
    diag_ck(lds_raw, 1, WS(phase_args()) + WS_QLAT, 4096);
#endif
    if (PHSEL & (1u << 18)) indexer_phase_w(lds_raw);
    if (DUP & (1u << 18)) { GRID_BAR(); indexer_phase_w(lds_raw); }
    if (DUP & (1u << 22)) { GRID_BAR(); indexer_probe_w<1>(lds_raw); }
    if (DUP & (1u << 23)) { GRID_BAR(); indexer_probe_w<2>(lds_raw); }
#if defined(DIAG2) && DIAG2 == 23
    diag_ck(lds_raw, 2, WS(phase_args()) + WS_MASK, 512);
#endif
#if defined(DIAG2) && DIAG2 == 12
    diag_ck(lds_raw, 2, WS(phase_args()) + WS_MASK, 512); diag_final(lds_raw); return;
#endif
    GRID_BAR();
    if (PHSEL & (1u << 19)) attention_phase_w(lds_raw);
    if (DUP & (1u << 19)) { GRID_BAR(); attention_phase_w(lds_raw); }
    __syncthreads();
    if (PHSEL & (1u << 5)) inproj_c_phase(lds_raw);
#if defined(DIAG2) && DIAG2 == 23
    diag_ck(lds_raw, 3, WS(phase_args()) + WS_OLAT, 4096); diag_final(lds_raw); return;
#endif
#if defined(DIAG2) && DIAG2 == 13
    diag_ck(lds_raw, 3, WS(phase_args()) + WS_QLAT, 4096); diag_final(lds_raw); return;
#endif
#if defined(DIAG2) && DIAG2 == 24
    diag_ck(lds_raw, 0, OUT(phase_args()), 8192);
#endif
    GRID_BAR();
    if ((PHSEL & (1u << 8)) && (blockIdx.x & 1) == 0) { convert_only_phase(lds_raw); __syncthreads(); }
    if (PHSEL & (1u << 20)) mix_a_phase(lds_raw);
    if (DUP & (1u << 20)) { GRID_BAR(); mix_a_phase(lds_raw); }
    if (PHSEL & (1u << 6)) mix_b_phase(lds_raw);
    if (DUP & (1u << 6)) { GRID_BAR(); mix_b_phase(lds_raw); }
    if ((PHSEL & (1u << 8)) && (blockIdx.x & 1) != 0) { __syncthreads(); convert_only_phase(lds_raw); }
#if defined(DIAG2) && DIAG2 == 24
    diag_ck(lds_raw, 1, WS(phase_args()) + WS_MIX, 4096);
#endif
#if defined(DIAG2) && DIAG2 == 28
    diag_ck(lds_raw, 3, WS(phase_args()) + WS_MIX, 4096);
#endif
    GRID_BAR();
    if (PHSEL & (1u << 7)) out_phase(lds_raw);
    if (DUP & (1u << 7)) { GRID_BAR(); out_phase(lds_raw); }
#if defined(DIAG2) && (DIAG2 == 38 || DIAG2 == 39)
    { asm volatile("s_waitcnt vmcnt(0)" ::: "memory"); __syncthreads(); if (threadIdx.x == 0) atomicAdd((unsigned*)(WS(phase_args()) + WS_CTL) + 16384 + 64 * 9, 1u); }
#endif
    GRID_BAR();
#if defined(DIAG2) && (DIAG2 == 38 || DIAG2 == 39)
    { if (threadIdx.x == 0) { unsigned* nb_ = (unsigned*)(WS(phase_args()) + WS_CTL) + 16384; const unsigned d_ = __hip_atomic_load(nb_ + 64 * 9, __ATOMIC_RELAXED, __HIP_MEMORY_SCOPE_AGENT); if (d_ != gridDim.x * (unsigned)(phase_args().pass + 1)) atomicAdd(nb_ + 64 * 10, 1u); } }
#endif
#if defined(DIAG2) && DIAG2 == 24
    diag_ck(lds_raw, 2, OUT(phase_args()), 8192); diag_ck(lds_raw, 3, WS(phase_args()) + WS_X2B, 2048); diag_final(lds_raw); return;
#endif
#if defined(DIAG2) && DIAG2 == 28
    diag_ck(lds_raw, 0, OUT(phase_args()), 8192); diag_ck(lds_raw, 1, WS(phase_args()) + WS_X2B, 2048);
#endif
    if (DUP & (1u << 21)) { convert_only_phase(lds_raw); GRID_BAR(); }
#if defined(DIAG2) && (DIAG2 == 29 || DIAG2 == 30 || DIAG2 == 31)
    diag_ck(lds_raw, 0, WS(phase_args()) + WS_MISC, 8);
#endif
    if (PHSEL & (1u << 8)) router_phase_w(lds_raw);
    GRID_BAR();
#if defined(DIAG2) && DIAG2 == 25
    diag_ck(lds_raw, 0, WS(phase_args()) + WS_WGU, 4096); diag_ck(lds_raw, 1, WS(phase_args()) + WS_WD, 2048);
#endif
#if defined(DIAG2) && DIAG2 == 26
    diag_ck(lds_raw, 0, WS(phase_args()) + WS_WGU, 4096); diag_ck(lds_raw, 1, WS(phase_args()) + WS_WD, 2048); diag_final(lds_raw); return;
#endif
#if defined(DIAG2) && DIAG2 == 29
    diag_final(lds_raw); return;
#endif
#if defined(DIAG2) && (DIAG2 >= 30 && DIAG2 <= 40)
    { grid_bar(lds_raw); ArgsRef a = phase_args(); const unsigned* nb = (const unsigned*)(WS(a) + WS_CTL) + 16384; float c = 0.f;
      if (a.pass == 1) { unsigned n = __hip_atomic_load(nb + 64 * 3, __ATOMIC_RELAXED, __HIP_MEMORY_SCOPE_AGENT);
#if DIAG2 == 31
        n = n >> 5;
#endif
#if DIAG2 == 38
        n = __hip_atomic_load(nb + 64 * 10, __ATOMIC_RELAXED, __HIP_MEMORY_SCOPE_AGENT);
#endif
#if DIAG2 == 40
        n = (__hip_atomic_load(nb + 64 * 11, __ATOMIC_RELAXED, __HIP_MEMORY_SCOPE_AGENT) ? 1u : 0u) + (__hip_atomic_load(nb + 64 * 12, __ATOMIC_RELAXED, __HIP_MEMORY_SCOPE_AGENT) ? 2u : 0u) + (__hip_atomic_load(nb + 64 * 13, __ATOMIC_RELAXED, __HIP_MEMORY_SCOPE_AGENT) ? 4u : 0u);
#endif
#if DIAG2 == 39
        n = (__hip_atomic_load(nb + 64 * 10, __ATOMIC_RELAXED, __HIP_MEMORY_SCOPE_AGENT) ? 1u : 0u) + (n ? 2u : 0u);
#endif
#if DIAG2 >= 34 && DIAG2 <= 37
        n = __builtin_popcount(__hip_atomic_load(nb + 64 * (DIAG2 - 30), __ATOMIC_RELAXED, __HIP_MEMORY_SCOPE_AGENT));
#endif
        c = (float)(n > 30u ? 30u : n); }
      grid_bar(lds_raw);
      for (size_t i = (size_t)blockIdx.x * 512 + threadIdx.x; i < (size_t)T * D; i += (size_t)gridDim.x * 512) OUT(a)[i] = c; return; }
#endif
#if defined(DIAG2) && (DIAG2 == 27 || DIAG2 == 28)
    { grid_bar(lds_raw); ArgsRef a = phase_args(); unsigned* sums = (unsigned*)(WS(a) + WS_CTL + 256 * 1024); unsigned* nbad = (unsigned*)(WS(a) + WS_CTL) + 16384;
      const unsigned* rec = (const unsigned*)(WS(a) + WS_REC); const unsigned* gc = (const unsigned*)(WS(a) + WS_CTL) + CW_CNT;
      for (int t = blockIdx.x * 512 + threadIdx.x; t < T; t += gridDim.x * 512) { unsigned sm = 0u; for (int k = 0; k < 4; ++k) { sm = sm * 31u + rec[(size_t)t * 16 + 4 * k]; sm = sm * 31u + rec[(size_t)t * 16 + 4 * k + 2]; sm = sm * 31u + rec[(size_t)t * 16 + 4 * k + 3]; }
          if (a.pass == 0) sums[2 * 16384 + t] = sm; else if (sums[2 * 16384 + t] != sm) atomicAdd(nbad + 64 * 2, 1u); }
      if (blockIdx.x == 0 && threadIdx.x < 64) { const unsigned v = gc[threadIdx.x]; if (a.pass == 0) sums[65536 + threadIdx.x] = v; else if (sums[65536 + threadIdx.x] != v) atomicAdd(nbad + 64 * 2, 1u); }
      grid_bar(lds_raw);
#if DIAG2 == 27
      diag_final(lds_raw); return;
#endif
    }
#endif
    if (PHSEL & (1u << 9)) moe_gateup_phase<0>(lds_raw);
    if (DUP & (1u << 9)) { GRID_BAR(); moe_gateup_phase<0>(lds_raw); }
    if (DUP & (1u << 24)) { GRID_BAR(); moe_gateup_probe<0>(lds_raw); }
    GRID_BAR();
    if (PHSEL & (1u << 10)) moe_down_phase<0>(lds_raw);
    if (DUP & (1u << 10)) { GRID_BAR(); moe_down_phase<0>(lds_raw); }
    if (DUP & (1u << 25)) { GRID_BAR(); moe_down_probe<0>(lds_raw); }
    GRID_BAR();
    if (PHSEL & (1u << 11)) moe_combine_phase<0>(lds_raw);
#if defined(DIAG2) && DIAG2 == 20
    diag_ck(lds_raw, 0, OUT(phase_args()), 8192); diag_final(lds_raw);
#endif
#if defined(DIAG2) && DIAG2 == 28
    diag_final(lds_raw);
#endif
}

extern "C" void kernel_launch(void* const* d_in, const int* in_sizes, int n_in, void* d_out, int out_size, void* d_ws, size_t ws_size, hipStream_t stream) {
    static int grid = 0;
    if (grid == 0) {
        if (n_in != 24 || out_size != T * D || ws_size < WS_END2) { fprintf(stderr, "kernel_launch: unexpected shapes n_in %d out %d ws %zu (need %zu)\n", n_in, out_size, ws_size, (size_t)WS_END2); grid = -1; return; }
        int dev = 0, cus = 0, per_cu = 0;
        if (hipGetDevice(&dev) != hipSuccess || hipDeviceGetAttribute(&cus, hipDeviceAttributeMultiprocessorCount, dev) != hipSuccess) { grid = -1; return; }
        if (hipFuncSetAttribute((const void*)fwd, hipFuncAttributeMaxDynamicSharedMemorySize, LDS_BYTES) != hipSuccess) { fprintf(stderr, "kernel_launch: hipFuncSetAttribute failed\n"); grid = -1; return; }
        if (hipOccupancyMaxActiveBlocksPerMultiprocessor(&per_cu, (const void*)fwd, 512, LDS_BYTES) != hipSuccess || per_cu < 1) fprintf(stderr, "kernel_launch: occupancy query reports %d\n", per_cu);
        (void)hipGetLastError();
        grid = cus;
    }
    if (grid < 0) return;
    if (hipMemsetAsync((char*)d_ws + WS_CTL, 0, CTL_BYTES, stream) != hipSuccess) return;
    Args a{};
    for (int i = 0; i < 24; ++i) a.in[i] = (const float*)d_in[i];
    a.out = (float*)d_out; a.ws = (unsigned char*)d_ws; a.pass = 0;
    hipLaunchKernelGGL(fwd, dim3(grid), dim3(512), LDS_BYTES, stream, a);
#ifdef DIAG2
    if (hipMemsetAsync((char*)d_ws + WS_CTL, 0, 49152, stream) != hipSuccess) return;
    a.pass = 1;
    hipLaunchKernelGGL(fwd, dim3(grid), dim3(512), LDS_BYTES, stream, a);
#endif
}
```
